# Optimizing an MI355X kernel written in HIP

```python
import jax, jax.numpy as jnp
from jax import lax
import numpy as np


D_MODEL = 1024
BATCH = 8
SEQ = 4096
DEPTH = 1

CTX_LEN = 256
GRID_W = 64
D_RNN = 1024
N_LRU_BLOCKS = 16
LRU_BLOCK = D_RNN // N_LRU_BLOCKS
CONV_W = 4
LRU_C = 8.0
N_HEADS = 16
HEAD_DIM = 64
D_NA = N_HEADS * HEAD_DIM
WIN_R = 8
WIN_C = 16
QBLK_C = 16
KBLK_C = 32
ROPE_BASE = 10000.0
N_EXPERTS = 16
D_EXPERT = 2048
EC_CAPACITY = 2
IN_SIZES = (D_RNN, D_RNN, D_NA, D_NA, D_NA, D_MODEL, D_MODEL)
N_IN = sum(IN_SIZES)
EPS = 1e-6
NEG_INF = -1e30

kernel_name = 'hybrid_rglru_natten_ecmoe_dit_layer'


def rms_norm(x):
    xf = x.astype(jnp.float32)
    return (xf * lax.rsqrt(jnp.mean(xf * xf, axis=-1, keepdims=True) + EPS)).astype(x.dtype)


def modulate(x, shift, scale):
    return x * (1 + scale) + shift


def split_in(z):
    offsets = [int(o) for o in np.cumsum(IN_SIZES)[:-1]]
    return jnp.split(z, offsets, axis=-1)


def centred_dwconv(x, w, b):
    n = x.shape[1]
    left = CONV_W // 2
    xp = jnp.pad(x, ((0, 0), (left, CONV_W - 1 - left), (0, 0)))
    out = b.astype(x.dtype)
    for k in range(CONV_W):
        out = out + xp[:, k:k + n] * w[k]
    return out


def rglru_coeffs(xc, wa, ba, wi, bi, lam):
    B, N, _ = xc.shape
    f32 = jnp.float32
    xf = xc.astype(f32)
    xb = xf.reshape(B, N, N_LRU_BLOCKS, LRU_BLOCK)
    r = jax.nn.sigmoid(jnp.einsum('bngi,gij->bngj', xb, wa.astype(f32)).reshape(B, N, D_RNN) + ba.astype(f32))
    i = jax.nn.sigmoid(jnp.einsum('bngi,gij->bngj', xb, wi.astype(f32)).reshape(B, N, D_RNN) + bi.astype(f32))
    log_a = -LRU_C * r * jax.nn.softplus(-lam.astype(f32))
    a = jnp.exp(log_a)
    b = jnp.sqrt(-jnp.expm1(2.0 * log_a)) * (i * xf)
    return a, b


def _lin_combine(e1, e2):
    a1, b1 = e1
    a2, b2 = e2
    return a1 * a2, a2 * b1 + b2


def linear_recurrence(a, b, h0, reverse):
    A, Bc = lax.associative_scan(_lin_combine, (a, b), axis=1, reverse=reverse)
    return A * h0[:, None, :] + Bc


def axial_rope_angles(n):
    t = jnp.arange(n)
    row = (t // GRID_W).astype(jnp.float32)
    col = (t % GRID_W).astype(jnp.float32)
    n_freq = HEAD_DIM // 4
    inv = ROPE_BASE ** (-jnp.arange(n_freq, dtype=jnp.float32) / n_freq)
    return row[:, None] * inv, col[:, None] * inv


def _rotate(x, ang):
    half = x.shape[-1] // 2
    x1, x2 = x[..., :half], x[..., half:]
    cos = jnp.cos(ang)[:, None, :].astype(x.dtype)
    sin = jnp.sin(ang)[:, None, :].astype(x.dtype)
    return jnp.concatenate([x1 * cos - x2 * sin, x1 * sin + x2 * cos], axis=-1)


def axial_rope(x, ang_r, ang_c):
    h = HEAD_DIM // 2
    return jnp.concatenate([_rotate(x[..., :h], ang_r), _rotate(x[..., h:], ang_c)], axis=-1)


def context_attention(q, k, v):
    s = jnp.einsum('bqhd,bkhd->bhqk', q, k).astype(jnp.float32) * (HEAD_DIM ** -0.5)
    p = jax.nn.softmax(s, axis=-1).astype(v.dtype)
    return jnp.einsum('bhqk,bkhd->bqhd', p, v)


def neighbourhood_attention(q, k, v, k_ctx, v_ctx, rpb):
    B, N, H, Dh = q.shape
    rows = N // GRID_W
    win_r = min(WIN_R, rows)
    n_cb = GRID_W // QBLK_C
    qcols = np.arange(GRID_W).reshape(n_cb, QBLK_C)
    cstart = np.clip(qcols - WIN_C // 2, 0, GRID_W - WIN_C)
    kstart = np.clip(np.arange(n_cb) * QBLK_C - WIN_C // 2, 0, GRID_W - KBLK_C)
    kcols = kstart[:, None] + np.arange(KBLK_C)
    col_ok = (kcols[:, None, :] >= cstart[:, :, None]) & (kcols[:, None, :] < cstart[:, :, None] + WIN_C)
    dc_idx = np.clip(kcols[:, None, :] - qcols[:, :, None], -(WIN_C - 1), WIN_C - 1) + WIN_C - 1
    rpb_c = rpb[:, :, dc_idx]
    scale = Dh ** -0.5
    qg = q.reshape(B, rows, GRID_W, H, Dh)
    kg = k.reshape(B, rows, GRID_W, H, Dh)
    vg = v.reshape(B, rows, GRID_W, H, Dh)
    n_loc = win_r * KBLK_C

    def one_row(r):
        rs = jnp.clip(r - win_r // 2, 0, rows - win_r)
        qr = lax.dynamic_index_in_dim(qg, r, axis=1, keepdims=False).reshape(B, n_cb, QBLK_C, H, Dh)
        kb = lax.dynamic_slice_in_dim(kg, rs, win_r, axis=1)[:, :, kcols]
        vb = lax.dynamic_slice_in_dim(vg, rs, win_r, axis=1)[:, :, kcols]
        s_loc = jnp.einsum('bjqhd,brjkhd->bhjqrk', qr, kb).astype(jnp.float32) * scale
        dr_idx = rs + jnp.arange(win_r) - r + WIN_R - 1
        bias = jnp.take(rpb_c, dr_idx, axis=1).transpose(0, 2, 3, 1, 4).astype(jnp.float32)
        s_loc = jnp.where(col_ok[:, :, None, :], s_loc + bias, NEG_INF)
        s_loc = s_loc.reshape(B, H, n_cb, QBLK_C, n_loc)
        s_ctx = jnp.einsum('bjqhd,bkhd->bhjqk', qr, k_ctx).astype(jnp.float32) * scale
        p = jax.nn.softmax(jnp.concatenate([s_loc, s_ctx], axis=-1), axis=-1).astype(v.dtype)
        p_loc = p[..., :n_loc].reshape(B, H, n_cb, QBLK_C, win_r, KBLK_C)
        o = (jnp.einsum('bhjqrk,brjkhd->bjqhd', p_loc, vb)
             + jnp.einsum('bhjqk,bkhd->bjqhd', p[..., n_loc:], v_ctx))
        return o.reshape(B, GRID_W, H, Dh)

    out = lax.map(one_row, jnp.arange(rows))
    return out.transpose(1, 0, 2, 3, 4).reshape(B, N, H * Dh)


def expert_choice_moe(xn, w_router, w_gate, w_up, w_down):
    B, N, _ = xn.shape
    cap = EC_CAPACITY * N // N_EXPERTS
    logits = jnp.einsum('bnd,de->bne', xn, w_router).astype(jnp.float32)
    aff = jax.nn.softmax(logits, axis=-1)
    g, idx = lax.top_k(aff.transpose(0, 2, 1), cap)
    bidx = jnp.arange(B)[:, None, None]
    xe = xn[bidx, idx]
    hid = jax.nn.silu(jnp.einsum('becd,edf->becf', xe, w_gate)) * jnp.einsum('becd,edf->becf', xe, w_up)
    ye = jnp.einsum('becf,efd->becd', hid, w_down) * g[..., None].astype(xn.dtype)
    return jnp.zeros_like(xn).at[bidx, idx].add(ye)


def setup_inputs(seed: int = 0) -> dict:
    key = jax.random.key(seed)
    ks = jax.random.split(key, 24)
    f32 = jnp.float32

    def nrm(k, shape, fan_in):
        return jax.random.normal(k, shape, f32) * (fan_in ** -0.5)

    def small(k, shape):
        return 0.02 * jax.random.normal(k, shape, f32)

    u = jax.random.uniform(ks[14], (DEPTH, 2, D_RNN), f32, minval=0.9, maxval=0.999)
    p = u ** (1.0 / LRU_C)
    lam = jnp.log(p) - jnp.log1p(-p)
    return {
        'x': jax.random.normal(ks[0], (BATCH, SEQ, D_MODEL), f32),
        'c': jax.random.normal(ks[1], (BATCH, D_MODEL), f32),
        'ctx': jax.random.normal(ks[2], (BATCH, CTX_LEN, D_MODEL), f32),
        'c_ctx': jax.random.normal(ks[3], (D_MODEL,), f32),
        'w_mod': nrm(ks[4], (DEPTH, D_MODEL, 6 * D_MODEL), D_MODEL),
        'b_mod': small(ks[5], (DEPTH, 6 * D_MODEL)),
        'w_in': nrm(ks[6], (DEPTH, D_MODEL, N_IN), D_MODEL),
        'b_in': small(ks[7], (DEPTH, N_IN)),
        'conv_w': nrm(ks[8], (DEPTH, CONV_W, D_RNN), CONV_W),
        'conv_b': small(ks[9], (DEPTH, D_RNN)),
        'lru_wa': nrm(ks[10], (DEPTH, 2, N_LRU_BLOCKS, LRU_BLOCK, LRU_BLOCK), LRU_BLOCK),
        'lru_ba': small(ks[11], (DEPTH, 2, D_RNN)),
        'lru_wi': nrm(ks[12], (DEPTH, 2, N_LRU_BLOCKS, LRU_BLOCK, LRU_BLOCK), LRU_BLOCK),
        'lru_bi': small(ks[13], (DEPTH, 2, D_RNN)),
        'lru_lambda': lam,
        'na_rpb': 0.1 * jax.random.normal(ks[15], (DEPTH, N_HEADS, 2 * WIN_R - 1, 2 * WIN_C - 1), f32),
        'w_proj_rnn': nrm(ks[16], (DEPTH, D_RNN, D_MODEL), D_RNN),
        'w_proj_na': nrm(ks[17], (DEPTH, D_NA, D_MODEL), D_NA),
        'w_out': nrm(ks[18], (DEPTH, D_MODEL, D_MODEL), D_MODEL),
        'w_router': nrm(ks[19], (DEPTH, D_MODEL, N_EXPERTS), D_MODEL),
        'w_exp_gate': nrm(ks[20], (DEPTH, N_EXPERTS, D_MODEL, D_EXPERT), D_MODEL),
        'w_exp_up': nrm(ks[21], (DEPTH, N_EXPERTS, D_MODEL, D_EXPERT), D_MODEL),
        'w_exp_down': nrm(ks[22], (DEPTH, N_EXPERTS, D_EXPERT, D_MODEL), D_EXPERT),
        'final_norm': 1.0 + small(ks[23], (D_MODEL,)),
    }


def reference(x, c, ctx, c_ctx, w_mod, b_mod, w_in, b_in, conv_w, conv_b,
              lru_wa, lru_ba, lru_wi, lru_bi, lru_lambda, na_rpb,
              w_proj_rnn, w_proj_na, w_out, w_router, w_exp_gate, w_exp_up, w_exp_down,
              final_norm):
    B, N, _ = x.shape
    L = ctx.shape[1]
    ang_r, ang_c = axial_rope_angles(N)
    h_ctx = ctx
    for l in range(DEPTH):
        last = l == DEPTH - 1
        mod = (jax.nn.silu(c) @ w_mod[l] + b_mod[l])[:, None, :]
        sh1, sc1, g1, sh2, sc2, g2 = jnp.split(mod, 6, axis=-1)
        modc = (jax.nn.silu(c_ctx) @ w_mod[l] + b_mod[l])[None, None, :]
        csh1, csc1, cg1, csh2, csc2, cg2 = jnp.split(modc, 6, axis=-1)

        xn = modulate(rms_norm(x), sh1, sc1)
        cn = modulate(rms_norm(h_ctx), csh1, csc1)
        yg, xr, q, k, v, gr, gn = split_in(xn @ w_in[l] + b_in[l])
        ycg, xrc, qc, kc, vc, grc, gnc = split_in(cn @ w_in[l] + b_in[l])

        xr = centred_dwconv(xr, conv_w[l], conv_b[l])
        xrc = centred_dwconv(xrc, conv_w[l], conv_b[l])
        h_lat = None
        ctx_states = []
        for d in range(2):
            rev = d == 1
            pa = (lru_wa[l, d], lru_ba[l, d], lru_wi[l, d], lru_bi[l, d], lru_lambda[l, d])
            ac, bc = rglru_coeffs(xrc, *pa)
            hc = linear_recurrence(ac, bc, jnp.zeros_like(ac[:, 0]), rev)
            h_end = hc[:, 0] if rev else hc[:, -1]
            a, b = rglru_coeffs(xr, *pa)
            hd = linear_recurrence(a, b, h_end, rev)
            h_lat = hd if h_lat is None else h_lat + hd
            ctx_states.append(hc)
        y_rnn = h_lat.astype(x.dtype) * jax.nn.gelu(yg)

        q4 = axial_rope(q.reshape(B, N, N_HEADS, HEAD_DIM), ang_r, ang_c)
        k4 = axial_rope(k.reshape(B, N, N_HEADS, HEAD_DIM), ang_r, ang_c)
        v4 = v.reshape(B, N, N_HEADS, HEAD_DIM)
        kc4 = kc.reshape(B, L, N_HEADS, HEAD_DIM)
        vc4 = vc.reshape(B, L, N_HEADS, HEAD_DIM)
        y_na = neighbourhood_attention(q4, k4, v4, kc4, vc4, na_rpb[l])

        mix = jax.nn.sigmoid(gr) * (y_rnn @ w_proj_rnn[l]) + jax.nn.sigmoid(gn) * (y_na @ w_proj_na[l])
        x = x + g1 * (mix @ w_out[l])
        if not last:
            yc_rnn = (ctx_states[0] + ctx_states[1]).astype(x.dtype) * jax.nn.gelu(ycg)
            yc_na = context_attention(qc.reshape(B, L, N_HEADS, HEAD_DIM), kc4, vc4).reshape(B, L, D_NA)
            mixc = (jax.nn.sigmoid(grc) * (yc_rnn @ w_proj_rnn[l])
                    + jax.nn.sigmoid(gnc) * (yc_na @ w_proj_na[l]))
            h_ctx = h_ctx + cg1 * (mixc @ w_out[l])

        xn2 = modulate(rms_norm(x), sh2, sc2)
        x = x + g2 * expert_choice_moe(xn2, w_router[l], w_exp_gate[l], w_exp_up[l], w_exp_down[l])
        if not last:
            cn2 = modulate(rms_norm(h_ctx), csh2, csc2)
            h_ctx = h_ctx + cg2 * expert_choice_moe(cn2, w_router[l], w_exp_gate[l], w_exp_up[l], w_exp_down[l])
    return rms_norm(x) * final_norm
```

```cpp
#include <hip/hip_runtime.h>
#include <hip/hip_cooperative_groups.h>
#include <cstdio>
#include <cstdint>
namespace cg = cooperative_groups;

#define LAS __attribute__((address_space(3)))
typedef unsigned short bf16_t;
typedef short bf16x8 __attribute__((ext_vector_type(8)));
typedef float f32x4 __attribute__((ext_vector_type(4)));
typedef float f32x2 __attribute__((ext_vector_type(2)));
typedef unsigned u32x4 __attribute__((ext_vector_type(4)));
typedef unsigned u32x2 __attribute__((ext_vector_type(2)));

constexpr int NB = 8, SEQ = 4096, DM = 1024, CTX = 256;
constexpr int MLAT = NB * SEQ, MCTX = NB * CTX;
constexpr int NIN = 7168, NEXP = 16, DEXP = 2048, CAP = 512, EROWS = NB * CAP;
constexpr int LDZ = 7168, ZC_YG = 0, ZC_Q = 1024, ZC_XR = 2048, ZC_K = 3072, ZC_V = 4096, ZC_GR = 5120, ZC_GN = 6144;
constexpr int LDC = 3072, CC_XR = 0, CC_K = 1024, CC_V = 2048;
constexpr float LOG2E = 1.4426950408889634f;
constexpr float QSCALE = 0.125f * LOG2E;

constexpr size_t MiB = 1u << 20;
constexpr size_t WS_CTL = 0;
constexpr size_t WS_MOD = 1 * MiB;
constexpr size_t WS_MODP = 2 * MiB;
constexpr size_t WS_ROPE = 9 * MiB;
constexpr size_t WS_BINZ = 9 * MiB + 65536;
constexpr size_t WS_AFF = 10 * MiB;
constexpr size_t WS_SELIDX = 12 * MiB;
constexpr size_t WS_SELG = 12 * MiB + 262144;
constexpr size_t WS_SLOT = 13 * MiB;
constexpr size_t WS_WINT = 16 * MiB;
constexpr size_t WS_WMIX = 30 * MiB;
constexpr size_t WS_WOUT = 34 * MiB;
constexpr size_t WS_ZC = 36 * MiB;
constexpr size_t WS_XN = 48 * MiB;
constexpr size_t WS_Z = 116 * MiB;
constexpr size_t WS_WGU = 116 * MiB;
constexpr size_t WS_WD = 244 * MiB;
constexpr size_t WS_HID = 308 * MiB;
constexpr size_t WS_YE = 116 * MiB;
constexpr size_t WS_END = 564 * MiB;

constexpr int NTHREADS = 512, NWAVES = 8;
constexpr int LDS_BYTES = 147456;

__device__ __forceinline__ unsigned f2bf(float f) { unsigned u = __builtin_bit_cast(unsigned, f); return (u + 0x7fffu + ((u >> 16) & 1u)) >> 16; }
__device__ __forceinline__ float bf2f(unsigned h) { return __builtin_bit_cast(float, h << 16); }
__device__ __forceinline__ unsigned pk2(float lo, float hi) { return f2bf(lo) | (f2bf(hi) << 16); }
__device__ __forceinline__ unsigned cvt_pk_bf16(float lo, float hi) { unsigned r; asm volatile("v_cvt_pk_bf16_f32 %0, %1, %2" : "=v"(r) : "v"(lo), "v"(hi)); return r; }
__device__ __forceinline__ float wave_sum(float v) {
#pragma unroll
    for (int o = 1; o < 64; o <<= 1) v += __shfl_xor(v, o);
    return v;
}
__device__ __forceinline__ float sigmoidf_(float x) { return __builtin_amdgcn_rcpf(1.0f + __builtin_amdgcn_exp2f(-x * LOG2E)); }
__device__ __forceinline__ float gelu_tanh(float x) { const float u = 0.7978845608028654f * (x + 0.044715f * x * x * x); return x * __builtin_amdgcn_rcpf(1.0f + __builtin_amdgcn_exp2f(-2.0f * LOG2E * u)); }
#define LDS_WAIT() asm volatile("s_waitcnt lgkmcnt(0)" ::: "memory")

namespace pg8 {
constexpr int BM = 256, BK = 64, HALF = 128, HTB = HALF * BK * 2, STAGE_BYTES = 8 * HTB, NXCD = 8, WGM = 8;
__host__ __device__ __forceinline__ int lds_byte(int r, int c) { const int st = (r >> 4) * 2 + (c >> 5), rr = r & 15, cc = c & 31, ob = rr * 64 + cc * 2; return st * 1024 + (ob ^ (((ob >> 9) & 1) << 5)); }
__host__ __device__ __forceinline__ void stage_rc(int b, int& R, int& C) { const int st = b / 1024, sb = b % 1024, swz = sb ^ (((sb >> 9) & 1) << 5); R = (st >> 1) * 16 + swz / 64; C = (st & 1) * 32 + (swz % 64) / 2; }
__host__ __device__ __forceinline__ int perm32(int rho) { const int n = rho >> 4, i = rho & 15; return 8 * (i >> 2) + 4 * n + (i & 3); }

struct Unit { int pm, pb, x0, x1; };

__device__ __forceinline__ void tile_of(int L, int nM, int nN, int& pm, int& pn) {
    const int nwg = nM * nN; int wgid = L;
    { const int q = nwg / NXCD, r = nwg % NXCD, xcd = wgid % NXCD, off = wgid / NXCD; wgid = (xcd < r ? xcd * (q + 1) : r * (q + 1) + (xcd - r) * q) + off; }
    const int nig = WGM * nN, gid = wgid / nig, fm = gid * WGM, gsz = (nM - fm) < WGM ? (nM - fm) : WGM;
    pm = fm + ((wgid % nig) % gsz); pn = (wgid % nig) / gsz;
}

template <class Epi, class Sched>
__device__ __forceinline__ void gemm_phase(LAS unsigned char* lds, const Sched& S, const Epi& E) {
    const int tid = threadIdx.x, wid = __builtin_amdgcn_readfirstlane(tid >> 6), lane = tid & 63, wr = wid >> 2, wc = wid & 3, fr = lane & 15, fq = lane >> 4;
    const int K = S.K, nt = K / BK;
    int Rl[2], Cl[2];
    unsigned voffA[2][2], voffB[2];
#pragma unroll
    for (int i = 0; i < 2; ++i) { stage_rc(tid * 16 + i * 8192, Rl[i], Cl[i]); const int Rb = Epi::PERM ? ((Rl[i] & ~31) + perm32(Rl[i] & 31)) : Rl[i];
        voffB[i] = (unsigned)(Rb * S.ldb + Cl[i]) * 2u; }
    const size_t kstep = (size_t)(BK * 2);
    const size_t hstepB = (size_t)HALF * S.ldb * 2;
    const unsigned ldsw = (unsigned)wid * 1024u;
    const int aoff = lds_byte(wr * 64 + fr, fq * 8), boff = lds_byte(wc * 32 + fr, fq * 8);
#define PG8_SA(b, h) (((b) * 2 + (h)) * HTB)
#define PG8_SB(b, h) ((4 + (b) * 2 + (h)) * HTB)
#define PG8_STAGEB(bufoff, gbase) do { _Pragma("unroll") for (int _i = 0; _i < 2; ++_i) \
        __builtin_amdgcn_global_load_lds((const unsigned*)((const char*)(gbase) + voffB[_i]), (LAS unsigned*)(lds + (bufoff) + ldsw + _i * 8192), 16, 0, 0); } while (0)
#define PG8_STAGEA(bufoff, gbase, h, vo) do { _Pragma("unroll") for (int _i = 0; _i < 2; ++_i) \
        __builtin_amdgcn_global_load_lds((const unsigned*)((const char*)(gbase) + (vo)[h][_i]), (LAS unsigned*)(lds + (bufoff) + ldsw + _i * 8192), 16, 0, 0); } while (0)
#define PG8_LDA(dst, b, h) do { _Pragma("unroll") for (int m = 0; m < 4; ++m) _Pragma("unroll") for (int k = 0; k < 2; ++k) dst[m][k] = *(const LAS bf16x8*)(lds + PG8_SA(b, h) + aoff + m * 2048 + k * 1024); } while (0)
#define PG8_LDB(dst, b, h) do { _Pragma("unroll") for (int n = 0; n < 2; ++n) _Pragma("unroll") for (int k = 0; k < 2; ++k) dst[n][k] = *(const LAS bf16x8*)(lds + PG8_SB(b, h) + boff + n * 2048 + k * 1024); } while (0)
#define PG8_MMA(ai, bj, At, Bt) do { __builtin_amdgcn_s_setprio(1); _Pragma("unroll") for (int m = 0; m < 4; ++m) _Pragma("unroll") for (int n = 0; n < 2; ++n) _Pragma("unroll") for (int k = 0; k < 2; ++k) \
        acc[ai][bj][m][n] = __builtin_amdgcn_mfma_f32_16x16x32_bf16(Bt[n][k], At[m][k], acc[ai][bj][m][n], 0, 0, 0); __builtin_amdgcn_s_setprio(0); } while (0)
#define PG8_WAIT_V(n) asm volatile("s_waitcnt vmcnt(" #n ")" ::: "memory")
#define PG8_WAIT_L(n) asm volatile("s_waitcnt lgkmcnt(" #n ")" ::: "memory")
#define PG8_BAR __builtin_amdgcn_s_barrier()
#define PG8_SCHED __builtin_amdgcn_sched_barrier(0)
#define PG8_SETVO(vo, u) do { _Pragma("unroll") for (int _h = 0; _h < 2; ++_h) _Pragma("unroll") for (int _i = 0; _i < 2; ++_i) { \
        if constexpr (Sched::GATHER) (vo)[_h][_i] = (unsigned)(S.row_of(u, _h * HALF + Rl[_i]) * S.lda + Cl[_i]) * 2u; \
        else (vo)[_h][_i] = (unsigned)((_h * HALF + Rl[_i]) * S.lda + Cl[_i]) * 2u; } } while (0)
    Unit cur, nxt; int ui = 0;
    if (!S.next(0, cur)) return;
    f32x4 acc[2][2][4][2];
#pragma unroll
    for (int a = 0; a < 2; ++a)
#pragma unroll
        for (int b = 0; b < 2; ++b)
#pragma unroll
            for (int m = 0; m < 4; ++m)
#pragma unroll
                for (int n = 0; n < 2; ++n) acc[a][b][m][n] = (f32x4){0.f, 0.f, 0.f, 0.f};
    bf16x8 At[4][2], B0[2][2], B1[2][2];
    const char* cA = S.a_ptr(cur); const char* cB = S.b_ptr(cur);
    PG8_SETVO(voffA, cur);
    PG8_STAGEB(PG8_SB(0, 0), cB); PG8_STAGEB(PG8_SB(0, 1), cB + hstepB); PG8_STAGEA(PG8_SA(0, 0), cA, 0, voffA); PG8_STAGEA(PG8_SA(0, 1), cA, 1, voffA);
    if (wr == 1) PG8_BAR;
    PG8_WAIT_V(2); PG8_BAR;
    PG8_STAGEB(PG8_SB(1, 0), cB + kstep); PG8_STAGEA(PG8_SA(1, 0), cA + kstep, 0, voffA); PG8_STAGEB(PG8_SB(1, 1), cB + hstepB + kstep);
    PG8_WAIT_V(6); PG8_BAR;
    for (;;) {
        const bool has_next = S.next(ui + 1, nxt);
        const char* nA = has_next ? S.a_ptr(nxt) : cA; const char* nB = has_next ? S.b_ptr(nxt) : cB;
        for (int t = 0; t < nt; t += 2) {
            const bool last = (t == nt - 2);
            const char* a1 = cA + (size_t)(t + 1) * kstep;
            const char* a2 = last ? nA : cA + (size_t)(t + 2) * kstep; const char* b2 = last ? nB : cB + (size_t)(t + 2) * kstep;
            const char* a3 = a2 + kstep; const char* b3 = b2 + kstep;
            PG8_LDB(B0, 0, 0); PG8_LDB(B1, 0, 1); PG8_SCHED; PG8_LDA(At, 0, 0); PG8_STAGEA(PG8_SA(1, 1), a1, 1, voffA);
            if (last && has_next) { PG8_SETVO(voffA, nxt); }
            PG8_WAIT_V(8); PG8_WAIT_L(0); PG8_BAR; PG8_MMA(0, 0, At, B0); PG8_MMA(0, 1, At, B1); PG8_BAR; PG8_SCHED;
            PG8_LDA(At, 0, 1); PG8_STAGEB(PG8_SB(0, 0), b2); PG8_STAGEB(PG8_SB(0, 1), b2 + hstepB); PG8_STAGEA(PG8_SA(0, 0), a2, 0, voffA);
            PG8_WAIT_V(8); PG8_WAIT_L(0); PG8_BAR; PG8_MMA(1, 0, At, B0); PG8_MMA(1, 1, At, B1); PG8_BAR; PG8_SCHED;
            PG8_LDB(B0, 1, 0); PG8_LDB(B1, 1, 1); PG8_SCHED; PG8_LDA(At, 1, 0); PG8_STAGEA(PG8_SA(0, 1), a2, 1, voffA);
            PG8_WAIT_V(8); PG8_WAIT_L(0); PG8_BAR; PG8_MMA(0, 0, At, B0); PG8_MMA(0, 1, At, B1); PG8_BAR; PG8_SCHED;
            PG8_LDA(At, 1, 1); PG8_STAGEB(PG8_SB(1, 0), b3); PG8_STAGEB(PG8_SB(1, 1), b3 + hstepB); PG8_STAGEA(PG8_SA(1, 0), a3, 0, voffA);
            PG8_WAIT_V(8); PG8_WAIT_L(0); PG8_BAR; PG8_MMA(1, 0, At, B0); PG8_MMA(1, 1, At, B1); PG8_BAR; PG8_SCHED;
        }
        if (wr == 0) PG8_BAR;
        E(acc, cur, wr, wc, fr, fq);
        if (!has_next) break;
#pragma unroll
        for (int a = 0; a < 2; ++a)
#pragma unroll
            for (int b = 0; b < 2; ++b)
#pragma unroll
                for (int m = 0; m < 4; ++m)
#pragma unroll
                    for (int n = 0; n < 2; ++n) acc[a][b][m][n] = (f32x4){0.f, 0.f, 0.f, 0.f};
        cur = nxt; cA = nA; cB = nB; ++ui;
        if (wr == 1) PG8_BAR;
    }
    PG8_WAIT_V(0);
    PG8_BAR;
#undef PG8_SA
#undef PG8_SB
#undef PG8_STAGEA
#undef PG8_STAGEB
#undef PG8_LDA
#undef PG8_LDB
#undef PG8_MMA
#undef PG8_WAIT_V
#undef PG8_WAIT_L
#undef PG8_BAR
#undef PG8_SCHED
#undef PG8_SETVO
}
}

struct InprojSched {
    static constexpr bool GATHER = false;
    const bf16_t* XN; const bf16_t* W; int G, c; int lda, ldb, K;
    __device__ __forceinline__ bool next(int i, pg8::Unit& u) const {
        const int L = i * G + c;
        if (L < 128 * 28) { int pm, pn; pg8::tile_of(L, 128, 28, pm, pn); u.pm = pm; u.pb = pn; u.x0 = 0; u.x1 = 0; return true; }
        const int idx = L - 128 * 28; if (idx >= 96) return false;
        u.pm = 128 + (idx & 7); u.pb = 8 + (idx >> 3); u.x0 = 1; u.x1 = 0; return true;
    }
    __device__ __forceinline__ const char* a_ptr(const pg8::Unit& u) const { return (const char*)XN + (size_t)u.pm * 256 * 1024 * 2; }
    __device__ __forceinline__ const char* b_ptr(const pg8::Unit& u) const { return (const char*)W + (size_t)u.pb * 256 * 1024 * 2; }
    __device__ __forceinline__ int row_of(const pg8::Unit&, int r) const { return r; }
};
struct MixSched {
    static constexpr bool GATHER = false;
    const bf16_t* Z; const bf16_t* W; int G, c; int lda, ldb, K;
    __device__ __forceinline__ bool next(int i, pg8::Unit& u) const {
        const int L = (i >> 1) * G + c; if (L >= 128 * 4) return false;
        int pm, pn; pg8::tile_of(L, 128, 4, pm, pn); const int pass = i & 1;
        u.pm = pm; u.pb = pass * 4 + pn; u.x0 = pn; u.x1 = pass; return true;
    }
    __device__ __forceinline__ const char* a_ptr(const pg8::Unit& u) const { return (const char*)Z + ((size_t)u.pm * 256 * LDZ + (u.x1 ? ZC_Q : ZC_YG)) * 2; }
    __device__ __forceinline__ const char* b_ptr(const pg8::Unit& u) const { return (const char*)W + (size_t)u.pb * 256 * 1024 * 2; }
    __device__ __forceinline__ int row_of(const pg8::Unit&, int r) const { return r; }
};
struct WoutSched {
    static constexpr bool GATHER = false;
    const bf16_t* Z; const bf16_t* W; int G, c; int lda, ldb, K;
    __device__ __forceinline__ bool next(int i, pg8::Unit& u) const {
        const int L = i * G + c; if (L >= 128 * 4) return false;
        int pm, pn; pg8::tile_of(L, 128, 4, pm, pn); u.pm = pm; u.pb = pn; u.x0 = pn; u.x1 = 0; return true;
    }
    __device__ __forceinline__ const char* a_ptr(const pg8::Unit& u) const { return (const char*)Z + ((size_t)u.pm * 256 * LDZ + ZC_XR) * 2; }
    __device__ __forceinline__ const char* b_ptr(const pg8::Unit& u) const { return (const char*)W + (size_t)u.pb * 256 * 1024 * 2; }
    __device__ __forceinline__ int row_of(const pg8::Unit&, int r) const { return r; }
};
struct Moe1Sched {
    static constexpr bool GATHER = true;
    const bf16_t* XN2; const bf16_t* W; const int* selidx; int G, c; int lda, ldb, K;
    __device__ __forceinline__ bool next(int i, pg8::Unit& u) const {
        const int L = i * G + c; if (L >= 16 * 256) return false;
        const int e = L >> 8, w = L & 255, x = w & 7, j = w >> 3;
        const int mt = (x & 3) * 4 + (j & 3), nt = (x >> 2) * 8 + (j >> 2);
        u.pm = e * 16 + mt; u.pb = e * 16 + nt; u.x0 = nt; u.x1 = e; return true;
    }
    __device__ __forceinline__ const char* a_ptr(const pg8::Unit&) const { return (const char*)XN2; }
    __device__ __forceinline__ const char* b_ptr(const pg8::Unit& u) const { return (const char*)W + (size_t)u.pb * 256 * 1024 * 2; }
    __device__ __forceinline__ int row_of(const pg8::Unit& u, int r) const { return selidx[u.pm * 256 + r]; }
};
struct Moe2Sched {
    static constexpr bool GATHER = false;
    const bf16_t* HID; const bf16_t* W; int G, c; int lda, ldb, K;
    __device__ __forceinline__ bool next(int i, pg8::Unit& u) const {
        const int L = i * G + c; if (L >= 16 * 64) return false;
        const int e = L >> 6, w = L & 63, mt = w >> 2, pn = w & 3;
        u.pm = e * 16 + mt; u.pb = e * 4 + pn; u.x0 = pn; u.x1 = e; return true;
    }
    __device__ __forceinline__ const char* a_ptr(const pg8::Unit& u) const { return (const char*)HID + (size_t)u.pm * 256 * 2048 * 2; }
    __device__ __forceinline__ const char* b_ptr(const pg8::Unit& u) const { return (const char*)W + (size_t)u.pb * 256 * 2048 * 2; }
    __device__ __forceinline__ int row_of(const pg8::Unit&, int r) const { return r; }
};

typedef const f32x4 (&AccRef)[2][2][4][2];
struct EpiInproj {
    static constexpr bool PERM = true;
    bf16_t* Z; bf16_t* ZC; const float* binz; const float* rope;
    __device__ __forceinline__ void operator()(AccRef acc, const pg8::Unit& u, int wr, int wc, int fr, int fq) const {
        const bool isctx = u.x0 != 0;
        const int seg = u.pb >> 2, colt = u.pb * 256, cl = wc * 32 + 8 * fq;
        f32x4 bv[2][2];
#pragma unroll
        for (int bj = 0; bj < 2; ++bj)
#pragma unroll
            for (int n = 0; n < 2; ++n) bv[bj][n] = *(const f32x4*)(binz + colt + bj * 128 + cl + 4 * n);
        bf16_t* base; int ld, row0;
        if (!isctx) { base = Z + colt; ld = LDZ; row0 = u.pm * 256; } else { base = ZC + (colt - 2048); ld = LDC; row0 = (u.pm - 128) * 256; }
        const bool dorope = (seg == 1) || (seg == 3 && !isctx);
        const float qs = (seg == 1) ? QSCALE : 1.0f;
#pragma unroll
        for (int ai = 0; ai < 2; ++ai)
#pragma unroll
            for (int m = 0; m < 4; ++m) {
                const int r = row0 + ai * 128 + wr * 64 + m * 16 + fr;
                bf16_t* rowp = base + (size_t)r * ld + cl;
                f32x4 cs0 = (f32x4){1.f, 0.f, 1.f, 0.f}, cs1 = cs0;
                if (dorope) { const int t = r & 4095; const int pos = (wc & 1) ? (t & 63) : (t >> 6); const float* cp = rope + (pos * 16 + 4 * fq) * 2; cs0 = *(const f32x4*)cp; cs1 = *(const f32x4*)(cp + 4); }
#pragma unroll
                for (int bj = 0; bj < 2; ++bj) {
                    f32x4 v0 = acc[ai][bj][m][0] + bv[bj][0], v1 = acc[ai][bj][m][1] + bv[bj][1];
                    if (seg == 0) {
#pragma unroll
                        for (int j = 0; j < 4; ++j) { v0[j] = gelu_tanh(v0[j]); v1[j] = gelu_tanh(v1[j]); }
                    } else if (seg >= 5) {
#pragma unroll
                        for (int j = 0; j < 4; ++j) { v0[j] = sigmoidf_(v0[j]); v1[j] = sigmoidf_(v1[j]); }
                    } else if (dorope) {
                        const float c[4] = {cs0[0], cs0[2], cs1[0], cs1[2]}, s[4] = {cs0[1], cs0[3], cs1[1], cs1[3]};
#pragma unroll
                        for (int j = 0; j < 4; ++j) { const float x1 = v0[j], x2 = v1[j]; v0[j] = (x1 * c[j] - x2 * s[j]) * qs; v1[j] = (x1 * s[j] + x2 * c[j]) * qs; }
                    }
                    u32x4 w; w.x = cvt_pk_bf16(v0[0], v0[1]); w.y = cvt_pk_bf16(v0[2], v0[3]); w.z = cvt_pk_bf16(v1[0], v1[1]); w.w = cvt_pk_bf16(v1[2], v1[3]);
                    *(u32x4*)(rowp + bj * 128) = w;
                }
            }
    }
};
struct EpiMix {
    static constexpr bool PERM = true;
    bf16_t* Z;
    __device__ __forceinline__ void operator()(AccRef acc, const pg8::Unit& u, int wr, int wc, int fr, int fq) const {
        const int pass = u.x1, colt = u.x0 * 256, cl = wc * 32 + 8 * fq;
        const int gcol = (pass ? ZC_GN : ZC_GR) + colt + cl, ocol = ZC_XR + colt + cl;
        const int r0 = u.pm * 256 + wr * 64 + fr;
#pragma unroll
        for (int ai = 0; ai < 2; ++ai)
#pragma unroll
            for (int m = 0; m < 4; ++m) {
                bf16_t* rowz = Z + (size_t)(r0 + ai * 128 + m * 16) * LDZ;
#pragma unroll
                for (int bj = 0; bj < 2; ++bj) {
                    const u32x4 g = *(const u32x4*)(rowz + gcol + bj * 128);
                    f32x4 v0 = acc[ai][bj][m][0] * (f32x4){bf2f(g.x & 0xffffu), bf2f(g.x >> 16), bf2f(g.y & 0xffffu), bf2f(g.y >> 16)};
                    f32x4 v1 = acc[ai][bj][m][1] * (f32x4){bf2f(g.z & 0xffffu), bf2f(g.z >> 16), bf2f(g.w & 0xffffu), bf2f(g.w >> 16)};
                    if (pass) { const u32x4 t = *(const u32x4*)(rowz + ocol + bj * 128);
                        v0 += (f32x4){bf2f(t.x & 0xffffu), bf2f(t.x >> 16), bf2f(t.y & 0xffffu), bf2f(t.y >> 16)};
                        v1 += (f32x4){bf2f(t.z & 0xffffu), bf2f(t.z >> 16), bf2f(t.w & 0xffffu), bf2f(t.w >> 16)}; }
                    u32x4 w; w.x = cvt_pk_bf16(v0[0], v0[1]); w.y = cvt_pk_bf16(v0[2], v0[3]); w.z = cvt_pk_bf16(v1[0], v1[1]); w.w = cvt_pk_bf16(v1[2], v1[3]);
                    *(u32x4*)(rowz + ocol + bj * 128) = w;
                }
            }
    }
};
struct EpiWout {
    static constexpr bool PERM = false;
    const float* x; float* out; const float* mod;
    __device__ __forceinline__ void operator()(AccRef acc, const pg8::Unit& u, int wr, int wc, int fr, int fq) const {
        const int col0 = u.x0 * 256 + wc * 32 + 4 * fq;
        const float* g1p = mod + (size_t)(u.pm >> 4) * 6144 + 2048 + col0;
        f32x4 gv[2][2];
#pragma unroll
        for (int bj = 0; bj < 2; ++bj)
#pragma unroll
            for (int n = 0; n < 2; ++n) gv[bj][n] = *(const f32x4*)(g1p + bj * 128 + n * 16);
#pragma unroll
        for (int ai = 0; ai < 2; ++ai)
#pragma unroll
            for (int m = 0; m < 4; ++m) {
                const size_t off = (size_t)(u.pm * 256 + ai * 128 + wr * 64 + m * 16 + fr) * DM + col0;
#pragma unroll
                for (int bj = 0; bj < 2; ++bj)
#pragma unroll
                    for (int n = 0; n < 2; ++n) { const f32x4 xv = *(const f32x4*)(x + off + bj * 128 + n * 16); *(f32x4*)(out + off + bj * 128 + n * 16) = xv + gv[bj][n] * acc[ai][bj][m][n]; }
            }
    }
};
struct EpiMoe1 {
    static constexpr bool PERM = true;
    bf16_t* HID;
    __device__ __forceinline__ void operator()(AccRef acc, const pg8::Unit& u, int wr, int wc, int fr, int fq) const {
        const int col0 = u.x0 * 128 + wc * 32 + 8 * fq;
#pragma unroll
        for (int ai = 0; ai < 2; ++ai)
#pragma unroll
            for (int m = 0; m < 4; ++m) {
                const size_t r = (size_t)u.pm * 256 + ai * 128 + wr * 64 + m * 16 + fr;
                f32x4 h0, h1;
#pragma unroll
                for (int j = 0; j < 4; ++j) { const float g0 = acc[ai][0][m][0][j], g1 = acc[ai][0][m][1][j];
                    h0[j] = g0 * sigmoidf_(g0) * acc[ai][1][m][0][j]; h1[j] = g1 * sigmoidf_(g1) * acc[ai][1][m][1][j]; }
                u32x4 w; w.x = cvt_pk_bf16(h0[0], h0[1]); w.y = cvt_pk_bf16(h0[2], h0[3]); w.z = cvt_pk_bf16(h1[0], h1[1]); w.w = cvt_pk_bf16(h1[2], h1[3]);
                *(u32x4*)(HID + r * DEXP + col0) = w;
            }
    }
};
struct EpiMoe2 {
    static constexpr bool PERM = true;
    bf16_t* YE; const float* selg;
    __device__ __forceinline__ void operator()(AccRef acc, const pg8::Unit& u, int wr, int wc, int fr, int fq) const {
        const int col0 = u.x0 * 256 + wc * 32 + 8 * fq;
#pragma unroll
        for (int ai = 0; ai < 2; ++ai)
#pragma unroll
            for (int m = 0; m < 4; ++m) {
                const size_t r = (size_t)u.pm * 256 + ai * 128 + wr * 64 + m * 16 + fr;
                const float g = selg[r];
#pragma unroll
                for (int bj = 0; bj < 2; ++bj) {
                    const f32x4 v0 = acc[ai][bj][m][0] * g, v1 = acc[ai][bj][m][1] * g;
                    u32x4 w; w.x = cvt_pk_bf16(v0[0], v0[1]); w.y = cvt_pk_bf16(v0[2], v0[3]); w.z = cvt_pk_bf16(v1[0], v1[1]); w.w = cvt_pk_bf16(v1[2], v1[3]);
                    *(u32x4*)(YE + r * DM + col0 + bj * 128) = w;
                }
            }
    }
};

struct Params {
    const float *x, *c, *ctx, *c_ctx, *w_mod, *b_mod, *w_in, *b_in, *conv_w, *conv_b, *lru_wa, *lru_ba, *lru_wi, *lru_bi, *lru_lambda, *na_rpb,
                *w_proj_rnn, *w_proj_na, *w_out, *w_router, *w_exp_gate, *w_exp_up, *w_exp_down, *final_norm;
    float* out; unsigned char* ws;
    int ph_lo, ph_hi;
};

__device__ __forceinline__ int zcol_of(int n) {
    const int seg = n >> 10, o = n & 1023;
    if (seg == 0) return ZC_YG + o;
    if (seg == 1) return ZC_XR + o;
    if (seg == 4) return ZC_V + o;
    if (seg == 5) return ZC_GR + o;
    if (seg == 6) return ZC_GN + o;
    const int hh = o >> 6, d = o & 63, g2 = d >> 5, dd = d & 31, nn = dd >> 4, j = dd & 15, a = j >> 2, jj = j & 3;
    return (seg == 2 ? ZC_Q : ZC_K) + hh * 64 + g2 * 32 + 8 * a + 4 * nn + jj;
}
template <class RowMap>
__device__ __forceinline__ void transpose_item(const float* W, int ldw, int k0, int n0, bf16_t* WT, int ldk, RowMap rowmap, LAS float* scr, int lane) {
#pragma unroll 8
    for (int i = 0; i < 32; ++i) { const int kk = 2 * i + (lane >> 5); scr[kk * 33 + (lane & 31)] = W[(size_t)(k0 + kk) * ldw + n0 + (lane & 31)]; }
    LDS_WAIT(); asm volatile("" ::: "memory");
    const int c = lane & 7;
#pragma unroll
    for (int j = 0; j < 4; ++j) { const int n = (lane >> 3) + 8 * j; const LAS float* s = scr + (8 * c) * 33 + n;
        u32x4 o; o.x = pk2(s[0 * 33], s[1 * 33]); o.y = pk2(s[2 * 33], s[3 * 33]); o.z = pk2(s[4 * 33], s[5 * 33]); o.w = pk2(s[6 * 33], s[7 * 33]);
        *(u32x4*)(WT + (size_t)rowmap(n0 + n) * ldk + k0 + 8 * c) = o; }
    LDS_WAIT(); asm volatile("" ::: "memory");
}
__device__ __forceinline__ void phase_prep(const Params& p, LAS unsigned char* lds) {
    const int tid = threadIdx.x, lane = tid & 63, wave = tid >> 6, G = gridDim.x;
    unsigned char* ws = p.ws;
    {
        LAS float* scr = (LAS float*)(lds + wave * 16384);
        bf16_t* WINT = (bf16_t*)(ws + WS_WINT); bf16_t* WMIX = (bf16_t*)(ws + WS_WMIX); bf16_t* WOUT = (bf16_t*)(ws + WS_WOUT);
        const int gw = blockIdx.x * NWAVES + wave, NGW = G * NWAVES;
        constexpr int I_IN = 16 * (NIN / 32), I_P = 16 * 32;
        for (int it = gw; it < I_IN + 3 * I_P; it += NGW) {
            int r = it;
            if (r < I_IN) { const int nblk = NIN / 32, kb = r / nblk, nb = r % nblk; transpose_item(p.w_in, NIN, 64 * kb, 32 * nb, WINT, 1024, [](int n) { return zcol_of(n); }, scr, lane); continue; } r -= I_IN;
            const int kb = (r % I_P) / 32, nb = (r % I_P) % 32, which = r / I_P;
            if (which == 0) transpose_item(p.w_proj_rnn, 1024, 64 * kb, 32 * nb, WMIX, 1024, [](int n) { return n; }, scr, lane);
            else if (which == 1) transpose_item(p.w_proj_na, 1024, 64 * kb, 32 * nb, WMIX, 1024, [](int n) { return 1024 + n; }, scr, lane);
            else transpose_item(p.w_out, 1024, 64 * kb, 32 * nb, WOUT, 1024, [](int n) { return n; }, scr, lane);
        }
    }
    __syncthreads();
    {
        LAS float* sS = (LAS float*)lds;
        float* MODP = (float*)(ws + WS_MODP);
        for (int it = blockIdx.x; it < 24 * 16; it += G) {
            const int nb = it % 24, kc = it / 24, k0 = kc * 64;
            for (int e = tid; e < 9 * 64; e += NTHREADS) { const int r = e >> 6, k = e & 63; const float v = (r < 8) ? p.c[r * 1024 + k0 + k] : p.c_ctx[k0 + k]; sS[e] = v * sigmoidf_(v); }
            __syncthreads();
            const int n = nb * 256 + (tid & 255), kh = tid >> 8;
            float a[9];
#pragma unroll
            for (int r = 0; r < 9; ++r) a[r] = 0.f;
            for (int k = 0; k < 32; ++k) { const int kk = kh * 32 + k; const float w = p.w_mod[(size_t)(k0 + kk) * 6144 + n];
#pragma unroll
                for (int r = 0; r < 9; ++r) a[r] += sS[r * 64 + kk] * w; }
#pragma unroll
            for (int r = 0; r < 9; ++r) MODP[((size_t)(kc * 2 + kh) * 9 + r) * 6144 + n] = a[r];
            __syncthreads();
        }
    }
    {
        float* ROPE = (float*)(ws + WS_ROPE); float* BINZ = (float*)(ws + WS_BINZ);
        const int gt = blockIdx.x * NTHREADS + tid, NGT = G * NTHREADS;
        for (int e = gt; e < 64 * 16; e += NGT) { const int pos = e >> 4, j = e & 15; const float inv = powf(10000.0f, -(float)j / 16.0f); const float ang = (float)pos * inv; ROPE[2 * e] = cosf(ang); ROPE[2 * e + 1] = sinf(ang); }
        for (int n = gt; n < NIN; n += NGT) BINZ[zcol_of(n)] = p.b_in[n];
    }
}

__device__ __forceinline__ void norm_row_to_bf16(const float* xrow, bf16_t* orow, const LAS float* sh, const LAS float* sc, int lane) {
    const f32x4* xr = (const f32x4*)xrow + lane;
    f32x4 v[4]; float s = 0.f;
#pragma unroll
    for (int j = 0; j < 4; ++j) { v[j] = xr[64 * j]; s += (v[j].x * v[j].x + v[j].y * v[j].y) + (v[j].z * v[j].z + v[j].w * v[j].w); }
    const float rs = 1.0f / sqrtf(wave_sum(s) * (1.0f / DM) + 1e-6f);
    unsigned long long* o8 = (unsigned long long*)orow + lane;
#pragma unroll
    for (int j = 0; j < 4; ++j) { const int c0 = 4 * lane + 256 * j; const f32x4 hh = *(const LAS f32x4*)(sh + c0), cc = *(const LAS f32x4*)(sc + c0);
        const f32x4 y = v[j] * rs * (cc + 1.0f) + hh;
        o8[64 * j] = (unsigned long long)pk2(y.x, y.y) | ((unsigned long long)pk2(y.z, y.w) << 32); }
}
__device__ __forceinline__ void phase_norm1(const Params& p, LAS unsigned char* lds) {
    const int tid = threadIdx.x, lane = tid & 63, wave = tid >> 6, G = gridDim.x;
    unsigned char* ws = p.ws;
    const float* MODP = (const float*)(ws + WS_MODP); float* MOD = (float*)(ws + WS_MOD);
    for (int e = blockIdx.x * NTHREADS + tid; e < 9 * 6144; e += G * NTHREADS) { const int r = e / 6144, n = e % 6144; float s = p.b_mod[n];
        for (int k = 0; k < 32; ++k) s += MODP[((size_t)k * 9 + r) * 6144 + n]; MOD[e] = s; }
    LAS float* sh = (LAS float*)lds; LAS float* sc = sh + 1024;
    bf16_t* XN = (bf16_t*)(ws + WS_XN);
    for (int it = blockIdx.x; it < 256 + 8; it += G) {
        const bool isctx = it >= 256; const int mr = isctx ? 8 : (it >> 5);
        __syncthreads();
        for (int e = tid; e < 2048; e += NTHREADS) { float s = p.b_mod[e];
            for (int k = 0; k < 32; ++k) s += MODP[((size_t)k * 9 + mr) * 6144 + e]; sh[e] = s; }
        __syncthreads();
        const int nrows = isctx ? 256 : 128;
        for (int r = wave; r < nrows; r += NWAVES) {
            if (!isctx) { const size_t row = (size_t)it * 128 + r; norm_row_to_bf16(p.x + row * DM, XN + row * DM, sh, sc, lane); }
            else { const size_t row = (size_t)(it - 256) * 256 + r; norm_row_to_bf16(p.ctx + row * DM, XN + ((size_t)MLAT + row) * DM, sh, sc, lane); }
        }
    }
}

__device__ __forceinline__ void phase_rnn(const Params& p, LAS unsigned char* lds) {
    const int tid = threadIdx.x, lane = tid & 63, wave = tid >> 6, G = gridDim.x;
    unsigned char* ws = p.ws;
    bf16_t* Z = (bf16_t*)(ws + WS_Z); const bf16_t* ZCb = (const bf16_t*)(ws + WS_ZC); bf16_t* HF = (bf16_t*)(ws + WS_XN);
    LAS float* xc = (LAS float*)lds;
    LAS float* Wl = (LAS float*)(lds + 65536);
    LAS float* segA = (LAS float*)(lds + 65536 + 16384);
    LAS float* segB = segA + 512;
    const int c = lane & 31, hh = lane >> 5;
    for (int it = blockIdx.x; it < 256; it += G) {
        const int b = it >> 5, g = (it >> 1) & 15, half = it & 1;
        const int ch = 64 * g + 32 * half + c;
        const int tt = tid >> 1, cb = 64 * g + 32 * (tid & 1);
        for (int dir = 0; dir < 2; ++dir) {
            __syncthreads();
            for (int e = tid; e < 2 * 64 * 32; e += NTHREADS) { const int mat = e >> 11, i = (e >> 5) & 63, cc = e & 31;
                const float* src = mat ? p.lru_wi : p.lru_wa; Wl[e] = src[(((size_t)dir * 16 + g) * 64 + i) * 64 + 32 * half + cc]; }
            const float ba = p.lru_ba[dir * 1024 + ch], bi = p.lru_bi[dir * 1024 + ch];
            const float lam = p.lru_lambda[dir * 1024 + ch];
            const float sp = (lam > 15.f) ? expf(-lam) : log1pf(expf(-lam));
            const float clam = -8.0f * sp * LOG2E;
            float hc = 0.f;
            for (int step = 0; step < 17; ++step) {
                const bool isctx = (step == 0);
                const int kchunk = isctx ? 0 : (dir == 0 ? step - 1 : 16 - step);
                const int t0 = kchunk * 256, len = isctx ? CTX : SEQ;
                const bf16_t* src = isctx ? (ZCb + (size_t)b * CTX * LDC + CC_XR) : (Z + (size_t)b * SEQ * LDZ + ZC_XR);
                const int ld = isctx ? LDC : LDZ;
                __syncthreads();
                {
                    float a[32];
#pragma unroll
                    for (int j = 0; j < 32; ++j) a[j] = p.conv_b[cb + j];
#pragma unroll
                    for (int k = 0; k < 4; ++k) { const int ts = t0 + tt + k - 2;
                        if (ts >= 0 && ts < len) { const u32x4* rp = (const u32x4*)(src + (size_t)ts * ld + cb);
#pragma unroll
                            for (int q = 0; q < 4; ++q) { const u32x4 w = rp[q]; const float* cw = p.conv_w + k * 1024 + cb + 8 * q;
                                a[8 * q + 0] += bf2f(w.x & 0xffffu) * cw[0]; a[8 * q + 1] += bf2f(w.x >> 16) * cw[1]; a[8 * q + 2] += bf2f(w.y & 0xffffu) * cw[2]; a[8 * q + 3] += bf2f(w.y >> 16) * cw[3];
                                a[8 * q + 4] += bf2f(w.z & 0xffffu) * cw[4]; a[8 * q + 5] += bf2f(w.z >> 16) * cw[5]; a[8 * q + 6] += bf2f(w.w & 0xffffu) * cw[6]; a[8 * q + 7] += bf2f(w.w >> 16) * cw[7]; } } }
                    LAS f32x4* dst = (LAS f32x4*)(xc + tt * 64 + 32 * (tid & 1));
#pragma unroll
                    for (int q = 0; q < 8; ++q) dst[q] = (f32x4){a[4 * q], a[4 * q + 1], a[4 * q + 2], a[4 * q + 3]};
                }
                __syncthreads();
                float ar[16], ai[16];
#pragma unroll
                for (int j = 0; j < 16; ++j) { ar[j] = 0.f; ai[j] = 0.f; }
                const LAS float* xrow = xc + (32 * wave + 16 * hh) * 64;
                for (int i4 = 0; i4 < 16; ++i4) {
                    float wa_[4], wi_[4];
#pragma unroll
                    for (int q = 0; q < 4; ++q) { wa_[q] = Wl[(4 * i4 + q) * 32 + c]; wi_[q] = Wl[2048 + (4 * i4 + q) * 32 + c]; }
#pragma unroll
                    for (int j = 0; j < 16; ++j) { const f32x4 xv = *(const LAS f32x4*)(xrow + j * 64 + 4 * i4);
                        ar[j] += xv.x * wa_[0] + xv.y * wa_[1] + xv.z * wa_[2] + xv.w * wa_[3];
                        ai[j] += xv.x * wi_[0] + xv.y * wi_[1] + xv.z * wi_[2] + xv.w * wi_[3]; }
                }
#pragma unroll
                for (int j = 0; j < 16; ++j) {
                    const float r = sigmoidf_(ar[j] + ba), ig = sigmoidf_(ai[j] + bi);
                    const float l2 = r * clam;
                    const float a = __builtin_amdgcn_exp2f(l2);
                    const float om = -expm1f(2.0f * 0.6931471805599453f * l2);
                    const float xv = xrow[j * 64 + 32 * half + c];
                    ar[j] = a; ai[j] = sqrtf(fmaxf(om, 0.f)) * ig * xv;
                }
                float P = 1.f, H = 0.f;
                if (dir == 0) {
#pragma unroll
                    for (int j = 0; j < 16; ++j) { H = ar[j] * H + ai[j]; P *= ar[j]; }
                } else {
#pragma unroll
                    for (int j = 15; j >= 0; --j) { H = ar[j] * H + ai[j]; P *= ar[j]; }
                }
                const int s = 2 * wave + hh;
                segA[s * 32 + c] = P; segB[s * 32 + c] = H;
                __syncthreads();
                float h = hc, hin = 0.f;
                if (dir == 0) { for (int q = 0; q < 16; ++q) { if (q == s) hin = h; h = segA[q * 32 + c] * h + segB[q * 32 + c]; } }
                else { for (int q = 15; q >= 0; --q) { if (q == s) hin = h; h = segA[q * 32 + c] * h + segB[q * 32 + c]; } }
                hc = h;
                if (!isctx) {
                    const size_t tb = (size_t)b * SEQ + t0 + 32 * wave + 16 * hh;
                    h = hin;
                    if (dir == 0) {
#pragma unroll
                        for (int j = 0; j < 16; ++j) { h = ar[j] * h + ai[j]; HF[(tb + j) * DM + ch] = (bf16_t)f2bf(h); }
                    } else {
#pragma unroll
                        for (int j = 15; j >= 0; --j) { h = ar[j] * h + ai[j];
                            const float hf = bf2f(HF[(tb + j) * DM + ch]); bf16_t* yp = Z + (tb + j) * LDZ + ZC_YG + ch;
                            *yp = (bf16_t)f2bf((hf + h) * bf2f(*yp)); }
                    }
                }
            }
        }
    }
}

__device__ __forceinline__ void phase_attn(const Params& p, LAS unsigned char* lds) {
    const int tid = threadIdx.x, G = gridDim.x;
    unsigned char* ws = p.ws;
    bf16_t* Z = (bf16_t*)(ws + WS_Z); const bf16_t* ZCb = (const bf16_t*)(ws + WS_ZC);
    for (int it = blockIdx.x; it < NB * 16 * 8; it += G) {
        const int b = it >> 7, h = (it >> 3) & 15, rg = it & 7;
        const int r = 8 * rg + (tid >> 6), cq = tid & 63, t = r * 64 + cq;
        bf16_t* qrow = Z + ((size_t)b * SEQ + t) * LDZ + ZC_Q + h * 64;
        float q[64], o[64];
#pragma unroll
        for (int j = 0; j < 8; ++j) { const u32x4 w = ((const u32x4*)qrow)[j];
            q[8 * j + 0] = bf2f(w.x & 0xffffu); q[8 * j + 1] = bf2f(w.x >> 16); q[8 * j + 2] = bf2f(w.y & 0xffffu); q[8 * j + 3] = bf2f(w.y >> 16);
            q[8 * j + 4] = bf2f(w.z & 0xffffu); q[8 * j + 5] = bf2f(w.z >> 16); q[8 * j + 6] = bf2f(w.w & 0xffffu); q[8 * j + 7] = bf2f(w.w >> 16); }
#pragma unroll
        for (int j = 0; j < 64; ++j) o[j] = 0.f;
        float mx = -1e30f, l = 0.f;
        const int rs = min(max(r - 4, 0), 56), cs = min(max(cq - 8, 0), 48);
        const float* rpb = p.na_rpb + (size_t)h * 15 * 31;
        for (int kk = 0; kk < 128 + CTX; ++kk) {
            const bf16_t* krow; const bf16_t* vrow; float bias = 0.f;
            if (kk < 128) { const int kr = rs + (kk >> 4), kc = cs + (kk & 15); const size_t tk = (size_t)b * SEQ + kr * 64 + kc;
                krow = Z + tk * LDZ + ZC_K + h * 64; vrow = Z + tk * LDZ + ZC_V + h * 64; bias = rpb[(kr - r + 7) * 31 + (kc - cq + 15)] * LOG2E; }
            else { const size_t tk = (size_t)b * CTX + (kk - 128); krow = ZCb + tk * LDC + CC_K + h * 64; vrow = ZCb + tk * LDC + CC_V + h * 64; }
            float s = 0.f;
#pragma unroll
            for (int j = 0; j < 8; ++j) { const u32x4 w = ((const u32x4*)krow)[j];
                s += q[8 * j + 0] * bf2f(w.x & 0xffffu) + q[8 * j + 1] * bf2f(w.x >> 16) + q[8 * j + 2] * bf2f(w.y & 0xffffu) + q[8 * j + 3] * bf2f(w.y >> 16)
                   + q[8 * j + 4] * bf2f(w.z & 0xffffu) + q[8 * j + 5] * bf2f(w.z >> 16) + q[8 * j + 6] * bf2f(w.w & 0xffffu) + q[8 * j + 7] * bf2f(w.w >> 16); }
            s += bias;
            const float mn = fmaxf(mx, s), sc = __builtin_amdgcn_exp2f(mx - mn), pr = __builtin_amdgcn_exp2f(s - mn);
            mx = mn; l = l * sc + pr;
#pragma unroll
            for (int j = 0; j < 8; ++j) { const u32x4 w = ((const u32x4*)vrow)[j];
                o[8 * j + 0] = o[8 * j + 0] * sc + pr * bf2f(w.x & 0xffffu); o[8 * j + 1] = o[8 * j + 1] * sc + pr * bf2f(w.x >> 16);
                o[8 * j + 2] = o[8 * j + 2] * sc + pr * bf2f(w.y & 0xffffu); o[8 * j + 3] = o[8 * j + 3] * sc + pr * bf2f(w.y >> 16);
                o[8 * j + 4] = o[8 * j + 4] * sc + pr * bf2f(w.z & 0xffffu); o[8 * j + 5] = o[8 * j + 5] * sc + pr * bf2f(w.z >> 16);
                o[8 * j + 6] = o[8 * j + 6] * sc + pr * bf2f(w.w & 0xffffu); o[8 * j + 7] = o[8 * j + 7] * sc + pr * bf2f(w.w >> 16); }
        }
        const float il = 1.0f / l;
#pragma unroll
        for (int j = 0; j < 8; ++j) { u32x4 w; w.x = pk2(o[8 * j] * il, o[8 * j + 1] * il); w.y = pk2(o[8 * j + 2] * il, o[8 * j + 3] * il); w.z = pk2(o[8 * j + 4] * il, o[8 * j + 5] * il); w.w = pk2(o[8 * j + 6] * il, o[8 * j + 7] * il);
            ((u32x4*)qrow)[j] = w; }
    }
}

__device__ __forceinline__ void phase_norm2(const Params& p, LAS unsigned char* lds) {
    const int tid = threadIdx.x, lane = tid & 63, wave = tid >> 6, G = gridDim.x;
    unsigned char* ws = p.ws;
    const float* MOD = (const float*)(ws + WS_MOD); bf16_t* XN2 = (bf16_t*)(ws + WS_XN); float* AFF = (float*)(ws + WS_AFF);
    const int gw = blockIdx.x * NWAVES + wave, NGW = G * NWAVES;
    for (int row = gw; row < MLAT; row += NGW) {
        const int b = row >> 12;
        const f32x4* xr = (const f32x4*)(p.out + (size_t)row * DM) + lane;
        f32x4 v[4]; float s = 0.f;
#pragma unroll
        for (int j = 0; j < 4; ++j) { v[j] = xr[64 * j]; s += (v[j].x * v[j].x + v[j].y * v[j].y) + (v[j].z * v[j].z + v[j].w * v[j].w); }
        const float rs = 1.0f / sqrtf(wave_sum(s) * (1.0f / DM) + 1e-6f);
        unsigned long long* o8 = (unsigned long long*)(XN2 + (size_t)row * DM) + lane;
        float lg[16];
#pragma unroll
        for (int e = 0; e < 16; ++e) lg[e] = 0.f;
#pragma unroll
        for (int j = 0; j < 4; ++j) { const int c0 = 4 * lane + 256 * j;
            const f32x4 hh = *(const f32x4*)(MOD + (size_t)b * 6144 + 3072 + c0), cc = *(const f32x4*)(MOD + (size_t)b * 6144 + 4096 + c0);
            const f32x4 y = v[j] * rs * (cc + 1.0f) + hh;
            o8[64 * j] = (unsigned long long)pk2(y.x, y.y) | ((unsigned long long)pk2(y.z, y.w) << 32);
#pragma unroll
            for (int q = 0; q < 4; ++q) { const f32x4* wr = (const f32x4*)(p.w_router + (size_t)(c0 + q) * 16);
#pragma unroll
                for (int e4 = 0; e4 < 4; ++e4) { const f32x4 w = wr[e4]; lg[4 * e4] += y[q] * w.x; lg[4 * e4 + 1] += y[q] * w.y; lg[4 * e4 + 2] += y[q] * w.z; lg[4 * e4 + 3] += y[q] * w.w; } } }
        float mx = -1e30f;
#pragma unroll
        for (int e = 0; e < 16; ++e) { lg[e] = wave_sum(lg[e]); mx = fmaxf(mx, lg[e]); }
        float sum = 0.f;
#pragma unroll
        for (int e = 0; e < 16; ++e) { lg[e] = expf(lg[e] - mx); sum += lg[e]; }
        const float is = 1.0f / sum;
        if (lane < 16) { float val = 0.f;
#pragma unroll
            for (int e = 0; e < 16; ++e) val = (lane == e) ? lg[e] * is : val;
            AFF[(size_t)row * 16 + lane] = val; }
    }
}

__device__ __forceinline__ void phase_topk(const Params& p, LAS unsigned char* lds) {
    const int tid = threadIdx.x, lane = tid & 63, wave = tid >> 6, G = gridDim.x;
    unsigned char* ws = p.ws;
    const float* AFF = (const float*)(ws + WS_AFF); int* SELIDX = (int*)(ws + WS_SELIDX); float* SELG = (float*)(ws + WS_SELG); int* SLOT = (int*)(ws + WS_SLOT);
    LAS unsigned* hist = (LAS unsigned*)lds;
    LAS unsigned* ctl = hist + 256;
    LAS unsigned* wtot = hist + 264;
    for (int it = blockIdx.x; it < NB * NEXP; it += G) {
        const int b = it >> 4, e = it & 15;
        unsigned v[8];
#pragma unroll
        for (int j = 0; j < 8; ++j) v[j] = __builtin_bit_cast(unsigned, AFF[((size_t)b * SEQ + tid * 8 + j) * 16 + e]);
        unsigned prefix = 0u, mask = 0u, need = CAP;
        for (int shift = 24; shift >= 0; shift -= 8) {
            __syncthreads();
            if (tid < 256) hist[tid] = 0u;
            __syncthreads();
#pragma unroll
            for (int j = 0; j < 8; ++j) if ((v[j] & mask) == prefix) atomicAdd((unsigned*)&hist[(v[j] >> shift) & 255u], 1u);
            __syncthreads();
            if (tid == 0) { unsigned cum = 0u; int bin = 255; for (; bin > 0; --bin) { const unsigned hv = hist[bin]; if (cum + hv >= need) break; cum += hv; } ctl[0] = (unsigned)bin; ctl[1] = need - cum; }
            __syncthreads();
            prefix |= ctl[0] << shift; mask |= 255u << shift; need = ctl[1];
        }
        unsigned ngt = 0u, neq = 0u;
#pragma unroll
        for (int j = 0; j < 8; ++j) { ngt += (v[j] > prefix) ? 1u : 0u; neq += (v[j] == prefix) ? 1u : 0u; }
        unsigned sg = ngt, se = neq;
#pragma unroll
        for (int o = 1; o < 64; o <<= 1) { const unsigned a = __shfl_up(sg, o), c2 = __shfl_up(se, o); if (lane >= o) { sg += a; se += c2; } }
        __syncthreads();
        if (lane == 63) { wtot[wave] = sg; wtot[8 + wave] = se; }
        __syncthreads();
        unsigned og = sg - ngt, oe = se - neq, totg = 0u;
        for (int w = 0; w < 8; ++w) { const unsigned a = wtot[w], c2 = wtot[8 + w]; if (w < wave) { og += a; oe += c2; } totg += a; }
#pragma unroll
        for (int j = 0; j < 8; ++j) {
            const int tkn = tid * 8 + j; int slot = -1;
            if (v[j] > prefix) slot = (int)og++;
            else if (v[j] == prefix) { if (oe < need) slot = (int)(totg + oe); ++oe; }
            const int erow = b * CAP + slot;
            SLOT[((size_t)b * SEQ + tkn) * 16 + e] = (slot >= 0) ? erow : -1;
            if (slot >= 0) { SELIDX[e * EROWS + erow] = b * SEQ + tkn; SELG[e * EROWS + erow] = __builtin_bit_cast(float, v[j]); }
        }
    }
    __syncthreads();
    {
        LAS float* scr = (LAS float*)(lds + wave * 16384);
        bf16_t* WGU = (bf16_t*)(ws + WS_WGU); bf16_t* WD = (bf16_t*)(ws + WS_WD);
        const int gw = blockIdx.x * NWAVES + wave, NGW = G * NWAVES;
        constexpr int I_G = 16 * 64, I_D = 32 * 32;
        for (int it = gw; it < 16 * (2 * I_G + I_D); it += NGW) {
            const int e = it / (2 * I_G + I_D); int r = it % (2 * I_G + I_D);
            if (r < 2 * I_G) { const int up = r / I_G; r %= I_G; const int kb = r / 64, nb = r % 64;
                const float* W = (up ? p.w_exp_up : p.w_exp_gate) + (size_t)e * 1024 * 2048;
                transpose_item(W, 2048, 64 * kb, 32 * nb, WGU + (size_t)e * 4096 * 1024, 1024, [up](int n) { return 256 * (n >> 7) + 128 * up + (n & 127); }, scr, lane); }
            else { r -= 2 * I_G; const int kb = r / 32, nb = r % 32;
                transpose_item(p.w_exp_down + (size_t)e * 2048 * 1024, 1024, 64 * kb, 32 * nb, WD + (size_t)e * 1024 * 2048, 2048, [](int n) { return n; }, scr, lane); }
        }
    }
}

__device__ __forceinline__ void phase_final(const Params& p, LAS unsigned char* lds) {
    const int tid = threadIdx.x, lane = tid & 63, wave = tid >> 6, G = gridDim.x;
    unsigned char* ws = p.ws;
    const float* MOD = (const float*)(ws + WS_MOD); const int* SLOT = (const int*)(ws + WS_SLOT); const bf16_t* YE = (const bf16_t*)(ws + WS_YE);
    const int gw = blockIdx.x * NWAVES + wave, NGW = G * NWAVES;
    for (int row = gw; row < MLAT; row += NGW) {
        const int b = row >> 12;
        f32x4* xr = (f32x4*)(p.out + (size_t)row * DM) + lane;
        f32x4 v[4], mo[4];
#pragma unroll
        for (int j = 0; j < 4; ++j) { v[j] = xr[64 * j]; mo[j] = (f32x4){0.f, 0.f, 0.f, 0.f}; }
        const int myslot = (lane < 16) ? SLOT[(size_t)row * 16 + lane] : -1;
        for (int e = 0; e < 16; ++e) {
            const int sl = __shfl(myslot, e);
            if (sl >= 0) { const unsigned long long* yp = (const unsigned long long*)(YE + ((size_t)e * EROWS + sl) * DM) + lane;
#pragma unroll
                for (int j = 0; j < 4; ++j) { const unsigned long long w = yp[64 * j]; const unsigned lo = (unsigned)w, hi = (unsigned)(w >> 32);
                    mo[j].x += bf2f(lo & 0xffffu); mo[j].y += bf2f(lo >> 16); mo[j].z += bf2f(hi & 0xffffu); mo[j].w += bf2f(hi >> 16); } }
        }
        float s = 0.f;
#pragma unroll
        for (int j = 0; j < 4; ++j) { const int c0 = 4 * lane + 256 * j; const f32x4 g2 = *(const f32x4*)(MOD + (size_t)b * 6144 + 5120 + c0);
            v[j] = v[j] + g2 * mo[j]; s += (v[j].x * v[j].x + v[j].y * v[j].y) + (v[j].z * v[j].z + v[j].w * v[j].w); }
        const float rs = 1.0f / sqrtf(wave_sum(s) * (1.0f / DM) + 1e-6f);
#pragma unroll
        for (int j = 0; j < 4; ++j) { const int c0 = 4 * lane + 256 * j; const f32x4 fn = *(const f32x4*)(p.final_norm + c0); xr[64 * j] = v[j] * rs * fn; }
    }
}

constexpr int NPHASE = 12;
__global__ void __launch_bounds__(NTHREADS, 2) mk_fwd(Params p) {
    extern __shared__ __attribute__((aligned(16))) unsigned char lds_raw[];
    LAS unsigned char* lds = (LAS unsigned char*)lds_raw;
    cg::grid_group grid = cg::this_grid();
    unsigned char* ws = p.ws;
    const int G = gridDim.x, cblk = blockIdx.x;
#ifndef PH_MASK
#define PH_MASK 0xfff
#endif
#define IN(k) (((PH_MASK >> (k)) & 1) && p.ph_lo <= (k) && (k) < p.ph_hi)
#define SEAM(k) do { if (IN(k) && IN((k) + 1)) grid.sync(); } while (0)
    if (IN(0)) phase_prep(p, lds);
    SEAM(0);
    if (IN(1)) phase_norm1(p, lds);
    SEAM(1);
    if (IN(2)) {
        InprojSched S{(const bf16_t*)(ws + WS_XN), (const bf16_t*)(ws + WS_WINT), G, cblk, 1024, 1024, 1024};
        EpiInproj E{(bf16_t*)(ws + WS_Z), (bf16_t*)(ws + WS_ZC), (const float*)(ws + WS_BINZ), (const float*)(ws + WS_ROPE)};
        pg8::gemm_phase<EpiInproj, InprojSched>(lds, S, E);
    }
    SEAM(2);
    if (IN(3)) phase_rnn(p, lds);
    if (IN(3) && IN(4)) __syncthreads();
    if (IN(4)) phase_attn(p, lds);
    SEAM(4);
    if (IN(5)) {
        MixSched S{(const bf16_t*)(ws + WS_Z), (const bf16_t*)(ws + WS_WMIX), G, cblk, LDZ, 1024, 1024};
        EpiMix E{(bf16_t*)(ws + WS_Z)};
        pg8::gemm_phase<EpiMix, MixSched>(lds, S, E);
    }
    SEAM(5);
    if (IN(6)) {
        WoutSched S{(const bf16_t*)(ws + WS_Z), (const bf16_t*)(ws + WS_WOUT), G, cblk, LDZ, 1024, 1024};
        EpiWout E{p.x, p.out, (const float*)(ws + WS_MOD)};
        pg8::gemm_phase<EpiWout, WoutSched>(lds, S, E);
    }
    SEAM(6);
    if (IN(7)) phase_norm2(p, lds);
    SEAM(7);
    if (IN(8)) phase_topk(p, lds);
    SEAM(8);
    if (IN(9)) {
        Moe1Sched S{(const bf16_t*)(ws + WS_XN), (const bf16_t*)(ws + WS_WGU), (const int*)(ws + WS_SELIDX), G, cblk, 1024, 1024, 1024};
        EpiMoe1 E{(bf16_t*)(ws + WS_HID)};
        pg8::gemm_phase<EpiMoe1, Moe1Sched>(lds, S, E);
    }
    SEAM(9);
    if (IN(10)) {
        Moe2Sched S{(const bf16_t*)(ws + WS_HID), (const bf16_t*)(ws + WS_WD), G, cblk, 2048, 2048, 2048};
        EpiMoe2 E{(bf16_t*)(ws + WS_YE), (const float*)(ws + WS_SELG)};
        pg8::gemm_phase<EpiMoe2, Moe2Sched>(lds, S, E);
    }
    SEAM(10);
    if (IN(11)) phase_final(p, lds);
#undef IN
#undef SEAM
}

#ifndef MK_SINGLE
#define MK_SINGLE 1
#endif
extern "C" void kernel_launch(void* const* d_in, const int* in_sizes, int n_in, void* d_out, int out_size, void* d_ws, size_t ws_size, hipStream_t stream) {
    static int grid = 0;
    if (grid == 0) {
        int dev = 0, cus = 0, per_cu = 0;
        if (n_in != 24 || out_size != MLAT * DM || ws_size < WS_END) { fprintf(stderr, "kernel_launch: unexpected problem (n_in %d, out %d, ws %zu < %zu)\n", n_in, out_size, ws_size, (size_t)WS_END); grid = -1; return; }
        if (hipGetDevice(&dev) != hipSuccess || hipDeviceGetAttribute(&cus, hipDeviceAttributeMultiprocessorCount, dev) != hipSuccess) { grid = -1; return; }
        if (hipFuncSetAttribute((const void*)mk_fwd, hipFuncAttributeMaxDynamicSharedMemorySize, LDS_BYTES) != hipSuccess) { fprintf(stderr, "kernel_launch: hipFuncSetAttribute failed\n"); grid = -1; return; }
        if (hipOccupancyMaxActiveBlocksPerMultiprocessor(&per_cu, (const void*)mk_fwd, NTHREADS, LDS_BYTES) != hipSuccess || per_cu < 1) { fprintf(stderr, "kernel_launch: occupancy query says %d\n", per_cu); grid = -1; return; }
        grid = cus;
    }
    if (grid < 0) return;
    (void)hipMemsetAsync((char*)d_ws + WS_CTL, 0, 1 * MiB, stream);
    Params p{};
    const float** pp = (const float**)&p;
    for (int i = 0; i < 24; ++i) pp[i] = (const float*)d_in[i];
    p.out = (float*)d_out; p.ws = (unsigned char*)d_ws;
#if MK_SINGLE
    p.ph_lo = 0; p.ph_hi = NPHASE;
    void* args[] = {&p};
    hipError_t e = hipLaunchCooperativeKernel((const void*)mk_fwd, dim3(grid), dim3(NTHREADS), args, LDS_BYTES, stream);
    if (e != hipSuccess) fprintf(stderr, "kernel_launch: cooperative launch failed: %s (grid %d)\n", hipGetErrorString(e), grid);
#else
    for (int ph = 0; ph < NPHASE; ++ph) {
        p.ph_lo = ph; p.ph_hi = ph + 1;
        hipLaunchKernelGGL(mk_fwd, dim3(grid), dim3(NTHREADS), LDS_BYTES, stream, p);
    }
#endif
}
```

```cpp
#include <hip/hip_runtime.h>
#include <hip/hip_cooperative_groups.h>
#include <cstdio>
#include <cstdint>
namespace cg = cooperative_groups;

#define LAS __attribute__((address_space(3)))
typedef unsigned short bf16_t;
typedef short bf16x8 __attribute__((ext_vector_type(8)));
typedef float f32x4 __attribute__((ext_vector_type(4)));
typedef float f32x2 __attribute__((ext_vector_type(2)));
typedef unsigned u32x4 __attribute__((ext_vector_type(4)));
typedef unsigned u32x2 __attribute__((ext_vector_type(2)));

constexpr int NB = 8, SEQ = 4096, DM = 1024, CTX = 256;
constexpr int MLAT = NB * SEQ, MCTX = NB * CTX;
constexpr int NIN = 7168, NEXP = 16, DEXP = 2048, CAP = 512, EROWS = NB * CAP;
constexpr int LDZ = 7168, ZC_YG = 0, ZC_Q = 1024, ZC_XR = 2048, ZC_K = 3072, ZC_V = 4096, ZC_GR = 5120, ZC_GN = 6144;
constexpr int LDC = 3072, CC_XR = 0, CC_K = 1024, CC_V = 2048;
constexpr float LOG2E = 1.4426950408889634f;
constexpr float QSCALE = 0.125f * LOG2E;

constexpr size_t MiB = 1u << 20;
constexpr size_t WS_CTL = 0;
constexpr size_t WS_MOD = 1 * MiB;
constexpr size_t WS_MODP = 2 * MiB;
constexpr size_t WS_ROPE = 9 * MiB;
constexpr size_t WS_BINZ = 9 * MiB + 65536;
constexpr size_t WS_AFF = 10 * MiB;
constexpr size_t WS_SELIDX = 12 * MiB;
constexpr size_t WS_SELG = 12 * MiB + 262144;
constexpr size_t WS_SLOT = 13 * MiB;
constexpr size_t WS_WINT = 16 * MiB;
constexpr size_t WS_WMIX = 30 * MiB;
constexpr size_t WS_WOUT = 34 * MiB;
constexpr size_t WS_ZC = 36 * MiB;
constexpr size_t WS_XN = 48 * MiB;
constexpr size_t WS_Z = 116 * MiB;
constexpr size_t WS_WGU = 116 * MiB;
constexpr size_t WS_WD = 244 * MiB;
constexpr size_t WS_HID = 308 * MiB;
constexpr size_t WS_YE = 116 * MiB;
constexpr size_t WS_END = 564 * MiB;

constexpr int NTHREADS = 512, NWAVES = 8;
constexpr int LDS_BYTES = 147456;

__device__ __forceinline__ unsigned f2bf(float f) { unsigned u = __builtin_bit_cast(unsigned, f); return (u + 0x7fffu + ((u >> 16) & 1u)) >> 16; }
__device__ __forceinline__ float bf2f(unsigned h) { return __builtin_bit_cast(float, h << 16); }
__device__ __forceinline__ unsigned pk2(float lo, float hi) { return f2bf(lo) | (f2bf(hi) << 16); }
__device__ __forceinline__ unsigned cvt_pk_bf16(float lo, float hi) { unsigned r; asm volatile("v_cvt_pk_bf16_f32 %0, %1, %2" : "=v"(r) : "v"(lo), "v"(hi)); return r; }
__device__ __forceinline__ float wave_sum(float v) {
#pragma unroll
    for (int o = 1; o < 64; o <<= 1) v += __shfl_xor(v, o);
    return v;
}
__device__ __forceinline__ float sigmoidf_(float x) { return __builtin_amdgcn_rcpf(1.0f + __builtin_amdgcn_exp2f(-x * LOG2E)); }
__device__ __forceinline__ float gelu_tanh(float x) { const float u = 0.7978845608028654f * (x + 0.044715f * x * x * x); return x * __builtin_amdgcn_rcpf(1.0f + __builtin_amdgcn_exp2f(-2.0f * LOG2E * u)); }
#define LDS_WAIT() asm volatile("s_waitcnt lgkmcnt(0)" ::: "memory")

namespace pg8 {
constexpr int BM = 256, BK = 64, HALF = 128, HTB = HALF * BK * 2, STAGE_BYTES = 8 * HTB, NXCD = 8, WGM = 8;
__host__ __device__ __forceinline__ int lds_byte(int r, int c) { const int st = (r >> 4) * 2 + (c >> 5), rr = r & 15, cc = c & 31, ob = rr * 64 + cc * 2; return st * 1024 + (ob ^ (((ob >> 9) & 1) << 5)); }
__host__ __device__ __forceinline__ void stage_rc(int b, int& R, int& C) { const int st = b / 1024, sb = b % 1024, swz = sb ^ (((sb >> 9) & 1) << 5); R = (st >> 1) * 16 + swz / 64; C = (st & 1) * 32 + (swz % 64) / 2; }
__host__ __device__ __forceinline__ int perm32(int rho) { const int n = rho >> 4, i = rho & 15; return 8 * (i >> 2) + 4 * n + (i & 3); }

struct Unit { int pm, pb, x0, x1; };

__device__ __forceinline__ void tile_of(int L, int nM, int nN, int& pm, int& pn) {
    const int nwg = nM * nN; int wgid = L;
    { const int q = nwg / NXCD, r = nwg % NXCD, xcd = wgid % NXCD, off = wgid / NXCD; wgid = (xcd < r ? xcd * (q + 1) : r * (q + 1) + (xcd - r) * q) + off; }
    const int nig = WGM * nN, gid = wgid / nig, fm = gid * WGM, gsz = (nM - fm) < WGM ? (nM - fm) : WGM;
    pm = fm + ((wgid % nig) % gsz); pn = (wgid % nig) / gsz;
}

template <class Epi, class Sched>
__device__ __forceinline__ void gemm_phase(LAS unsigned char* lds, const Sched& S, const Epi& E) {
    const int tid = threadIdx.x, wid = __builtin_amdgcn_readfirstlane(tid >> 6), lane = tid & 63, wr = wid >> 2, wc = wid & 3, fr = lane & 15, fq = lane >> 4;
    const int K = S.K, nt = K / BK;
    int Rl[2], Cl[2];
    unsigned voffA[2][2], voffB[2];
#pragma unroll
    for (int i = 0; i < 2; ++i) { stage_rc(tid * 16 + i * 8192, Rl[i], Cl[i]); const int Rb = Epi::PERM ? ((Rl[i] & ~31) + perm32(Rl[i] & 31)) : Rl[i];
        voffB[i] = (unsigned)(Rb * S.ldb + Cl[i]) * 2u; }
    const size_t kstep = (size_t)(BK * 2);
    const size_t hstepB = (size_t)HALF * S.ldb * 2;
    const unsigned ldsw = (unsigned)wid * 1024u;
    const int aoff = lds_byte(wr * 64 + fr, fq * 8), boff = lds_byte(wc * 32 + fr, fq * 8);
#define PG8_SA(b, h) (((b) * 2 + (h)) * HTB)
#define PG8_SB(b, h) ((4 + (b) * 2 + (h)) * HTB)
#define PG8_STAGEB(bufoff, gbase) do { _Pragma("unroll") for (int _i = 0; _i < 2; ++_i) \
        __builtin_amdgcn_global_load_lds((const unsigned*)((const char*)(gbase) + voffB[_i]), (LAS unsigned*)(lds + (bufoff) + ldsw + _i * 8192), 16, 0, 0); } while (0)
#define PG8_STAGEA(bufoff, gbase, h, vo) do { _Pragma("unroll") for (int _i = 0; _i < 2; ++_i) \
        __builtin_amdgcn_global_load_lds((const unsigned*)((const char*)(gbase) + (vo)[h][_i]), (LAS unsigned*)(lds + (bufoff) + ldsw + _i * 8192), 16, 0, 0); } while (0)
#define PG8_LDA(dst, b, h) do { _Pragma("unroll") for (int m = 0; m < 4; ++m) _Pragma("unroll") for (int k = 0; k < 2; ++k) dst[m][k] = *(const LAS bf16x8*)(lds + PG8_SA(b, h) + aoff + m * 2048 + k * 1024); } while (0)
#define PG8_LDB(dst, b, h) do { _Pragma("unroll") for (int n = 0; n < 2; ++n) _Pragma("unroll") for (int k = 0; k < 2; ++k) dst[n][k] = *(const LAS bf16x8*)(lds + PG8_SB(b, h) + boff + n * 2048 + k * 1024); } while (0)
#define PG8_MMA(ai, bj, At, Bt) do { __builtin_amdgcn_s_setprio(1); _Pragma("unroll") for (int m = 0; m < 4; ++m) _Pragma("unroll") for (int n = 0; n < 2; ++n) _Pragma("unroll") for (int k = 0; k < 2; ++k) \
        acc[ai][bj][m][n] = __builtin_amdgcn_mfma_f32_16x16x32_bf16(Bt[n][k], At[m][k], acc[ai][bj][m][n], 0, 0, 0); __builtin_amdgcn_s_setprio(0); } while (0)
#define PG8_WAIT_V(n) asm volatile("s_waitcnt vmcnt(" #n ")" ::: "memory")
#define PG8_WAIT_L(n) asm volatile("s_waitcnt lgkmcnt(" #n ")" ::: "memory")
#define PG8_BAR __builtin_amdgcn_s_barrier()
#define PG8_SCHED __builtin_amdgcn_sched_barrier(0)
#define PG8_SETVO(vo, u) do { _Pragma("unroll") for (int _h = 0; _h < 2; ++_h) _Pragma("unroll") for (int _i = 0; _i < 2; ++_i) { \
        if constexpr (Sched::GATHER) (vo)[_h][_i] = (unsigned)(S.row_of(u, _h * HALF + Rl[_i]) * S.lda + Cl[_i]) * 2u; \
        else (vo)[_h][_i] = (unsigned)((_h * HALF + Rl[_i]) * S.lda + Cl[_i]) * 2u; } } while (0)
    Unit cur, nxt; int ui = 0;
    if (!S.next(0, cur)) return;
    f32x4 acc[2][2][4][2];
#pragma unroll
    for (int a = 0; a < 2; ++a)
#pragma unroll
        for (int b = 0; b < 2; ++b)
#pragma unroll
            for (int m = 0; m < 4; ++m)
#pragma unroll
                for (int n = 0; n < 2; ++n) acc[a][b][m][n] = (f32x4){0.f, 0.f, 0.f, 0.f};
    bf16x8 At[4][2], B0[2][2], B1[2][2];
    const char* cA = S.a_ptr(cur); const char* cB = S.b_ptr(cur);
    PG8_SETVO(voffA, cur);
    PG8_STAGEB(PG8_SB(0, 0), cB); PG8_STAGEB(PG8_SB(0, 1), cB + hstepB); PG8_STAGEA(PG8_SA(0, 0), cA, 0, voffA); PG8_STAGEA(PG8_SA(0, 1), cA, 1, voffA);
    if (wr == 1) PG8_BAR;
    PG8_WAIT_V(2); PG8_BAR;
    PG8_STAGEB(PG8_SB(1, 0), cB + kstep); PG8_STAGEA(PG8_SA(1, 0), cA + kstep, 0, voffA); PG8_STAGEB(PG8_SB(1, 1), cB + hstepB + kstep);
    PG8_WAIT_V(6); PG8_BAR;
    for (;;) {
        const bool has_next = S.next(ui + 1, nxt);
        const char* nA = has_next ? S.a_ptr(nxt) : cA; const char* nB = has_next ? S.b_ptr(nxt) : cB;
        for (int t = 0; t < nt; t += 2) {
            const bool last = (t == nt - 2);
            const char* a1 = cA + (size_t)(t + 1) * kstep;
            const char* a2 = last ? nA : cA + (size_t)(t + 2) * kstep; const char* b2 = last ? nB : cB + (size_t)(t + 2) * kstep;
            const char* a3 = a2 + kstep; const char* b3 = b2 + kstep;
            PG8_LDB(B0, 0, 0); PG8_LDB(B1, 0, 1); PG8_SCHED; PG8_LDA(At, 0, 0); PG8_STAGEA(PG8_SA(1, 1), a1, 1, voffA);
            if (last && has_next) { PG8_SETVO(voffA, nxt); }
            PG8_WAIT_V(8); PG8_WAIT_L(0); PG8_BAR; PG8_MMA(0, 0, At, B0); PG8_MMA(0, 1, At, B1); PG8_BAR; PG8_SCHED;
            PG8_LDA(At, 0, 1); PG8_STAGEB(PG8_SB(0, 0), b2); PG8_STAGEB(PG8_SB(0, 1), b2 + hstepB); PG8_STAGEA(PG8_SA(0, 0), a2, 0, voffA);
            PG8_WAIT_V(8); PG8_WAIT_L(0); PG8_BAR; PG8_MMA(1, 0, At, B0); PG8_MMA(1, 1, At, B1); PG8_BAR; PG8_SCHED;
            PG8_LDB(B0, 1, 0); PG8_LDB(B1, 1, 1); PG8_SCHED; PG8_LDA(At, 1, 0); PG8_STAGEA(PG8_SA(0, 1), a2, 1, voffA);
            PG8_WAIT_V(8); PG8_WAIT_L(0); PG8_BAR; PG8_MMA(0, 0, At, B0); PG8_MMA(0, 1, At, B1); PG8_BAR; PG8_SCHED;
            PG8_LDA(At, 1, 1); PG8_STAGEB(PG8_SB(1, 0), b3); PG8_STAGEB(PG8_SB(1, 1), b3 + hstepB); PG8_STAGEA(PG8_SA(1, 0), a3, 0, voffA);
            PG8_WAIT_V(8); PG8_WAIT_L(0); PG8_BAR; PG8_MMA(1, 0, At, B0); PG8_MMA(1, 1, At, B1); PG8_BAR; PG8_SCHED;
        }
        if (wr == 0) PG8_BAR;
        E(acc, cur, wr, wc, fr, fq);
        if (!has_next) break;
#pragma unroll
        for (int a = 0; a < 2; ++a)
#pragma unroll
            for (int b = 0; b < 2; ++b)
#pragma unroll
                for (int m = 0; m < 4; ++m)
#pragma unroll
                    for (int n = 0; n < 2; ++n) acc[a][b][m][n] = (f32x4){0.f, 0.f, 0.f, 0.f};
        cur = nxt; cA = nA; cB = nB; ++ui;
        if (wr == 1) PG8_BAR;
    }
    PG8_WAIT_V(0);
    PG8_BAR;
#undef PG8_SA
#undef PG8_SB
#undef PG8_STAGEA
#undef PG8_STAGEB
#undef PG8_LDA
#undef PG8_LDB
#undef PG8_MMA
#undef PG8_WAIT_V
#undef PG8_WAIT_L
#undef PG8_BAR
#undef PG8_SCHED
#undef PG8_SETVO
}
}

struct InprojSched {
    static constexpr bool GATHER = false;
    const bf16_t* XN; const bf16_t* W; int G, c; int lda, ldb, K;
    __device__ __forceinline__ bool next(int i, pg8::Unit& u) const {
        const int L = i * G + c;
        if (L < 128 * 28) { int pm, pn; pg8::tile_of(L, 128, 28, pm, pn); u.pm = pm; u.pb = pn; u.x0 = 0; u.x1 = 0; return true; }
        const int idx = L - 128 * 28; if (idx >= 96) return false;
        u.pm = 128 + (idx & 7); u.pb = 8 + (idx >> 3); u.x0 = 1; u.x1 = 0; return true;
    }
    __device__ __forceinline__ const char* a_ptr(const pg8::Unit& u) const { return (const char*)XN + (size_t)u.pm * 256 * 1024 * 2; }
    __device__ __forceinline__ const char* b_ptr(const pg8::Unit& u) const { return (const char*)W + (size_t)u.pb * 256 * 1024 * 2; }
    __device__ __forceinline__ int row_of(const pg8::Unit&, int r) const { return r; }
};
struct MixSched {
    static constexpr bool GATHER = false;
    const bf16_t* Z; const bf16_t* W; int G, c; int lda, ldb, K;
    __device__ __forceinline__ bool next(int i, pg8::Unit& u) const {
        const int L = (i >> 1) * G + c; if (L >= 128 * 4) return false;
        int pm, pn; pg8::tile_of(L, 128, 4, pm, pn); const int pass = i & 1;
        u.pm = pm; u.pb = pass * 4 + pn; u.x0 = pn; u.x1 = pass; return true;
    }
    __device__ __forceinline__ const char* a_ptr(const pg8::Unit& u) const { return (const char*)Z + ((size_t)u.pm * 256 * LDZ + (u.x1 ? ZC_Q : ZC_YG)) * 2; }
    __device__ __forceinline__ const char* b_ptr(const pg8::Unit& u) const { return (const char*)W + (size_t)u.pb * 256 * 1024 * 2; }
    __device__ __forceinline__ int row_of(const pg8::Unit&, int r) const { return r; }
};
struct WoutSched {
    static constexpr bool GATHER = false;
    const bf16_t* Z; const bf16_t* W; int G, c; int lda, ldb, K;
    __device__ __forceinline__ bool next(int i, pg8::Unit& u) const {
        const int L = i * G + c; if (L >= 128 * 4) return false;
        int pm, pn; pg8::tile_of(L, 128, 4, pm, pn); u.pm = pm; u.pb = pn; u.x0 = pn; u.x1 = 0; return true;
    }
    __device__ __forceinline__ const char* a_ptr(const pg8::Unit& u) const { return (const char*)Z + ((size_t)u.pm * 256 * LDZ + ZC_XR) * 2; }
    __device__ __forceinline__ const char* b_ptr(const pg8::Unit& u) const { return (const char*)W + (size_t)u.pb * 256 * 1024 * 2; }
    __device__ __forceinline__ int row_of(const pg8::Unit&, int r) const { return r; }
};
struct Moe1Sched {
    static constexpr bool GATHER = true;
    const bf16_t* XN2; const bf16_t* W; const int* selidx; int G, c; int lda, ldb, K;
    __device__ __forceinline__ bool next(int i, pg8::Unit& u) const {
        const int L = i * G + c; if (L >= 16 * 256) return false;
        const int e = L >> 8, w = L & 255, x = w & 7, j = w >> 3;
        const int mt = (x & 3) * 4 + (j & 3), nt = (x >> 2) * 8 + (j >> 2);
        u.pm = e * 16 + mt; u.pb = e * 16 + nt; u.x0 = nt; u.x1 = e; return true;
    }
    __device__ __forceinline__ const char* a_ptr(const pg8::Unit&) const { return (const char*)XN2; }
    __device__ __forceinline__ const char* b_ptr(const pg8::Unit& u) const { return (const char*)W + (size_t)u.pb * 256 * 1024 * 2; }
    __device__ __forceinline__ int row_of(const pg8::Unit& u, int r) const { return selidx[u.pm * 256 + r]; }
};
struct Moe2Sched {
    static constexpr bool GATHER = false;
    const bf16_t* HID; const bf16_t* W; int G, c; int lda, ldb, K;
    __device__ __forceinline__ bool next(int i, pg8::Unit& u) const {
        const int L = i * G + c; if (L >= 16 * 64) return false;
        const int e = L >> 6, w = L & 63, mt = w >> 2, pn = w & 3;
        u.pm = e * 16 + mt; u.pb = e * 4 + pn; u.x0 = pn; u.x1 = e; return true;
    }
    __device__ __forceinline__ const char* a_ptr(const pg8::Unit& u) const { return (const char*)HID + (size_t)u.pm * 256 * 2048 * 2; }
    __device__ __forceinline__ const char* b_ptr(const pg8::Unit& u) const { return (const char*)W + (size_t)u.pb * 256 * 2048 * 2; }
    __device__ __forceinline__ int row_of(const pg8::Unit&, int r) const { return r; }
};

typedef const f32x4 (&AccRef)[2][2][4][2];
struct EpiInproj {
    static constexpr bool PERM = true;
    bf16_t* Z; bf16_t* ZC; const float* binz; const float* rope;
    __device__ __forceinline__ void operator()(AccRef acc, const pg8::Unit& u, int wr, int wc, int fr, int fq) const {
        const bool isctx = u.x0 != 0;
        const int seg = u.pb >> 2, colt = u.pb * 256, cl = wc * 32 + 8 * fq;
        f32x4 bv[2][2];
#pragma unroll
        for (int bj = 0; bj < 2; ++bj)
#pragma unroll
            for (int n = 0; n < 2; ++n) bv[bj][n] = *(const f32x4*)(binz + colt + bj * 128 + cl + 4 * n);
        bf16_t* base; int ld, row0;
        if (!isctx) { base = Z + colt; ld = LDZ; row0 = u.pm * 256; } else { base = ZC + (colt - 2048); ld = LDC; row0 = (u.pm - 128) * 256; }
        const bool dorope = (seg == 1) || (seg == 3 && !isctx);
        const float qs = (seg == 1) ? QSCALE : 1.0f;
#pragma unroll
        for (int ai = 0; ai < 2; ++ai)
#pragma unroll
            for (int m = 0; m < 4; ++m) {
                const int r = row0 + ai * 128 + wr * 64 + m * 16 + fr;
                bf16_t* rowp = base + (size_t)r * ld + cl;
                f32x4 cs0 = (f32x4){1.f, 0.f, 1.f, 0.f}, cs1 = cs0;
                if (dorope) { const int t = r & 4095; const int pos = (wc & 1) ? (t & 63) : (t >> 6); const float* cp = rope + (pos * 16 + 4 * fq) * 2; cs0 = *(const f32x4*)cp; cs1 = *(const f32x4*)(cp + 4); }
#pragma unroll
                for (int bj = 0; bj < 2; ++bj) {
                    f32x4 v0 = acc[ai][bj][m][0] + bv[bj][0], v1 = acc[ai][bj][m][1] + bv[bj][1];
                    if (seg == 0) {
#pragma unroll
                        for (int j = 0; j < 4; ++j) { v0[j] = gelu_tanh(v0[j]); v1[j] = gelu_tanh(v1[j]); }
                    } else if (seg >= 5) {
#pragma unroll
                        for (int j = 0; j < 4; ++j) { v0[j] = sigmoidf_(v0[j]); v1[j] = sigmoidf_(v1[j]); }
                    } else if (dorope) {
                        const float c[4] = {cs0[0], cs0[2], cs1[0], cs1[2]}, s[4] = {cs0[1], cs0[3], cs1[1], cs1[3]};
#pragma unroll
                        for (int j = 0; j < 4; ++j) { const float x1 = v0[j], x2 = v1[j]; v0[j] = (x1 * c[j] - x2 * s[j]) * qs; v1[j] = (x1 * s[j] + x2 * c[j]) * qs; }
                    }
                    u32x4 w; w.x = cvt_pk_bf16(v0[0], v0[1]); w.y = cvt_pk_bf16(v0[2], v0[3]); w.z = cvt_pk_bf16(v1[0], v1[1]); w.w = cvt_pk_bf16(v1[2], v1[3]);
                    *(u32x4*)(rowp + bj * 128) = w;
                }
            }
    }
};
struct EpiMix {
    static constexpr bool PERM = true;
    bf16_t* Z;
    __device__ __forceinline__ void operator()(AccRef acc, const pg8::Unit& u, int wr, int wc, int fr, int fq) const {
        const int pass = u.x1, colt = u.x0 * 256, cl = wc * 32 + 8 * fq;
        const int gcol = (pass ? ZC_GN : ZC_GR) + colt + cl, ocol = ZC_XR + colt + cl;
        const int r0 = u.pm * 256 + wr * 64 + fr;
#pragma unroll
        for (int ai = 0; ai < 2; ++ai)
#pragma unroll
            for (int m = 0; m < 4; ++m) {
                bf16_t* rowz = Z + (size_t)(r0 + ai * 128 + m * 16) * LDZ;
#pragma unroll
                for (int bj = 0; bj < 2; ++bj) {
                    const u32x4 g = *(const u32x4*)(rowz + gcol + bj * 128);
                    f32x4 v0 = acc[ai][bj][m][0] * (f32x4){bf2f(g.x & 0xffffu), bf2f(g.x >> 16), bf2f(g.y & 0xffffu), bf2f(g.y >> 16)};
                    f32x4 v1 = acc[ai][bj][m][1] * (f32x4){bf2f(g.z & 0xffffu), bf2f(g.z >> 16), bf2f(g.w & 0xffffu), bf2f(g.w >> 16)};
                    if (pass) { const u32x4 t = *(const u32x4*)(rowz + ocol + bj * 128);
                        v0 += (f32x4){bf2f(t.x & 0xffffu), bf2f(t.x >> 16), bf2f(t.y & 0xffffu), bf2f(t.y >> 16)};
                        v1 += (f32x4){bf2f(t.z & 0xffffu), bf2f(t.z >> 16), bf2f(t.w & 0xffffu), bf2f(t.w >> 16)}; }
                    u32x4 w; w.x = cvt_pk_bf16(v0[0], v0[1]); w.y = cvt_pk_bf16(v0[2], v0[3]); w.z = cvt_pk_bf16(v1[0], v1[1]); w.w = cvt_pk_bf16(v1[2], v1[3]);
                    *(u32x4*)(rowz + ocol + bj * 128) = w;
                }
            }
    }
};
struct EpiWout {
    static constexpr bool PERM = false;
    const float* x; float* out; const float* mod;
    __device__ __forceinline__ void operator()(AccRef acc, const pg8::Unit& u, int wr, int wc, int fr, int fq) const {
        const int col0 = u.x0 * 256 + wc * 32 + 4 * fq;
        const float* g1p = mod + (size_t)(u.pm >> 4) * 6144 + 2048 + col0;
        f32x4 gv[2][2];
#pragma unroll
        for (int bj = 0; bj < 2; ++bj)
#pragma unroll
            for (int n = 0; n < 2; ++n) gv[bj][n] = *(const f32x4*)(g1p + bj * 128 + n * 16);
#pragma unroll
        for (int ai = 0; ai < 2; ++ai)
#pragma unroll
            for (int m = 0; m < 4; ++m) {
                const size_t off = (size_t)(u.pm * 256 + ai * 128 + wr * 64 + m * 16 + fr) * DM + col0;
#pragma unroll
                for (int bj = 0; bj < 2; ++bj)
#pragma unroll
                    for (int n = 0; n < 2; ++n) { const f32x4 xv = *(const f32x4*)(x + off + bj * 128 + n * 16); *(f32x4*)(out + off + bj * 128 + n * 16) = xv + gv[bj][n] * acc[ai][bj][m][n]; }
            }
    }
};
struct EpiMoe1 {
    static constexpr bool PERM = true;
    bf16_t* HID;
    __device__ __forceinline__ void operator()(AccRef acc, const pg8::Unit& u, int wr, int wc, int fr, int fq) const {
        const int col0 = u.x0 * 128 + wc * 32 + 8 * fq;
#pragma unroll
        for (int ai = 0; ai < 2; ++ai)
#pragma unroll
            for (int m = 0; m < 4; ++m) {
                const size_t r = (size_t)u.pm * 256 + ai * 128 + wr * 64 + m * 16 + fr;
                f32x4 h0, h1;
#pragma unroll
                for (int j = 0; j < 4; ++j) { const float g0 = acc[ai][0][m][0][j], g1 = acc[ai][0][m][1][j];
                    h0[j] = g0 * sigmoidf_(g0) * acc[ai][1][m][0][j]; h1[j] = g1 * sigmoidf_(g1) * acc[ai][1][m][1][j]; }
                u32x4 w; w.x = cvt_pk_bf16(h0[0], h0[1]); w.y = cvt_pk_bf16(h0[2], h0[3]); w.z = cvt_pk_bf16(h1[0], h1[1]); w.w = cvt_pk_bf16(h1[2], h1[3]);
                *(u32x4*)(HID + r * DEXP + col0) = w;
            }
    }
};
struct EpiMoe2 {
    static constexpr bool PERM = true;
    bf16_t* YE; const float* selg;
    __device__ __forceinline__ void operator()(AccRef acc, const pg8::Unit& u, int wr, int wc, int fr, int fq) const {
        const int col0 = u.x0 * 256 + wc * 32 + 8 * fq;
#pragma unroll
        for (int ai = 0; ai < 2; ++ai)
#pragma unroll
            for (int m = 0; m < 4; ++m) {
                const size_t r = (size_t)u.pm * 256 + ai * 128 + wr * 64 + m * 16 + fr;
                const float g = selg[r];
#pragma unroll
                for (int bj = 0; bj < 2; ++bj) {
                    const f32x4 v0 = acc[ai][bj][m][0] * g, v1 = acc[ai][bj][m][1] * g;
                    u32x4 w; w.x = cvt_pk_bf16(v0[0], v0[1]); w.y = cvt_pk_bf16(v0[2], v0[3]); w.z = cvt_pk_bf16(v1[0], v1[1]); w.w = cvt_pk_bf16(v1[2], v1[3]);
                    *(u32x4*)(YE + r * DM + col0 + bj * 128) = w;
                }
            }
    }
};

struct Params {
    const float *x, *c, *ctx, *c_ctx, *w_mod, *b_mod, *w_in, *b_in, *conv_w, *conv_b, *lru_wa, *lru_ba, *lru_wi, *lru_bi, *lru_lambda, *na_rpb,
                *w_proj_rnn, *w_proj_na, *w_out, *w_router, *w_exp_gate, *w_exp_up, *w_exp_down, *final_norm;
    float* out; unsigned char* ws;
    int ph_lo, ph_hi;
};

__device__ __forceinline__ int zcol_of(int n) {
    const int seg = n >> 10, o = n & 1023;
    if (seg == 0) return ZC_YG + o;
    if (seg == 1) return ZC_XR + o;
    if (seg == 4) return ZC_V + o;
    if (seg == 5) return ZC_GR + o;
    if (seg == 6) return ZC_GN + o;
    const int hh = o >> 6, d = o & 63, g2 = d >> 5, dd = d & 31, nn = dd >> 4, j = dd & 15, a = j >> 2, jj = j & 3;
    return (seg == 2 ? ZC_Q : ZC_K) + hh * 64 + g2 * 32 + 8 * a + 4 * nn + jj;
}
template <class RowMap>
__device__ __forceinline__ void transpose_item(const float* W, int ldw, int k0, int n0, bf16_t* WT, int ldk, RowMap rowmap, LAS float* scr, int lane) {
#pragma unroll 8
    for (int i = 0; i < 32; ++i) { const int kk = 2 * i + (lane >> 5); scr[kk * 33 + (lane & 31)] = W[(size_t)(k0 + kk) * ldw + n0 + (lane & 31)]; }
    LDS_WAIT(); asm volatile("" ::: "memory");
    const int c = lane & 7;
#pragma unroll
    for (int j = 0; j < 4; ++j) { const int n = (lane >> 3) + 8 * j; const LAS float* s = scr + (8 * c) * 33 + n;
        u32x4 o; o.x = pk2(s[0 * 33], s[1 * 33]); o.y = pk2(s[2 * 33], s[3 * 33]); o.z = pk2(s[4 * 33], s[5 * 33]); o.w = pk2(s[6 * 33], s[7 * 33]);
        *(u32x4*)(WT + (size_t)rowmap(n0 + n) * ldk + k0 + 8 * c) = o; }
    LDS_WAIT(); asm volatile("" ::: "memory");
}
__device__ __forceinline__ void phase_prep(const Params& p, LAS unsigned char* lds) {
    const int tid = threadIdx.x, lane = tid & 63, wave = tid >> 6, G = gridDim.x;
    unsigned char* ws = p.ws;
    {
        LAS float* scr = (LAS float*)(lds + wave * 16384);
        bf16_t* WINT = (bf16_t*)(ws + WS_WINT); bf16_t* WMIX = (bf16_t*)(ws + WS_WMIX); bf16_t* WOUT = (bf16_t*)(ws + WS_WOUT);
        const int gw = blockIdx.x * NWAVES + wave, NGW = G * NWAVES;
        constexpr int I_IN = 16 * (NIN / 32), I_P = 16 * 32;
        for (int it = gw; it < I_IN + 3 * I_P; it += NGW) {
            int r = it;
            if (r < I_IN) { const int nblk = NIN / 32, kb = r / nblk, nb = r % nblk; transpose_item(p.w_in, NIN, 64 * kb, 32 * nb, WINT, 1024, [](int n) { return zcol_of(n); }, scr, lane); continue; } r -= I_IN;
            const int kb = (r % I_P) / 32, nb = (r % I_P) % 32, which = r / I_P;
            if (which == 0) transpose_item(p.w_proj_rnn, 1024, 64 * kb, 32 * nb, WMIX, 1024, [](int n) { return n; }, scr, lane);
            else if (which == 1) transpose_item(p.w_proj_na, 1024, 64 * kb, 32 * nb, WMIX, 1024, [](int n) { return 1024 + n; }, scr, lane);
            else transpose_item(p.w_out, 1024, 64 * kb, 32 * nb, WOUT, 1024, [](int n) { return n; }, scr, lane);
        }
    }
    __syncthreads();
    {
        LAS float* sS = (LAS float*)lds;
        float* MODP = (float*)(ws + WS_MODP);
        for (int it = blockIdx.x; it < 24 * 16; it += G) {
            const int nb = it % 24, kc = it / 24, k0 = kc * 64;
            for (int e = tid; e < 9 * 64; e += NTHREADS) { const int r = e >> 6, k = e & 63; const float v = (r < 8) ? p.c[r * 1024 + k0 + k] : p.c_ctx[k0 + k]; sS[e] = v * sigmoidf_(v); }
            __syncthreads();
            const int n = nb * 256 + (tid & 255), kh = tid >> 8;
            float a[9];
#pragma unroll
            for (int r = 0; r < 9; ++r) a[r] = 0.f;
            for (int k = 0; k < 32; ++k) { const int kk = kh * 32 + k; const float w = p.w_mod[(size_t)(k0 + kk) * 6144 + n];
#pragma unroll
                for (int r = 0; r < 9; ++r) a[r] += sS[r * 64 + kk] * w; }
#pragma unroll
            for (int r = 0; r < 9; ++r) MODP[((size_t)(kc * 2 + kh) * 9 + r) * 6144 + n] = a[r];
            __syncthreads();
        }
    }
    {
        float* ROPE = (float*)(ws + WS_ROPE); float* BINZ = (float*)(ws + WS_BINZ);
        const int gt = blockIdx.x * NTHREADS + tid, NGT = G * NTHREADS;
        for (int e = gt; e < 64 * 16; e += NGT) { const int pos = e >> 4, j = e & 15; const float inv = powf(10000.0f, -(float)j / 16.0f); const float ang = (float)pos * inv; ROPE[2 * e] = cosf(ang); ROPE[2 * e + 1] = sinf(ang); }
        for (int n = gt; n < NIN; n += NGT) BINZ[zcol_of(n)] = p.b_in[n];
    }
}

__device__ __forceinline__ void norm_row_to_bf16(const float* xrow, bf16_t* orow, const LAS float* sh, const LAS float* sc, int lane) {
    const f32x4* xr = (const f32x4*)xrow + lane;
    f32x4 v[4]; float s = 0.f;
#pragma unroll
    for (int j = 0; j < 4; ++j) { v[j] = xr[64 * j]; s += (v[j].x * v[j].x + v[j].y * v[j].y) + (v[j].z * v[j].z + v[j].w * v[j].w); }
    const float rs = 1.0f / sqrtf(wave_sum(s) * (1.0f / DM) + 1e-6f);
    unsigned long long* o8 = (unsigned long long*)orow + lane;
#pragma unroll
    for (int j = 0; j < 4; ++j) { const int c0 = 4 * lane + 256 * j; const f32x4 hh = *(const LAS f32x4*)(sh + c0), cc = *(const LAS f32x4*)(sc + c0);
        const f32x4 y = v[j] * rs * (cc + 1.0f) + hh;
        o8[64 * j] = (unsigned long long)pk2(y.x, y.y) | ((unsigned long long)pk2(y.z, y.w) << 32); }
}
__device__ __forceinline__ void phase_norm1(const Params& p, LAS unsigned char* lds) {
    const int tid = threadIdx.x, lane = tid & 63, wave = tid >> 6, G = gridDim.x;
    unsigned char* ws = p.ws;
    const float* MODP = (const float*)(ws + WS_MODP); float* MOD = (float*)(ws + WS_MOD);
    for (int e = blockIdx.x * NTHREADS + tid; e < 9 * 6144; e += G * NTHREADS) { const int r = e / 6144, n = e % 6144; float s = p.b_mod[n];
        for (int k = 0; k < 32; ++k) s += MODP[((size_t)k * 9 + r) * 6144 + n]; MOD[e] = s; }
    LAS float* sh = (LAS float*)lds; LAS float* sc = sh + 1024;
    bf16_t* XN = (bf16_t*)(ws + WS_XN);
    for (int it = blockIdx.x; it < 256 + 8; it += G) {
        const bool isctx = it >= 256; const int mr = isctx ? 8 : (it >> 5);
        __syncthreads();
        for (int e = tid; e < 2048; e += NTHREADS) { float s = p.b_mod[e];
            for (int k = 0; k < 32; ++k) s += MODP[((size_t)k * 9 + mr) * 6144 + e]; sh[e] = s; }
        __syncthreads();
        const int nrows = isctx ? 256 : 128;
        for (int r = wave; r < nrows; r += NWAVES) {
            if (!isctx) { const size_t row = (size_t)it * 128 + r; norm_row_to_bf16(p.x + row * DM, XN + row * DM, sh, sc, lane); }
            else { const size_t row = (size_t)(it - 256) * 256 + r; norm_row_to_bf16(p.ctx + row * DM, XN + ((size_t)MLAT + row) * DM, sh, sc, lane); }
        }
    }
}

typedef float f32x16 __attribute__((ext_vector_type(16)));
constexpr int RN_XS = 144;
constexpr int RN_XC = 0, RN_WT = 256 * RN_XS, RN_SEG = RN_WT + 64 * RN_XS;
__device__ __forceinline__ void phase_rnn(const Params& p, LAS unsigned char* lds) {
    const int tid = threadIdx.x, lane = tid & 63, wave = __builtin_amdgcn_readfirstlane(tid >> 6), G = gridDim.x;
    unsigned char* ws = p.ws;
    bf16_t* Z = (bf16_t*)(ws + WS_Z); const bf16_t* ZCb = (const bf16_t*)(ws + WS_ZC); bf16_t* HF = (bf16_t*)(ws + WS_XN);
    LAS unsigned char* xcb = lds + RN_XC;
    LAS unsigned char* wtb = lds + RN_WT;
    LAS float* segA = (LAS float*)(lds + RN_SEG);
    LAS float* segB = segA + 512;
    const int c = lane & 31, hh = lane >> 5;
    const int taur = 16 * ((c >> 2) & 1) + 4 * (c >> 3) + (c & 3);
    for (int it = blockIdx.x; it < 256; it += G) {
        const int b = it >> 5, g = (it >> 1) & 15, half = it & 1;
        const int ch = 64 * g + 32 * half + c;
        const int tt = tid >> 1, cb = 64 * g + 32 * (tid & 1);
        for (int dir = 0; dir < 2; ++dir) {
            __syncthreads();
            for (int e = tid; e < 2 * 64 * 32; e += NTHREADS) { const int mat = e >> 11, i = (e >> 5) & 63, cc = e & 31;
                const float* src = mat ? p.lru_wi : p.lru_wa;
                *(LAS bf16_t*)(wtb + (mat * 32 + cc) * RN_XS + i * 2) = (bf16_t)f2bf(src[(((size_t)dir * 16 + g) * 64 + i) * 64 + 32 * half + cc]); }
            __syncthreads();
            bf16x8 Bw[2][4];
#pragma unroll
            for (int mat = 0; mat < 2; ++mat)
#pragma unroll
                for (int s4 = 0; s4 < 4; ++s4) Bw[mat][s4] = *(const LAS bf16x8*)(wtb + (mat * 32 + c) * RN_XS + (16 * s4 + 8 * hh) * 2);
            const float ba = p.lru_ba[dir * 1024 + ch], bi = p.lru_bi[dir * 1024 + ch];
            const float lam = p.lru_lambda[dir * 1024 + ch];
            const float sp = (lam > 15.f) ? expf(-lam) : log1pf(expf(-lam));
            const float clam = -8.0f * sp * LOG2E;
            float hc = 0.f;
            for (int step = 0; step < 17; ++step) {
                const bool isctx = (step == 0);
                const int kchunk = isctx ? 0 : (dir == 0 ? step - 1 : 16 - step);
                const int t0 = kchunk * 256, len = isctx ? CTX : SEQ;
                const bf16_t* src = isctx ? (ZCb + (size_t)b * CTX * LDC + CC_XR) : (Z + (size_t)b * SEQ * LDZ + ZC_XR);
                const int ld = isctx ? LDC : LDZ;
                __syncthreads();
                {
                    float a[32];
#pragma unroll
                    for (int j = 0; j < 32; ++j) a[j] = p.conv_b[cb + j];
#pragma unroll
                    for (int k = 0; k < 4; ++k) { const int ts = t0 + tt + k - 2;
                        if (ts >= 0 && ts < len) { const u32x4* rp = (const u32x4*)(src + (size_t)ts * ld + cb);
#pragma unroll
                            for (int q = 0; q < 4; ++q) { const u32x4 w = rp[q]; const float* cw = p.conv_w + k * 1024 + cb + 8 * q;
                                a[8 * q + 0] += bf2f(w.x & 0xffffu) * cw[0]; a[8 * q + 1] += bf2f(w.x >> 16) * cw[1]; a[8 * q + 2] += bf2f(w.y & 0xffffu) * cw[2]; a[8 * q + 3] += bf2f(w.y >> 16) * cw[3];
                                a[8 * q + 4] += bf2f(w.z & 0xffffu) * cw[4]; a[8 * q + 5] += bf2f(w.z >> 16) * cw[5]; a[8 * q + 6] += bf2f(w.w & 0xffffu) * cw[6]; a[8 * q + 7] += bf2f(w.w >> 16) * cw[7]; } } }
                    LAS u32x4* dst = (LAS u32x4*)(xcb + tt * RN_XS + 64 * (tid & 1));
#pragma unroll
                    for (int q = 0; q < 4; ++q) { u32x4 w; w.x = cvt_pk_bf16(a[8 * q], a[8 * q + 1]); w.y = cvt_pk_bf16(a[8 * q + 2], a[8 * q + 3]); w.z = cvt_pk_bf16(a[8 * q + 4], a[8 * q + 5]); w.w = cvt_pk_bf16(a[8 * q + 6], a[8 * q + 7]); dst[q] = w; }
                }
                __syncthreads();
                f32x16 ar, ai;
#pragma unroll
                for (int j = 0; j < 16; ++j) { ar[j] = 0.f; ai[j] = 0.f; }
                const LAS unsigned char* arow = xcb + (32 * wave + taur) * RN_XS + 16 * hh;
#pragma unroll
                for (int s4 = 0; s4 < 4; ++s4) { const bf16x8 af = *(const LAS bf16x8*)(arow + 32 * s4);
                    ar = __builtin_amdgcn_mfma_f32_32x32x16_bf16(af, Bw[0][s4], ar, 0, 0, 0);
                    ai = __builtin_amdgcn_mfma_f32_32x32x16_bf16(af, Bw[1][s4], ai, 0, 0, 0); }
                const LAS unsigned char* xcol = xcb + (32 * wave + 16 * hh) * RN_XS + (32 * half + c) * 2;
#pragma unroll
                for (int j = 0; j < 16; ++j) {
                    const float r = sigmoidf_(ar[j] + ba), ig = sigmoidf_(ai[j] + bi);
                    const float l2 = r * clam;
                    const float a = __builtin_amdgcn_exp2f(l2);
                    const float om = -expm1f(2.0f * 0.6931471805599453f * l2);
                    const float xv = bf2f(*(const LAS bf16_t*)(xcol + j * RN_XS));
                    ar[j] = a; ai[j] = sqrtf(fmaxf(om, 0.f)) * ig * xv;
                }
                float P = 1.f, H = 0.f;
                if (dir == 0) {
#pragma unroll
                    for (int j = 0; j < 16; ++j) { H = ar[j] * H + ai[j]; P *= ar[j]; }
                } else {
#pragma unroll
                    for (int j = 15; j >= 0; --j) { H = ar[j] * H + ai[j]; P *= ar[j]; }
                }
                const int s = 2 * wave + hh;
                segA[s * 32 + c] = P; segB[s * 32 + c] = H;
                __syncthreads();
                float h = hc, hin = 0.f;
                if (dir == 0) { for (int q = 0; q < 16; ++q) { if (q == s) hin = h; h = segA[q * 32 + c] * h + segB[q * 32 + c]; } }
                else { for (int q = 15; q >= 0; --q) { if (q == s) hin = h; h = segA[q * 32 + c] * h + segB[q * 32 + c]; } }
                hc = h;
                if (!isctx) {
                    const size_t tb = (size_t)b * SEQ + t0 + 32 * wave + 16 * hh;
                    h = hin;
                    if (dir == 0) {
#pragma unroll
                        for (int j = 0; j < 16; ++j) { h = ar[j] * h + ai[j]; HF[(tb + j) * DM + ch] = (bf16_t)f2bf(h); }
                    } else {
#pragma unroll
                        for (int j = 15; j >= 0; --j) { h = ar[j] * h + ai[j];
                            const float hf = bf2f(HF[(tb + j) * DM + ch]); bf16_t* yp = Z + (tb + j) * LDZ + ZC_YG + ch;
                            *yp = (bf16_t)f2bf((hf + h) * bf2f(*yp)); }
                    }
                }
            }
        }
    }
}

constexpr int AT_KS = 144, AT_VS = 160, AT_KB = 64 * AT_KS, AT_VB = 64 * AT_VS, AT_SLOT = AT_KB + AT_VB, AT_BIAS = 2 * AT_SLOT;
typedef short s16x4 __attribute__((ext_vector_type(4)));
struct QBlk { bf16x8 q[2]; f32x4 o[4]; float m, l; };
template <bool LOCAL>
__device__ __forceinline__ void attn_proc32(QBlk& S, const LAS unsigned char* Kc, const LAS unsigned char* Vc, int kc0, int lane, int lo, const LAS float* brow, int dc0) {
    const int i = lane & 15, kq = lane >> 4;
    f32x4 s0 = (f32x4){0.f, 0.f, 0.f, 0.f}, s1 = s0;
#pragma unroll
    for (int ks = 0; ks < 2; ++ks) {
        const bf16x8 a0 = *(const LAS bf16x8*)(Kc + (kc0 + i) * AT_KS + ks * 64 + kq * 16);
        const bf16x8 a1 = *(const LAS bf16x8*)(Kc + (kc0 + 16 + i) * AT_KS + ks * 64 + kq * 16);
        s0 = __builtin_amdgcn_mfma_f32_16x16x32_bf16(a0, S.q[ks], s0, 0, 0, 0);
        s1 = __builtin_amdgcn_mfma_f32_16x16x32_bf16(a1, S.q[ks], s1, 0, 0, 0);
    }
    if (LOCAL) {
#pragma unroll
        for (int r = 0; r < 4; ++r) {
            const int d0 = min(max(dc0 + r, 0), 30), d1 = min(max(dc0 + 16 + r, 0), 30);
            const float b0 = brow[d0], b1 = brow[d1];
            s0[r] = (r >= lo && r < lo + 16) ? s0[r] + b0 : -1e30f;
            s1[r] = (16 + r >= lo && 16 + r < lo + 16) ? s1[r] + b1 : -1e30f;
        }
    }
    float mc = fmaxf(fmaxf(fmaxf(s0[0], s0[1]), fmaxf(s0[2], s0[3])), fmaxf(fmaxf(s1[0], s1[1]), fmaxf(s1[2], s1[3])));
    mc = fmaxf(mc, __shfl_xor(mc, 16)); mc = fmaxf(mc, __shfl_xor(mc, 32));
    const float mn = fmaxf(S.m, mc), alpha = __builtin_amdgcn_exp2f(S.m - mn);
    S.m = mn;
    float ps = 0.f;
#pragma unroll
    for (int r = 0; r < 4; ++r) { s0[r] = __builtin_amdgcn_exp2f(s0[r] - mn); s1[r] = __builtin_amdgcn_exp2f(s1[r] - mn); ps += s0[r] + s1[r]; }
    S.l = S.l * alpha + ps;
    bf16x8 pb;
    { const unsigned w0 = cvt_pk_bf16(s0[0], s0[1]), w1 = cvt_pk_bf16(s0[2], s0[3]), w2 = cvt_pk_bf16(s1[0], s1[1]), w3 = cvt_pk_bf16(s1[2], s1[3]);
      const u32x4 w = (u32x4){w0, w1, w2, w3}; pb = __builtin_bit_cast(bf16x8, w); }
    const LAS unsigned char* vp = Vc + (kc0 + 4 * kq + ((lane & 15) >> 2)) * AT_VS + (lane & 3) * 8;
#pragma unroll
    for (int dt = 0; dt < 4; ++dt) {
        const s16x4 lo4 = __builtin_bit_cast(s16x4, __builtin_amdgcn_ds_read_tr16_b64_v4i16((LAS s16x4*)(vp + dt * 32)));
        const s16x4 hi4 = __builtin_bit_cast(s16x4, __builtin_amdgcn_ds_read_tr16_b64_v4i16((LAS s16x4*)(vp + dt * 32 + 16 * AT_VS)));
        const bf16x8 av = (bf16x8){lo4[0], lo4[1], lo4[2], lo4[3], hi4[0], hi4[1], hi4[2], hi4[3]};
        S.o[dt] = __builtin_amdgcn_mfma_f32_16x16x32_bf16(av, pb, S.o[dt] * alpha, 0, 0, 0);
    }
}
__device__ __forceinline__ void phase_attn(const Params& p, LAS unsigned char* lds) {
    const int tid = threadIdx.x, lane = tid & 63, wave = __builtin_amdgcn_readfirstlane(tid >> 6), G = gridDim.x;
    unsigned char* ws = p.ws;
    bf16_t* Z = (bf16_t*)(ws + WS_Z); const bf16_t* ZCb = (const bf16_t*)(ws + WS_ZC);
    LAS float* btab = (LAS float*)(lds + AT_BIAS);
    const int j = wave & 3, c16 = lane & 15, fq = lane >> 4;
    const int cq = 16 * j + c16, cst = min(max(cq - 8, 0), 48), kst = min(max(16 * j - 8, 0), 32);
    const int lo = cst - kst - 4 * fq;
    const int dc0 = kst + 4 * fq - cq + 15;
    const int lkey = tid >> 3, lpc = tid & 7;
    for (int u = blockIdx.x; u < NB * 16 * 16; u += G) {
        const int b = u >> 8, h = (u >> 4) & 15, r0 = 4 * (u & 15);
        const int kr_lo = min(max(r0 - 4, 0), 56), kr_hi = min(max(r0 - 1, 0), 56) + 7, nloc = kr_hi - kr_lo + 1, nch = nloc + 4;
        const int rA = r0 + (wave >> 2), rB = rA + 2, rsA = min(max(rA - 4, 0), 56), rsB = min(max(rB - 4, 0), 56);
        bf16_t* qA = Z + ((size_t)b * SEQ + rA * 64 + cq) * LDZ + ZC_Q + h * 64;
        bf16_t* qB = Z + ((size_t)b * SEQ + rB * 64 + cq) * LDZ + ZC_Q + h * 64;
        QBlk A, Bq;
#pragma unroll
        for (int ks = 0; ks < 2; ++ks) { A.q[ks] = *(const bf16x8*)(qA + ks * 32 + fq * 8); Bq.q[ks] = *(const bf16x8*)(qB + ks * 32 + fq * 8); }
#pragma unroll
        for (int dt = 0; dt < 4; ++dt) { A.o[dt] = (f32x4){0.f, 0.f, 0.f, 0.f}; Bq.o[dt] = (f32x4){0.f, 0.f, 0.f, 0.f}; }
        A.m = -1e30f; A.l = 0.f; Bq.m = -1e30f; Bq.l = 0.f;
        for (int e = tid; e < 15 * 31; e += NTHREADS) btab[e] = p.na_rpb[(size_t)h * 465 + e] * LOG2E;
        const bf16_t* kbase = Z + ((size_t)b * SEQ + lkey) * LDZ + ZC_K + h * 64 + lpc * 8;
        const bf16_t* cbase = ZCb + ((size_t)b * CTX + lkey) * LDC + CC_K + h * 64 + lpc * 8;
        u32x4 kreg, vreg;
        { const bf16_t* src = kbase + (size_t)kr_lo * 64 * LDZ; kreg = *(const u32x4*)src; vreg = *(const u32x4*)(src + (ZC_V - ZC_K)); }
        *(LAS u32x4*)(lds + lkey * AT_KS + lpc * 16) = kreg; *(LAS u32x4*)(lds + AT_KB + lkey * AT_VS + lpc * 16) = vreg;
        __syncthreads();
        for (int c = 0; c < nch; ++c) {
            if (c + 1 < nch) {
                if (c + 1 < nloc) { const bf16_t* src = kbase + (size_t)(kr_lo + c + 1) * 64 * LDZ; kreg = *(const u32x4*)src; vreg = *(const u32x4*)(src + (ZC_V - ZC_K)); }
                else { const bf16_t* src = cbase + (size_t)(c + 1 - nloc) * 64 * LDC; kreg = *(const u32x4*)src; vreg = *(const u32x4*)(src + (CC_V - CC_K)); }
            }
            const LAS unsigned char* Kc = lds + (c & 1) * AT_SLOT; const LAS unsigned char* Vc = Kc + AT_KB;
            if (c < nloc) {
                const int kr = kr_lo + c;
                if (kr >= rsA && kr < rsA + 8) attn_proc32<true>(A, Kc, Vc, kst, lane, lo, btab + (kr - rA + 7) * 31, dc0);
                if (kr >= rsB && kr < rsB + 8) attn_proc32<true>(Bq, Kc, Vc, kst, lane, lo, btab + (kr - rB + 7) * 31, dc0);
            } else {
                attn_proc32<false>(A, Kc, Vc, 0, lane, 0, btab, 0); attn_proc32<false>(A, Kc, Vc, 32, lane, 0, btab, 0);
                attn_proc32<false>(Bq, Kc, Vc, 0, lane, 0, btab, 0); attn_proc32<false>(Bq, Kc, Vc, 32, lane, 0, btab, 0);
            }
            if (c + 1 < nch) { LAS unsigned char* d = lds + ((c + 1) & 1) * AT_SLOT; *(LAS u32x4*)(d + lkey * AT_KS + lpc * 16) = kreg; *(LAS u32x4*)(d + AT_KB + lkey * AT_VS + lpc * 16) = vreg; }
            __syncthreads();
        }
        {
            float l = A.l; l += __shfl_xor(l, 16); l += __shfl_xor(l, 32); const float il = 1.0f / l;
#pragma unroll
            for (int dt = 0; dt < 4; ++dt) { const f32x4 o = A.o[dt] * il; u32x2 w; w.x = cvt_pk_bf16(o[0], o[1]); w.y = cvt_pk_bf16(o[2], o[3]); *(u32x2*)(qA + dt * 16 + fq * 4) = w; }
            l = Bq.l; l += __shfl_xor(l, 16); l += __shfl_xor(l, 32); const float il2 = 1.0f / l;
#pragma unroll
            for (int dt = 0; dt < 4; ++dt) { const f32x4 o = Bq.o[dt] * il2; u32x2 w; w.x = cvt_pk_bf16(o[0], o[1]); w.y = cvt_pk_bf16(o[2], o[3]); *(u32x2*)(qB + dt * 16 + fq * 4) = w; }
        }
    }
}

__device__ __forceinline__ void phase_norm2(const Params& p, LAS unsigned char* lds) {
    const int tid = threadIdx.x, lane = tid & 63, wave = tid >> 6, G = gridDim.x;
    unsigned char* ws = p.ws;
    const float* MOD = (const float*)(ws + WS_MOD); bf16_t* XN2 = (bf16_t*)(ws + WS_XN); float* AFF = (float*)(ws + WS_AFF);
    const int gw = blockIdx.x * NWAVES + wave, NGW = G * NWAVES;
    for (int row = gw; row < MLAT; row += NGW) {
        const int b = row >> 12;
        const f32x4* xr = (const f32x4*)(p.out + (size_t)row * DM) + lane;
        f32x4 v[4]; float s = 0.f;
#pragma unroll
        for (int j = 0; j < 4; ++j) { v[j] = xr[64 * j]; s += (v[j].x * v[j].x + v[j].y * v[j].y) + (v[j].z * v[j].z + v[j].w * v[j].w); }
        const float rs = 1.0f / sqrtf(wave_sum(s) * (1.0f / DM) + 1e-6f);
        unsigned long long* o8 = (unsigned long long*)(XN2 + (size_t)row * DM) + lane;
        float lg[16];
#pragma unroll
        for (int e = 0; e < 16; ++e) lg[e] = 0.f;
#pragma unroll
        for (int j = 0; j < 4; ++j) { const int c0 = 4 * lane + 256 * j;
            const f32x4 hh = *(const f32x4*)(MOD + (size_t)b * 6144 + 3072 + c0), cc = *(const f32x4*)(MOD + (size_t)b * 6144 + 4096 + c0);
            const f32x4 y = v[j] * rs * (cc + 1.0f) + hh;
            o8[64 * j] = (unsigned long long)pk2(y.x, y.y) | ((unsigned long long)pk2(y.z, y.w) << 32);
#pragma unroll
            for (int q = 0; q < 4; ++q) { const f32x4* wr = (const f32x4*)(p.w_router + (size_t)(c0 + q) * 16);
#pragma unroll
                for (int e4 = 0; e4 < 4; ++e4) { const f32x4 w = wr[e4]; lg[4 * e4] += y[q] * w.x; lg[4 * e4 + 1] += y[q] * w.y; lg[4 * e4 + 2] += y[q] * w.z; lg[4 * e4 + 3] += y[q] * w.w; } } }
        float mx = -1e30f;
#pragma unroll
        for (int e = 0; e < 16; ++e) { lg[e] = wave_sum(lg[e]); mx = fmaxf(mx, lg[e]); }
        float sum = 0.f;
#pragma unroll
        for (int e = 0; e < 16; ++e) { lg[e] = expf(lg[e] - mx); sum += lg[e]; }
        const float is = 1.0f / sum;
        if (lane < 16) { float val = 0.f;
#pragma unroll
            for (int e = 0; e < 16; ++e) val = (lane == e) ? lg[e] * is : val;
            AFF[(size_t)row * 16 + lane] = val; }
    }
}

__device__ __forceinline__ void phase_topk(const Params& p, LAS unsigned char* lds) {
    const int tid = threadIdx.x, lane = tid & 63, wave = tid >> 6, G = gridDim.x;
    unsigned char* ws = p.ws;
    const float* AFF = (const float*)(ws + WS_AFF); int* SELIDX = (int*)(ws + WS_SELIDX); float* SELG = (float*)(ws + WS_SELG); int* SLOT = (int*)(ws + WS_SLOT);
    LAS unsigned* hist = (LAS unsigned*)lds;
    LAS unsigned* ctl = hist + 256;
    LAS unsigned* wtot = hist + 264;
    for (int it = blockIdx.x; it < NB * NEXP; it += G) {
        const int b = it >> 4, e = it & 15;
        unsigned v[8];
#pragma unroll
        for (int j = 0; j < 8; ++j) v[j] = __builtin_bit_cast(unsigned, AFF[((size_t)b * SEQ + tid * 8 + j) * 16 + e]);
        unsigned prefix = 0u, mask = 0u, need = CAP;
        for (int shift = 24; shift >= 0; shift -= 8) {
            __syncthreads();
            if (tid < 256) hist[tid] = 0u;
            __syncthreads();
#pragma unroll
            for (int j = 0; j < 8; ++j) if ((v[j] & mask) == prefix) atomicAdd((unsigned*)&hist[(v[j] >> shift) & 255u], 1u);
            __syncthreads();
            if (tid == 0) { unsigned cum = 0u; int bin = 255; for (; bin > 0; --bin) { const unsigned hv = hist[bin]; if (cum + hv >= need) break; cum += hv; } ctl[0] = (unsigned)bin; ctl[1] = need - cum; }
            __syncthreads();
            prefix |= ctl[0] << shift; mask |= 255u << shift; need = ctl[1];
        }
        unsigned ngt = 0u, neq = 0u;
#pragma unroll
        for (int j = 0; j < 8; ++j) { ngt += (v[j] > prefix) ? 1u : 0u; neq += (v[j] == prefix) ? 1u : 0u; }
        unsigned sg = ngt, se = neq;
#pragma unroll
        for (int o = 1; o < 64; o <<= 1) { const unsigned a = __shfl_up(sg, o), c2 = __shfl_up(se, o); if (lane >= o) { sg += a; se += c2; } }
        __syncthreads();
        if (lane == 63) { wtot[wave] = sg; wtot[8 + wave] = se; }
        __syncthreads();
        unsigned og = sg - ngt, oe = se - neq, totg = 0u;
        for (int w = 0; w < 8; ++w) { const unsigned a = wtot[w], c2 = wtot[8 + w]; if (w < wave) { og += a; oe += c2; } totg += a; }
#pragma unroll
        for (int j = 0; j < 8; ++j) {
            const int tkn = tid * 8 + j; int slot = -1;
            if (v[j] > prefix) slot = (int)og++;
            else if (v[j] == prefix) { if (oe < need) slot = (int)(totg + oe); ++oe; }
            const int erow = b * CAP + slot;
            SLOT[((size_t)b * SEQ + tkn) * 16 + e] = (slot >= 0) ? erow : -1;
            if (slot >= 0) { SELIDX[e * EROWS + erow] = b * SEQ + tkn; SELG[e * EROWS + erow] = __builtin_bit_cast(float, v[j]); }
        }
    }
    __syncthreads();
    {
        LAS float* scr = (LAS float*)(lds + wave * 16384);
        bf16_t* WGU = (bf16_t*)(ws + WS_WGU); bf16_t* WD = (bf16_t*)(ws + WS_WD);
        const int gw = blockIdx.x * NWAVES + wave, NGW = G * NWAVES;
        constexpr int I_G = 16 * 64, I_D = 32 * 32;
        for (int it = gw; it < 16 * (2 * I_G + I_D); it += NGW) {
            const int e = it / (2 * I_G + I_D); int r = it % (2 * I_G + I_D);
            if (r < 2 * I_G) { const int up = r / I_G; r %= I_G; const int kb = r / 64, nb = r % 64;
                const float* W = (up ? p.w_exp_up : p.w_exp_gate) + (size_t)e * 1024 * 2048;
                transpose_item(W, 2048, 64 * kb, 32 * nb, WGU + (size_t)e * 4096 * 1024, 1024, [up](int n) { return 256 * (n >> 7) + 128 * up + (n & 127); }, scr, lane); }
            else { r -= 2 * I_G; const int kb = r / 32, nb = r % 32;
                transpose_item(p.w_exp_down + (size_t)e * 2048 * 1024, 1024, 64 * kb, 32 * nb, WD + (size_t)e * 1024 * 2048, 2048, [](int n) { return n; }, scr, lane); }
        }
    }
}

__device__ __forceinline__ void phase_final(const Params& p, LAS unsigned char* lds) {
    const int tid = threadIdx.x, lane = tid & 63, wave = tid >> 6, G = gridDim.x;
    unsigned char* ws = p.ws;
    const float* MOD = (const float*)(ws + WS_MOD); const int* SLOT = (const int*)(ws + WS_SLOT); const bf16_t* YE = (const bf16_t*)(ws + WS_YE);
    const int gw = blockIdx.x * NWAVES + wave, NGW = G * NWAVES;
    for (int row = gw; row < MLAT; row += NGW) {
        const int b = row >> 12;
        f32x4* xr = (f32x4*)(p.out + (size_t)row * DM) + lane;
        f32x4 v[4], mo[4];
#pragma unroll
        for (int j = 0; j < 4; ++j) { v[j] = xr[64 * j]; mo[j] = (f32x4){0.f, 0.f, 0.f, 0.f}; }
        const int myslot = (lane < 16) ? SLOT[(size_t)row * 16 + lane] : -1;
        for (int e = 0; e < 16; ++e) {
            const int sl = __shfl(myslot, e);
            if (sl >= 0) { const unsigned long long* yp = (const unsigned long long*)(YE + ((size_t)e * EROWS + sl) * DM) + lane;
#pragma unroll
                for (int j = 0; j < 4; ++j) { const unsigned long long w = yp[64 * j]; const unsigned lo = (unsigned)w, hi = (unsigned)(w >> 32);
                    mo[j].x += bf2f(lo & 0xffffu); mo[j].y += bf2f(lo >> 16); mo[j].z += bf2f(hi & 0xffffu); mo[j].w += bf2f(hi >> 16); } }
        }
        float s = 0.f;
#pragma unroll
        for (int j = 0; j < 4; ++j) { const int c0 = 4 * lane + 256 * j; const f32x4 g2 = *(const f32x4*)(MOD + (size_t)b * 6144 + 5120 + c0);
            v[j] = v[j] + g2 * mo[j]; s += (v[j].x * v[j].x + v[j].y * v[j].y) + (v[j].z * v[j].z + v[j].w * v[j].w); }
        const float rs = 1.0f / sqrtf(wave_sum(s) * (1.0f / DM) + 1e-6f);
#pragma unroll
        for (int j = 0; j < 4; ++j) { const int c0 = 4 * lane + 256 * j; const f32x4 fn = *(const f32x4*)(p.final_norm + c0); xr[64 * j] = v[j] * rs * fn; }
    }
}

constexpr int NPHASE = 12;
__global__ void __launch_bounds__(NTHREADS, 2) mk_fwd(Params p) {
    extern __shared__ __attribute__((aligned(16))) unsigned char lds_raw[];
    LAS unsigned char* lds = (LAS unsigned char*)lds_raw;
    cg::grid_group grid = cg::this_grid();
    unsigned char* ws = p.ws;
    const int G = gridDim.x, cblk = blockIdx.x;
#ifndef PH_MASK
#define PH_MASK 0xfff
#endif
#define IN(k) (((PH_MASK >> (k)) & 1) && p.ph_lo <= (k) && (k) < p.ph_hi)
#define SEAM(k) do { if (IN(k) && IN((k) + 1)) grid.sync(); } while (0)
    if (IN(0)) phase_prep(p, lds);
    SEAM(0);
    if (IN(1)) phase_norm1(p, lds);
    SEAM(1);
    if (IN(2)) {
        InprojSched S{(const bf16_t*)(ws + WS_XN), (const bf16_t*)(ws + WS_WINT), G, cblk, 1024, 1024, 1024};
        EpiInproj E{(bf16_t*)(ws + WS_Z), (bf16_t*)(ws + WS_ZC), (const float*)(ws + WS_BINZ), (const float*)(ws + WS_ROPE)};
        pg8::gemm_phase<EpiInproj, InprojSched>(lds, S, E);
    }
    SEAM(2);
    if (IN(3)) phase_rnn(p, lds);
    if (IN(3) && IN(4)) __syncthreads();
    if (IN(4)) phase_attn(p, lds);
    SEAM(4);
    if (IN(5)) {
        MixSched S{(const bf16_t*)(ws + WS_Z), (const bf16_t*)(ws + WS_WMIX), G, cblk, LDZ, 1024, 1024};
        EpiMix E{(bf16_t*)(ws + WS_Z)};
        pg8::gemm_phase<EpiMix, MixSched>(lds, S, E);
    }
    SEAM(5);
    if (IN(6)) {
        WoutSched S{(const bf16_t*)(ws + WS_Z), (const bf16_t*)(ws + WS_WOUT), G, cblk, LDZ, 1024, 1024};
        EpiWout E{p.x, p.out, (const float*)(ws + WS_MOD)};
        pg8::gemm_phase<EpiWout, WoutSched>(lds, S, E);
    }
    SEAM(6);
    if (IN(7)) phase_norm2(p, lds);
    SEAM(7);
    if (IN(8)) phase_topk(p, lds);
    SEAM(8);
    if (IN(9)) {
        Moe1Sched S{(const bf16_t*)(ws + WS_XN), (const bf16_t*)(ws + WS_WGU), (const int*)(ws + WS_SELIDX), G, cblk, 1024, 1024, 1024};
        EpiMoe1 E{(bf16_t*)(ws + WS_HID)};
        pg8::gemm_phase<EpiMoe1, Moe1Sched>(lds, S, E);
    }
    SEAM(9);
    if (IN(10)) {
        Moe2Sched S{(const bf16_t*)(ws + WS_HID), (const bf16_t*)(ws + WS_WD), G, cblk, 2048, 2048, 2048};
        EpiMoe2 E{(bf16_t*)(ws + WS_YE), (const float*)(ws + WS_SELG)};
        pg8::gemm_phase<EpiMoe2, Moe2Sched>(lds, S, E);
    }
    SEAM(10);
    if (IN(11)) phase_final(p, lds);
#undef IN
#undef SEAM
}

#ifndef MK_SINGLE
#define MK_SINGLE 1
#endif
extern "C" void kernel_launch(void* const* d_in, const int* in_sizes, int n_in, void* d_out, int out_size, void* d_ws, size_t ws_size, hipStream_t stream) {
    static int grid = 0;
    if (grid == 0) {
        int dev = 0, cus = 0, per_cu = 0;
        if (n_in != 24 || out_size != MLAT * DM || ws_size < WS_END) { fprintf(stderr, "kernel_launch: unexpected problem (n_in %d, out %d, ws %zu < %zu)\n", n_in, out_size, ws_size, (size_t)WS_END); grid = -1; return; }
        if (hipGetDevice(&dev) != hipSuccess || hipDeviceGetAttribute(&cus, hipDeviceAttributeMultiprocessorCount, dev) != hipSuccess) { grid = -1; return; }
        if (hipFuncSetAttribute((const void*)mk_fwd, hipFuncAttributeMaxDynamicSharedMemorySize, LDS_BYTES) != hipSuccess) { fprintf(stderr, "kernel_launch: hipFuncSetAttribute failed\n"); grid = -1; return; }
        if (hipOccupancyMaxActiveBlocksPerMultiprocessor(&per_cu, (const void*)mk_fwd, NTHREADS, LDS_BYTES) != hipSuccess || per_cu < 1) { fprintf(stderr, "kernel_launch: occupancy query says %d\n", per_cu); grid = -1; return; }
        grid = cus;
    }
    if (grid < 0) return;
    (void)hipMemsetAsync((char*)d_ws + WS_CTL, 0, 1 * MiB, stream);
    Params p{};
    const float** pp = (const float**)&p;
    for (int i = 0; i < 24; ++i) pp[i] = (const float*)d_in[i];
    p.out = (float*)d_out; p.ws = (unsigned char*)d_ws;
#if MK_SINGLE
    p.ph_lo = 0; p.ph_hi = NPHASE;
    void* args[] = {&p};
    hipError_t e = hipLaunchCooperativeKernel((const void*)mk_fwd, dim3(grid), dim3(NTHREADS), args, LDS_BYTES, stream);
    if (e != hipSuccess) fprintf(stderr, "kernel_launch: cooperative launch failed: %s (grid %d)\n", hipGetErrorString(e), grid);
#else
#ifndef REP_MASK
#define REP_MASK 0
#endif
    for (int ph = 0; ph < NPHASE; ++ph) {
        p.ph_lo = ph; p.ph_hi = ph + 1;
        for (int rep = 0; rep < 1 + ((REP_MASK >> ph) & 1); ++rep) hipLaunchKernelGGL(mk_fwd, dim3(grid), dim3(NTHREADS), LDS_BYTES, stream, p);
    }
#endif
}
```

```cpp
#include <hip/hip_runtime.h>
#include <hip/hip_cooperative_groups.h>
#include <cstdio>
#include <cstdint>
namespace cg = cooperative_groups;

#define LAS __attribute__((address_space(3)))
typedef unsigned short bf16_t;
typedef short bf16x8 __attribute__((ext_vector_type(8)));
typedef float f32x4 __attribute__((ext_vector_type(4)));
typedef float f32x2 __attribute__((ext_vector_type(2)));
typedef unsigned u32x4 __attribute__((ext_vector_type(4)));
typedef unsigned u32x2 __attribute__((ext_vector_type(2)));

constexpr int NB = 8, SEQ = 4096, DM = 1024, CTX = 256;
constexpr int MLAT = NB * SEQ, MCTX = NB * CTX;
constexpr int NIN = 7168, NEXP = 16, DEXP = 2048, CAP = 512, EROWS = NB * CAP;
constexpr int LDZ = 7168, ZC_YG = 0, ZC_Q = 1024, ZC_XR = 2048, ZC_K = 3072, ZC_V = 4096, ZC_GR = 5120, ZC_GN = 6144;
constexpr int LDC = 3072, CC_XR = 0, CC_K = 1024, CC_V = 2048;
constexpr float LOG2E = 1.4426950408889634f;
constexpr float QSCALE = 0.125f * LOG2E;

constexpr size_t MiB = 1u << 20;
constexpr size_t WS_CTL = 0;
constexpr size_t WS_MOD = 1 * MiB;
constexpr size_t WS_MODP = 2 * MiB;
constexpr size_t WS_ROPE = 9 * MiB;
constexpr size_t WS_BINZ = 9 * MiB + 65536;
constexpr size_t WS_AFF = 10 * MiB;
constexpr size_t WS_SELIDX = 12 * MiB;
constexpr size_t WS_SELG = 12 * MiB + 262144;
constexpr size_t WS_SLOT = 13 * MiB;
constexpr size_t WS_WINT = 16 * MiB;
constexpr size_t WS_WMIX = 30 * MiB;
constexpr size_t WS_WOUT = 34 * MiB;
constexpr size_t WS_ZC = 36 * MiB;
constexpr size_t WS_XN = 48 * MiB;
constexpr size_t WS_Z = 116 * MiB;
constexpr size_t WS_WGU = 116 * MiB;
constexpr size_t WS_WD = 244 * MiB;
constexpr size_t WS_HID = 308 * MiB;
constexpr size_t WS_YE = 116 * MiB;
constexpr size_t WS_END = 564 * MiB;

constexpr int NTHREADS = 512, NWAVES = 8;
constexpr int LDS_BYTES = 147456;

__device__ __forceinline__ unsigned f2bf(float f) { unsigned u = __builtin_bit_cast(unsigned, f); return (u + 0x7fffu + ((u >> 16) & 1u)) >> 16; }
__device__ __forceinline__ float bf2f(unsigned h) { return __builtin_bit_cast(float, h << 16); }
__device__ __forceinline__ unsigned pk2(float lo, float hi) { return f2bf(lo) | (f2bf(hi) << 16); }
__device__ __forceinline__ unsigned cvt_pk_bf16(float lo, float hi) { unsigned r; asm volatile("v_cvt_pk_bf16_f32 %0, %1, %2" : "=v"(r) : "v"(lo), "v"(hi)); return r; }
__device__ __forceinline__ float wave_sum(float v) {
#pragma unroll
    for (int o = 1; o < 64; o <<= 1) v += __shfl_xor(v, o);
    return v;
}
__device__ __forceinline__ float sigmoidf_(float x) { return __builtin_amdgcn_rcpf(1.0f + __builtin_amdgcn_exp2f(-x * LOG2E)); }
__device__ __forceinline__ float gelu_tanh(float x) { const float u = 0.7978845608028654f * (x + 0.044715f * x * x * x); return x * __builtin_amdgcn_rcpf(1.0f + __builtin_amdgcn_exp2f(-2.0f * LOG2E * u)); }
#define LDS_WAIT() asm volatile("s_waitcnt lgkmcnt(0)" ::: "memory")

namespace pg8 {
constexpr int BM = 256, BK = 64, HALF = 128, HTB = HALF * BK * 2, STAGE_BYTES = 8 * HTB, NXCD = 8, WGM = 8;
__host__ __device__ __forceinline__ int lds_byte(int r, int c) { const int st = (r >> 4) * 2 + (c >> 5), rr = r & 15, cc = c & 31, ob = rr * 64 + cc * 2; return st * 1024 + (ob ^ (((ob >> 9) & 1) << 5)); }
__host__ __device__ __forceinline__ void stage_rc(int b, int& R, int& C) { const int st = b / 1024, sb = b % 1024, swz = sb ^ (((sb >> 9) & 1) << 5); R = (st >> 1) * 16 + swz / 64; C = (st & 1) * 32 + (swz % 64) / 2; }
__host__ __device__ __forceinline__ int perm32(int rho) { const int n = rho >> 4, i = rho & 15; return 8 * (i >> 2) + 4 * n + (i & 3); }

struct Unit { int pm, pb, x0, x1; };

__device__ __forceinline__ void tile_of(int L, int nM, int nN, int& pm, int& pn) {
    const int nwg = nM * nN; int wgid = L;
    { const int q = nwg / NXCD, r = nwg % NXCD, xcd = wgid % NXCD, off = wgid / NXCD; wgid = (xcd < r ? xcd * (q + 1) : r * (q + 1) + (xcd - r) * q) + off; }
    const int nig = WGM * nN, gid = wgid / nig, fm = gid * WGM, gsz = (nM - fm) < WGM ? (nM - fm) : WGM;
    pm = fm + ((wgid % nig) % gsz); pn = (wgid % nig) / gsz;
}

template <class Epi, class Sched>
__device__ __forceinline__ void gemm_phase(LAS unsigned char* lds, const Sched& S, const Epi& E) {
    const int tid = threadIdx.x, wid = __builtin_amdgcn_readfirstlane(tid >> 6), lane = tid & 63, wr = wid >> 2, wc = wid & 3, fr = lane & 15, fq = lane >> 4;
    const int K = S.K, nt = K / BK;
    int Rl[2], Cl[2];
    unsigned voffA[2][2], voffB[2];
#pragma unroll
    for (int i = 0; i < 2; ++i) { stage_rc(tid * 16 + i * 8192, Rl[i], Cl[i]); const int Rb = Epi::PERM ? ((Rl[i] & ~31) + perm32(Rl[i] & 31)) : Rl[i];
        voffB[i] = (unsigned)(Rb * S.ldb + Cl[i]) * 2u; }
    const size_t kstep = (size_t)(BK * 2);
    const size_t hstepB = (size_t)HALF * S.ldb * 2;
    const unsigned ldsw = (unsigned)wid * 1024u;
    const int aoff = lds_byte(wr * 64 + fr, fq * 8), boff = lds_byte(wc * 32 + fr, fq * 8);
#define PG8_SA(b, h) (((b) * 2 + (h)) * HTB)
#define PG8_SB(b, h) ((4 + (b) * 2 + (h)) * HTB)
#define PG8_STAGEB(bufoff, gbase) do { _Pragma("unroll") for (int _i = 0; _i < 2; ++_i) \
        __builtin_amdgcn_global_load_lds((const unsigned*)((const char*)(gbase) + voffB[_i]), (LAS unsigned*)(lds + (bufoff) + ldsw + _i * 8192), 16, 0, 0); } while (0)
#define PG8_STAGEA(bufoff, gbase, h, vo) do { _Pragma("unroll") for (int _i = 0; _i < 2; ++_i) \
        __builtin_amdgcn_global_load_lds((const unsigned*)((const char*)(gbase) + (vo)[h][_i]), (LAS unsigned*)(lds + (bufoff) + ldsw + _i * 8192), 16, 0, 0); } while (0)
#define PG8_LDA(dst, b, h) do { _Pragma("unroll") for (int m = 0; m < 4; ++m) _Pragma("unroll") for (int k = 0; k < 2; ++k) dst[m][k] = *(const LAS bf16x8*)(lds + PG8_SA(b, h) + aoff + m * 2048 + k * 1024); } while (0)
#define PG8_LDB(dst, b, h) do { _Pragma("unroll") for (int n = 0; n < 2; ++n) _Pragma("unroll") for (int k = 0; k < 2; ++k) dst[n][k] = *(const LAS bf16x8*)(lds + PG8_SB(b, h) + boff + n * 2048 + k * 1024); } while (0)
#define PG8_MMA(ai, bj, At, Bt) do { __builtin_amdgcn_s_setprio(1); _Pragma("unroll") for (int m = 0; m < 4; ++m) _Pragma("unroll") for (int n = 0; n < 2; ++n) _Pragma("unroll") for (int k = 0; k < 2; ++k) \
        acc[ai][bj][m][n] = __builtin_amdgcn_mfma_f32_16x16x32_bf16(Bt[n][k], At[m][k], acc[ai][bj][m][n], 0, 0, 0); __builtin_amdgcn_s_setprio(0); } while (0)
#define PG8_WAIT_V(n) asm volatile("s_waitcnt vmcnt(" #n ")" ::: "memory")
#define PG8_WAIT_L(n) asm volatile("s_waitcnt lgkmcnt(" #n ")" ::: "memory")
#define PG8_BAR __builtin_amdgcn_s_barrier()
#define PG8_SCHED __builtin_amdgcn_sched_barrier(0)
#define PG8_SETVO(vo, u) do { _Pragma("unroll") for (int _h = 0; _h < 2; ++_h) _Pragma("unroll") for (int _i = 0; _i < 2; ++_i) { \
        if constexpr (Sched::GATHER) (vo)[_h][_i] = (unsigned)(S.row_of(u, _h * HALF + Rl[_i]) * S.lda + Cl[_i]) * 2u; \
        else (vo)[_h][_i] = (unsigned)((_h * HALF + Rl[_i]) * S.lda + Cl[_i]) * 2u; } } while (0)
    Unit cur, nxt; int ui = 0;
    if (!S.next(0, cur)) return;
    f32x4 acc[2][2][4][2];
#pragma unroll
    for (int a = 0; a < 2; ++a)
#pragma unroll
        for (int b = 0; b < 2; ++b)
#pragma unroll
            for (int m = 0; m < 4; ++m)
#pragma unroll
                for (int n = 0; n < 2; ++n) acc[a][b][m][n] = (f32x4){0.f, 0.f, 0.f, 0.f};
    bf16x8 At[4][2], B0[2][2], B1[2][2];
    const char* cA = S.a_ptr(cur); const char* cB = S.b_ptr(cur);
    PG8_SETVO(voffA, cur);
    PG8_STAGEB(PG8_SB(0, 0), cB); PG8_STAGEB(PG8_SB(0, 1), cB + hstepB); PG8_STAGEA(PG8_SA(0, 0), cA, 0, voffA); PG8_STAGEA(PG8_SA(0, 1), cA, 1, voffA);
    if (wr == 1) PG8_BAR;
    PG8_WAIT_V(2); PG8_BAR;
    PG8_STAGEB(PG8_SB(1, 0), cB + kstep); PG8_STAGEA(PG8_SA(1, 0), cA + kstep, 0, voffA); PG8_STAGEB(PG8_SB(1, 1), cB + hstepB + kstep);
    PG8_WAIT_V(6); PG8_BAR;
    for (;;) {
        const bool has_next = S.next(ui + 1, nxt);
        const char* nA = has_next ? S.a_ptr(nxt) : cA; const char* nB = has_next ? S.b_ptr(nxt) : cB;
        for (int t = 0; t < nt; t += 2) {
            const bool last = (t == nt - 2);
            const char* a1 = cA + (size_t)(t + 1) * kstep;
            const char* a2 = last ? nA : cA + (size_t)(t + 2) * kstep; const char* b2 = last ? nB : cB + (size_t)(t + 2) * kstep;
            const char* a3 = a2 + kstep; const char* b3 = b2 + kstep;
            PG8_LDB(B0, 0, 0); PG8_LDB(B1, 0, 1); PG8_SCHED; PG8_LDA(At, 0, 0); PG8_STAGEA(PG8_SA(1, 1), a1, 1, voffA);
            if (last && has_next) { PG8_SETVO(voffA, nxt); }
            PG8_WAIT_V(8); PG8_WAIT_L(0); PG8_BAR; PG8_MMA(0, 0, At, B0); PG8_MMA(0, 1, At, B1); PG8_BAR; PG8_SCHED;
            PG8_LDA(At, 0, 1); PG8_STAGEB(PG8_SB(0, 0), b2); PG8_STAGEB(PG8_SB(0, 1), b2 + hstepB); PG8_STAGEA(PG8_SA(0, 0), a2, 0, voffA);
            PG8_WAIT_V(8); PG8_WAIT_L(0); PG8_BAR; PG8_MMA(1, 0, At, B0); PG8_MMA(1, 1, At, B1); PG8_BAR; PG8_SCHED;
            PG8_LDB(B0, 1, 0); PG8_LDB(B1, 1, 1); PG8_SCHED; PG8_LDA(At, 1, 0); PG8_STAGEA(PG8_SA(0, 1), a2, 1, voffA);
            PG8_WAIT_V(8); PG8_WAIT_L(0); PG8_BAR; PG8_MMA(0, 0, At, B0); PG8_MMA(0, 1, At, B1); PG8_BAR; PG8_SCHED;
            PG8_LDA(At, 1, 1); PG8_STAGEB(PG8_SB(1, 0), b3); PG8_STAGEB(PG8_SB(1, 1), b3 + hstepB); PG8_STAGEA(PG8_SA(1, 0), a3, 0, voffA);
            PG8_WAIT_V(8); PG8_WAIT_L(0); PG8_BAR; PG8_MMA(1, 0, At, B0); PG8_MMA(1, 1, At, B1); PG8_BAR; PG8_SCHED;
        }
        if (wr == 0) PG8_BAR;
        E(acc, cur, wr, wc, fr, fq);
        if (!has_next) break;
#pragma unroll
        for (int a = 0; a < 2; ++a)
#pragma unroll
            for (int b = 0; b < 2; ++b)
#pragma unroll
                for (int m = 0; m < 4; ++m)
#pragma unroll
                    for (int n = 0; n < 2; ++n) acc[a][b][m][n] = (f32x4){0.f, 0.f, 0.f, 0.f};
        cur = nxt; cA = nA; cB = nB; ++ui;
        if (wr == 1) PG8_BAR;
    }
    PG8_WAIT_V(0);
    PG8_BAR;
#undef PG8_SA
#undef PG8_SB
#undef PG8_STAGEA
#undef PG8_STAGEB
#undef PG8_LDA
#undef PG8_LDB
#undef PG8_MMA
#undef PG8_WAIT_V
#undef PG8_WAIT_L
#undef PG8_BAR
#undef PG8_SCHED
#undef PG8_SETVO
}
}

struct InprojSched {
    static constexpr bool GATHER = false;
    const bf16_t* XN; const bf16_t* W; int G, c; int lda, ldb, K;
    __device__ __forceinline__ bool next(int i, pg8::Unit& u) const {
        const int L = i * G + c;
        if (L < 128 * 28) { int pm, pn; pg8::tile_of(L, 128, 28, pm, pn); u.pm = pm; u.pb = pn; u.x0 = 0; u.x1 = 0; return true; }
        const int idx = L - 128 * 28; if (idx >= 96) return false;
        u.pm = 128 + (idx & 7); u.pb = 8 + (idx >> 3); u.x0 = 1; u.x1 = 0; return true;
    }
    __device__ __forceinline__ const char* a_ptr(const pg8::Unit& u) const { return (const char*)XN + (size_t)u.pm * 256 * 1024 * 2; }
    __device__ __forceinline__ const char* b_ptr(const pg8::Unit& u) const { return (const char*)W + (size_t)u.pb * 256 * 1024 * 2; }
    __device__ __forceinline__ int row_of(const pg8::Unit&, int r) const { return r; }
};
struct MixSched {
    static constexpr bool GATHER = false;
    const bf16_t* Z; const bf16_t* W; int G, c; int lda, ldb, K;
    __device__ __forceinline__ bool next(int i, pg8::Unit& u) const {
        const int L = (i >> 1) * G + c; if (L >= 128 * 4) return false;
        int pm, pn; pg8::tile_of(L, 128, 4, pm, pn); const int pass = i & 1;
        u.pm = pm; u.pb = pass * 4 + pn; u.x0 = pn; u.x1 = pass; return true;
    }
    __device__ __forceinline__ const char* a_ptr(const pg8::Unit& u) const { return (const char*)Z + ((size_t)u.pm * 256 * LDZ + (u.x1 ? ZC_Q : ZC_YG)) * 2; }
    __device__ __forceinline__ const char* b_ptr(const pg8::Unit& u) const { return (const char*)W + (size_t)u.pb * 256 * 1024 * 2; }
    __device__ __forceinline__ int row_of(const pg8::Unit&, int r) const { return r; }
};
struct WoutSched {
    static constexpr bool GATHER = false;
    const bf16_t* Z; const bf16_t* W; int G, c; int lda, ldb, K;
    __device__ __forceinline__ bool next(int i, pg8::Unit& u) const {
        const int L = i * G + c; if (L >= 128 * 4) return false;
        int pm, pn; pg8::tile_of(L, 128, 4, pm, pn); u.pm = pm; u.pb = pn; u.x0 = pn; u.x1 = 0; return true;
    }
    __device__ __forceinline__ const char* a_ptr(const pg8::Unit& u) const { return (const char*)Z + ((size_t)u.pm * 256 * LDZ + ZC_XR) * 2; }
    __device__ __forceinline__ const char* b_ptr(const pg8::Unit& u) const { return (const char*)W + (size_t)u.pb * 256 * 1024 * 2; }
    __device__ __forceinline__ int row_of(const pg8::Unit&, int r) const { return r; }
};
struct Moe1Sched {
    static constexpr bool GATHER = true;
    const bf16_t* XN2; const bf16_t* W; const int* selidx; int G, c; int lda, ldb, K;
    __device__ __forceinline__ bool next(int i, pg8::Unit& u) const {
        const int L = i * G + c; if (L >= 16 * 256) return false;
        const int e = L >> 8, w = L & 255, x = w & 7, j = w >> 3;
        const int mt = (x & 3) * 4 + (j & 3), nt = (x >> 2) * 8 + (j >> 2);
        u.pm = e * 16 + mt; u.pb = e * 16 + nt; u.x0 = nt; u.x1 = e; return true;
    }
    __device__ __forceinline__ const char* a_ptr(const pg8::Unit&) const { return (const char*)XN2; }
    __device__ __forceinline__ const char* b_ptr(const pg8::Unit& u) const { return (const char*)W + (size_t)u.pb * 256 * 1024 * 2; }
    __device__ __forceinline__ int row_of(const pg8::Unit& u, int r) const { return selidx[u.pm * 256 + r]; }
};
struct Moe2Sched {
    static constexpr bool GATHER = false;
    const bf16_t* HID; const bf16_t* W; int G, c; int lda, ldb, K;
    __device__ __forceinline__ bool next(int i, pg8::Unit& u) const {
        const int L = i * G + c; if (L >= 16 * 64) return false;
        const int e = L >> 6, w = L & 63, mt = w >> 2, pn = w & 3;
        u.pm = e * 16 + mt; u.pb = e * 4 + pn; u.x0 = pn; u.x1 = e; return true;
    }
    __device__ __forceinline__ const char* a_ptr(const pg8::Unit& u) const { return (const char*)HID + (size_t)u.pm * 256 * 2048 * 2; }
    __device__ __forceinline__ const char* b_ptr(const pg8::Unit& u) const { return (const char*)W + (size_t)u.pb * 256 * 2048 * 2; }
    __device__ __forceinline__ int row_of(const pg8::Unit&, int r) const { return r; }
};

typedef const f32x4 (&AccRef)[2][2][4][2];
struct EpiInproj {
    static constexpr bool PERM = true;
    bf16_t* Z; bf16_t* ZC; const float* binz; const float* rope;
    __device__ __forceinline__ void operator()(AccRef acc, const pg8::Unit& u, int wr, int wc, int fr, int fq) const {
        const bool isctx = u.x0 != 0;
        const int seg = u.pb >> 2, colt = u.pb * 256, cl = wc * 32 + 8 * fq;
        f32x4 bv[2][2];
#pragma unroll
        for (int bj = 0; bj < 2; ++bj)
#pragma unroll
            for (int n = 0; n < 2; ++n) bv[bj][n] = *(const f32x4*)(binz + colt + bj * 128 + cl + 4 * n);
        bf16_t* base; int ld, row0;
        if (!isctx) { base = Z + colt; ld = LDZ; row0 = u.pm * 256; } else { base = ZC + (colt - 2048); ld = LDC; row0 = (u.pm - 128) * 256; }
        const bool dorope = (seg == 1) || (seg == 3 && !isctx);
        const float qs = (seg == 1) ? QSCALE : 1.0f;
#pragma unroll
        for (int ai = 0; ai < 2; ++ai)
#pragma unroll
            for (int m = 0; m < 4; ++m) {
                const int r = row0 + ai * 128 + wr * 64 + m * 16 + fr;
                bf16_t* rowp = base + (size_t)r * ld + cl;
                f32x4 cs0 = (f32x4){1.f, 0.f, 1.f, 0.f}, cs1 = cs0;
                if (dorope) { const int t = r & 4095; const int pos = (wc & 1) ? (t & 63) : (t >> 6); const float* cp = rope + (pos * 16 + 4 * fq) * 2; cs0 = *(const f32x4*)cp; cs1 = *(const f32x4*)(cp + 4); }
#pragma unroll
                for (int bj = 0; bj < 2; ++bj) {
                    f32x4 v0 = acc[ai][bj][m][0] + bv[bj][0], v1 = acc[ai][bj][m][1] + bv[bj][1];
                    if (seg == 0) {
#pragma unroll
                        for (int j = 0; j < 4; ++j) { v0[j] = gelu_tanh(v0[j]); v1[j] = gelu_tanh(v1[j]); }
                    } else if (seg >= 5) {
#pragma unroll
                        for (int j = 0; j < 4; ++j) { v0[j] = sigmoidf_(v0[j]); v1[j] = sigmoidf_(v1[j]); }
                    } else if (dorope) {
                        const float c[4] = {cs0[0], cs0[2], cs1[0], cs1[2]}, s[4] = {cs0[1], cs0[3], cs1[1], cs1[3]};
#pragma unroll
                        for (int j = 0; j < 4; ++j) { const float x1 = v0[j], x2 = v1[j]; v0[j] = (x1 * c[j] - x2 * s[j]) * qs; v1[j] = (x1 * s[j] + x2 * c[j]) * qs; }
                    }
                    u32x4 w; w.x = cvt_pk_bf16(v0[0], v0[1]); w.y = cvt_pk_bf16(v0[2], v0[3]); w.z = cvt_pk_bf16(v1[0], v1[1]); w.w = cvt_pk_bf16(v1[2], v1[3]);
                    *(u32x4*)(rowp + bj * 128) = w;
                }
            }
    }
};
struct EpiMix {
    static constexpr bool PERM = true;
    bf16_t* Z;
    __device__ __forceinline__ void operator()(AccRef acc, const pg8::Unit& u, int wr, int wc, int fr, int fq) const {
        const int pass = u.x1, colt = u.x0 * 256, cl = wc * 32 + 8 * fq;
        const int gcol = (pass ? ZC_GN : ZC_GR) + colt + cl, ocol = ZC_XR + colt + cl;
        const int r0 = u.pm * 256 + wr * 64 + fr;
#pragma unroll
        for (int ai = 0; ai < 2; ++ai)
#pragma unroll
            for (int m = 0; m < 4; ++m) {
                bf16_t* rowz = Z + (size_t)(r0 + ai * 128 + m * 16) * LDZ;
#pragma unroll
                for (int bj = 0; bj < 2; ++bj) {
                    const u32x4 g = *(const u32x4*)(rowz + gcol + bj * 128);
                    f32x4 v0 = acc[ai][bj][m][0] * (f32x4){bf2f(g.x & 0xffffu), bf2f(g.x >> 16), bf2f(g.y & 0xffffu), bf2f(g.y >> 16)};
                    f32x4 v1 = acc[ai][bj][m][1] * (f32x4){bf2f(g.z & 0xffffu), bf2f(g.z >> 16), bf2f(g.w & 0xffffu), bf2f(g.w >> 16)};
                    if (pass) { const u32x4 t = *(const u32x4*)(rowz + ocol + bj * 128);
                        v0 += (f32x4){bf2f(t.x & 0xffffu), bf2f(t.x >> 16), bf2f(t.y & 0xffffu), bf2f(t.y >> 16)};
                        v1 += (f32x4){bf2f(t.z & 0xffffu), bf2f(t.z >> 16), bf2f(t.w & 0xffffu), bf2f(t.w >> 16)}; }
                    u32x4 w; w.x = cvt_pk_bf16(v0[0], v0[1]); w.y = cvt_pk_bf16(v0[2], v0[3]); w.z = cvt_pk_bf16(v1[0], v1[1]); w.w = cvt_pk_bf16(v1[2], v1[3]);
                    *(u32x4*)(rowz + ocol + bj * 128) = w;
                }
            }
    }
};
struct EpiWout {
    static constexpr bool PERM = false;
    const float* x; float* out; const float* mod;
    __device__ __forceinline__ void operator()(AccRef acc, const pg8::Unit& u, int wr, int wc, int fr, int fq) const {
        const int col0 = u.x0 * 256 + wc * 32 + 4 * fq;
        const float* g1p = mod + (size_t)(u.pm >> 4) * 6144 + 2048 + col0;
        f32x4 gv[2][2];
#pragma unroll
        for (int bj = 0; bj < 2; ++bj)
#pragma unroll
            for (int n = 0; n < 2; ++n) gv[bj][n] = *(const f32x4*)(g1p + bj * 128 + n * 16);
#pragma unroll
        for (int ai = 0; ai < 2; ++ai)
#pragma unroll
            for (int m = 0; m < 4; ++m) {
                const size_t off = (size_t)(u.pm * 256 + ai * 128 + wr * 64 + m * 16 + fr) * DM + col0;
#pragma unroll
                for (int bj = 0; bj < 2; ++bj)
#pragma unroll
                    for (int n = 0; n < 2; ++n) { const f32x4 xv = *(const f32x4*)(x + off + bj * 128 + n * 16); *(f32x4*)(out + off + bj * 128 + n * 16) = xv + gv[bj][n] * acc[ai][bj][m][n]; }
            }
    }
};
struct EpiMoe1 {
    static constexpr bool PERM = true;
    bf16_t* HID;
    __device__ __forceinline__ void operator()(AccRef acc, const pg8::Unit& u, int wr, int wc, int fr, int fq) const {
        const int col0 = u.x0 * 128 + wc * 32 + 8 * fq;
#pragma unroll
        for (int ai = 0; ai < 2; ++ai)
#pragma unroll
            for (int m = 0; m < 4; ++m) {
                const size_t r = (size_t)u.pm * 256 + ai * 128 + wr * 64 + m * 16 + fr;
                f32x4 h0, h1;
#pragma unroll
                for (int j = 0; j < 4; ++j) { const float g0 = acc[ai][0][m][0][j], g1 = acc[ai][0][m][1][j];
                    h0[j] = g0 * sigmoidf_(g0) * acc[ai][1][m][0][j]; h1[j] = g1 * sigmoidf_(g1) * acc[ai][1][m][1][j]; }
                u32x4 w; w.x = cvt_pk_bf16(h0[0], h0[1]); w.y = cvt_pk_bf16(h0[2], h0[3]); w.z = cvt_pk_bf16(h1[0], h1[1]); w.w = cvt_pk_bf16(h1[2], h1[3]);
                *(u32x4*)(HID + r * DEXP + col0) = w;
            }
    }
};
struct EpiMoe2 {
    static constexpr bool PERM = true;
    bf16_t* YE; const float* selg;
    __device__ __forceinline__ void operator()(AccRef acc, const pg8::Unit& u, int wr, int wc, int fr, int fq) const {
        const int col0 = u.x0 * 256 + wc * 32 + 8 * fq;
#pragma unroll
        for (int ai = 0; ai < 2; ++ai)
#pragma unroll
            for (int m = 0; m < 4; ++m) {
                const size_t r = (size_t)u.pm * 256 + ai * 128 + wr * 64 + m * 16 + fr;
                const float g = selg[r];
#pragma unroll
                for (int bj = 0; bj < 2; ++bj) {
                    const f32x4 v0 = acc[ai][bj][m][0] * g, v1 = acc[ai][bj][m][1] * g;
                    u32x4 w; w.x = cvt_pk_bf16(v0[0], v0[1]); w.y = cvt_pk_bf16(v0[2], v0[3]); w.z = cvt_pk_bf16(v1[0], v1[1]); w.w = cvt_pk_bf16(v1[2], v1[3]);
                    *(u32x4*)(YE + r * DM + col0 + bj * 128) = w;
                }
            }
    }
};

struct Params {
    const float *x, *c, *ctx, *c_ctx, *w_mod, *b_mod, *w_in, *b_in, *conv_w, *conv_b, *lru_wa, *lru_ba, *lru_wi, *lru_bi, *lru_lambda, *na_rpb,
                *w_proj_rnn, *w_proj_na, *w_out, *w_router, *w_exp_gate, *w_exp_up, *w_exp_down, *final_norm;
    float* out; unsigned char* ws;
    int ph_lo, ph_hi, probe, pad;
};

__device__ __forceinline__ int zcol_of(int n) {
    const int seg = n >> 10, o = n & 1023;
    if (seg == 0) return ZC_YG + o;
    if (seg == 1) return ZC_XR + o;
    if (seg == 4) return ZC_V + o;
    if (seg == 5) return ZC_GR + o;
    if (seg == 6) return ZC_GN + o;
    const int hh = o >> 6, d = o & 63, g2 = d >> 5, dd = d & 31, nn = dd >> 4, j = dd & 15, a = j >> 2, jj = j & 3;
    return (seg == 2 ? ZC_Q : ZC_K) + hh * 64 + g2 * 32 + 8 * a + 4 * nn + jj;
}
constexpr int TR_SCR = 64 * 65 * 4;
template <class RowMap>
__device__ __forceinline__ void transpose_item(const float* W, int ldw, int k0, int n0, bf16_t* WT, int ldk, RowMap rowmap, LAS float* scr, int lane) {
    const int ln = lane & 15, lk = lane >> 4;
    f32x4 v[16];
#pragma unroll
    for (int i = 0; i < 16; ++i) v[i] = *(const f32x4*)(W + (size_t)(k0 + 4 * i + lk) * ldw + n0 + 4 * ln);
#pragma unroll
    for (int i = 0; i < 16; ++i) { LAS float* d = scr + (4 * i + lk) * 65 + 4 * ln; d[0] = v[i].x; d[1] = v[i].y; d[2] = v[i].z; d[3] = v[i].w; }
    LDS_WAIT(); asm volatile("" ::: "memory");
    const int kg = lane & 7;
#pragma unroll
    for (int j = 0; j < 8; ++j) { const int n = (lane >> 3) + 8 * j; const LAS float* sp = scr + (8 * kg) * 65 + n;
        u32x4 o; o.x = cvt_pk_bf16(sp[0 * 65], sp[1 * 65]); o.y = cvt_pk_bf16(sp[2 * 65], sp[3 * 65]); o.z = cvt_pk_bf16(sp[4 * 65], sp[5 * 65]); o.w = cvt_pk_bf16(sp[6 * 65], sp[7 * 65]);
        *(u32x4*)(WT + (size_t)rowmap(n0 + n) * ldk + k0 + 8 * kg) = o; }
    LDS_WAIT(); asm volatile("" ::: "memory");
}
__device__ __forceinline__ void phase_prep(const Params& p, LAS unsigned char* lds) {
    const int tid = threadIdx.x, lane = tid & 63, wave = tid >> 6, G = gridDim.x;
    unsigned char* ws = p.ws;
    {
        LAS float* scr = (LAS float*)(lds + wave * TR_SCR);
        bf16_t* WINT = (bf16_t*)(ws + WS_WINT); bf16_t* WMIX = (bf16_t*)(ws + WS_WMIX); bf16_t* WOUT = (bf16_t*)(ws + WS_WOUT);
        const int gw = blockIdx.x * NWAVES + wave, NGW = G * NWAVES;
        constexpr int I_IN = 16 * (NIN / 64), I_P = 16 * 16;
        for (int it = gw; it < I_IN + 3 * I_P; it += NGW) {
            int r = it;
            if (r < I_IN) { const int nblk = NIN / 64, kb = r / nblk, nb = r % nblk; transpose_item(p.w_in, NIN, 64 * kb, 64 * nb, WINT, 1024, [](int n) { return zcol_of(n); }, scr, lane); continue; } r -= I_IN;
            const int kb = (r % I_P) / 16, nb = (r % I_P) % 16, which = r / I_P;
            if (which == 0) transpose_item(p.w_proj_rnn, 1024, 64 * kb, 64 * nb, WMIX, 1024, [](int n) { return n; }, scr, lane);
            else if (which == 1) transpose_item(p.w_proj_na, 1024, 64 * kb, 64 * nb, WMIX, 1024, [](int n) { return 1024 + n; }, scr, lane);
            else transpose_item(p.w_out, 1024, 64 * kb, 64 * nb, WOUT, 1024, [](int n) { return n; }, scr, lane);
        }
    }
    __syncthreads();
    {
        LAS float* sS = (LAS float*)lds;
        LAS float* red = sS + 9 * 1024;
        float* MOD = (float*)(ws + WS_MOD);
        if (blockIdx.x < 192) {
            for (int e = tid; e < 9 * 1024; e += NTHREADS) { const int r = e >> 10, k = e & 1023; const float v = (r < 8) ? p.c[r * 1024 + k] : p.c_ctx[k]; sS[e] = v * sigmoidf_(v); }
            __syncthreads();
        }
        for (int it = blockIdx.x; it < 192; it += G) {
            const int n0 = it * 32, kk = tid >> 3, c4 = tid & 7;
            f32x4 a[9];
#pragma unroll
            for (int r = 0; r < 9; ++r) a[r] = (f32x4){0.f, 0.f, 0.f, 0.f};
#pragma unroll 4
            for (int i = 0; i < 16; ++i) { const int k = kk + 64 * i; const f32x4 w = *(const f32x4*)(p.w_mod + (size_t)k * 6144 + n0 + 4 * c4);
#pragma unroll
                for (int r = 0; r < 9; ++r) a[r] += w * sS[r * 1024 + k]; }
#pragma unroll
            for (int r = 0; r < 9; ++r) *(LAS f32x4*)(red + (kk * 9 + r) * 32 + 4 * c4) = a[r];
            __syncthreads();
            if (tid < 288) { const int r = tid >> 5, col = tid & 31; float sum = p.b_mod[n0 + col];
                for (int q = 0; q < 64; ++q) sum += red[(q * 9 + r) * 32 + col];
                MOD[r * 6144 + n0 + col] = sum; }
            __syncthreads();
        }
    }
    {
        float* ROPE = (float*)(ws + WS_ROPE); float* BINZ = (float*)(ws + WS_BINZ);
        const int gt = blockIdx.x * NTHREADS + tid, NGT = G * NTHREADS;
        for (int e = gt; e < 64 * 16; e += NGT) { const int pos = e >> 4, j = e & 15; const float inv = powf(10000.0f, -(float)j / 16.0f); const float ang = (float)pos * inv; ROPE[2 * e] = cosf(ang); ROPE[2 * e + 1] = sinf(ang); }
        for (int n = gt; n < NIN; n += NGT) BINZ[zcol_of(n)] = p.b_in[n];
    }
}

__device__ __forceinline__ void phase_norm1(const Params& p, LAS unsigned char* lds) {
    const int tid = threadIdx.x, lane = tid & 63, wave = tid >> 6, G = gridDim.x;
    unsigned char* ws = p.ws;
    const float* MOD = (const float*)(ws + WS_MOD);
    bf16_t* XN = (bf16_t*)(ws + WS_XN);
    const int gw = blockIdx.x * NWAVES + wave, NGW = G * NWAVES;
    for (int row = gw; row < MLAT + MCTX; row += NGW) {
        const bool isctx = row >= MLAT; const int mr = isctx ? 8 : (row >> 12);
        const float* xrow = isctx ? p.ctx + (size_t)(row - MLAT) * DM : p.x + (size_t)row * DM;
        const float* sh = MOD + (size_t)mr * 6144; const float* sc = sh + 1024;
        const f32x4* xr = (const f32x4*)xrow + lane;
        f32x4 v[4]; float s = 0.f;
#pragma unroll
        for (int j = 0; j < 4; ++j) { v[j] = xr[64 * j]; s += (v[j].x * v[j].x + v[j].y * v[j].y) + (v[j].z * v[j].z + v[j].w * v[j].w); }
        const float rs = 1.0f / sqrtf(wave_sum(s) * (1.0f / DM) + 1e-6f);
        unsigned long long* o8 = (unsigned long long*)(XN + (size_t)row * DM) + lane;
#pragma unroll
        for (int j = 0; j < 4; ++j) { const int c0 = 4 * lane + 256 * j; const f32x4 hh = *(const f32x4*)(sh + c0), cc = *(const f32x4*)(sc + c0);
            const f32x4 y = v[j] * rs * (cc + 1.0f) + hh;
            o8[64 * j] = (unsigned long long)pk2(y.x, y.y) | ((unsigned long long)pk2(y.z, y.w) << 32); }
    }
}

typedef float f32x16 __attribute__((ext_vector_type(16)));
constexpr int RN_XS = 144;
constexpr int RN_XC = 0, RN_WT = 256 * RN_XS, RN_SEG = RN_WT + 64 * RN_XS;
__device__ __forceinline__ void phase_rnn(const Params& p, LAS unsigned char* lds, const bool dry) {
    const int tid = threadIdx.x, lane = tid & 63, wave = __builtin_amdgcn_readfirstlane(tid >> 6), G = gridDim.x;
    unsigned char* ws = p.ws;
    bf16_t* Z = (bf16_t*)(ws + WS_Z); const bf16_t* ZCb = (const bf16_t*)(ws + WS_ZC); bf16_t* HF = (bf16_t*)(ws + WS_XN);
    LAS unsigned char* xcb = lds + RN_XC;
    LAS unsigned char* wtb = lds + RN_WT;
    LAS float* segA = (LAS float*)(lds + RN_SEG);
    LAS float* segB = segA + 512;
    const int c = lane & 31, hh = lane >> 5;
    const int taur = 16 * ((c >> 2) & 1) + 4 * (c >> 3) + (c & 3);
    for (int it = blockIdx.x; it < 256; it += G) {
        const int b = it >> 5, g = (it >> 1) & 15, half = it & 1;
        const int ch = 64 * g + 32 * half + c;
        const int tt = tid >> 1, cb = 64 * g + 32 * (tid & 1);
        for (int dir = 0; dir < 2; ++dir) {
            __syncthreads();
            for (int e = tid; e < 2 * 64 * 32; e += NTHREADS) { const int mat = e >> 11, i = (e >> 5) & 63, cc = e & 31;
                const float* src = mat ? p.lru_wi : p.lru_wa;
                *(LAS bf16_t*)(wtb + (mat * 32 + cc) * RN_XS + i * 2) = (bf16_t)f2bf(src[(((size_t)dir * 16 + g) * 64 + i) * 64 + 32 * half + cc]); }
            __syncthreads();
            bf16x8 Bw[2][4];
#pragma unroll
            for (int mat = 0; mat < 2; ++mat)
#pragma unroll
                for (int s4 = 0; s4 < 4; ++s4) Bw[mat][s4] = *(const LAS bf16x8*)(wtb + (mat * 32 + c) * RN_XS + (16 * s4 + 8 * hh) * 2);
            const float ba = p.lru_ba[dir * 1024 + ch], bi = p.lru_bi[dir * 1024 + ch];
            const float lam = p.lru_lambda[dir * 1024 + ch];
            const float sp = (lam > 15.f) ? expf(-lam) : log1pf(expf(-lam));
            const float clam = -8.0f * sp * LOG2E;
            float hc = 0.f;
            for (int step = 0; step < 17; ++step) {
                const bool isctx = (step == 0);
                const int kchunk = isctx ? 0 : (dir == 0 ? step - 1 : 16 - step);
                const int t0 = kchunk * 256, len = isctx ? CTX : SEQ;
                const bf16_t* src = isctx ? (ZCb + (size_t)b * CTX * LDC + CC_XR) : (Z + (size_t)b * SEQ * LDZ + ZC_XR);
                const int ld = isctx ? LDC : LDZ;
                __syncthreads();
                {
                    float a[32];
#pragma unroll
                    for (int j = 0; j < 32; ++j) a[j] = p.conv_b[cb + j];
#pragma unroll
                    for (int k = 0; k < 4; ++k) { const int ts = t0 + tt + k - 2;
                        if (ts >= 0 && ts < len) { const u32x4* rp = (const u32x4*)(src + (size_t)ts * ld + cb);
#pragma unroll
                            for (int q = 0; q < 4; ++q) { const u32x4 w = rp[q]; const float* cw = p.conv_w + k * 1024 + cb + 8 * q;
                                a[8 * q + 0] += bf2f(w.x & 0xffffu) * cw[0]; a[8 * q + 1] += bf2f(w.x >> 16) * cw[1]; a[8 * q + 2] += bf2f(w.y & 0xffffu) * cw[2]; a[8 * q + 3] += bf2f(w.y >> 16) * cw[3];
                                a[8 * q + 4] += bf2f(w.z & 0xffffu) * cw[4]; a[8 * q + 5] += bf2f(w.z >> 16) * cw[5]; a[8 * q + 6] += bf2f(w.w & 0xffffu) * cw[6]; a[8 * q + 7] += bf2f(w.w >> 16) * cw[7]; } } }
                    LAS u32x4* dst = (LAS u32x4*)(xcb + tt * RN_XS + 64 * (tid & 1));
#pragma unroll
                    for (int q = 0; q < 4; ++q) { u32x4 w; w.x = cvt_pk_bf16(a[8 * q], a[8 * q + 1]); w.y = cvt_pk_bf16(a[8 * q + 2], a[8 * q + 3]); w.z = cvt_pk_bf16(a[8 * q + 4], a[8 * q + 5]); w.w = cvt_pk_bf16(a[8 * q + 6], a[8 * q + 7]); dst[q] = w; }
                }
                __syncthreads();
                f32x16 ar, ai;
#pragma unroll
                for (int j = 0; j < 16; ++j) { ar[j] = 0.f; ai[j] = 0.f; }
                const LAS unsigned char* arow = xcb + (32 * wave + taur) * RN_XS + 16 * hh;
#pragma unroll
                for (int s4 = 0; s4 < 4; ++s4) { const bf16x8 af = *(const LAS bf16x8*)(arow + 32 * s4);
                    ar = __builtin_amdgcn_mfma_f32_32x32x16_bf16(af, Bw[0][s4], ar, 0, 0, 0);
                    ai = __builtin_amdgcn_mfma_f32_32x32x16_bf16(af, Bw[1][s4], ai, 0, 0, 0); }
                const LAS unsigned char* xcol = xcb + (32 * wave + 16 * hh) * RN_XS + (32 * half + c) * 2;
#pragma unroll
                for (int j = 0; j < 16; ++j) {
                    const float r = sigmoidf_(ar[j] + ba), ig = sigmoidf_(ai[j] + bi);
                    const float l2 = r * clam;
                    const float a = __builtin_amdgcn_exp2f(l2);
                    const float om = -expm1f(2.0f * 0.6931471805599453f * l2);
                    const float xv = bf2f(*(const LAS bf16_t*)(xcol + j * RN_XS));
                    ar[j] = a; ai[j] = sqrtf(fmaxf(om, 0.f)) * ig * xv;
                }
                float P = 1.f, H = 0.f;
                if (dir == 0) {
#pragma unroll
                    for (int j = 0; j < 16; ++j) { H = ar[j] * H + ai[j]; P *= ar[j]; }
                } else {
#pragma unroll
                    for (int j = 15; j >= 0; --j) { H = ar[j] * H + ai[j]; P *= ar[j]; }
                }
                const int s = 2 * wave + hh;
                segA[s * 32 + c] = P; segB[s * 32 + c] = H;
                __syncthreads();
                float h = hc, hin = 0.f;
                if (dir == 0) { for (int q = 0; q < 16; ++q) { if (q == s) hin = h; h = segA[q * 32 + c] * h + segB[q * 32 + c]; } }
                else { for (int q = 15; q >= 0; --q) { if (q == s) hin = h; h = segA[q * 32 + c] * h + segB[q * 32 + c]; } }
                hc = h;
                if (!isctx) {
                    const size_t tb = (size_t)b * SEQ + t0 + 32 * wave + 16 * hh;
                    h = hin;
                    if (dir == 0) {
#pragma unroll
                        for (int j = 0; j < 16; ++j) { h = ar[j] * h + ai[j]; if (!dry) HF[(tb + j) * DM + ch] = (bf16_t)f2bf(h); }
                    } else {
#pragma unroll
                        for (int j = 15; j >= 0; --j) { h = ar[j] * h + ai[j];
                            const float hf = bf2f(HF[(tb + j) * DM + ch]); bf16_t* yp = Z + (tb + j) * LDZ + ZC_YG + ch;
                            const bf16_t yv = (bf16_t)f2bf((hf + h) * bf2f(*yp)); if (!dry) *yp = yv; }
                    }
                }
            }
        }
    }
}

constexpr int AT_KS = 144, AT_VS = 160, AT_KB = 64 * AT_KS, AT_VB = 64 * AT_VS, AT_SLOT = AT_KB + AT_VB, AT_BIAS = 2 * AT_SLOT;
typedef short s16x4 __attribute__((ext_vector_type(4)));
struct QBlk { bf16x8 q[2]; f32x4 o[4]; float m, l; };
template <bool LOCAL>
__device__ __forceinline__ void attn_proc32(QBlk& S, const LAS unsigned char* Kc, const LAS unsigned char* Vc, int kc0, int lane, int lo, const LAS float* brow, int dc0) {
    const int i = lane & 15, kq = lane >> 4;
    f32x4 s0 = (f32x4){0.f, 0.f, 0.f, 0.f}, s1 = s0;
#pragma unroll
    for (int ks = 0; ks < 2; ++ks) {
        const bf16x8 a0 = *(const LAS bf16x8*)(Kc + (kc0 + i) * AT_KS + ks * 64 + kq * 16);
        const bf16x8 a1 = *(const LAS bf16x8*)(Kc + (kc0 + 16 + i) * AT_KS + ks * 64 + kq * 16);
        s0 = __builtin_amdgcn_mfma_f32_16x16x32_bf16(a0, S.q[ks], s0, 0, 0, 0);
        s1 = __builtin_amdgcn_mfma_f32_16x16x32_bf16(a1, S.q[ks], s1, 0, 0, 0);
    }
    if (LOCAL) {
#pragma unroll
        for (int r = 0; r < 4; ++r) {
            const int d0 = min(max(dc0 + r, 0), 30), d1 = min(max(dc0 + 16 + r, 0), 30);
            const float b0 = brow[d0], b1 = brow[d1];
            s0[r] = (r >= lo && r < lo + 16) ? s0[r] + b0 : -1e30f;
            s1[r] = (16 + r >= lo && 16 + r < lo + 16) ? s1[r] + b1 : -1e30f;
        }
    }
    float mc = fmaxf(fmaxf(fmaxf(s0[0], s0[1]), fmaxf(s0[2], s0[3])), fmaxf(fmaxf(s1[0], s1[1]), fmaxf(s1[2], s1[3])));
    mc = fmaxf(mc, __shfl_xor(mc, 16)); mc = fmaxf(mc, __shfl_xor(mc, 32));
    const float mn = fmaxf(S.m, mc), alpha = __builtin_amdgcn_exp2f(S.m - mn);
    S.m = mn;
    float ps = 0.f;
#pragma unroll
    for (int r = 0; r < 4; ++r) { s0[r] = __builtin_amdgcn_exp2f(s0[r] - mn); s1[r] = __builtin_amdgcn_exp2f(s1[r] - mn); ps += s0[r] + s1[r]; }
    S.l = S.l * alpha + ps;
    bf16x8 pb;
    { const unsigned w0 = cvt_pk_bf16(s0[0], s0[1]), w1 = cvt_pk_bf16(s0[2], s0[3]), w2 = cvt_pk_bf16(s1[0], s1[1]), w3 = cvt_pk_bf16(s1[2], s1[3]);
      const u32x4 w = (u32x4){w0, w1, w2, w3}; pb = __builtin_bit_cast(bf16x8, w); }
    const LAS unsigned char* vp = Vc + (kc0 + 4 * kq + ((lane & 15) >> 2)) * AT_VS + (lane & 3) * 8;
#pragma unroll
    for (int dt = 0; dt < 4; ++dt) {
        const s16x4 lo4 = __builtin_bit_cast(s16x4, __builtin_amdgcn_ds_read_tr16_b64_v4i16((LAS s16x4*)(vp + dt * 32)));
        const s16x4 hi4 = __builtin_bit_cast(s16x4, __builtin_amdgcn_ds_read_tr16_b64_v4i16((LAS s16x4*)(vp + dt * 32 + 16 * AT_VS)));
        const bf16x8 av = (bf16x8){lo4[0], lo4[1], lo4[2], lo4[3], hi4[0], hi4[1], hi4[2], hi4[3]};
        S.o[dt] = __builtin_amdgcn_mfma_f32_16x16x32_bf16(av, pb, S.o[dt] * alpha, 0, 0, 0);
    }
}
__device__ __forceinline__ void phase_attn(const Params& p, LAS unsigned char* lds, const bool dry) {
    const int tid = threadIdx.x, lane = tid & 63, wave = __builtin_amdgcn_readfirstlane(tid >> 6), G = gridDim.x;
    unsigned char* ws = p.ws;
    bf16_t* Z = (bf16_t*)(ws + WS_Z); const bf16_t* ZCb = (const bf16_t*)(ws + WS_ZC);
    LAS float* btab = (LAS float*)(lds + AT_BIAS);
    const int j = wave & 3, c16 = lane & 15, fq = lane >> 4;
    const int cq = 16 * j + c16, cst = min(max(cq - 8, 0), 48), kst = min(max(16 * j - 8, 0), 32);
    const int lo = cst - kst - 4 * fq;
    const int dc0 = kst + 4 * fq - cq + 15;
    const int lkey = tid >> 3, lpc = tid & 7;
    for (int u = blockIdx.x; u < NB * 16 * 16; u += G) {
        const int b = u >> 8, h = (u >> 4) & 15, r0 = 4 * (u & 15);
        const int kr_lo = min(max(r0 - 4, 0), 56), kr_hi = min(max(r0 - 1, 0), 56) + 7, nloc = kr_hi - kr_lo + 1, nch = nloc + 4;
        const int rA = r0 + (wave >> 2), rB = rA + 2, rsA = min(max(rA - 4, 0), 56), rsB = min(max(rB - 4, 0), 56);
        bf16_t* qA = Z + ((size_t)b * SEQ + rA * 64 + cq) * LDZ + ZC_Q + h * 64;
        bf16_t* qB = Z + ((size_t)b * SEQ + rB * 64 + cq) * LDZ + ZC_Q + h * 64;
        QBlk A, Bq;
#pragma unroll
        for (int ks = 0; ks < 2; ++ks) { A.q[ks] = *(const bf16x8*)(qA + ks * 32 + fq * 8); Bq.q[ks] = *(const bf16x8*)(qB + ks * 32 + fq * 8); }
#pragma unroll
        for (int dt = 0; dt < 4; ++dt) { A.o[dt] = (f32x4){0.f, 0.f, 0.f, 0.f}; Bq.o[dt] = (f32x4){0.f, 0.f, 0.f, 0.f}; }
        A.m = -1e30f; A.l = 0.f; Bq.m = -1e30f; Bq.l = 0.f;
        for (int e = tid; e < 15 * 31; e += NTHREADS) btab[e] = p.na_rpb[(size_t)h * 465 + e] * LOG2E;
        const bf16_t* kbase = Z + ((size_t)b * SEQ + lkey) * LDZ + ZC_K + h * 64 + lpc * 8;
        const bf16_t* cbase = ZCb + ((size_t)b * CTX + lkey) * LDC + CC_K + h * 64 + lpc * 8;
        u32x4 kreg, vreg;
        { const bf16_t* src = kbase + (size_t)kr_lo * 64 * LDZ; kreg = *(const u32x4*)src; vreg = *(const u32x4*)(src + (ZC_V - ZC_K)); }
        *(LAS u32x4*)(lds + lkey * AT_KS + lpc * 16) = kreg; *(LAS u32x4*)(lds + AT_KB + lkey * AT_VS + lpc * 16) = vreg;
        __syncthreads();
        for (int c = 0; c < nch; ++c) {
            if (c + 1 < nch) {
                if (c + 1 < nloc) { const bf16_t* src = kbase + (size_t)(kr_lo + c + 1) * 64 * LDZ; kreg = *(const u32x4*)src; vreg = *(const u32x4*)(src + (ZC_V - ZC_K)); }
                else { const bf16_t* src = cbase + (size_t)(c + 1 - nloc) * 64 * LDC; kreg = *(const u32x4*)src; vreg = *(const u32x4*)(src + (CC_V - CC_K)); }
            }
            const LAS unsigned char* Kc = lds + (c & 1) * AT_SLOT; const LAS unsigned char* Vc = Kc + AT_KB;
            if (c < nloc) {
                const int kr = kr_lo + c;
                if (kr >= rsA && kr < rsA + 8) attn_proc32<true>(A, Kc, Vc, kst, lane, lo, btab + (kr - rA + 7) * 31, dc0);
                if (kr >= rsB && kr < rsB + 8) attn_proc32<true>(Bq, Kc, Vc, kst, lane, lo, btab + (kr - rB + 7) * 31, dc0);
            } else {
                attn_proc32<false>(A, Kc, Vc, 0, lane, 0, btab, 0); attn_proc32<false>(A, Kc, Vc, 32, lane, 0, btab, 0);
                attn_proc32<false>(Bq, Kc, Vc, 0, lane, 0, btab, 0); attn_proc32<false>(Bq, Kc, Vc, 32, lane, 0, btab, 0);
            }
            if (c + 1 < nch) { LAS unsigned char* d = lds + ((c + 1) & 1) * AT_SLOT; *(LAS u32x4*)(d + lkey * AT_KS + lpc * 16) = kreg; *(LAS u32x4*)(d + AT_KB + lkey * AT_VS + lpc * 16) = vreg; }
            __syncthreads();
        }
        {
            float l = A.l; l += __shfl_xor(l, 16); l += __shfl_xor(l, 32); const float il = 1.0f / l;
#pragma unroll
            for (int dt = 0; dt < 4; ++dt) { const f32x4 o = A.o[dt] * il; u32x2 w; w.x = cvt_pk_bf16(o[0], o[1]); w.y = cvt_pk_bf16(o[2], o[3]); if (!dry) *(u32x2*)(qA + dt * 16 + fq * 4) = w; }
            l = Bq.l; l += __shfl_xor(l, 16); l += __shfl_xor(l, 32); const float il2 = 1.0f / l;
#pragma unroll
            for (int dt = 0; dt < 4; ++dt) { const f32x4 o = Bq.o[dt] * il2; u32x2 w; w.x = cvt_pk_bf16(o[0], o[1]); w.y = cvt_pk_bf16(o[2], o[3]); if (!dry) *(u32x2*)(qB + dt * 16 + fq * 4) = w; }
        }
    }
}

__device__ __forceinline__ void phase_norm2(const Params& p, LAS unsigned char* lds) {
    const int tid = threadIdx.x, lane = tid & 63, wave = tid >> 6, G = gridDim.x;
    unsigned char* ws = p.ws;
    const float* MOD = (const float*)(ws + WS_MOD); bf16_t* XN2 = (bf16_t*)(ws + WS_XN); float* AFF = (float*)(ws + WS_AFF);
    LAS float* wrT = (LAS float*)lds;
    for (int e = tid; e < 16 * 1024; e += NTHREADS) wrT[(e & 15) * 1024 + (e >> 4)] = p.w_router[e];
    __syncthreads();
    const int gw = blockIdx.x * NWAVES + wave, NGW = G * NWAVES;
    const bool b5 = lane & 32, b4 = lane & 16, b3 = lane & 8, b2 = lane & 4;
    const int myex = (b5 ? 8 : 0) + (b4 ? 4 : 0) + (b3 ? 2 : 0) + (b2 ? 1 : 0);
    for (int row = gw; row < MLAT; row += NGW) {
        const int b = row >> 12;
        const f32x4* xr = (const f32x4*)(p.out + (size_t)row * DM) + lane;
        f32x4 v[4]; float s = 0.f;
#pragma unroll
        for (int j = 0; j < 4; ++j) { v[j] = xr[64 * j]; s += (v[j].x * v[j].x + v[j].y * v[j].y) + (v[j].z * v[j].z + v[j].w * v[j].w); }
        const float rs = 1.0f / sqrtf(wave_sum(s) * (1.0f / DM) + 1e-6f);
        unsigned long long* o8 = (unsigned long long*)(XN2 + (size_t)row * DM) + lane;
#pragma unroll
        for (int j = 0; j < 4; ++j) { const int c0 = 4 * lane + 256 * j;
            const f32x4 hh = *(const f32x4*)(MOD + (size_t)b * 6144 + 3072 + c0), cc = *(const f32x4*)(MOD + (size_t)b * 6144 + 4096 + c0);
            v[j] = v[j] * rs * (cc + 1.0f) + hh;
            o8[64 * j] = (unsigned long long)pk2(v[j].x, v[j].y) | ((unsigned long long)pk2(v[j].z, v[j].w) << 32); }
        float lg[16];
#pragma unroll
        for (int e = 0; e < 16; ++e) { float a = 0.f;
#pragma unroll
            for (int j = 0; j < 4; ++j) { const f32x4 w = *(const LAS f32x4*)(wrT + e * 1024 + 4 * lane + 256 * j); a += (v[j].x * w.x + v[j].y * w.y) + (v[j].z * w.z + v[j].w * w.w); }
            lg[e] = a; if (e & 1) asm volatile("" ::: "memory"); }
        float t8[8], t4[4], t2[2], t1;
#pragma unroll
        for (int i = 0; i < 8; ++i) { const float snd = b5 ? lg[i] : lg[i + 8], kp = b5 ? lg[i + 8] : lg[i]; t8[i] = kp + __shfl_xor(snd, 32); }
#pragma unroll
        for (int i = 0; i < 4; ++i) { const float snd = b4 ? t8[i] : t8[i + 4], kp = b4 ? t8[i + 4] : t8[i]; t4[i] = kp + __shfl_xor(snd, 16); }
#pragma unroll
        for (int i = 0; i < 2; ++i) { const float snd = b3 ? t4[i] : t4[i + 2], kp = b3 ? t4[i + 2] : t4[i]; t2[i] = kp + __shfl_xor(snd, 8); }
        { const float snd = b2 ? t2[0] : t2[1], kp = b2 ? t2[1] : t2[0]; t1 = kp + __shfl_xor(snd, 4); }
        t1 += __shfl_xor(t1, 2); t1 += __shfl_xor(t1, 1);
        float mx = t1;
        mx = fmaxf(mx, __shfl_xor(mx, 4)); mx = fmaxf(mx, __shfl_xor(mx, 8)); mx = fmaxf(mx, __shfl_xor(mx, 16)); mx = fmaxf(mx, __shfl_xor(mx, 32));
        const float ex = expf(t1 - mx);
        float sum = ex;
        sum += __shfl_xor(sum, 4); sum += __shfl_xor(sum, 8); sum += __shfl_xor(sum, 16); sum += __shfl_xor(sum, 32);
        if ((lane & 3) == 0) AFF[(size_t)row * 16 + myex] = ex / sum;
    }
}

__device__ __forceinline__ void phase_topk(const Params& p, LAS unsigned char* lds) {
    const int tid = threadIdx.x, lane = tid & 63, wave = tid >> 6, G = gridDim.x;
    unsigned char* ws = p.ws;
    const float* AFF = (const float*)(ws + WS_AFF); int* SELIDX = (int*)(ws + WS_SELIDX); float* SELG = (float*)(ws + WS_SELG); int* SLOT = (int*)(ws + WS_SLOT);
    LAS unsigned* hist = (LAS unsigned*)lds;
    LAS unsigned* ctl = hist + 256;
    LAS unsigned* wtot = hist + 264;
    for (int it = blockIdx.x; it < NB * NEXP; it += G) {
        const int b = it >> 4, e = it & 15;
        unsigned v[8];
#pragma unroll
        for (int j = 0; j < 8; ++j) v[j] = __builtin_bit_cast(unsigned, AFF[((size_t)b * SEQ + tid * 8 + j) * 16 + e]);
        unsigned prefix = 0u, mask = 0u, need = CAP;
        for (int shift = 24; shift >= 0; shift -= 8) {
            __syncthreads();
            if (tid < 256) hist[tid] = 0u;
            __syncthreads();
#pragma unroll
            for (int j = 0; j < 8; ++j) if ((v[j] & mask) == prefix) atomicAdd((unsigned*)&hist[(v[j] >> shift) & 255u], 1u);
            __syncthreads();
            if (tid == 0) { unsigned cum = 0u; int bin = 255; for (; bin > 0; --bin) { const unsigned hv = hist[bin]; if (cum + hv >= need) break; cum += hv; } ctl[0] = (unsigned)bin; ctl[1] = need - cum; }
            __syncthreads();
            prefix |= ctl[0] << shift; mask |= 255u << shift; need = ctl[1];
        }
        unsigned ngt = 0u, neq = 0u;
#pragma unroll
        for (int j = 0; j < 8; ++j) { ngt += (v[j] > prefix) ? 1u : 0u; neq += (v[j] == prefix) ? 1u : 0u; }
        unsigned sg = ngt, se = neq;
#pragma unroll
        for (int o = 1; o < 64; o <<= 1) { const unsigned a = __shfl_up(sg, o), c2 = __shfl_up(se, o); if (lane >= o) { sg += a; se += c2; } }
        __syncthreads();
        if (lane == 63) { wtot[wave] = sg; wtot[8 + wave] = se; }
        __syncthreads();
        unsigned og = sg - ngt, oe = se - neq, totg = 0u;
        for (int w = 0; w < 8; ++w) { const unsigned a = wtot[w], c2 = wtot[8 + w]; if (w < wave) { og += a; oe += c2; } totg += a; }
#pragma unroll
        for (int j = 0; j < 8; ++j) {
            const int tkn = tid * 8 + j; int slot = -1;
            if (v[j] > prefix) slot = (int)og++;
            else if (v[j] == prefix) { if (oe < need) slot = (int)(totg + oe); ++oe; }
            const int erow = b * CAP + slot;
            SLOT[((size_t)b * SEQ + tkn) * 16 + e] = (slot >= 0) ? erow : -1;
            if (slot >= 0) { SELIDX[e * EROWS + erow] = b * SEQ + tkn; SELG[e * EROWS + erow] = __builtin_bit_cast(float, v[j]); }
        }
    }
    __syncthreads();
    {
        LAS float* scr = (LAS float*)(lds + wave * TR_SCR);
        bf16_t* WGU = (bf16_t*)(ws + WS_WGU); bf16_t* WD = (bf16_t*)(ws + WS_WD);
        const int gw = blockIdx.x * NWAVES + wave, NGW = G * NWAVES;
        constexpr int I_G = 16 * 32, I_D = 32 * 16;
        for (int it = gw; it < 16 * (2 * I_G + I_D); it += NGW) {
            const int e = it / (2 * I_G + I_D); int r = it % (2 * I_G + I_D);
            if (r < 2 * I_G) { const int up = r / I_G; r %= I_G; const int kb = r / 32, nb = r % 32;
                const float* W = (up ? p.w_exp_up : p.w_exp_gate) + (size_t)e * 1024 * 2048;
                transpose_item(W, 2048, 64 * kb, 64 * nb, WGU + (size_t)e * 4096 * 1024, 1024, [up](int n) { return 256 * (n >> 7) + 128 * up + (n & 127); }, scr, lane); }
            else { r -= 2 * I_G; const int kb = r / 16, nb = r % 16;
                transpose_item(p.w_exp_down + (size_t)e * 2048 * 1024, 1024, 64 * kb, 64 * nb, WD + (size_t)e * 1024 * 2048, 2048, [](int n) { return n; }, scr, lane); }
        }
    }
}

__device__ __forceinline__ void phase_final(const Params& p, LAS unsigned char* lds, const bool dry) {
    const int tid = threadIdx.x, lane = tid & 63, wave = tid >> 6, G = gridDim.x;
    unsigned char* ws = p.ws;
    const float* MOD = (const float*)(ws + WS_MOD); const int* SLOT = (const int*)(ws + WS_SLOT); const bf16_t* YE = (const bf16_t*)(ws + WS_YE);
    const int gw = blockIdx.x * NWAVES + wave, NGW = G * NWAVES;
    for (int row = gw; row < MLAT; row += NGW) {
        const int b = row >> 12;
        f32x4* xr = (f32x4*)(p.out + (size_t)row * DM) + lane;
        f32x4 v[4], mo[4];
#pragma unroll
        for (int j = 0; j < 4; ++j) { v[j] = xr[64 * j]; mo[j] = (f32x4){0.f, 0.f, 0.f, 0.f}; }
        const int myslot = (lane < 16) ? SLOT[(size_t)row * 16 + lane] : -1;
        for (int e = 0; e < 16; ++e) {
            const int sl = __shfl(myslot, e);
            if (sl >= 0) { const unsigned long long* yp = (const unsigned long long*)(YE + ((size_t)e * EROWS + sl) * DM) + lane;
#pragma unroll
                for (int j = 0; j < 4; ++j) { const unsigned long long w = yp[64 * j]; const unsigned lo = (unsigned)w, hi = (unsigned)(w >> 32);
                    mo[j].x += bf2f(lo & 0xffffu); mo[j].y += bf2f(lo >> 16); mo[j].z += bf2f(hi & 0xffffu); mo[j].w += bf2f(hi >> 16); } }
        }
        float s = 0.f;
#pragma unroll
        for (int j = 0; j < 4; ++j) { const int c0 = 4 * lane + 256 * j; const f32x4 g2 = *(const f32x4*)(MOD + (size_t)b * 6144 + 5120 + c0);
            v[j] = v[j] + g2 * mo[j]; s += (v[j].x * v[j].x + v[j].y * v[j].y) + (v[j].z * v[j].z + v[j].w * v[j].w); }
        const float rs = 1.0f / sqrtf(wave_sum(s) * (1.0f / DM) + 1e-6f);
#pragma unroll
        for (int j = 0; j < 4; ++j) { const int c0 = 4 * lane + 256 * j; const f32x4 fn = *(const f32x4*)(p.final_norm + c0); if (!dry) xr[64 * j] = v[j] * rs * fn; }
    }
}

#define XB_TMO      128
#define XB_XCNT(j)  (256  + 64 * (j))
#define XB_XSUB(j)  (1280 + 64 * (j))
#define XB_XGEN(j)  (2304 + 64 * (j))
#define XB_TOP      3328
#define XB_TOPGEN   3392
#define XCD_BAR_WORDS 3456
#define XB_SPIN_CAP (1u << 20)
__device__ __forceinline__ unsigned xb_ld(unsigned* p)              { return __hip_atomic_load(p, __ATOMIC_RELAXED, __HIP_MEMORY_SCOPE_AGENT); }
__device__ __forceinline__ unsigned xb_add(unsigned* p, unsigned v) { return __hip_atomic_fetch_add(p, v, __ATOMIC_RELAXED, __HIP_MEMORY_SCOPE_AGENT); }
__device__ __forceinline__ unsigned xb_xcc_id() { return (unsigned)__builtin_amdgcn_s_getreg((3 << 11) | 20) & 0xFu; }
#define XB_SPIN(cond, bar) do { unsigned _sp = 0; while (cond) { __builtin_amdgcn_s_sleep(1); \
    if ((++_sp & 255u) == 0u) { if (xb_ld(&(bar)[XB_TMO])) break; if (_sp > XB_SPIN_CAP) { atomicAdd(&(bar)[XB_TMO], 1u); break; } } } } while (0)
struct XcdBarrier { unsigned* bar; unsigned x; volatile LAS unsigned* st; };
__device__ __forceinline__ XcdBarrier xcd_barrier_post(unsigned* bar, volatile LAS unsigned* st) {
    XcdBarrier b; b.bar = bar; b.x = xb_xcc_id(); b.st = st;
    if (threadIdx.x == 0) (void)xb_add(&bar[XB_XCNT(b.x)], 1u);
    return b;
}
__device__ __forceinline__ void xcd_barrier_complete(unsigned* bar, unsigned x, unsigned& nloc, unsigned& nx) {
    const unsigned G = gridDim.x * gridDim.y * gridDim.z;
    unsigned sum, cnt, mine, sp = 0u;
    for (;;) {
        sum = 0u; cnt = 0u; mine = 0u;
#pragma unroll
        for (unsigned j = 0; j < 16; ++j) { const unsigned c = xb_ld(&bar[XB_XCNT(j)]); sum += c; cnt += (c > 0u) ? 1u : 0u; mine = (j == x) ? c : mine; }
        if (sum == G) break;
        __builtin_amdgcn_s_sleep(1);
        if ((++sp & 255u) == 0u) { if (xb_ld(&bar[XB_TMO])) break; if (sp > XB_SPIN_CAP) { atomicAdd(&bar[XB_TMO], 1u); break; } }
    }
    nloc = mine > 0u ? mine : 1u; nx = cnt > 0u ? cnt : 1u;
}
__device__ __forceinline__ void xcd_barrier(const XcdBarrier& b) {
    asm volatile("s_waitcnt vmcnt(0)" ::: "memory");
    __syncthreads();
    if (threadIdx.x == 0) {
        unsigned* bar = b.bar;
        __builtin_amdgcn_s_waitcnt(0);
        unsigned nloc = b.st[0], nx = b.st[1];
        if (nloc == 0u) { xcd_barrier_complete(bar, b.x, nloc, nx); b.st[0] = nloc; b.st[1] = nx; }
        const unsigned old = xb_add(&bar[XB_XSUB(b.x)], 1u);
        const unsigned gen = old / nloc;
        if (old + 1u == (gen + 1u) * nloc) {
            __builtin_amdgcn_fence(__ATOMIC_RELEASE, "agent");
            asm volatile("s_waitcnt vmcnt(0)" ::: "memory");
            const unsigned og = xb_add(&bar[XB_TOP], 1u);
            const unsigned tg = og / nx;
            if (og + 1u == (tg + 1u) * nx) xb_add(&bar[XB_TOPGEN], 1u);
            else XB_SPIN(xb_ld(&bar[XB_TOPGEN]) == tg, bar);
            __builtin_amdgcn_fence(__ATOMIC_ACQUIRE, "agent");
            xb_add(&bar[XB_XGEN(b.x)], 1u);
            asm volatile("s_waitcnt vmcnt(0)" ::: "memory");
        } else {
            XB_SPIN(xb_ld(&bar[XB_XGEN(b.x)]) == gen, bar);
            __builtin_amdgcn_fence(__ATOMIC_ACQUIRE, "agent");
            asm volatile("s_waitcnt vmcnt(0)" ::: "memory");
        }
    }
    __syncthreads();
}

constexpr int NPHASE = 12;
__global__ void __launch_bounds__(NTHREADS, 2) mk_fwd(Params p) {
    extern __shared__ __attribute__((aligned(16))) unsigned char lds_raw[];
    LAS unsigned char* lds = (LAS unsigned char*)lds_raw;
    cg::grid_group grid = cg::this_grid();
    unsigned char* ws = p.ws;
    const int G = gridDim.x, cblk = blockIdx.x;
#ifndef PH_MASK
#define PH_MASK 0xfff
#endif
#define IN(k) (((PH_MASK >> (k)) & 1) && p.ph_lo <= (k) && (k) < p.ph_hi)
    { volatile LAS unsigned* st0 = (volatile LAS unsigned*)(lds + LDS_BYTES - 256); if (threadIdx.x < 64) st0[threadIdx.x] = 0u; }
    __syncthreads();
    XcdBarrier xbar = xcd_barrier_post((unsigned*)(ws + WS_CTL) + 4096, (volatile LAS unsigned*)(lds + LDS_BYTES - 256));
#define SEAM(k) do { if (IN(k) && IN((k) + 1)) { if ((k) == 0) grid.sync(); else xcd_barrier(xbar); } } while (0)
    if (IN(0)) phase_prep(p, lds);
    SEAM(0);
    if (IN(1)) phase_norm1(p, lds);
    SEAM(1);
    if (IN(2)) {
        InprojSched S{(const bf16_t*)(ws + WS_XN), (const bf16_t*)(ws + WS_WINT), G, cblk, 1024, 1024, 1024};
        EpiInproj E{(bf16_t*)(ws + WS_Z), (bf16_t*)(ws + WS_ZC), (const float*)(ws + WS_BINZ), (const float*)(ws + WS_ROPE)};
        pg8::gemm_phase<EpiInproj, InprojSched>(lds, S, E);
    }
    SEAM(2);
    if (IN(3)) { if (p.probe & 8) { phase_rnn(p, lds, true); __syncthreads(); } phase_rnn(p, lds, false); }
    if (IN(3) && IN(4)) __syncthreads();
    if (IN(4)) { if (p.probe & 16) { phase_attn(p, lds, true); __syncthreads(); } phase_attn(p, lds, false); }
    SEAM(4);
    if (IN(5)) {
        MixSched S{(const bf16_t*)(ws + WS_Z), (const bf16_t*)(ws + WS_WMIX), G, cblk, LDZ, 1024, 1024};
        EpiMix E{(bf16_t*)(ws + WS_Z)};
        pg8::gemm_phase<EpiMix, MixSched>(lds, S, E);
    }
    SEAM(5);
    if (IN(6)) {
        WoutSched S{(const bf16_t*)(ws + WS_Z), (const bf16_t*)(ws + WS_WOUT), G, cblk, LDZ, 1024, 1024};
        EpiWout E{p.x, p.out, (const float*)(ws + WS_MOD)};
        pg8::gemm_phase<EpiWout, WoutSched>(lds, S, E);
    }
    SEAM(6);
    if (IN(7)) phase_norm2(p, lds);
    SEAM(7);
    if (IN(8)) phase_topk(p, lds);
    SEAM(8);
    if (IN(9)) {
        Moe1Sched S{(const bf16_t*)(ws + WS_XN), (const bf16_t*)(ws + WS_WGU), (const int*)(ws + WS_SELIDX), G, cblk, 1024, 1024, 1024};
        EpiMoe1 E{(bf16_t*)(ws + WS_HID)};
        pg8::gemm_phase<EpiMoe1, Moe1Sched>(lds, S, E);
    }
    SEAM(9);
    if (IN(10)) {
        Moe2Sched S{(const bf16_t*)(ws + WS_HID), (const bf16_t*)(ws + WS_WD), G, cblk, 2048, 2048, 2048};
        EpiMoe2 E{(bf16_t*)(ws + WS_YE), (const float*)(ws + WS_SELG)};
        pg8::gemm_phase<EpiMoe2, Moe2Sched>(lds, S, E);
    }
    SEAM(10);
    if (IN(11)) { if (p.probe & 2048) { phase_final(p, lds, true); __syncthreads(); } phase_final(p, lds, false); }
#undef IN
#undef SEAM
}

#ifndef MK_SINGLE
#define MK_SINGLE 1
#endif
extern "C" void kernel_launch(void* const* d_in, const int* in_sizes, int n_in, void* d_out, int out_size, void* d_ws, size_t ws_size, hipStream_t stream) {
    static int grid = 0;
    if (grid == 0) {
        int dev = 0, cus = 0, per_cu = 0;
        if (n_in != 24 || out_size != MLAT * DM || ws_size < WS_END) { fprintf(stderr, "kernel_launch: unexpected problem (n_in %d, out %d, ws %zu < %zu)\n", n_in, out_size, ws_size, (size_t)WS_END); grid = -1; return; }
        if (hipGetDevice(&dev) != hipSuccess || hipDeviceGetAttribute(&cus, hipDeviceAttributeMultiprocessorCount, dev) != hipSuccess) { grid = -1; return; }
        if (hipFuncSetAttribute((const void*)mk_fwd, hipFuncAttributeMaxDynamicSharedMemorySize, LDS_BYTES) != hipSuccess) { fprintf(stderr, "kernel_launch: hipFuncSetAttribute failed\n"); grid = -1; return; }
        if (hipOccupancyMaxActiveBlocksPerMultiprocessor(&per_cu, (const void*)mk_fwd, NTHREADS, LDS_BYTES) != hipSuccess || per_cu < 1) { fprintf(stderr, "kernel_launch: occupancy query says %d\n", per_cu); grid = -1; return; }
        grid = cus;
    }
    if (grid < 0) return;
    (void)hipMemsetAsync((char*)d_ws + WS_CTL, 0, 1 * MiB, stream);
    Params p{};
    const float** pp = (const float**)&p;
    for (int i = 0; i < 24; ++i) pp[i] = (const float*)d_in[i];
#ifndef PROBE_MASK
#define PROBE_MASK 0
#endif
    p.out = (float*)d_out; p.ws = (unsigned char*)d_ws; p.probe = PROBE_MASK;
#if MK_SINGLE
    p.ph_lo = 0; p.ph_hi = NPHASE;
    void* args[] = {&p};
    hipError_t e = hipLaunchCooperativeKernel((const void*)mk_fwd, dim3(grid), dim3(NTHREADS), args, LDS_BYTES, stream);
    if (e != hipSuccess) fprintf(stderr, "kernel_launch: cooperative launch failed: %s (grid %d)\n", hipGetErrorString(e), grid);
#else
#ifndef REP_MASK
#define REP_MASK 0
#endif
    for (int ph = 0; ph < NPHASE; ++ph) {
        p.ph_lo = ph; p.ph_hi = ph + 1;
        for (int rep = 0; rep < 1 + ((REP_MASK >> ph) & 1); ++rep) hipLaunchKernelGGL(mk_fwd, dim3(grid), dim3(NTHREADS), LDS_BYTES, stream, p);
    }
#endif
}
```

```cpp
#include <hip/hip_runtime.h>
#include <hip/hip_cooperative_groups.h>
#include <cstdio>
#include <cstdint>
namespace cg = cooperative_groups;

#define LAS __attribute__((address_space(3)))
typedef unsigned short bf16_t;
typedef short bf16x8 __attribute__((ext_vector_type(8)));
typedef float f32x4 __attribute__((ext_vector_type(4)));
typedef float f32x2 __attribute__((ext_vector_type(2)));
typedef unsigned u32x4 __attribute__((ext_vector_type(4)));
typedef unsigned u32x2 __attribute__((ext_vector_type(2)));

constexpr int NB = 8, SEQ = 4096, DM = 1024, CTX = 256;
constexpr int MLAT = NB * SEQ, MCTX = NB * CTX;
constexpr int NIN = 7168, NEXP = 16, DEXP = 2048, CAP = 512, EROWS = NB * CAP;
constexpr int LDZ = 7168, ZC_YG = 0, ZC_Q = 1024, ZC_XR = 2048, ZC_K = 3072, ZC_V = 4096, ZC_GR = 5120, ZC_GN = 6144;
constexpr int LDC = 3072, CC_XR = 0, CC_K = 1024, CC_V = 2048;
constexpr float LOG2E = 1.4426950408889634f;
constexpr float QSCALE = 0.125f * LOG2E;

constexpr size_t MiB = 1u << 20;
constexpr size_t WS_CTL = 0;
constexpr size_t WS_MOD = 1 * MiB;
constexpr size_t WS_MODP = 2 * MiB;
constexpr size_t WS_ROPE = 9 * MiB;
constexpr size_t WS_BINZ = 9 * MiB + 65536;
constexpr size_t WS_AFF = 10 * MiB;
constexpr size_t WS_SELIDX = 12 * MiB;
constexpr size_t WS_SELG = 12 * MiB + 262144;
constexpr size_t WS_SLOT = 13 * MiB;
constexpr size_t WS_WINT = 16 * MiB;
constexpr size_t WS_WMIX = 30 * MiB;
constexpr size_t WS_WOUT = 34 * MiB;
constexpr size_t WS_ZC = 36 * MiB;
constexpr size_t WS_XN = 48 * MiB;
constexpr size_t WS_Z = 116 * MiB;
constexpr size_t WS_WGU = 116 * MiB;
constexpr size_t WS_WD = 180 * MiB;
constexpr size_t WS_HID = 212 * MiB;
constexpr size_t WS_YE = 340 * MiB;
constexpr size_t WS_END = 564 * MiB;

constexpr int NTHREADS = 512, NWAVES = 8;
constexpr int LDS_BYTES = 147456;

__device__ __forceinline__ unsigned f2bf(float f) { unsigned u = __builtin_bit_cast(unsigned, f); return (u + 0x7fffu + ((u >> 16) & 1u)) >> 16; }
__device__ __forceinline__ float bf2f(unsigned h) { return __builtin_bit_cast(float, h << 16); }
__device__ __forceinline__ unsigned pk2(float lo, float hi) { return f2bf(lo) | (f2bf(hi) << 16); }
__device__ __forceinline__ unsigned cvt_pk_bf16(float lo, float hi) { unsigned r; asm volatile("v_cvt_pk_bf16_f32 %0, %1, %2" : "=v"(r) : "v"(lo), "v"(hi)); return r; }
__device__ __forceinline__ float wave_sum(float v) {
#pragma unroll
    for (int o = 1; o < 64; o <<= 1) v += __shfl_xor(v, o);
    return v;
}
__device__ __forceinline__ float sigmoidf_(float x) { return __builtin_amdgcn_rcpf(1.0f + __builtin_amdgcn_exp2f(-x * LOG2E)); }
__device__ __forceinline__ float gelu_tanh(float x) { const float u = 0.7978845608028654f * (x + 0.044715f * x * x * x); return x * __builtin_amdgcn_rcpf(1.0f + __builtin_amdgcn_exp2f(-2.0f * LOG2E * u)); }
#define LDS_WAIT() asm volatile("s_waitcnt lgkmcnt(0)" ::: "memory")

namespace pg8 {
constexpr int BM = 256, BK = 64, HALF = 128, HTB = HALF * BK * 2, STAGE_BYTES = 8 * HTB, NXCD = 8, WGM = 8;
__host__ __device__ __forceinline__ int lds_byte(int r, int c) { const int st = (r >> 4) * 2 + (c >> 5), rr = r & 15, cc = c & 31, ob = rr * 64 + cc * 2; return st * 1024 + (ob ^ (((ob >> 9) & 1) << 5)); }
__host__ __device__ __forceinline__ void stage_rc(int b, int& R, int& C) { const int st = b / 1024, sb = b % 1024, swz = sb ^ (((sb >> 9) & 1) << 5); R = (st >> 1) * 16 + swz / 64; C = (st & 1) * 32 + (swz % 64) / 2; }
__host__ __device__ __forceinline__ int perm32(int rho) { const int n = rho >> 4, i = rho & 15; return 8 * (i >> 2) + 4 * n + (i & 3); }

struct Unit { int pm, pb, x0, x1; };

__device__ __forceinline__ void tile_of(int L, int nM, int nN, int& pm, int& pn) {
    const int nwg = nM * nN; int wgid = L;
    { const int q = nwg / NXCD, r = nwg % NXCD, xcd = wgid % NXCD, off = wgid / NXCD; wgid = (xcd < r ? xcd * (q + 1) : r * (q + 1) + (xcd - r) * q) + off; }
    const int nig = WGM * nN, gid = wgid / nig, fm = gid * WGM, gsz = (nM - fm) < WGM ? (nM - fm) : WGM;
    pm = fm + ((wgid % nig) % gsz); pn = (wgid % nig) / gsz;
}

typedef int i32x8 __attribute__((ext_vector_type(8)));
constexpr int F8_SCALE_W = 0x79797979, F8_SCALE_X = 0x7f7f7f7f;
template <class Epi, class Sched, bool F8 = false>
__device__ __forceinline__ void gemm_phase(LAS unsigned char* lds, const Sched& S, const Epi& E) {
    const int tid = threadIdx.x, wid = __builtin_amdgcn_readfirstlane(tid >> 6), lane = tid & 63, wr = wid >> 2, wc = wid & 3, fr = lane & 15, fq = lane >> 4;
    constexpr int ESZ = F8 ? 1 : 2;
    const int K = S.K, nt = K * ESZ / (BK * 2);
    int Rl[2], Cl[2];
    unsigned voffA[2][2], voffB[2];
#pragma unroll
    for (int i = 0; i < 2; ++i) { stage_rc(tid * 16 + i * 8192, Rl[i], Cl[i]); const int Rb = Epi::PERM ? ((Rl[i] & ~31) + perm32(Rl[i] & 31)) : Rl[i];
        voffB[i] = (unsigned)(Rb * S.ldb * ESZ + Cl[i] * 2); }
    const size_t kstep = (size_t)(BK * 2);
    const size_t hstepB = (size_t)HALF * S.ldb * ESZ, hstepA = (size_t)HALF * S.lda * ESZ;
    const unsigned ldsw = (unsigned)wid * 1024u;
    const int aoff = F8 ? lds_byte(wr * 64 + fr, fq * 16) : lds_byte(wr * 64 + fr, fq * 8), boff = F8 ? lds_byte(wc * 32 + fr, fq * 16) : lds_byte(wc * 32 + fr, fq * 8);
#define PG8_SA(b, h) (((b) * 2 + (h)) * HTB)
#define PG8_SB(b, h) ((4 + (b) * 2 + (h)) * HTB)
#define PG8_STAGEB(bufoff, gbase) do { _Pragma("unroll") for (int _i = 0; _i < 2; ++_i) \
        __builtin_amdgcn_global_load_lds((const unsigned*)((const char*)(gbase) + voffB[_i]), (LAS unsigned*)(lds + (bufoff) + ldsw + _i * 8192), 16, 0, 0); } while (0)
#define PG8_STAGEA(bufoff, gbase, h, vo) do { _Pragma("unroll") for (int _i = 0; _i < 2; ++_i) { \
        if constexpr (Sched::GATHER) __builtin_amdgcn_global_load_lds((const unsigned*)((const char*)(gbase) + (vo)[h][_i]), (LAS unsigned*)(lds + (bufoff) + ldsw + _i * 8192), 16, 0, 0); \
        else __builtin_amdgcn_global_load_lds((const unsigned*)((const char*)(gbase) + (h) * hstepA + (vo)[0][_i]), (LAS unsigned*)(lds + (bufoff) + ldsw + _i * 8192), 16, 0, 0); } } while (0)
#define PG8_LD8(d, addr) do { const u32x4 lo_ = *(const LAS u32x4*)(addr), hi_ = *(const LAS u32x4*)((addr) + 16); d = (i32x8){(int)lo_.x, (int)lo_.y, (int)lo_.z, (int)lo_.w, (int)hi_.x, (int)hi_.y, (int)hi_.z, (int)hi_.w}; } while (0)
#define PG8_LDA(dst, b, h) do { if constexpr (F8) { _Pragma("unroll") for (int m = 0; m < 4; ++m) PG8_LD8(dst##8[m], lds + PG8_SA(b, h) + aoff + m * 2048); } \
        else { _Pragma("unroll") for (int m = 0; m < 4; ++m) _Pragma("unroll") for (int k = 0; k < 2; ++k) dst[m][k] = *(const LAS bf16x8*)(lds + PG8_SA(b, h) + aoff + m * 2048 + k * 1024); } } while (0)
#define PG8_LDB(dst, b, h) do { if constexpr (F8) { _Pragma("unroll") for (int n = 0; n < 2; ++n) PG8_LD8(dst##8[n], lds + PG8_SB(b, h) + boff + n * 2048); } \
        else { _Pragma("unroll") for (int n = 0; n < 2; ++n) _Pragma("unroll") for (int k = 0; k < 2; ++k) dst[n][k] = *(const LAS bf16x8*)(lds + PG8_SB(b, h) + boff + n * 2048 + k * 1024); } } while (0)
#define PG8_MMA(ai, bj, At, Bt) do { __builtin_amdgcn_s_setprio(1); _Pragma("unroll") for (int m = 0; m < 4; ++m) _Pragma("unroll") for (int n = 0; n < 2; ++n) { \
        if constexpr (F8) acc[ai][bj][m][n] = __builtin_amdgcn_mfma_scale_f32_16x16x128_f8f6f4(Bt##8[n], At##8[m], acc[ai][bj][m][n], 0, 0, 0, F8_SCALE_W, 0, F8_SCALE_X); \
        else { _Pragma("unroll") for (int k = 0; k < 2; ++k) acc[ai][bj][m][n] = __builtin_amdgcn_mfma_f32_16x16x32_bf16(Bt[n][k], At[m][k], acc[ai][bj][m][n], 0, 0, 0); } } \
        __builtin_amdgcn_s_setprio(0); } while (0)
#define PG8_WAIT_V(n) asm volatile("s_waitcnt vmcnt(" #n ")" ::: "memory")
#define PG8_WAIT_L(n) asm volatile("s_waitcnt lgkmcnt(" #n ")" ::: "memory")
#define PG8_BAR __builtin_amdgcn_s_barrier()
#define PG8_SCHED __builtin_amdgcn_sched_barrier(0)
#define PG8_SETVO(vo, u) do { _Pragma("unroll") for (int _h = 0; _h < 2; ++_h) _Pragma("unroll") for (int _i = 0; _i < 2; ++_i) { \
        if constexpr (Sched::GATHER) (vo)[_h][_i] = (unsigned)(S.row_of(u, _h * HALF + Rl[_i]) * S.lda * ESZ + Cl[_i] * 2); \
        else (vo)[_h][_i] = (unsigned)((_h * HALF + Rl[_i]) * S.lda * ESZ + Cl[_i] * 2); } } while (0)
    Unit cur, nxt; int ui = 0;
    if (!S.next(0, cur)) return;
    f32x4 acc[2][2][4][2];
#pragma unroll
    for (int a = 0; a < 2; ++a)
#pragma unroll
        for (int b = 0; b < 2; ++b)
#pragma unroll
            for (int m = 0; m < 4; ++m)
#pragma unroll
                for (int n = 0; n < 2; ++n) acc[a][b][m][n] = (f32x4){0.f, 0.f, 0.f, 0.f};
    bf16x8 At[4][2], B0[2][2], B1[2][2];
    i32x8 At8[4], B08[2], B18[2];
    const char* cA = S.a_ptr(cur); const char* cB = S.b_ptr(cur);
    PG8_SETVO(voffA, cur);
    PG8_STAGEB(PG8_SB(0, 0), cB); PG8_STAGEB(PG8_SB(0, 1), cB + hstepB); PG8_STAGEA(PG8_SA(0, 0), cA, 0, voffA); PG8_STAGEA(PG8_SA(0, 1), cA, 1, voffA);
    if (wr == 1) PG8_BAR;
    PG8_WAIT_V(2); PG8_BAR;
    PG8_STAGEB(PG8_SB(1, 0), cB + kstep); PG8_STAGEA(PG8_SA(1, 0), cA + kstep, 0, voffA); PG8_STAGEB(PG8_SB(1, 1), cB + hstepB + kstep);
    PG8_WAIT_V(6); PG8_BAR;
    for (;;) {
        const bool has_next = S.next(ui + 1, nxt);
        const char* nA = has_next ? S.a_ptr(nxt) : cA; const char* nB = has_next ? S.b_ptr(nxt) : cB;
#pragma unroll 1
        for (int t = 0; t < nt; t += 2) {
            const bool last = (t == nt - 2);
            const char* a1 = cA + (size_t)(t + 1) * kstep;
            const char* a2 = last ? nA : cA + (size_t)(t + 2) * kstep; const char* b2 = last ? nB : cB + (size_t)(t + 2) * kstep;
            const char* a3 = a2 + kstep; const char* b3 = b2 + kstep;
            PG8_LDB(B0, 0, 0); PG8_LDB(B1, 0, 1); PG8_SCHED; PG8_LDA(At, 0, 0); PG8_STAGEA(PG8_SA(1, 1), a1, 1, voffA);
            if (last && has_next) { PG8_SETVO(voffA, nxt); asm volatile("" : "+v"(voffA[0][0]), "+v"(voffA[0][1]), "+v"(voffA[1][0]), "+v"(voffA[1][1])); }
            PG8_WAIT_V(8); PG8_WAIT_L(0); PG8_BAR; PG8_MMA(0, 0, At, B0); PG8_MMA(0, 1, At, B1); PG8_BAR; PG8_SCHED;
            PG8_LDA(At, 0, 1); PG8_STAGEB(PG8_SB(0, 0), b2); PG8_STAGEB(PG8_SB(0, 1), b2 + hstepB); PG8_STAGEA(PG8_SA(0, 0), a2, 0, voffA);
            PG8_WAIT_V(8); PG8_WAIT_L(0); PG8_BAR; PG8_MMA(1, 0, At, B0); PG8_MMA(1, 1, At, B1); PG8_BAR; PG8_SCHED;
            PG8_LDB(B0, 1, 0); PG8_LDB(B1, 1, 1); PG8_SCHED; PG8_LDA(At, 1, 0); PG8_STAGEA(PG8_SA(0, 1), a2, 1, voffA);
            PG8_WAIT_V(8); PG8_WAIT_L(0); PG8_BAR; PG8_MMA(0, 0, At, B0); PG8_MMA(0, 1, At, B1); PG8_BAR; PG8_SCHED;
            PG8_LDA(At, 1, 1); PG8_STAGEB(PG8_SB(1, 0), b3); PG8_STAGEB(PG8_SB(1, 1), b3 + hstepB); PG8_STAGEA(PG8_SA(1, 0), a3, 0, voffA);
            PG8_WAIT_V(8); PG8_WAIT_L(0); PG8_BAR; PG8_MMA(1, 0, At, B0); PG8_MMA(1, 1, At, B1); PG8_BAR; PG8_SCHED;
        }
        if (wr == 0) PG8_BAR;
        E(acc, cur, wr, wc, fr, fq);
        if (!has_next) break;
#pragma unroll
        for (int a = 0; a < 2; ++a)
#pragma unroll
            for (int b = 0; b < 2; ++b)
#pragma unroll
                for (int m = 0; m < 4; ++m)
#pragma unroll
                    for (int n = 0; n < 2; ++n) acc[a][b][m][n] = (f32x4){0.f, 0.f, 0.f, 0.f};
        cur = nxt; cA = nA; cB = nB; ++ui;
        if (wr == 1) PG8_BAR;
    }
    PG8_WAIT_V(0);
    PG8_BAR;
#undef PG8_SA
#undef PG8_SB
#undef PG8_STAGEA
#undef PG8_STAGEB
#undef PG8_LDA
#undef PG8_LDB
#undef PG8_MMA
#undef PG8_LD8
#undef PG8_WAIT_V
#undef PG8_WAIT_L
#undef PG8_BAR
#undef PG8_SCHED
#undef PG8_SETVO
}
}

struct InprojSched {
    static constexpr bool GATHER = false;
    const bf16_t* XN; const bf16_t* W; int G, c; int lda, ldb, K;
    __device__ __forceinline__ bool next(int i, pg8::Unit& u) const {
        const int L = i * G + c;
        if (L < 128 * 28) { int pm, pn; pg8::tile_of(L, 128, 28, pm, pn); u.pm = pm; u.pb = pn; u.x0 = 0; u.x1 = 0; return true; }
        const int idx = L - 128 * 28; if (idx >= 96) return false;
        u.pm = 128 + (idx & 7); u.pb = 8 + (idx >> 3); u.x0 = 1; u.x1 = 0; return true;
    }
    __device__ __forceinline__ const char* a_ptr(const pg8::Unit& u) const { return (const char*)XN + (size_t)u.pm * 256 * 1024 * 2; }
    __device__ __forceinline__ const char* b_ptr(const pg8::Unit& u) const { return (const char*)W + (size_t)u.pb * 256 * 1024 * 2; }
    __device__ __forceinline__ int row_of(const pg8::Unit&, int r) const { return r; }
};
struct MixSched {
    static constexpr bool GATHER = false;
    const bf16_t* Z; const bf16_t* W; int G, c; int lda, ldb, K;
    __device__ __forceinline__ bool next(int i, pg8::Unit& u) const {
        const int L = (i >> 1) * G + c; if (L >= 128 * 4) return false;
        int pm, pn; pg8::tile_of(L, 128, 4, pm, pn); const int pass = i & 1;
        u.pm = pm; u.pb = pass * 4 + pn; u.x0 = pn; u.x1 = pass; return true;
    }
    __device__ __forceinline__ const char* a_ptr(const pg8::Unit& u) const { return (const char*)Z + ((size_t)u.pm * 256 * LDZ + (u.x1 ? ZC_Q : ZC_YG)) * 2; }
    __device__ __forceinline__ const char* b_ptr(const pg8::Unit& u) const { return (const char*)W + (size_t)u.pb * 256 * 1024 * 2; }
    __device__ __forceinline__ int row_of(const pg8::Unit&, int r) const { return r; }
};
struct WoutSched {
    static constexpr bool GATHER = false;
    const bf16_t* Z; const bf16_t* W; int G, c; int lda, ldb, K;
    __device__ __forceinline__ bool next(int i, pg8::Unit& u) const {
        const int L = i * G + c; if (L >= 128 * 4) return false;
        int pm, pn; pg8::tile_of(L, 128, 4, pm, pn); u.pm = pm; u.pb = pn; u.x0 = pn; u.x1 = 0; return true;
    }
    __device__ __forceinline__ const char* a_ptr(const pg8::Unit& u) const { return (const char*)Z + ((size_t)u.pm * 256 * LDZ + ZC_XR) * 2; }
    __device__ __forceinline__ const char* b_ptr(const pg8::Unit& u) const { return (const char*)W + (size_t)u.pb * 256 * 1024 * 2; }
    __device__ __forceinline__ int row_of(const pg8::Unit&, int r) const { return r; }
};
struct Moe1Sched {
    static constexpr bool GATHER = true;
    const unsigned char* XN2; const unsigned char* W; const int* selidx; int G, c; int lda, ldb, K;
    __device__ __forceinline__ bool next(int i, pg8::Unit& u) const {
        const int L = i * G + c; if (L >= 16 * 256) return false;
        const int e = L >> 8, w = L & 255, x = w & 7, j = w >> 3;
        const int mt = (x & 3) * 4 + (j & 3), nt = (x >> 2) * 8 + (j >> 2);
        u.pm = e * 16 + mt; u.pb = e * 16 + nt; u.x0 = nt; u.x1 = e; return true;
    }
    __device__ __forceinline__ const char* a_ptr(const pg8::Unit&) const { return (const char*)XN2; }
    __device__ __forceinline__ const char* b_ptr(const pg8::Unit& u) const { return (const char*)W + (size_t)u.pb * 256 * 1024; }
    __device__ __forceinline__ int row_of(const pg8::Unit& u, int r) const { return selidx[u.pm * 256 + r]; }
};
struct Moe2Sched {
    static constexpr bool GATHER = true;
    const unsigned char* HID; const unsigned char* W; int G, c; int lda, ldb, K;
    __device__ __forceinline__ bool next(int i, pg8::Unit& u) const {
        const int L = i * G + c; if (L >= 16 * 64) return false;
        const int e = L >> 6, w = L & 63, mt = w >> 2, pn = w & 3;
        u.pm = e * 16 + mt; u.pb = e * 4 + pn; u.x0 = pn; u.x1 = e; return true;
    }
    __device__ __forceinline__ const char* a_ptr(const pg8::Unit& u) const { return (const char*)HID + (size_t)u.pm * 256 * 2048; }
    __device__ __forceinline__ const char* b_ptr(const pg8::Unit& u) const { return (const char*)W + (size_t)u.pb * 256 * 2048; }
    __device__ __forceinline__ int row_of(const pg8::Unit&, int r) const { return r; }
};

typedef const f32x4 (&AccRef)[2][2][4][2];
struct EpiInproj {
    static constexpr bool PERM = true;
    bf16_t* Z; bf16_t* ZC; const float* binz; const float* rope;
    __device__ __forceinline__ void operator()(AccRef acc, const pg8::Unit& u, int wr, int wc, int fr, int fq) const {
        const bool isctx = u.x0 != 0;
        const int seg = u.pb >> 2, colt = u.pb * 256, cl = wc * 32 + 8 * fq;
        f32x4 bv[2][2];
#pragma unroll
        for (int bj = 0; bj < 2; ++bj)
#pragma unroll
            for (int n = 0; n < 2; ++n) bv[bj][n] = *(const f32x4*)(binz + colt + bj * 128 + cl + 4 * n);
        bf16_t* base; int ld, row0;
        if (!isctx) { base = Z + colt; ld = LDZ; row0 = u.pm * 256; } else { base = ZC + (colt - 2048); ld = LDC; row0 = (u.pm - 128) * 256; }
        const bool dorope = (seg == 1) || (seg == 3 && !isctx);
        const float qs = (seg == 1) ? QSCALE : 1.0f;
#pragma unroll
        for (int ai = 0; ai < 2; ++ai)
#pragma unroll
            for (int m = 0; m < 4; ++m) {
                const int r = row0 + ai * 128 + wr * 64 + m * 16 + fr;
                bf16_t* rowp = base + (size_t)r * ld + cl;
                f32x4 cs0 = (f32x4){1.f, 0.f, 1.f, 0.f}, cs1 = cs0;
                if (dorope) { const int t = r & 4095; const int pos = (wc & 1) ? (t & 63) : (t >> 6); const float* cp = rope + (pos * 16 + 4 * fq) * 2; cs0 = *(const f32x4*)cp; cs1 = *(const f32x4*)(cp + 4); }
#pragma unroll
                for (int bj = 0; bj < 2; ++bj) {
                    f32x4 v0 = acc[ai][bj][m][0] + bv[bj][0], v1 = acc[ai][bj][m][1] + bv[bj][1];
                    if (seg == 0) {
#pragma unroll
                        for (int j = 0; j < 4; ++j) { v0[j] = gelu_tanh(v0[j]); v1[j] = gelu_tanh(v1[j]); }
                    } else if (seg >= 5) {
#pragma unroll
                        for (int j = 0; j < 4; ++j) { v0[j] = sigmoidf_(v0[j]); v1[j] = sigmoidf_(v1[j]); }
                    } else if (dorope) {
                        const float c[4] = {cs0[0], cs0[2], cs1[0], cs1[2]}, s[4] = {cs0[1], cs0[3], cs1[1], cs1[3]};
#pragma unroll
                        for (int j = 0; j < 4; ++j) { const float x1 = v0[j], x2 = v1[j]; v0[j] = (x1 * c[j] - x2 * s[j]) * qs; v1[j] = (x1 * s[j] + x2 * c[j]) * qs; }
                    }
                    u32x4 w; w.x = cvt_pk_bf16(v0[0], v0[1]); w.y = cvt_pk_bf16(v0[2], v0[3]); w.z = cvt_pk_bf16(v1[0], v1[1]); w.w = cvt_pk_bf16(v1[2], v1[3]);
                    *(u32x4*)(rowp + bj * 128) = w;
                }
            }
    }
};
struct EpiMix {
    static constexpr bool PERM = true;
    bf16_t* Z;
    __device__ __forceinline__ void operator()(AccRef acc, const pg8::Unit& u, int wr, int wc, int fr, int fq) const {
        const int pass = u.x1, colt = u.x0 * 256, cl = wc * 32 + 8 * fq;
        const int gcol = (pass ? ZC_GN : ZC_GR) + colt + cl, ocol = ZC_XR + colt + cl;
        const int r0 = u.pm * 256 + wr * 64 + fr;
#pragma unroll
        for (int ai = 0; ai < 2; ++ai)
#pragma unroll
            for (int m = 0; m < 4; ++m) {
                bf16_t* rowz = Z + (size_t)(r0 + ai * 128 + m * 16) * LDZ;
#pragma unroll
                for (int bj = 0; bj < 2; ++bj) {
                    const u32x4 g = *(const u32x4*)(rowz + gcol + bj * 128);
                    f32x4 v0 = acc[ai][bj][m][0] * (f32x4){bf2f(g.x & 0xffffu), bf2f(g.x >> 16), bf2f(g.y & 0xffffu), bf2f(g.y >> 16)};
                    f32x4 v1 = acc[ai][bj][m][1] * (f32x4){bf2f(g.z & 0xffffu), bf2f(g.z >> 16), bf2f(g.w & 0xffffu), bf2f(g.w >> 16)};
                    if (pass) { const u32x4 t = *(const u32x4*)(rowz + ocol + bj * 128);
                        v0 += (f32x4){bf2f(t.x & 0xffffu), bf2f(t.x >> 16), bf2f(t.y & 0xffffu), bf2f(t.y >> 16)};
                        v1 += (f32x4){bf2f(t.z & 0xffffu), bf2f(t.z >> 16), bf2f(t.w & 0xffffu), bf2f(t.w >> 16)}; }
                    u32x4 w; w.x = cvt_pk_bf16(v0[0], v0[1]); w.y = cvt_pk_bf16(v0[2], v0[3]); w.z = cvt_pk_bf16(v1[0], v1[1]); w.w = cvt_pk_bf16(v1[2], v1[3]);
                    *(u32x4*)(rowz + ocol + bj * 128) = w;
                }
            }
    }
};
struct EpiWout {
    static constexpr bool PERM = false;
    const float* x; float* out; const float* mod;
    __device__ __forceinline__ void operator()(AccRef acc, const pg8::Unit& u, int wr, int wc, int fr, int fq) const {
        const int col0 = u.x0 * 256 + wc * 32 + 4 * fq;
        const float* g1p = mod + (size_t)(u.pm >> 4) * 6144 + 2048 + col0;
        f32x4 gv[2][2];
#pragma unroll
        for (int bj = 0; bj < 2; ++bj)
#pragma unroll
            for (int n = 0; n < 2; ++n) gv[bj][n] = *(const f32x4*)(g1p + bj * 128 + n * 16);
#pragma unroll
        for (int ai = 0; ai < 2; ++ai)
#pragma unroll
            for (int m = 0; m < 4; ++m) {
                const size_t off = (size_t)(u.pm * 256 + ai * 128 + wr * 64 + m * 16 + fr) * DM + col0;
#pragma unroll
                for (int bj = 0; bj < 2; ++bj)
#pragma unroll
                    for (int n = 0; n < 2; ++n) { const f32x4 xv = *(const f32x4*)(x + off + bj * 128 + n * 16); *(f32x4*)(out + off + bj * 128 + n * 16) = xv + gv[bj][n] * acc[ai][bj][m][n]; }
            }
    }
};
__device__ __forceinline__ unsigned pk4_fp8(float a, float b, float c, float d) { int w = 0; w = __builtin_amdgcn_cvt_pk_fp8_f32(a, b, w, false); w = __builtin_amdgcn_cvt_pk_fp8_f32(c, d, w, true); return (unsigned)w; }
struct EpiMoe1 {
    static constexpr bool PERM = true;
    unsigned char* HID;
    __device__ __forceinline__ void operator()(AccRef acc, const pg8::Unit& u, int wr, int wc, int fr, int fq) const {
        const int col0 = u.x0 * 128 + wc * 32 + 8 * fq;
#pragma unroll
        for (int ai = 0; ai < 2; ++ai)
#pragma unroll
            for (int m = 0; m < 4; ++m) {
                const size_t r = (size_t)u.pm * 256 + ai * 128 + wr * 64 + m * 16 + fr;
                f32x4 h0, h1;
#pragma unroll
                for (int j = 0; j < 4; ++j) { const float g0 = acc[ai][0][m][0][j], g1 = acc[ai][0][m][1][j];
                    h0[j] = g0 * sigmoidf_(g0) * acc[ai][1][m][0][j]; h1[j] = g1 * sigmoidf_(g1) * acc[ai][1][m][1][j]; }
                u32x2 w; w.x = pk4_fp8(h0[0], h0[1], h0[2], h0[3]); w.y = pk4_fp8(h1[0], h1[1], h1[2], h1[3]);
                *(u32x2*)(HID + r * DEXP + col0) = w;
            }
    }
};
struct EpiMoe2 {
    static constexpr bool PERM = true;
    bf16_t* YE; const float* selg;
    __device__ __forceinline__ void operator()(AccRef acc, const pg8::Unit& u, int wr, int wc, int fr, int fq) const {
        const int col0 = u.x0 * 256 + wc * 32 + 8 * fq;
        const size_t r0 = (size_t)u.pm * 256 + wr * 64 + fr;
        bf16_t* base = YE + r0 * DM + col0;
#pragma unroll
        for (int ai = 0; ai < 2; ++ai)
#pragma unroll
            for (int m = 0; m < 4; ++m) {
                bf16_t* rowp = base + (size_t)(ai * 128 + m * 16) * DM;
#pragma unroll
                for (int bj = 0; bj < 2; ++bj) {
                    const f32x4 v0 = acc[ai][bj][m][0], v1 = acc[ai][bj][m][1];
                    u32x4 w; w.x = cvt_pk_bf16(v0[0], v0[1]); w.y = cvt_pk_bf16(v0[2], v0[3]); w.z = cvt_pk_bf16(v1[0], v1[1]); w.w = cvt_pk_bf16(v1[2], v1[3]);
                    *(u32x4*)(rowp + bj * 128) = w;
                }
            }
    }
};

struct Params {
    const float *x, *c, *ctx, *c_ctx, *w_mod, *b_mod, *w_in, *b_in, *conv_w, *conv_b, *lru_wa, *lru_ba, *lru_wi, *lru_bi, *lru_lambda, *na_rpb,
                *w_proj_rnn, *w_proj_na, *w_out, *w_router, *w_exp_gate, *w_exp_up, *w_exp_down, *final_norm;
    float* out; unsigned char* ws;
    int ph_lo, ph_hi, probe, pad;
};

__device__ __forceinline__ int zcol_of(int n) {
    const int seg = n >> 10, o = n & 1023;
    if (seg == 0) return ZC_YG + o;
    if (seg == 1) return ZC_XR + o;
    if (seg == 4) return ZC_V + o;
    if (seg == 5) return ZC_GR + o;
    if (seg == 6) return ZC_GN + o;
    const int hh = o >> 6, d = o & 63, g2 = d >> 5, dd = d & 31, nn = dd >> 4, j = dd & 15, a = j >> 2, jj = j & 3;
    return (seg == 2 ? ZC_Q : ZC_K) + hh * 64 + g2 * 32 + 8 * a + 4 * nn + jj;
}
constexpr int TR_SCR = 64 * 65 * 4;
template <class RowMap>
__device__ __forceinline__ void transpose_item(const float* W, int ldw, int k0, int n0, bf16_t* WT, int ldk, RowMap rowmap, LAS float* scr, int lane) {
    const int ln = lane & 15, lk = lane >> 4;
    f32x4 v[16];
#pragma unroll
    for (int i = 0; i < 16; ++i) v[i] = *(const f32x4*)(W + (size_t)(k0 + 4 * i + lk) * ldw + n0 + 4 * ln);
#pragma unroll
    for (int i = 0; i < 16; ++i) { LAS float* d = scr + (4 * i + lk) * 65 + 4 * ln; d[0] = v[i].x; d[1] = v[i].y; d[2] = v[i].z; d[3] = v[i].w; }
    LDS_WAIT(); asm volatile("" ::: "memory");
    const int kg = lane & 7;
#pragma unroll
    for (int j = 0; j < 8; ++j) { const int n = (lane >> 3) + 8 * j; const LAS float* sp = scr + (8 * kg) * 65 + n;
        u32x4 o; o.x = cvt_pk_bf16(sp[0 * 65], sp[1 * 65]); o.y = cvt_pk_bf16(sp[2 * 65], sp[3 * 65]); o.z = cvt_pk_bf16(sp[4 * 65], sp[5 * 65]); o.w = cvt_pk_bf16(sp[6 * 65], sp[7 * 65]);
        *(u32x4*)(WT + (size_t)rowmap(n0 + n) * ldk + k0 + 8 * kg) = o; }
    LDS_WAIT(); asm volatile("" ::: "memory");
}
template <class RowMap>
__device__ __forceinline__ void transpose_item_f8(const float* W, int ldw, int k0, int n0, unsigned char* WT, int ldk, RowMap rowmap, LAS float* scr, int lane) {
    const int ln = lane & 15, lk = lane >> 4;
    f32x4 v[16];
#pragma unroll
    for (int i = 0; i < 16; ++i) v[i] = *(const f32x4*)(W + (size_t)(k0 + 4 * i + lk) * ldw + n0 + 4 * ln);
#pragma unroll
    for (int i = 0; i < 16; ++i) { LAS float* d = scr + (4 * i + lk) * 65 + 4 * ln; d[0] = v[i].x * 64.f; d[1] = v[i].y * 64.f; d[2] = v[i].z * 64.f; d[3] = v[i].w * 64.f; }
    LDS_WAIT(); asm volatile("" ::: "memory");
    const int kq = lane & 3;
#pragma unroll
    for (int j = 0; j < 4; ++j) { const int n = (lane >> 2) + 16 * j; const LAS float* sp = scr + (16 * kq) * 65 + n;
        u32x4 o; o.x = pk4_fp8(sp[0 * 65], sp[1 * 65], sp[2 * 65], sp[3 * 65]); o.y = pk4_fp8(sp[4 * 65], sp[5 * 65], sp[6 * 65], sp[7 * 65]);
        o.z = pk4_fp8(sp[8 * 65], sp[9 * 65], sp[10 * 65], sp[11 * 65]); o.w = pk4_fp8(sp[12 * 65], sp[13 * 65], sp[14 * 65], sp[15 * 65]);
        *(u32x4*)(WT + (size_t)rowmap(n0 + n) * ldk + k0 + 16 * kq) = o; }
    LDS_WAIT(); asm volatile("" ::: "memory");
}
__device__ __forceinline__ void phase_prep(const Params& p, LAS unsigned char* lds) {
    const int tid = threadIdx.x, lane = tid & 63, wave = tid >> 6, G = gridDim.x;
    unsigned char* ws = p.ws;
    {
        LAS float* scr = (LAS float*)(lds + wave * TR_SCR);
        bf16_t* WINT = (bf16_t*)(ws + WS_WINT); bf16_t* WMIX = (bf16_t*)(ws + WS_WMIX); bf16_t* WOUT = (bf16_t*)(ws + WS_WOUT);
        const int gw = blockIdx.x * NWAVES + wave, NGW = G * NWAVES;
        constexpr int I_IN = 16 * (NIN / 64), I_P = 16 * 16;
        for (int it = gw; it < I_IN + 3 * I_P; it += NGW) {
            int r = it;
            if (r < I_IN) { const int nblk = NIN / 64, kb = r / nblk, nb = r % nblk; transpose_item(p.w_in, NIN, 64 * kb, 64 * nb, WINT, 1024, [](int n) { return zcol_of(n); }, scr, lane); continue; } r -= I_IN;
            const int kb = (r % I_P) / 16, nb = (r % I_P) % 16, which = r / I_P;
            if (which == 0) transpose_item(p.w_proj_rnn, 1024, 64 * kb, 64 * nb, WMIX, 1024, [](int n) { return n; }, scr, lane);
            else if (which == 1) transpose_item(p.w_proj_na, 1024, 64 * kb, 64 * nb, WMIX, 1024, [](int n) { return 1024 + n; }, scr, lane);
            else transpose_item(p.w_out, 1024, 64 * kb, 64 * nb, WOUT, 1024, [](int n) { return n; }, scr, lane);
        }
    }
    __syncthreads();
    {
        LAS float* sS = (LAS float*)lds;
        LAS float* red = sS + 9 * 1024;
        float* MOD = (float*)(ws + WS_MOD);
        if (blockIdx.x < 192) {
            for (int e = tid; e < 9 * 1024; e += NTHREADS) { const int r = e >> 10, k = e & 1023; const float v = (r < 8) ? p.c[r * 1024 + k] : p.c_ctx[k]; sS[e] = v * sigmoidf_(v); }
            __syncthreads();
        }
        for (int it = blockIdx.x; it < 192; it += G) {
            const int n0 = it * 32, kk = tid >> 3, c4 = tid & 7;
            f32x4 a[9];
#pragma unroll
            for (int r = 0; r < 9; ++r) a[r] = (f32x4){0.f, 0.f, 0.f, 0.f};
#pragma unroll 4
            for (int i = 0; i < 16; ++i) { const int k = kk + 64 * i; const f32x4 w = *(const f32x4*)(p.w_mod + (size_t)k * 6144 + n0 + 4 * c4);
#pragma unroll
                for (int r = 0; r < 9; ++r) a[r] += w * sS[r * 1024 + k]; }
#pragma unroll
            for (int r = 0; r < 9; ++r) *(LAS f32x4*)(red + (kk * 9 + r) * 32 + 4 * c4) = a[r];
            __syncthreads();
            if (tid < 288) { const int r = tid >> 5, col = tid & 31; float sum = p.b_mod[n0 + col];
                for (int q = 0; q < 64; ++q) sum += red[(q * 9 + r) * 32 + col];
                MOD[r * 6144 + n0 + col] = sum; }
            __syncthreads();
        }
    }
    {
        float* ROPE = (float*)(ws + WS_ROPE); float* BINZ = (float*)(ws + WS_BINZ);
        const int gt = blockIdx.x * NTHREADS + tid, NGT = G * NTHREADS;
        for (int e = gt; e < 64 * 16; e += NGT) { const int pos = e >> 4, j = e & 15; const float inv = powf(10000.0f, -(float)j / 16.0f); const float ang = (float)pos * inv; ROPE[2 * e] = cosf(ang); ROPE[2 * e + 1] = sinf(ang); }
        for (int n = gt; n < NIN; n += NGT) BINZ[zcol_of(n)] = p.b_in[n];
    }
}

__device__ __forceinline__ void phase_norm1(const Params& p, LAS unsigned char* lds) {
    const int tid = threadIdx.x, lane = tid & 63, wave = tid >> 6, G = gridDim.x;
    unsigned char* ws = p.ws;
    const float* MOD = (const float*)(ws + WS_MOD);
    bf16_t* XN = (bf16_t*)(ws + WS_XN);
    const int gw = blockIdx.x * NWAVES + wave, NGW = G * NWAVES;
    for (int row = gw; row < MLAT + MCTX; row += NGW) {
        const bool isctx = row >= MLAT; const int mr = isctx ? 8 : (row >> 12);
        const float* xrow = isctx ? p.ctx + (size_t)(row - MLAT) * DM : p.x + (size_t)row * DM;
        const float* sh = MOD + (size_t)mr * 6144; const float* sc = sh + 1024;
        const f32x4* xr = (const f32x4*)xrow + lane;
        f32x4 v[4]; float s = 0.f;
#pragma unroll
        for (int j = 0; j < 4; ++j) { v[j] = xr[64 * j]; s += (v[j].x * v[j].x + v[j].y * v[j].y) + (v[j].z * v[j].z + v[j].w * v[j].w); }
        const float rs = 1.0f / sqrtf(wave_sum(s) * (1.0f / DM) + 1e-6f);
        unsigned long long* o8 = (unsigned long long*)(XN + (size_t)row * DM) + lane;
#pragma unroll
        for (int j = 0; j < 4; ++j) { const int c0 = 4 * lane + 256 * j; const f32x4 hh = *(const f32x4*)(sh + c0), cc = *(const f32x4*)(sc + c0);
            const f32x4 y = v[j] * rs * (cc + 1.0f) + hh;
            o8[64 * j] = (unsigned long long)pk2(y.x, y.y) | ((unsigned long long)pk2(y.z, y.w) << 32); }
    }
}

typedef float f32x16 __attribute__((ext_vector_type(16)));
constexpr int RN_XS = 144;
constexpr int RN_XC = 0, RN_WT = 256 * RN_XS, RN_SEG = RN_WT + 64 * RN_XS, RN_ST = RN_SEG + 4096;
__device__ __forceinline__ void phase_rnn(const Params& p, LAS unsigned char* lds, const bool dry) {
    const int tid = threadIdx.x, lane = tid & 63, wave = __builtin_amdgcn_readfirstlane(tid >> 6), G = gridDim.x;
    unsigned char* ws = p.ws;
    bf16_t* Z = (bf16_t*)(ws + WS_Z); const bf16_t* ZCb = (const bf16_t*)(ws + WS_ZC); bf16_t* HF = (bf16_t*)(ws + WS_XN);
    LAS unsigned char* xcb = lds + RN_XC;
    LAS unsigned char* wtb = lds + RN_WT;
    LAS float* segA = (LAS float*)(lds + RN_SEG);
    LAS float* segB = segA + 512;
    LAS unsigned char* stg = lds + RN_ST;
    const int c = lane & 31, hh = lane >> 5;
    const int taur = 16 * ((c >> 2) & 1) + 4 * (c >> 3) + (c & 3);
    const int cg8 = tid & 7, run = tid >> 3;
    for (int it = blockIdx.x; it < 256; it += G) {
        const int b = it >> 5, g = (it >> 1) & 15, half = it & 1;
        const int ch = 64 * g + 32 * half + c;
        const int ch0 = 64 * g + 32 * half;
        float cw[4][8], cbv[8];
#pragma unroll
        for (int j = 0; j < 8; ++j) { cbv[j] = p.conv_b[64 * g + 8 * cg8 + j];
#pragma unroll
            for (int k = 0; k < 4; ++k) cw[k][j] = p.conv_w[k * 1024 + 64 * g + 8 * cg8 + j]; }
        const bf16_t* srcL = Z + (size_t)b * SEQ * LDZ + ZC_XR + 64 * g + 8 * cg8;
        const bf16_t* srcC = ZCb + (size_t)b * CTX * LDC + CC_XR + 64 * g + 8 * cg8;
        for (int dir = 0; dir < 2; ++dir) {
            u32x4 xr[7];
#pragma unroll
            for (int q = 0; q < 7; ++q) { const int ts = 4 * run - 2 + q; xr[q] = (ts >= 0 && ts < CTX) ? *(const u32x4*)(srcC + (size_t)ts * LDC) : (u32x4){0u, 0u, 0u, 0u}; }
            __syncthreads();
            for (int e = tid; e < 2 * 64 * 32; e += NTHREADS) { const int mat = e >> 11, i = (e >> 5) & 63, cc = e & 31;
                const float* src = mat ? p.lru_wi : p.lru_wa;
                *(LAS bf16_t*)(wtb + (mat * 32 + cc) * RN_XS + i * 2) = (bf16_t)f2bf(src[(((size_t)dir * 16 + g) * 64 + i) * 64 + 32 * half + cc]); }
            __syncthreads();
            bf16x8 Bw[2][4];
#pragma unroll
            for (int mat = 0; mat < 2; ++mat)
#pragma unroll
                for (int s4 = 0; s4 < 4; ++s4) Bw[mat][s4] = *(const LAS bf16x8*)(wtb + (mat * 32 + c) * RN_XS + (16 * s4 + 8 * hh) * 2);
            const float ba = p.lru_ba[dir * 1024 + ch], bi = p.lru_bi[dir * 1024 + ch];
            const float lam = p.lru_lambda[dir * 1024 + ch];
            const float sp = (lam > 15.f) ? expf(-lam) : log1pf(expf(-lam));
            const float clam = -8.0f * sp * LOG2E;
            float hc = 0.f;
            for (int step = 0; step < 17; ++step) {
                const bool isctx = (step == 0);
                const int t0 = isctx ? 0 : 256 * (dir == 0 ? step - 1 : 16 - step);
                {
                    float xf[7][8];
#pragma unroll
                    for (int q = 0; q < 7; ++q) { xf[q][0] = bf2f(xr[q].x & 0xffffu); xf[q][1] = bf2f(xr[q].x >> 16); xf[q][2] = bf2f(xr[q].y & 0xffffu); xf[q][3] = bf2f(xr[q].y >> 16);
                        xf[q][4] = bf2f(xr[q].z & 0xffffu); xf[q][5] = bf2f(xr[q].z >> 16); xf[q][6] = bf2f(xr[q].w & 0xffffu); xf[q][7] = bf2f(xr[q].w >> 16); }
#pragma unroll
                    for (int i = 0; i < 4; ++i) { float a[8];
#pragma unroll
                        for (int j = 0; j < 8; ++j) a[j] = cbv[j] + cw[0][j] * xf[i][j] + cw[1][j] * xf[i + 1][j] + cw[2][j] * xf[i + 2][j] + cw[3][j] * xf[i + 3][j];
                        u32x4 w; w.x = cvt_pk_bf16(a[0], a[1]); w.y = cvt_pk_bf16(a[2], a[3]); w.z = cvt_pk_bf16(a[4], a[5]); w.w = cvt_pk_bf16(a[6], a[7]);
                        *(LAS u32x4*)(xcb + (4 * run + i) * RN_XS + cg8 * 16) = w; }
                }
                if (step < 16) { const int tn = 256 * (dir == 0 ? step : 15 - step);
#pragma unroll
                    for (int q = 0; q < 7; ++q) { const int ts = tn + 4 * run - 2 + q; xr[q] = (ts >= 0 && ts < SEQ) ? *(const u32x4*)(srcL + (size_t)ts * LDZ) : (u32x4){0u, 0u, 0u, 0u}; } }
                u32x4 hfr[2], ygr[2];
                const size_t tb = (size_t)b * SEQ + t0;
                if (!isctx && dir == 1) {
#pragma unroll
                    for (int i = 0; i < 2; ++i) { const int pid = tid + NTHREADS * i, tk = pid >> 2, part = pid & 3;
                        hfr[i] = *(const u32x4*)(HF + (tb + tk) * DM + ch0 + 8 * part); ygr[i] = *(const u32x4*)(Z + (tb + tk) * LDZ + ZC_YG + ch0 + 8 * part); } }
                __syncthreads();
                f32x16 ar, ai;
#pragma unroll
                for (int j = 0; j < 16; ++j) { ar[j] = 0.f; ai[j] = 0.f; }
                const LAS unsigned char* arow = xcb + (32 * wave + taur) * RN_XS + 16 * hh;
#pragma unroll
                for (int s4 = 0; s4 < 4; ++s4) { const bf16x8 af = *(const LAS bf16x8*)(arow + 32 * s4);
                    ar = __builtin_amdgcn_mfma_f32_32x32x16_bf16(af, Bw[0][s4], ar, 0, 0, 0);
                    ai = __builtin_amdgcn_mfma_f32_32x32x16_bf16(af, Bw[1][s4], ai, 0, 0, 0); }
                const LAS unsigned char* xcol = xcb + (32 * wave + 16 * hh) * RN_XS + (32 * half + c) * 2;
#pragma unroll
                for (int j = 0; j < 16; ++j) {
                    const float r = sigmoidf_(ar[j] + ba), ig = sigmoidf_(ai[j] + bi);
                    const float l2 = r * clam;
                    const float a = __builtin_amdgcn_exp2f(l2);
                    const float x = 1.3862943611198906f * l2;
                    const float om = -x * (1.0f + x * (0.5f + x * (0.16666667f + x * (0.041666668f + x * (0.0083333338f + x * 0.0013888889f)))));
                    const float xv = bf2f(*(const LAS bf16_t*)(xcol + j * RN_XS));
                    ar[j] = a; ai[j] = __builtin_amdgcn_sqrtf(fmaxf(om, 0.f)) * ig * xv;
                }
                float P = 1.f, H = 0.f;
                if (dir == 0) {
#pragma unroll
                    for (int j = 0; j < 16; ++j) { H = ar[j] * H + ai[j]; P *= ar[j]; }
                } else {
#pragma unroll
                    for (int j = 15; j >= 0; --j) { H = ar[j] * H + ai[j]; P *= ar[j]; }
                }
                const int s = 2 * wave + hh;
                segA[s * 32 + c] = P; segB[s * 32 + c] = H;
                __syncthreads();
                float h = hc, hin = 0.f;
                if (dir == 0) {
#pragma unroll
                    for (int q = 0; q < 16; ++q) { if (q == s) hin = h; h = segA[q * 32 + c] * h + segB[q * 32 + c]; } }
                else {
#pragma unroll
                    for (int q = 15; q >= 0; --q) { if (q == s) hin = h; h = segA[q * 32 + c] * h + segB[q * 32 + c]; } }
                hc = h;
                if (!isctx) {
                    LAS float* sp0 = (LAS float*)(stg + (32 * wave + 16 * hh) * RN_XS) + c;
                    h = hin;
                    if (dir == 0) {
#pragma unroll
                        for (int j = 0; j < 16; ++j) { h = ar[j] * h + ai[j]; sp0[j * (RN_XS / 4)] = h; }
                    } else {
#pragma unroll
                        for (int j = 15; j >= 0; --j) { h = ar[j] * h + ai[j]; sp0[j * (RN_XS / 4)] = h; }
                    }
                    __syncthreads();
#pragma unroll
                    for (int i = 0; i < 2; ++i) { const int pid = tid + NTHREADS * i, tk = pid >> 2, part = pid & 3;
                        const LAS f32x4* sr = (const LAS f32x4*)(stg + tk * RN_XS + part * 32);
                        f32x4 h0 = sr[0], h1 = sr[1];
                        if (dir == 1) {
                            const u32x4 f = hfr[i], y = ygr[i];
                            h0 = (h0 + (f32x4){bf2f(f.x & 0xffffu), bf2f(f.x >> 16), bf2f(f.y & 0xffffu), bf2f(f.y >> 16)}) * (f32x4){bf2f(y.x & 0xffffu), bf2f(y.x >> 16), bf2f(y.y & 0xffffu), bf2f(y.y >> 16)};
                            h1 = (h1 + (f32x4){bf2f(f.z & 0xffffu), bf2f(f.z >> 16), bf2f(f.w & 0xffffu), bf2f(f.w >> 16)}) * (f32x4){bf2f(y.z & 0xffffu), bf2f(y.z >> 16), bf2f(y.w & 0xffffu), bf2f(y.w >> 16)};
                        }
                        u32x4 w; w.x = cvt_pk_bf16(h0[0], h0[1]); w.y = cvt_pk_bf16(h0[2], h0[3]); w.z = cvt_pk_bf16(h1[0], h1[1]); w.w = cvt_pk_bf16(h1[2], h1[3]);
                        if (!dry) { if (dir == 0) *(u32x4*)(HF + (tb + tk) * DM + ch0 + 8 * part) = w; else *(u32x4*)(Z + (tb + tk) * LDZ + ZC_YG + ch0 + 8 * part) = w; }
                    }
                }
            }
        }
    }
}

constexpr int AT_KS = 144, AT_VS = 160, AT_KB = 64 * AT_KS, AT_VB = 64 * AT_VS, AT_SLOT = AT_KB + AT_VB, AT_BIAS = 2 * AT_SLOT;
typedef short s16x4 __attribute__((ext_vector_type(4)));
struct QBlk { bf16x8 q[2]; f32x4 o[4]; float m, l; };
template <bool LOCAL>
__device__ __forceinline__ void attn_proc32(QBlk& S, const LAS unsigned char* Kc, const LAS unsigned char* Vc, int kc0, int lane, int lo, const LAS float* brow, int dc0) {
    const int i = lane & 15, kq = lane >> 4;
    f32x4 s0 = (f32x4){0.f, 0.f, 0.f, 0.f}, s1 = s0;
#pragma unroll
    for (int ks = 0; ks < 2; ++ks) {
        const bf16x8 a0 = *(const LAS bf16x8*)(Kc + (kc0 + i) * AT_KS + ks * 64 + kq * 16);
        const bf16x8 a1 = *(const LAS bf16x8*)(Kc + (kc0 + 16 + i) * AT_KS + ks * 64 + kq * 16);
        s0 = __builtin_amdgcn_mfma_f32_16x16x32_bf16(a0, S.q[ks], s0, 0, 0, 0);
        s1 = __builtin_amdgcn_mfma_f32_16x16x32_bf16(a1, S.q[ks], s1, 0, 0, 0);
    }
    if (LOCAL) {
#pragma unroll
        for (int r = 0; r < 4; ++r) {
            const int d0 = min(max(dc0 + r, 0), 30), d1 = min(max(dc0 + 16 + r, 0), 30);
            const float b0 = brow[d0], b1 = brow[d1];
            s0[r] = (r >= lo && r < lo + 16) ? s0[r] + b0 : -1e30f;
            s1[r] = (16 + r >= lo && 16 + r < lo + 16) ? s1[r] + b1 : -1e30f;
        }
    }
    float mc = fmaxf(fmaxf(fmaxf(s0[0], s0[1]), fmaxf(s0[2], s0[3])), fmaxf(fmaxf(s1[0], s1[1]), fmaxf(s1[2], s1[3])));
    mc = fmaxf(mc, __shfl_xor(mc, 16)); mc = fmaxf(mc, __shfl_xor(mc, 32));
    const float mn = fmaxf(S.m, mc), alpha = __builtin_amdgcn_exp2f(S.m - mn);
    S.m = mn;
    float ps = 0.f;
#pragma unroll
    for (int r = 0; r < 4; ++r) { s0[r] = __builtin_amdgcn_exp2f(s0[r] - mn); s1[r] = __builtin_amdgcn_exp2f(s1[r] - mn); ps += s0[r] + s1[r]; }
    S.l = S.l * alpha + ps;
    bf16x8 pb;
    { const unsigned w0 = cvt_pk_bf16(s0[0], s0[1]), w1 = cvt_pk_bf16(s0[2], s0[3]), w2 = cvt_pk_bf16(s1[0], s1[1]), w3 = cvt_pk_bf16(s1[2], s1[3]);
      const u32x4 w = (u32x4){w0, w1, w2, w3}; pb = __builtin_bit_cast(bf16x8, w); }
    const LAS unsigned char* vp = Vc + (kc0 + 4 * kq + ((lane & 15) >> 2)) * AT_VS + (lane & 3) * 8;
#pragma unroll
    for (int dt = 0; dt < 4; ++dt) {
        const s16x4 lo4 = __builtin_bit_cast(s16x4, __builtin_amdgcn_ds_read_tr16_b64_v4i16((LAS s16x4*)(vp + dt * 32)));
        const s16x4 hi4 = __builtin_bit_cast(s16x4, __builtin_amdgcn_ds_read_tr16_b64_v4i16((LAS s16x4*)(vp + dt * 32 + 16 * AT_VS)));
        const bf16x8 av = (bf16x8){lo4[0], lo4[1], lo4[2], lo4[3], hi4[0], hi4[1], hi4[2], hi4[3]};
        S.o[dt] = __builtin_amdgcn_mfma_f32_16x16x32_bf16(av, pb, S.o[dt] * alpha, 0, 0, 0);
    }
}
__device__ __forceinline__ void phase_attn(const Params& p, LAS unsigned char* lds, const bool dry) {
    const int tid = threadIdx.x, lane = tid & 63, wave = __builtin_amdgcn_readfirstlane(tid >> 6), G = gridDim.x;
    unsigned char* ws = p.ws;
    bf16_t* Z = (bf16_t*)(ws + WS_Z); const bf16_t* ZCb = (const bf16_t*)(ws + WS_ZC);
    LAS float* btab = (LAS float*)(lds + AT_BIAS);
    const int j = wave & 3, c16 = lane & 15, fq = lane >> 4;
    const int cq = 16 * j + c16, cst = min(max(cq - 8, 0), 48), kst = min(max(16 * j - 8, 0), 32);
    const int lo = cst - kst - 4 * fq;
    const int dc0 = kst + 4 * fq - cq + 15;
    const int lkey = tid >> 3, lpc = tid & 7;
    for (int u = blockIdx.x; u < NB * 16 * 16; u += G) {
        const int b = u >> 8, h = (u >> 4) & 15, r0 = 4 * (u & 15);
        const int kr_lo = min(max(r0 - 4, 0), 56), kr_hi = min(max(r0 - 1, 0), 56) + 7, nloc = kr_hi - kr_lo + 1, nch = nloc + 4;
        const int rA = r0 + (wave >> 2), rB = rA + 2, rsA = min(max(rA - 4, 0), 56), rsB = min(max(rB - 4, 0), 56);
        bf16_t* qA = Z + ((size_t)b * SEQ + rA * 64 + cq) * LDZ + ZC_Q + h * 64;
        bf16_t* qB = Z + ((size_t)b * SEQ + rB * 64 + cq) * LDZ + ZC_Q + h * 64;
        QBlk A, Bq;
#pragma unroll
        for (int ks = 0; ks < 2; ++ks) { A.q[ks] = *(const bf16x8*)(qA + ks * 32 + fq * 8); Bq.q[ks] = *(const bf16x8*)(qB + ks * 32 + fq * 8); }
#pragma unroll
        for (int dt = 0; dt < 4; ++dt) { A.o[dt] = (f32x4){0.f, 0.f, 0.f, 0.f}; Bq.o[dt] = (f32x4){0.f, 0.f, 0.f, 0.f}; }
        A.m = -1e30f; A.l = 0.f; Bq.m = -1e30f; Bq.l = 0.f;
        for (int e = tid; e < 15 * 31; e += NTHREADS) btab[e] = p.na_rpb[(size_t)h * 465 + e] * LOG2E;
        const bf16_t* kbase = Z + ((size_t)b * SEQ + lkey) * LDZ + ZC_K + h * 64 + lpc * 8;
        const bf16_t* cbase = ZCb + ((size_t)b * CTX + lkey) * LDC + CC_K + h * 64 + lpc * 8;
        u32x4 kreg, vreg;
        { const bf16_t* src = kbase + (size_t)kr_lo * 64 * LDZ; kreg = *(const u32x4*)src; vreg = *(const u32x4*)(src + (ZC_V - ZC_K)); }
        *(LAS u32x4*)(lds + lkey * AT_KS + lpc * 16) = kreg; *(LAS u32x4*)(lds + AT_KB + lkey * AT_VS + lpc * 16) = vreg;
        __syncthreads();
        for (int c = 0; c < nch; ++c) {
            if (c + 1 < nch) {
                if (c + 1 < nloc) { const bf16_t* src = kbase + (size_t)(kr_lo + c + 1) * 64 * LDZ; kreg = *(const u32x4*)src; vreg = *(const u32x4*)(src + (ZC_V - ZC_K)); }
                else { const bf16_t* src = cbase + (size_t)(c + 1 - nloc) * 64 * LDC; kreg = *(const u32x4*)src; vreg = *(const u32x4*)(src + (CC_V - CC_K)); }
            }
            const LAS unsigned char* Kc = lds + (c & 1) * AT_SLOT; const LAS unsigned char* Vc = Kc + AT_KB;
            if (c < nloc) {
                const int kr = kr_lo + c;
                if (kr >= rsA && kr < rsA + 8) attn_proc32<true>(A, Kc, Vc, kst, lane, lo, btab + (kr - rA + 7) * 31, dc0);
                if (kr >= rsB && kr < rsB + 8) attn_proc32<true>(Bq, Kc, Vc, kst, lane, lo, btab + (kr - rB + 7) * 31, dc0);
            } else {
                attn_proc32<false>(A, Kc, Vc, 0, lane, 0, btab, 0); attn_proc32<false>(A, Kc, Vc, 32, lane, 0, btab, 0);
                attn_proc32<false>(Bq, Kc, Vc, 0, lane, 0, btab, 0); attn_proc32<false>(Bq, Kc, Vc, 32, lane, 0, btab, 0);
            }
            if (c + 1 < nch) { LAS unsigned char* d = lds + ((c + 1) & 1) * AT_SLOT; *(LAS u32x4*)(d + lkey * AT_KS + lpc * 16) = kreg; *(LAS u32x4*)(d + AT_KB + lkey * AT_VS + lpc * 16) = vreg; }
            __syncthreads();
        }
        {
            float l = A.l; l += __shfl_xor(l, 16); l += __shfl_xor(l, 32); const float il = 1.0f / l;
#pragma unroll
            for (int dt = 0; dt < 4; ++dt) { const f32x4 o = A.o[dt] * il; u32x2 w; w.x = cvt_pk_bf16(o[0], o[1]); w.y = cvt_pk_bf16(o[2], o[3]); if (!dry) *(u32x2*)(qA + dt * 16 + fq * 4) = w; }
            l = Bq.l; l += __shfl_xor(l, 16); l += __shfl_xor(l, 32); const float il2 = 1.0f / l;
#pragma unroll
            for (int dt = 0; dt < 4; ++dt) { const f32x4 o = Bq.o[dt] * il2; u32x2 w; w.x = cvt_pk_bf16(o[0], o[1]); w.y = cvt_pk_bf16(o[2], o[3]); if (!dry) *(u32x2*)(qB + dt * 16 + fq * 4) = w; }
        }
    }
}

__device__ __forceinline__ void phase_norm2(const Params& p, LAS unsigned char* lds) {
    const int tid = threadIdx.x, lane = tid & 63, wave = tid >> 6, G = gridDim.x;
    unsigned char* ws = p.ws;
    const float* MOD = (const float*)(ws + WS_MOD); unsigned char* XN2 = ws + WS_XN; float* AFF = (float*)(ws + WS_AFF);
    LAS float* wrT = (LAS float*)lds;
    for (int e = tid; e < 16 * 1024; e += NTHREADS) wrT[(e & 15) * 1024 + (e >> 4)] = p.w_router[e];
    __syncthreads();
    const int gw = blockIdx.x * NWAVES + wave, NGW = G * NWAVES;
    const bool b5 = lane & 32, b4 = lane & 16, b3 = lane & 8, b2 = lane & 4;
    const int myex = (b5 ? 8 : 0) + (b4 ? 4 : 0) + (b3 ? 2 : 0) + (b2 ? 1 : 0);
    for (int row = gw; row < MLAT; row += NGW) {
        const int b = row >> 12;
        const f32x4* xr = (const f32x4*)(p.out + (size_t)row * DM) + lane;
        f32x4 v[4]; float s = 0.f;
#pragma unroll
        for (int j = 0; j < 4; ++j) { v[j] = xr[64 * j]; s += (v[j].x * v[j].x + v[j].y * v[j].y) + (v[j].z * v[j].z + v[j].w * v[j].w); }
        const float rs = 1.0f / sqrtf(wave_sum(s) * (1.0f / DM) + 1e-6f);
        unsigned* o4 = (unsigned*)(XN2 + (size_t)row * DM) + lane;
#pragma unroll
        for (int j = 0; j < 4; ++j) { const int c0 = 4 * lane + 256 * j;
            const f32x4 hh = *(const f32x4*)(MOD + (size_t)b * 6144 + 3072 + c0), cc = *(const f32x4*)(MOD + (size_t)b * 6144 + 4096 + c0);
            v[j] = v[j] * rs * (cc + 1.0f) + hh;
            o4[64 * j] = pk4_fp8(v[j].x, v[j].y, v[j].z, v[j].w); }
        float lg[16];
#pragma unroll
        for (int e = 0; e < 16; ++e) { float a = 0.f;
#pragma unroll
            for (int j = 0; j < 4; ++j) { const f32x4 w = *(const LAS f32x4*)(wrT + e * 1024 + 4 * lane + 256 * j); a += (v[j].x * w.x + v[j].y * w.y) + (v[j].z * w.z + v[j].w * w.w); }
            lg[e] = a; if (e & 1) asm volatile("" ::: "memory"); }
        float t8[8], t4[4], t2[2], t1;
#pragma unroll
        for (int i = 0; i < 8; ++i) { const float snd = b5 ? lg[i] : lg[i + 8], kp = b5 ? lg[i + 8] : lg[i]; t8[i] = kp + __shfl_xor(snd, 32); }
#pragma unroll
        for (int i = 0; i < 4; ++i) { const float snd = b4 ? t8[i] : t8[i + 4], kp = b4 ? t8[i + 4] : t8[i]; t4[i] = kp + __shfl_xor(snd, 16); }
#pragma unroll
        for (int i = 0; i < 2; ++i) { const float snd = b3 ? t4[i] : t4[i + 2], kp = b3 ? t4[i + 2] : t4[i]; t2[i] = kp + __shfl_xor(snd, 8); }
        { const float snd = b2 ? t2[0] : t2[1], kp = b2 ? t2[1] : t2[0]; t1 = kp + __shfl_xor(snd, 4); }
        t1 += __shfl_xor(t1, 2); t1 += __shfl_xor(t1, 1);
        float mx = t1;
        mx = fmaxf(mx, __shfl_xor(mx, 4)); mx = fmaxf(mx, __shfl_xor(mx, 8)); mx = fmaxf(mx, __shfl_xor(mx, 16)); mx = fmaxf(mx, __shfl_xor(mx, 32));
        const float ex = expf(t1 - mx);
        float sum = ex;
        sum += __shfl_xor(sum, 4); sum += __shfl_xor(sum, 8); sum += __shfl_xor(sum, 16); sum += __shfl_xor(sum, 32);
        if ((lane & 3) == 0) AFF[(size_t)row * 16 + myex] = ex / sum;
    }
}

__device__ __forceinline__ void phase_topk(const Params& p, LAS unsigned char* lds) {
    const int tid = threadIdx.x, lane = tid & 63, wave = tid >> 6, G = gridDim.x;
    unsigned char* ws = p.ws;
    const float* AFF = (const float*)(ws + WS_AFF); int* SELIDX = (int*)(ws + WS_SELIDX); float* SELG = (float*)(ws + WS_SELG); int* SLOT = (int*)(ws + WS_SLOT);
    LAS unsigned* hist = (LAS unsigned*)lds;
    LAS unsigned* ctl = hist + 256;
    LAS unsigned* wtot = hist + 264;
    for (int it = blockIdx.x; it < NB * NEXP; it += G) {
        const int b = it >> 4, e = it & 15;
        unsigned v[8];
#pragma unroll
        for (int j = 0; j < 8; ++j) v[j] = __builtin_bit_cast(unsigned, AFF[((size_t)b * SEQ + tid * 8 + j) * 16 + e]);
        unsigned prefix = 0u, mask = 0u, need = CAP;
        for (int shift = 24; shift >= 0; shift -= 8) {
            __syncthreads();
            if (tid < 256) hist[tid] = 0u;
            __syncthreads();
#pragma unroll
            for (int j = 0; j < 8; ++j) if ((v[j] & mask) == prefix) atomicAdd((unsigned*)&hist[(v[j] >> shift) & 255u], 1u);
            __syncthreads();
            if (tid == 0) { unsigned cum = 0u; int bin = 255; for (; bin > 0; --bin) { const unsigned hv = hist[bin]; if (cum + hv >= need) break; cum += hv; } ctl[0] = (unsigned)bin; ctl[1] = need - cum; }
            __syncthreads();
            prefix |= ctl[0] << shift; mask |= 255u << shift; need = ctl[1];
        }
        unsigned ngt = 0u, neq = 0u;
#pragma unroll
        for (int j = 0; j < 8; ++j) { ngt += (v[j] > prefix) ? 1u : 0u; neq += (v[j] == prefix) ? 1u : 0u; }
        unsigned sg = ngt, se = neq;
#pragma unroll
        for (int o = 1; o < 64; o <<= 1) { const unsigned a = __shfl_up(sg, o), c2 = __shfl_up(se, o); if (lane >= o) { sg += a; se += c2; } }
        __syncthreads();
        if (lane == 63) { wtot[wave] = sg; wtot[8 + wave] = se; }
        __syncthreads();
        unsigned og = sg - ngt, oe = se - neq, totg = 0u;
        for (int w = 0; w < 8; ++w) { const unsigned a = wtot[w], c2 = wtot[8 + w]; if (w < wave) { og += a; oe += c2; } totg += a; }
#pragma unroll
        for (int j = 0; j < 8; ++j) {
            const int tkn = tid * 8 + j; int slot = -1;
            if (v[j] > prefix) slot = (int)og++;
            else if (v[j] == prefix) { if (oe < need) slot = (int)(totg + oe); ++oe; }
            const int erow = b * CAP + slot;
            SLOT[((size_t)b * SEQ + tkn) * 16 + e] = (slot >= 0) ? erow : -1;
            if (slot >= 0) { SELIDX[e * EROWS + erow] = b * SEQ + tkn; SELG[e * EROWS + erow] = __builtin_bit_cast(float, v[j]); }
        }
    }
    __syncthreads();
    {
        LAS float* scr = (LAS float*)(lds + wave * TR_SCR);
        unsigned char* WGU = ws + WS_WGU; unsigned char* WD = ws + WS_WD;
        const int gw = blockIdx.x * NWAVES + wave, NGW = G * NWAVES;
        constexpr int I_G = 16 * 32, I_D = 32 * 16;
        for (int it = gw; it < 16 * (2 * I_G + I_D); it += NGW) {
            const int e = it / (2 * I_G + I_D); int r = it % (2 * I_G + I_D);
            if (r < 2 * I_G) { const int up = r / I_G; r %= I_G; const int kb = r / 32, nb = r % 32;
                const float* W = (up ? p.w_exp_up : p.w_exp_gate) + (size_t)e * 1024 * 2048;
                transpose_item_f8(W, 2048, 64 * kb, 64 * nb, WGU + (size_t)e * 4096 * 1024, 1024, [up](int n) { return 256 * (n >> 7) + 128 * up + (n & 127); }, scr, lane); }
            else { r -= 2 * I_G; const int kb = r / 16, nb = r % 16;
                transpose_item_f8(p.w_exp_down + (size_t)e * 2048 * 1024, 1024, 64 * kb, 64 * nb, WD + (size_t)e * 1024 * 2048, 2048, [](int n) { return n; }, scr, lane); }
        }
    }
}

__device__ __forceinline__ void phase_final(const Params& p, LAS unsigned char* lds, const bool dry) {
    const int tid = threadIdx.x, lane = tid & 63, wave = tid >> 6, G = gridDim.x;
    unsigned char* ws = p.ws;
    const float* MOD = (const float*)(ws + WS_MOD); const int* SLOT = (const int*)(ws + WS_SLOT); const bf16_t* YE = (const bf16_t*)(ws + WS_YE); const float* SELG = (const float*)(ws + WS_SELG);
    const int gw = blockIdx.x * NWAVES + wave, NGW = G * NWAVES;
    for (int row = gw; row < MLAT; row += NGW) {
        const int b = row >> 12;
        f32x4* xr = (f32x4*)(p.out + (size_t)row * DM) + lane;
        f32x4 v[4], mo[4];
#pragma unroll
        for (int j = 0; j < 4; ++j) { v[j] = xr[64 * j]; mo[j] = (f32x4){0.f, 0.f, 0.f, 0.f}; }
        const int myslot = (lane < 16) ? SLOT[(size_t)row * 16 + lane] : -1;
        for (int e = 0; e < 16; ++e) {
            const int sl = __shfl(myslot, e);
            if (sl >= 0) { const unsigned long long* yp = (const unsigned long long*)(YE + ((size_t)e * EROWS + sl) * DM) + lane; const float gt = SELG[e * EROWS + sl];
#pragma unroll
                for (int j = 0; j < 4; ++j) { const unsigned long long w = yp[64 * j]; const unsigned lo = (unsigned)w, hi = (unsigned)(w >> 32);
                    mo[j].x += gt * bf2f(lo & 0xffffu); mo[j].y += gt * bf2f(lo >> 16); mo[j].z += gt * bf2f(hi & 0xffffu); mo[j].w += gt * bf2f(hi >> 16); } }
        }
        float s = 0.f;
#pragma unroll
        for (int j = 0; j < 4; ++j) { const int c0 = 4 * lane + 256 * j; const f32x4 g2 = *(const f32x4*)(MOD + (size_t)b * 6144 + 5120 + c0);
            v[j] = v[j] + g2 * mo[j]; s += (v[j].x * v[j].x + v[j].y * v[j].y) + (v[j].z * v[j].z + v[j].w * v[j].w); }
        const float rs = 1.0f / sqrtf(wave_sum(s) * (1.0f / DM) + 1e-6f);
#pragma unroll
        for (int j = 0; j < 4; ++j) { const int c0 = 4 * lane + 256 * j; const f32x4 fn = *(const f32x4*)(p.final_norm + c0); if (!dry) xr[64 * j] = v[j] * rs * fn; }
    }
}

#define XB_TMO      128
#define XB_XCNT(j)  (256  + 64 * (j))
#define XB_XSUB(j)  (1280 + 64 * (j))
#define XB_XGEN(j)  (2304 + 64 * (j))
#define XB_TOP      3328
#define XB_TOPGEN   3392
#define XCD_BAR_WORDS 3456
#define XB_SPIN_CAP (1u << 20)
__device__ __forceinline__ unsigned xb_ld(unsigned* p)              { return __hip_atomic_load(p, __ATOMIC_RELAXED, __HIP_MEMORY_SCOPE_AGENT); }
__device__ __forceinline__ unsigned xb_add(unsigned* p, unsigned v) { return __hip_atomic_fetch_add(p, v, __ATOMIC_RELAXED, __HIP_MEMORY_SCOPE_AGENT); }
__device__ __forceinline__ unsigned xb_xcc_id() { return (unsigned)__builtin_amdgcn_s_getreg((3 << 11) | 20) & 0xFu; }
#define XB_SPIN(cond, bar) do { unsigned _sp = 0; while (cond) { __builtin_amdgcn_s_sleep(1); \
    if ((++_sp & 255u) == 0u) { if (xb_ld(&(bar)[XB_TMO])) break; if (_sp > XB_SPIN_CAP) { atomicAdd(&(bar)[XB_TMO], 1u); break; } } } } while (0)
struct XcdBarrier { unsigned* bar; unsigned x; volatile LAS unsigned* st; };
__device__ __forceinline__ XcdBarrier xcd_barrier_post(unsigned* bar, volatile LAS unsigned* st) {
    XcdBarrier b; b.bar = bar; b.x = xb_xcc_id(); b.st = st;
    if (threadIdx.x == 0) (void)xb_add(&bar[XB_XCNT(b.x)], 1u);
    return b;
}
__device__ __forceinline__ void xcd_barrier_complete(unsigned* bar, unsigned x, unsigned& nloc, unsigned& nx) {
    const unsigned G = gridDim.x * gridDim.y * gridDim.z;
    unsigned sum, cnt, mine, sp = 0u;
    for (;;) {
        sum = 0u; cnt = 0u; mine = 0u;
#pragma unroll
        for (unsigned j = 0; j < 16; ++j) { const unsigned c = xb_ld(&bar[XB_XCNT(j)]); sum += c; cnt += (c > 0u) ? 1u : 0u; mine = (j == x) ? c : mine; }
        if (sum == G) break;
        __builtin_amdgcn_s_sleep(1);
        if ((++sp & 255u) == 0u) { if (xb_ld(&bar[XB_TMO])) break; if (sp > XB_SPIN_CAP) { atomicAdd(&bar[XB_TMO], 1u); break; } }
    }
    nloc = mine > 0u ? mine : 1u; nx = cnt > 0u ? cnt : 1u;
}
__device__ __forceinline__ void xcd_barrier(const XcdBarrier& b) {
    asm volatile("s_waitcnt vmcnt(0)" ::: "memory");
    __syncthreads();
    if (threadIdx.x == 0) {
        unsigned* bar = b.bar;
        __builtin_amdgcn_s_waitcnt(0);
        unsigned nloc = b.st[0], nx = b.st[1];
        if (nloc == 0u) { xcd_barrier_complete(bar, b.x, nloc, nx); b.st[0] = nloc; b.st[1] = nx; }
        const unsigned old = xb_add(&bar[XB_XSUB(b.x)], 1u);
        const unsigned gen = old / nloc;
        if (old + 1u == (gen + 1u) * nloc) {
            __builtin_amdgcn_fence(__ATOMIC_RELEASE, "agent");
            asm volatile("s_waitcnt vmcnt(0)" ::: "memory");
            const unsigned og = xb_add(&bar[XB_TOP], 1u);
            const unsigned tg = og / nx;
            if (og + 1u == (tg + 1u) * nx) xb_add(&bar[XB_TOPGEN], 1u);
            else XB_SPIN(xb_ld(&bar[XB_TOPGEN]) == tg, bar);
            __builtin_amdgcn_fence(__ATOMIC_ACQUIRE, "agent");
            xb_add(&bar[XB_XGEN(b.x)], 1u);
            asm volatile("s_waitcnt vmcnt(0)" ::: "memory");
        } else {
            XB_SPIN(xb_ld(&bar[XB_XGEN(b.x)]) == gen, bar);
            __builtin_amdgcn_fence(__ATOMIC_ACQUIRE, "agent");
            asm volatile("s_waitcnt vmcnt(0)" ::: "memory");
        }
    }
    __syncthreads();
}

constexpr int NPHASE = 12;
__global__ void __launch_bounds__(NTHREADS, 2) mk_fwd(Params p) {
    extern __shared__ __attribute__((aligned(16))) unsigned char lds_raw[];
    LAS unsigned char* lds = (LAS unsigned char*)lds_raw;
    cg::grid_group grid = cg::this_grid();
    unsigned char* ws = p.ws;
    const int G = gridDim.x, cblk = blockIdx.x;
#ifndef PH_MASK
#define PH_MASK 0xfff
#endif
#define IN(k) (((PH_MASK >> (k)) & 1) && p.ph_lo <= (k) && (k) < p.ph_hi)
    { volatile LAS unsigned* st0 = (volatile LAS unsigned*)(lds + LDS_BYTES - 256); if (threadIdx.x < 64) st0[threadIdx.x] = 0u; }
    __syncthreads();
    XcdBarrier xbar = xcd_barrier_post((unsigned*)(ws + WS_CTL) + 4096, (volatile LAS unsigned*)(lds + LDS_BYTES - 256));
#define SEAM(k) do { if (IN(k) && IN((k) + 1)) { if ((k) == 0) grid.sync(); else xcd_barrier(xbar); } } while (0)
    if (IN(0)) phase_prep(p, lds);
    SEAM(0);
    if (IN(1)) phase_norm1(p, lds);
    SEAM(1);
    if (IN(2)) {
        InprojSched S{(const bf16_t*)(ws + WS_XN), (const bf16_t*)(ws + WS_WINT), G, cblk, 1024, 1024, 1024};
        EpiInproj E{(bf16_t*)(ws + WS_Z), (bf16_t*)(ws + WS_ZC), (const float*)(ws + WS_BINZ), (const float*)(ws + WS_ROPE)};
        pg8::gemm_phase<EpiInproj, InprojSched>(lds, S, E);
    }
    SEAM(2);
    if (IN(3)) { if (p.probe & 8) { phase_rnn(p, lds, true); __syncthreads(); } phase_rnn(p, lds, false); }
    if (IN(3) && IN(4)) __syncthreads();
    if (IN(4)) { if (p.probe & 16) { phase_attn(p, lds, true); __syncthreads(); } phase_attn(p, lds, false); }
    SEAM(4);
    if (IN(5)) {
        MixSched S{(const bf16_t*)(ws + WS_Z), (const bf16_t*)(ws + WS_WMIX), G, cblk, LDZ, 1024, 1024};
        EpiMix E{(bf16_t*)(ws + WS_Z)};
        pg8::gemm_phase<EpiMix, MixSched>(lds, S, E);
    }
    SEAM(5);
    if (IN(6)) {
        WoutSched S{(const bf16_t*)(ws + WS_Z), (const bf16_t*)(ws + WS_WOUT), G, cblk, LDZ, 1024, 1024};
        EpiWout E{p.x, p.out, (const float*)(ws + WS_MOD)};
        pg8::gemm_phase<EpiWout, WoutSched>(lds, S, E);
    }
    SEAM(6);
    if (IN(7)) phase_norm2(p, lds);
    SEAM(7);
    if (IN(8)) phase_topk(p, lds);
    SEAM(8);
    if (IN(9)) {
        Moe1Sched S{ws + WS_XN, ws + WS_WGU, (const int*)(ws + WS_SELIDX), G, cblk, 1024, 1024, 1024};
        EpiMoe1 E{ws + WS_HID};
        pg8::gemm_phase<EpiMoe1, Moe1Sched, true>(lds, S, E);
    }
    SEAM(9);
    if (IN(10)) {
        Moe2Sched S{ws + WS_HID, ws + WS_WD, G, cblk, 2048, 2048, 2048};
        EpiMoe2 E{(bf16_t*)(ws + WS_YE), (const float*)(ws + WS_SELG)};
        pg8::gemm_phase<EpiMoe2, Moe2Sched, true>(lds, S, E);
    }
    SEAM(10);
    if (IN(11)) { if (p.probe & 2048) { phase_final(p, lds, true); __syncthreads(); } phase_final(p, lds, false); }
#undef IN
#undef SEAM
}

#ifndef MK_SINGLE
#define MK_SINGLE 1
#endif
extern "C" void kernel_launch(void* const* d_in, const int* in_sizes, int n_in, void* d_out, int out_size, void* d_ws, size_t ws_size, hipStream_t stream) {
    static int grid = 0;
    if (grid == 0) {
        int dev = 0, cus = 0, per_cu = 0;
        if (n_in != 24 || out_size != MLAT * DM || ws_size < WS_END) { fprintf(stderr, "kernel_launch: unexpected problem (n_in %d, out %d, ws %zu < %zu)\n", n_in, out_size, ws_size, (size_t)WS_END); grid = -1; return; }
        if (hipGetDevice(&dev) != hipSuccess || hipDeviceGetAttribute(&cus, hipDeviceAttributeMultiprocessorCount, dev) != hipSuccess) { grid = -1; return; }
        if (hipFuncSetAttribute((const void*)mk_fwd, hipFuncAttributeMaxDynamicSharedMemorySize, LDS_BYTES) != hipSuccess) { fprintf(stderr, "kernel_launch: hipFuncSetAttribute failed\n"); grid = -1; return; }
        if (hipOccupancyMaxActiveBlocksPerMultiprocessor(&per_cu, (const void*)mk_fwd, NTHREADS, LDS_BYTES) != hipSuccess || per_cu < 1) { fprintf(stderr, "kernel_launch: occupancy query says %d\n", per_cu); grid = -1; return; }
        grid = cus;
    }
    if (grid < 0) return;
    (void)hipMemsetAsync((char*)d_ws + WS_CTL, 0, 1 * MiB, stream);
    Params p{};
    const float** pp = (const float**)&p;
    for (int i = 0; i < 24; ++i) pp[i] = (const float*)d_in[i];
#ifndef PROBE_MASK
#define PROBE_MASK 0
#endif
    p.out = (float*)d_out; p.ws = (unsigned char*)d_ws; p.probe = PROBE_MASK;
#if MK_SINGLE
    p.ph_lo = 0; p.ph_hi = NPHASE;
    void* args[] = {&p};
    hipError_t e = hipLaunchCooperativeKernel((const void*)mk_fwd, dim3(grid), dim3(NTHREADS), args, LDS_BYTES, stream);
    if (e != hipSuccess) fprintf(stderr, "kernel_launch: cooperative launch failed: %s (grid %d)\n", hipGetErrorString(e), grid);
#else
#ifndef REP_MASK
#define REP_MASK 0
#endif
    for (int ph = 0; ph < NPHASE; ++ph) {
        p.ph_lo = ph; p.ph_hi = ph + 1;
        for (int rep = 0; rep < 1 + ((REP_MASK >> ph) & 1); ++rep) hipLaunchKernelGGL(mk_fwd, dim3(grid), dim3(NTHREADS), LDS_BYTES, stream, p);
    }
#endif
}
```

```cpp
#include <hip/hip_runtime.h>
#include <hip/hip_cooperative_groups.h>
#include <cstdio>
#include <cstdint>
namespace cg = cooperative_groups;

#define LAS __attribute__((address_space(3)))
typedef unsigned short bf16_t;
typedef short bf16x8 __attribute__((ext_vector_type(8)));
typedef float f32x4 __attribute__((ext_vector_type(4)));
typedef float f32x2 __attribute__((ext_vector_type(2)));
typedef unsigned u32x4 __attribute__((ext_vector_type(4)));
typedef unsigned u32x2 __attribute__((ext_vector_type(2)));

constexpr int NB = 8, SEQ = 4096, DM = 1024, CTX = 256;
constexpr int MLAT = NB * SEQ, MCTX = NB * CTX;
constexpr int NIN = 7168, NEXP = 16, DEXP = 2048, CAP = 512, EROWS = NB * CAP;
constexpr int LDZ = 7168, ZC_YG = 0, ZC_Q = 1024, ZC_XR = 2048, ZC_K = 3072, ZC_V = 4096, ZC_GR = 5120, ZC_GN = 6144;
constexpr int LDC = 3072, CC_XR = 0, CC_K = 1024, CC_V = 2048;
constexpr float LOG2E = 1.4426950408889634f;
constexpr float QSCALE = 0.125f * LOG2E;

constexpr size_t MiB = 1u << 20;
constexpr size_t WS_CTL = 0;
constexpr size_t WS_MOD = 1 * MiB;
constexpr size_t WS_MODP = 2 * MiB;
constexpr size_t WS_ROPE = 9 * MiB;
constexpr size_t WS_BINZ = 9 * MiB + 65536;
constexpr size_t WS_AFF = 10 * MiB;
constexpr size_t WS_SELIDX = 12 * MiB;
constexpr size_t WS_SELG = 12 * MiB + 262144;
constexpr size_t WS_SLOT = 13 * MiB;
constexpr size_t WS_WINT = 16 * MiB;
constexpr size_t WS_WMIX = 30 * MiB;
constexpr size_t WS_WOUT = 34 * MiB;
constexpr size_t WS_ZC = 36 * MiB;
constexpr size_t WS_XN = 48 * MiB;
constexpr size_t WS_Z = 116 * MiB;
constexpr size_t WS_WGU = 116 * MiB;
constexpr size_t WS_WD = 180 * MiB;
constexpr size_t WS_HID = 212 * MiB;
constexpr size_t WS_YE = 340 * MiB;
constexpr size_t WS_X1 = 48 * MiB;
constexpr size_t WS_XN2 = 468 * MiB;
constexpr size_t WS_END = 564 * MiB;

constexpr int NTHREADS = 512, NWAVES = 8;
constexpr int LDS_BYTES = 147456;

__device__ __forceinline__ unsigned f2bf(float f) { unsigned u = __builtin_bit_cast(unsigned, f); return (u + 0x7fffu + ((u >> 16) & 1u)) >> 16; }
__device__ __forceinline__ float bf2f(unsigned h) { return __builtin_bit_cast(float, h << 16); }
__device__ __forceinline__ unsigned pk2(float lo, float hi) { return f2bf(lo) | (f2bf(hi) << 16); }
__device__ __forceinline__ unsigned cvt_pk_bf16(float lo, float hi) { unsigned r; asm volatile("v_cvt_pk_bf16_f32 %0, %1, %2" : "=v"(r) : "v"(lo), "v"(hi)); return r; }
__device__ __forceinline__ float wave_sum(float v) {
#pragma unroll
    for (int o = 1; o < 64; o <<= 1) v += __shfl_xor(v, o);
    return v;
}
__device__ __forceinline__ float sigmoidf_(float x) { return __builtin_amdgcn_rcpf(1.0f + __builtin_amdgcn_exp2f(-x * LOG2E)); }
__device__ __forceinline__ float gelu_tanh(float x) { const float u = 0.7978845608028654f * (x + 0.044715f * x * x * x); return x * __builtin_amdgcn_rcpf(1.0f + __builtin_amdgcn_exp2f(-2.0f * LOG2E * u)); }
#define LDS_WAIT() asm volatile("s_waitcnt lgkmcnt(0)" ::: "memory")

namespace pg8 {
constexpr int BM = 256, BK = 64, HALF = 128, HTB = HALF * BK * 2, STAGE_BYTES = 8 * HTB, NXCD = 8, WGM = 8;
__host__ __device__ __forceinline__ int lds_byte(int r, int c) { const int st = (r >> 4) * 2 + (c >> 5), rr = r & 15, cc = c & 31, ob = rr * 64 + cc * 2; return st * 1024 + (ob ^ (((ob >> 9) & 1) << 5)); }
__host__ __device__ __forceinline__ void stage_rc(int b, int& R, int& C) { const int st = b / 1024, sb = b % 1024, swz = sb ^ (((sb >> 9) & 1) << 5); R = (st >> 1) * 16 + swz / 64; C = (st & 1) * 32 + (swz % 64) / 2; }
__host__ __device__ __forceinline__ int perm32(int rho) { const int n = rho >> 4, i = rho & 15; return 8 * (i >> 2) + 4 * n + (i & 3); }

struct Unit { int pm, pb, x0, x1; };

__device__ __forceinline__ void tile_of(int L, int nM, int nN, int& pm, int& pn) {
    const int nwg = nM * nN; int wgid = L;
    { const int q = nwg / NXCD, r = nwg % NXCD, xcd = wgid % NXCD, off = wgid / NXCD; wgid = (xcd < r ? xcd * (q + 1) : r * (q + 1) + (xcd - r) * q) + off; }
    const int nig = WGM * nN, gid = wgid / nig, fm = gid * WGM, gsz = (nM - fm) < WGM ? (nM - fm) : WGM;
    pm = fm + ((wgid % nig) % gsz); pn = (wgid % nig) / gsz;
}

typedef int i32x8 __attribute__((ext_vector_type(8)));
constexpr int F8_SCALE_W = 0x79797979, F8_SCALE_X = 0x7f7f7f7f;
template <class Epi, class Sched, bool F8 = false>
__device__ __forceinline__ void gemm_phase(LAS unsigned char* lds, const Sched& S, const Epi& E) {
    const int tid = threadIdx.x, wid = __builtin_amdgcn_readfirstlane(tid >> 6), lane = tid & 63, wr = wid >> 2, wc = wid & 3, fr = lane & 15, fq = lane >> 4;
    constexpr int ESZ = F8 ? 1 : 2;
    const int K = S.K, nt = K * ESZ / (BK * 2);
    int Rl[2], Cl[2];
    unsigned voffA[2][2], voffB[2];
#pragma unroll
    for (int i = 0; i < 2; ++i) { stage_rc(tid * 16 + i * 8192, Rl[i], Cl[i]); const int Rb = Epi::PERM ? ((Rl[i] & ~31) + perm32(Rl[i] & 31)) : Rl[i];
        voffB[i] = (unsigned)(Rb * S.ldb * ESZ + Cl[i] * 2); }
    const size_t kstep = (size_t)(BK * 2);
    const size_t hstepB = (size_t)HALF * S.ldb * ESZ, hstepA = (size_t)HALF * S.lda * ESZ;
    const unsigned ldsw = (unsigned)wid * 1024u;
    const int aoff = F8 ? lds_byte(wr * 64 + fr, fq * 16) : lds_byte(wr * 64 + fr, fq * 8), boff = F8 ? lds_byte(wc * 32 + fr, fq * 16) : lds_byte(wc * 32 + fr, fq * 8);
#define PG8_SA(b, h) (((b) * 2 + (h)) * HTB)
#define PG8_SB(b, h) ((4 + (b) * 2 + (h)) * HTB)
#define PG8_STAGEB(bufoff, gbase) do { _Pragma("unroll") for (int _i = 0; _i < 2; ++_i) \
        __builtin_amdgcn_global_load_lds((const unsigned*)((const char*)(gbase) + voffB[_i]), (LAS unsigned*)(lds + (bufoff) + ldsw + _i * 8192), 16, 0, 0); } while (0)
#define PG8_STAGEA(bufoff, gbase, h, vo) do { _Pragma("unroll") for (int _i = 0; _i < 2; ++_i) { \
        if constexpr (Sched::GATHER) __builtin_amdgcn_global_load_lds((const unsigned*)((const char*)(gbase) + (vo)[h][_i]), (LAS unsigned*)(lds + (bufoff) + ldsw + _i * 8192), 16, 0, 0); \
        else __builtin_amdgcn_global_load_lds((const unsigned*)((const char*)(gbase) + (h) * hstepA + (vo)[0][_i]), (LAS unsigned*)(lds + (bufoff) + ldsw + _i * 8192), 16, 0, 0); } } while (0)
#define PG8_LD8(d, addr) do { const u32x4 lo_ = *(const LAS u32x4*)(addr), hi_ = *(const LAS u32x4*)((addr) + 16); d = (i32x8){(int)lo_.x, (int)lo_.y, (int)lo_.z, (int)lo_.w, (int)hi_.x, (int)hi_.y, (int)hi_.z, (int)hi_.w}; } while (0)
#define PG8_LDA(dst, b, h) do { if constexpr (F8) { _Pragma("unroll") for (int m = 0; m < 4; ++m) PG8_LD8(dst##8[m], lds + PG8_SA(b, h) + aoff + m * 2048); } \
        else { _Pragma("unroll") for (int m = 0; m < 4; ++m) _Pragma("unroll") for (int k = 0; k < 2; ++k) dst[m][k] = *(const LAS bf16x8*)(lds + PG8_SA(b, h) + aoff + m * 2048 + k * 1024); } } while (0)
#define PG8_LDB(dst, b, h) do { if constexpr (F8) { _Pragma("unroll") for (int n = 0; n < 2; ++n) PG8_LD8(dst##8[n], lds + PG8_SB(b, h) + boff + n * 2048); } \
        else { _Pragma("unroll") for (int n = 0; n < 2; ++n) _Pragma("unroll") for (int k = 0; k < 2; ++k) dst[n][k] = *(const LAS bf16x8*)(lds + PG8_SB(b, h) + boff + n * 2048 + k * 1024); } } while (0)
#define PG8_MMA(ai, bj, At, Bt) do { __builtin_amdgcn_s_setprio(1); _Pragma("unroll") for (int m = 0; m < 4; ++m) _Pragma("unroll") for (int n = 0; n < 2; ++n) { \
        if constexpr (F8) acc[ai][bj][m][n] = __builtin_amdgcn_mfma_scale_f32_16x16x128_f8f6f4(Bt##8[n], At##8[m], acc[ai][bj][m][n], 0, 0, 0, F8_SCALE_W, 0, F8_SCALE_X); \
        else { _Pragma("unroll") for (int k = 0; k < 2; ++k) acc[ai][bj][m][n] = __builtin_amdgcn_mfma_f32_16x16x32_bf16(Bt[n][k], At[m][k], acc[ai][bj][m][n], 0, 0, 0); } } \
        __builtin_amdgcn_s_setprio(0); } while (0)
#define PG8_WAIT_V(n) asm volatile("s_waitcnt vmcnt(" #n ")" ::: "memory")
#define PG8_WAIT_L(n) asm volatile("s_waitcnt lgkmcnt(" #n ")" ::: "memory")
#define PG8_BAR __builtin_amdgcn_s_barrier()
#define PG8_SCHED __builtin_amdgcn_sched_barrier(0)
#define PG8_SETVO(vo, u) do { _Pragma("unroll") for (int _h = 0; _h < 2; ++_h) _Pragma("unroll") for (int _i = 0; _i < 2; ++_i) { \
        if constexpr (Sched::GATHER) (vo)[_h][_i] = (unsigned)(S.row_of(u, _h * HALF + Rl[_i]) * S.lda * ESZ + Cl[_i] * 2); \
        else (vo)[_h][_i] = (unsigned)((_h * HALF + Rl[_i]) * S.lda * ESZ + Cl[_i] * 2); } } while (0)
#define PG8_TRIP_BODY \
            const bool last = (t == nt - 2); \
            const char* a1 = cA + (size_t)(t + 1) * kstep; \
            const char* a2 = last ? nA : cA + (size_t)(t + 2) * kstep; const char* b2 = last ? nB : cB + (size_t)(t + 2) * kstep; \
            const char* a3 = a2 + kstep; const char* b3 = b2 + kstep; \
            PG8_LDB(B0, 0, 0); PG8_LDB(B1, 0, 1); PG8_SCHED; PG8_LDA(At, 0, 0); PG8_STAGEA(PG8_SA(1, 1), a1, 1, voffA); \
            if (last && has_next) { PG8_SETVO(voffA, nxt); asm volatile("" : "+v"(voffA[0][0]), "+v"(voffA[0][1]), "+v"(voffA[1][0]), "+v"(voffA[1][1])); } \
            PG8_WAIT_V(8); PG8_WAIT_L(0); PG8_BAR; PG8_MMA(0, 0, At, B0); PG8_MMA(0, 1, At, B1); PG8_BAR; PG8_SCHED; \
            PG8_LDA(At, 0, 1); PG8_STAGEB(PG8_SB(0, 0), b2); PG8_STAGEB(PG8_SB(0, 1), b2 + hstepB); PG8_STAGEA(PG8_SA(0, 0), a2, 0, voffA); \
            PG8_WAIT_V(8); PG8_WAIT_L(0); PG8_BAR; PG8_MMA(1, 0, At, B0); PG8_MMA(1, 1, At, B1); PG8_BAR; PG8_SCHED; \
            PG8_LDB(B0, 1, 0); PG8_LDB(B1, 1, 1); PG8_SCHED; PG8_LDA(At, 1, 0); PG8_STAGEA(PG8_SA(0, 1), a2, 1, voffA); \
            PG8_WAIT_V(8); PG8_WAIT_L(0); PG8_BAR; PG8_MMA(0, 0, At, B0); PG8_MMA(0, 1, At, B1); PG8_BAR; PG8_SCHED; \
            PG8_LDA(At, 1, 1); PG8_STAGEB(PG8_SB(1, 0), b3); PG8_STAGEB(PG8_SB(1, 1), b3 + hstepB); PG8_STAGEA(PG8_SA(1, 0), a3, 0, voffA); \
            PG8_WAIT_V(8); PG8_WAIT_L(0); PG8_BAR; PG8_MMA(1, 0, At, B0); PG8_MMA(1, 1, At, B1); PG8_BAR; PG8_SCHED; \

    Unit cur, nxt; int ui = 0;
    if (!S.next(0, cur)) return;
    f32x4 acc[2][2][4][2];
#pragma unroll
    for (int a = 0; a < 2; ++a)
#pragma unroll
        for (int b = 0; b < 2; ++b)
#pragma unroll
            for (int m = 0; m < 4; ++m)
#pragma unroll
                for (int n = 0; n < 2; ++n) acc[a][b][m][n] = (f32x4){0.f, 0.f, 0.f, 0.f};
    bf16x8 At[4][2], B0[2][2], B1[2][2];
    i32x8 At8[4], B08[2], B18[2];
    const char* cA = S.a_ptr(cur); const char* cB = S.b_ptr(cur);
    PG8_SETVO(voffA, cur);
    PG8_STAGEB(PG8_SB(0, 0), cB); PG8_STAGEB(PG8_SB(0, 1), cB + hstepB); PG8_STAGEA(PG8_SA(0, 0), cA, 0, voffA); PG8_STAGEA(PG8_SA(0, 1), cA, 1, voffA);
    if (wr == 1) PG8_BAR;
    PG8_WAIT_V(2); PG8_BAR;
    PG8_STAGEB(PG8_SB(1, 0), cB + kstep); PG8_STAGEA(PG8_SA(1, 0), cA + kstep, 0, voffA); PG8_STAGEB(PG8_SB(1, 1), cB + hstepB + kstep);
    PG8_WAIT_V(6); PG8_BAR;
    for (;;) {
        const bool has_next = S.next(ui + 1, nxt);
        const char* nA = has_next ? S.a_ptr(nxt) : cA; const char* nB = has_next ? S.b_ptr(nxt) : cB;
        if constexpr (Epi::MID) {
#pragma unroll 1
            for (int t = 0; t < (nt >> 1); t += 2) { PG8_TRIP_BODY }
            PG8_SCHED; E.mid(acc, cur, wr, wc, fr, fq); PG8_SCHED;
#pragma unroll 1
            for (int t = (nt >> 1); t < nt; t += 2) { PG8_TRIP_BODY }
        } else {
#pragma unroll 1
            for (int t = 0; t < nt; t += 2) { PG8_TRIP_BODY }
        }
        if (wr == 0) PG8_BAR;
        E(acc, cur, wr, wc, fr, fq);
        if (!has_next) break;
#pragma unroll
        for (int a = 0; a < 2; ++a)
#pragma unroll
            for (int b = 0; b < 2; ++b)
#pragma unroll
                for (int m = 0; m < 4; ++m)
#pragma unroll
                    for (int n = 0; n < 2; ++n) acc[a][b][m][n] = (f32x4){0.f, 0.f, 0.f, 0.f};
        cur = nxt; cA = nA; cB = nB; ++ui;
        if (wr == 1) PG8_BAR;
    }
    PG8_WAIT_V(0);
    PG8_BAR;
#undef PG8_SA
#undef PG8_SB
#undef PG8_STAGEA
#undef PG8_STAGEB
#undef PG8_LDA
#undef PG8_LDB
#undef PG8_MMA
#undef PG8_LD8
#undef PG8_WAIT_V
#undef PG8_WAIT_L
#undef PG8_BAR
#undef PG8_SCHED
#undef PG8_SETVO
#undef PG8_TRIP_BODY
}
}

struct InprojSched {
    static constexpr bool GATHER = false;
    const bf16_t* XN; const bf16_t* W; int G, c; int lda, ldb, K;
    __device__ __forceinline__ bool next(int i, pg8::Unit& u) const {
        const int L = i * G + c;
        if (L < 128 * 28) { int pm, pn; pg8::tile_of(L, 128, 28, pm, pn); u.pm = pm; u.pb = pn; u.x0 = 0; u.x1 = 0; return true; }
        const int idx = L - 128 * 28; if (idx >= 96) return false;
        u.pm = 128 + (idx & 7); u.pb = 8 + (idx >> 3); u.x0 = 1; u.x1 = 0; return true;
    }
    __device__ __forceinline__ const char* a_ptr(const pg8::Unit& u) const { return (const char*)XN + (size_t)u.pm * 256 * 1024 * 2; }
    __device__ __forceinline__ const char* b_ptr(const pg8::Unit& u) const { return (const char*)W + (size_t)u.pb * 256 * 1024 * 2; }
    __device__ __forceinline__ int row_of(const pg8::Unit&, int r) const { return r; }
};
struct MixSched {
    static constexpr bool GATHER = false;
    const bf16_t* Z; const bf16_t* W; int G, c; int lda, ldb, K;
    __device__ __forceinline__ bool next(int i, pg8::Unit& u) const {
        const int L = i * G + c; if (L >= 128 * 4) return false;
        int pm, pn; pg8::tile_of(L, 128, 4, pm, pn); u.pm = pm; u.pb = pn; u.x0 = pn; u.x1 = 0; return true;
    }
    __device__ __forceinline__ const char* a_ptr(const pg8::Unit& u) const { return (const char*)Z + (size_t)u.pm * 256 * LDZ * 2; }
    __device__ __forceinline__ const char* b_ptr(const pg8::Unit& u) const { return (const char*)W + (size_t)u.pb * 256 * 2048 * 2; }
    __device__ __forceinline__ int row_of(const pg8::Unit&, int r) const { return r; }
};
struct WoutSched {
    static constexpr bool GATHER = false;
    const bf16_t* Z; const bf16_t* W; int G, c; int lda, ldb, K;
    __device__ __forceinline__ bool next(int i, pg8::Unit& u) const {
        const int L = i * G + c; if (L >= 128 * 4) return false;
        int pm, pn; pg8::tile_of(L, 128, 4, pm, pn); u.pm = pm; u.pb = pn; u.x0 = pn; u.x1 = 0; return true;
    }
    __device__ __forceinline__ const char* a_ptr(const pg8::Unit& u) const { return (const char*)Z + ((size_t)u.pm * 256 * LDZ + ZC_XR) * 2; }
    __device__ __forceinline__ const char* b_ptr(const pg8::Unit& u) const { return (const char*)W + (size_t)u.pb * 256 * 1024 * 2; }
    __device__ __forceinline__ int row_of(const pg8::Unit&, int r) const { return r; }
};
struct Moe1Sched {
    static constexpr bool GATHER = true;
    const unsigned char* XN2; const unsigned char* W; const int* selidx; int G, c; int lda, ldb, K;
    __device__ __forceinline__ bool next(int i, pg8::Unit& u) const {
        const int L = i * G + c; if (L >= 16 * 256) return false;
        const int e = L >> 8, w = L & 255, x = w & 7, j = w >> 3;
        const int mt = (x & 3) * 4 + (j & 3), nt = (x >> 2) * 8 + (j >> 2);
        u.pm = e * 16 + mt; u.pb = e * 16 + nt; u.x0 = nt; u.x1 = e; return true;
    }
    __device__ __forceinline__ const char* a_ptr(const pg8::Unit&) const { return (const char*)XN2; }
    __device__ __forceinline__ const char* b_ptr(const pg8::Unit& u) const { return (const char*)W + (size_t)u.pb * 256 * 1024; }
    __device__ __forceinline__ int row_of(const pg8::Unit& u, int r) const { return selidx[u.pm * 256 + r]; }
};
struct Moe2Sched {
    static constexpr bool GATHER = true;
    const unsigned char* HID; const unsigned char* W; int G, c; int lda, ldb, K;
    __device__ __forceinline__ bool next(int i, pg8::Unit& u) const {
        const int L = i * G + c; if (L >= 16 * 64) return false;
        const int e = L >> 6, w = L & 63, mt = w >> 2, pn = w & 3;
        u.pm = e * 16 + mt; u.pb = e * 4 + pn; u.x0 = pn; u.x1 = e; return true;
    }
    __device__ __forceinline__ const char* a_ptr(const pg8::Unit& u) const { return (const char*)HID + (size_t)u.pm * 256 * 2048; }
    __device__ __forceinline__ const char* b_ptr(const pg8::Unit& u) const { return (const char*)W + (size_t)u.pb * 256 * 2048; }
    __device__ __forceinline__ int row_of(const pg8::Unit&, int r) const { return r; }
};

typedef const f32x4 (&AccRef)[2][2][4][2];
template <bool PLAIN = false> struct EpiInproj {
    static constexpr bool PERM = true, MID = false;
    bf16_t* Z; bf16_t* ZC; const float* binz; const float* rope;
    __device__ __forceinline__ void operator()(AccRef acc, const pg8::Unit& u, int wr, int wc, int fr, int fq) const {
        const bool isctx = u.x0 != 0;
        const int seg = PLAIN ? 2 : (u.pb >> 2), colt = u.pb * 256, cl = wc * 32 + 8 * fq;
        f32x4 bv[2][2];
#pragma unroll
        for (int bj = 0; bj < 2; ++bj)
#pragma unroll
            for (int n = 0; n < 2; ++n) bv[bj][n] = *(const f32x4*)(binz + colt + bj * 128 + cl + 4 * n);
        bf16_t* base; int ld, row0;
        if (!isctx) { base = Z + colt; ld = LDZ; row0 = u.pm * 256; } else { base = ZC + (colt - 2048); ld = LDC; row0 = (u.pm - 128) * 256; }
        const bool dorope = (seg == 1) || (seg == 3 && !isctx);
        const float qs = (seg == 1) ? QSCALE : 1.0f;
#pragma unroll
        for (int ai = 0; ai < 2; ++ai)
#pragma unroll
            for (int m = 0; m < 4; ++m) {
                const int r = row0 + ai * 128 + wr * 64 + m * 16 + fr;
                bf16_t* rowp = base + (size_t)r * ld + cl;
                f32x4 cs0 = (f32x4){1.f, 0.f, 1.f, 0.f}, cs1 = cs0;
                if (dorope) { const int t = r & 4095; const int pos = (wc & 1) ? (t & 63) : (t >> 6); const float* cp = rope + (pos * 16 + 4 * fq) * 2; cs0 = *(const f32x4*)cp; cs1 = *(const f32x4*)(cp + 4); }
#pragma unroll
                for (int bj = 0; bj < 2; ++bj) {
                    f32x4 v0 = acc[ai][bj][m][0] + bv[bj][0], v1 = acc[ai][bj][m][1] + bv[bj][1];
                    if (seg == 0) {
#pragma unroll
                        for (int j = 0; j < 4; ++j) { v0[j] = gelu_tanh(v0[j]); v1[j] = gelu_tanh(v1[j]); }
                    } else if (seg >= 5) {
#pragma unroll
                        for (int j = 0; j < 4; ++j) { v0[j] = sigmoidf_(v0[j]); v1[j] = sigmoidf_(v1[j]); }
                    } else if (dorope) {
                        const float c[4] = {cs0[0], cs0[2], cs1[0], cs1[2]}, s[4] = {cs0[1], cs0[3], cs1[1], cs1[3]};
#pragma unroll
                        for (int j = 0; j < 4; ++j) { const float x1 = v0[j], x2 = v1[j]; v0[j] = (x1 * c[j] - x2 * s[j]) * qs; v1[j] = (x1 * s[j] + x2 * c[j]) * qs; }
                    }
                    u32x4 w; w.x = cvt_pk_bf16(v0[0], v0[1]); w.y = cvt_pk_bf16(v0[2], v0[3]); w.z = cvt_pk_bf16(v1[0], v1[1]); w.w = cvt_pk_bf16(v1[2], v1[3]);
                    *(u32x4*)(rowp + bj * 128) = w;
                }
            }
    }
};
struct EpiMix {
    static constexpr bool PERM = true, MID = true;
    bf16_t* Z;
    __device__ __forceinline__ void mid(f32x4 (&acc)[2][2][4][2], const pg8::Unit& u, int wr, int wc, int fr, int fq) const {
        const int colt = u.x0 * 256, cl = wc * 32 + 8 * fq;
        int r0 = u.pm * 256 + wr * 64 + fr; asm volatile("" : "+v"(r0));
#pragma unroll
        for (int ai = 0; ai < 2; ++ai)
#pragma unroll
            for (int m = 0; m < 4; ++m) {
                const bf16_t* rowz = Z + (size_t)(r0 + ai * 128 + m * 16) * LDZ + colt + cl;
#pragma unroll
                for (int bj = 0; bj < 2; ++bj) {
                    const u32x4 gr = *(const u32x4*)(rowz + ZC_GR + bj * 128), gn = *(const u32x4*)(rowz + ZC_GN + bj * 128);
                    const f32x4 r0v = (f32x4){bf2f(gr.x & 0xffffu), bf2f(gr.x >> 16), bf2f(gr.y & 0xffffu), bf2f(gr.y >> 16)}, r1v = (f32x4){bf2f(gr.z & 0xffffu), bf2f(gr.z >> 16), bf2f(gr.w & 0xffffu), bf2f(gr.w >> 16)};
                    const f32x4 n0v = (f32x4){bf2f(gn.x & 0xffffu), bf2f(gn.x >> 16), bf2f(gn.y & 0xffffu), bf2f(gn.y >> 16)}, n1v = (f32x4){bf2f(gn.z & 0xffffu), bf2f(gn.z >> 16), bf2f(gn.w & 0xffffu), bf2f(gn.w >> 16)};
#pragma unroll
                    for (int j = 0; j < 4; ++j) { acc[ai][bj][m][0][j] *= r0v[j] * __builtin_amdgcn_rcpf(fmaxf(n0v[j], 1e-30f)); acc[ai][bj][m][1][j] *= r1v[j] * __builtin_amdgcn_rcpf(fmaxf(n1v[j], 1e-30f)); }
                    asm volatile("" : "+v"(acc[ai][bj][m][0]), "+v"(acc[ai][bj][m][1]) :: "memory");
                }
            }
    }
    __device__ __forceinline__ void operator()(AccRef acc, const pg8::Unit& u, int wr, int wc, int fr, int fq) const {
        const int colt = u.x0 * 256, cl = wc * 32 + 8 * fq;
        int r0 = u.pm * 256 + wr * 64 + fr; asm volatile("" : "+v"(r0));
#pragma unroll
        for (int ai = 0; ai < 2; ++ai)
#pragma unroll
            for (int m = 0; m < 4; ++m) {
                bf16_t* rowz = Z + (size_t)(r0 + ai * 128 + m * 16) * LDZ + colt + cl;
#pragma unroll
                for (int bj = 0; bj < 2; ++bj) {
                    const u32x4 g = *(const u32x4*)(rowz + ZC_GN + bj * 128);
                    const f32x4 v0 = acc[ai][bj][m][0] * (f32x4){bf2f(g.x & 0xffffu), bf2f(g.x >> 16), bf2f(g.y & 0xffffu), bf2f(g.y >> 16)};
                    const f32x4 v1 = acc[ai][bj][m][1] * (f32x4){bf2f(g.z & 0xffffu), bf2f(g.z >> 16), bf2f(g.w & 0xffffu), bf2f(g.w >> 16)};
                    u32x4 w; w.x = cvt_pk_bf16(v0[0], v0[1]); w.y = cvt_pk_bf16(v0[2], v0[3]); w.z = cvt_pk_bf16(v1[0], v1[1]); w.w = cvt_pk_bf16(v1[2], v1[3]);
                    *(u32x4*)(rowz + ZC_XR + bj * 128) = w;
                }
            }
    }
};
struct EpiWout {
    static constexpr bool PERM = true, MID = false;
    const float* x; bf16_t* x1; const float* mod;
    __device__ __forceinline__ void operator()(AccRef acc, const pg8::Unit& u, int wr, int wc, int fr, int fq) const {
        const int col0 = u.x0 * 256 + wc * 32 + 8 * fq;
        const float* g1p = mod + (size_t)(u.pm >> 4) * 6144 + 2048 + col0;
        f32x4 gv[2][2];
#pragma unroll
        for (int bj = 0; bj < 2; ++bj)
#pragma unroll
            for (int n = 0; n < 2; ++n) gv[bj][n] = *(const f32x4*)(g1p + bj * 128 + n * 4);
#pragma unroll
        for (int ai = 0; ai < 2; ++ai)
#pragma unroll
            for (int m = 0; m < 4; ++m) {
                const size_t off = (size_t)(u.pm * 256 + ai * 128 + wr * 64 + m * 16 + fr) * DM + col0;
#pragma unroll
                for (int bj = 0; bj < 2; ++bj) {
                    const f32x4 x0 = *(const f32x4*)(x + off + bj * 128), x4 = *(const f32x4*)(x + off + bj * 128 + 4);
                    const f32x4 v0 = x0 + gv[bj][0] * acc[ai][bj][m][0], v1 = x4 + gv[bj][1] * acc[ai][bj][m][1];
                    u32x4 w; w.x = cvt_pk_bf16(v0[0], v0[1]); w.y = cvt_pk_bf16(v0[2], v0[3]); w.z = cvt_pk_bf16(v1[0], v1[1]); w.w = cvt_pk_bf16(v1[2], v1[3]);
                    *(u32x4*)(x1 + off + bj * 128) = w;
                }
            }
    }
};
__device__ __forceinline__ unsigned pk4_fp8(float a, float b, float c, float d) { int w = 0; w = __builtin_amdgcn_cvt_pk_fp8_f32(a, b, w, false); w = __builtin_amdgcn_cvt_pk_fp8_f32(c, d, w, true); return (unsigned)w; }
struct EpiMoe1 {
    static constexpr bool PERM = true, MID = false;
    unsigned char* HID;
    __device__ __forceinline__ void operator()(AccRef acc, const pg8::Unit& u, int wr, int wc, int fr, int fq) const {
        const int col0 = u.x0 * 128 + wc * 32 + 8 * fq;
#pragma unroll
        for (int ai = 0; ai < 2; ++ai)
#pragma unroll
            for (int m = 0; m < 4; ++m) {
                const size_t r = (size_t)u.pm * 256 + ai * 128 + wr * 64 + m * 16 + fr;
                f32x4 h0, h1;
#pragma unroll
                for (int j = 0; j < 4; ++j) { const float g0 = acc[ai][0][m][0][j], g1 = acc[ai][0][m][1][j];
                    h0[j] = g0 * sigmoidf_(g0) * acc[ai][1][m][0][j]; h1[j] = g1 * sigmoidf_(g1) * acc[ai][1][m][1][j]; }
                u32x2 w; w.x = pk4_fp8(h0[0], h0[1], h0[2], h0[3]); w.y = pk4_fp8(h1[0], h1[1], h1[2], h1[3]);
                *(u32x2*)(HID + r * DEXP + col0) = w;
            }
    }
};
struct EpiMoe2 {
    static constexpr bool PERM = true, MID = false;
    bf16_t* YE; const float* selg;
    __device__ __forceinline__ void operator()(AccRef acc, const pg8::Unit& u, int wr, int wc, int fr, int fq) const {
        const int col0 = u.x0 * 256 + wc * 32 + 8 * fq;
        const size_t r0 = (size_t)u.pm * 256 + wr * 64 + fr;
        bf16_t* base = YE + r0 * DM + col0;
#pragma unroll
        for (int ai = 0; ai < 2; ++ai)
#pragma unroll
            for (int m = 0; m < 4; ++m) {
                bf16_t* rowp = base + (size_t)(ai * 128 + m * 16) * DM;
#pragma unroll
                for (int bj = 0; bj < 2; ++bj) {
                    const f32x4 v0 = acc[ai][bj][m][0], v1 = acc[ai][bj][m][1];
                    u32x4 w; w.x = cvt_pk_bf16(v0[0], v0[1]); w.y = cvt_pk_bf16(v0[2], v0[3]); w.z = cvt_pk_bf16(v1[0], v1[1]); w.w = cvt_pk_bf16(v1[2], v1[3]);
                    *(u32x4*)(rowp + bj * 128) = w;
                }
            }
    }
};

struct Params {
    const float *x, *c, *ctx, *c_ctx, *w_mod, *b_mod, *w_in, *b_in, *conv_w, *conv_b, *lru_wa, *lru_ba, *lru_wi, *lru_bi, *lru_lambda, *na_rpb,
                *w_proj_rnn, *w_proj_na, *w_out, *w_router, *w_exp_gate, *w_exp_up, *w_exp_down, *final_norm;
    float* out; unsigned char* ws;
    int ph_lo, ph_hi, probe, pad;
};

__device__ __forceinline__ int zcol_of(int n) {
    const int seg = n >> 10, o = n & 1023;
    if (seg == 0) return ZC_YG + o;
    if (seg == 1) return ZC_XR + o;
    if (seg == 4) return ZC_V + o;
    if (seg == 5) return ZC_GR + o;
    if (seg == 6) return ZC_GN + o;
    const int hh = o >> 6, d = o & 63, g2 = d >> 5, dd = d & 31, nn = dd >> 4, j = dd & 15, a = j >> 2, jj = j & 3;
    return (seg == 2 ? ZC_Q : ZC_K) + hh * 64 + g2 * 32 + 8 * a + 4 * nn + jj;
}
constexpr int TR_SCR = 64 * 65 * 4;
template <class RowMap>
__device__ __forceinline__ void transpose_item(const float* W, int ldw, int k0, int n0, bf16_t* WT, int ldk, RowMap rowmap, LAS float* scr, int lane) {
    const int ln = lane & 15, lk = lane >> 4;
    f32x4 v[16];
#pragma unroll
    for (int i = 0; i < 16; ++i) v[i] = *(const f32x4*)(W + (size_t)(k0 + 4 * i + lk) * ldw + n0 + 4 * ln);
#pragma unroll
    for (int i = 0; i < 16; ++i) { LAS float* d = scr + (4 * i + lk) * 65 + 4 * ln; d[0] = v[i].x; d[1] = v[i].y; d[2] = v[i].z; d[3] = v[i].w; }
    LDS_WAIT(); asm volatile("" ::: "memory");
    const int kg = lane & 7;
#pragma unroll
    for (int j = 0; j < 8; ++j) { const int n = (lane >> 3) + 8 * j; const LAS float* sp = scr + (8 * kg) * 65 + n;
        u32x4 o; o.x = cvt_pk_bf16(sp[0 * 65], sp[1 * 65]); o.y = cvt_pk_bf16(sp[2 * 65], sp[3 * 65]); o.z = cvt_pk_bf16(sp[4 * 65], sp[5 * 65]); o.w = cvt_pk_bf16(sp[6 * 65], sp[7 * 65]);
        *(u32x4*)(WT + (size_t)rowmap(n0 + n) * ldk + k0 + 8 * kg) = o; }
    LDS_WAIT(); asm volatile("" ::: "memory");
}
template <class RowMap>
__device__ __forceinline__ void transpose_item_f8(const float* W, int ldw, int k0, int n0, unsigned char* WT, int ldk, RowMap rowmap, LAS float* scr, int lane) {
    const int ln = lane & 15, lk = lane >> 4;
    f32x4 v[16];
#pragma unroll
    for (int i = 0; i < 16; ++i) v[i] = *(const f32x4*)(W + (size_t)(k0 + 4 * i + lk) * ldw + n0 + 4 * ln);
#pragma unroll
    for (int i = 0; i < 16; ++i) { LAS float* d = scr + (4 * i + lk) * 65 + 4 * ln; d[0] = v[i].x * 64.f; d[1] = v[i].y * 64.f; d[2] = v[i].z * 64.f; d[3] = v[i].w * 64.f; }
    LDS_WAIT(); asm volatile("" ::: "memory");
    const int kq = lane & 3;
#pragma unroll
    for (int j = 0; j < 4; ++j) { const int n = (lane >> 2) + 16 * j; const LAS float* sp = scr + (16 * kq) * 65 + n;
        u32x4 o; o.x = pk4_fp8(sp[0 * 65], sp[1 * 65], sp[2 * 65], sp[3 * 65]); o.y = pk4_fp8(sp[4 * 65], sp[5 * 65], sp[6 * 65], sp[7 * 65]);
        o.z = pk4_fp8(sp[8 * 65], sp[9 * 65], sp[10 * 65], sp[11 * 65]); o.w = pk4_fp8(sp[12 * 65], sp[13 * 65], sp[14 * 65], sp[15 * 65]);
        *(u32x4*)(WT + (size_t)rowmap(n0 + n) * ldk + k0 + 16 * kq) = o; }
    LDS_WAIT(); asm volatile("" ::: "memory");
}
__device__ __forceinline__ void phase_prep(const Params& p, LAS unsigned char* lds) {
    const int tid = threadIdx.x, lane = tid & 63, wave = tid >> 6, G = gridDim.x;
    unsigned char* ws = p.ws;
    {
        LAS float* scr = (LAS float*)(lds + wave * TR_SCR);
        bf16_t* WINT = (bf16_t*)(ws + WS_WINT); bf16_t* WMIX = (bf16_t*)(ws + WS_WMIX); bf16_t* WOUT = (bf16_t*)(ws + WS_WOUT);
        const int gw = blockIdx.x * NWAVES + wave, NGW = G * NWAVES;
        constexpr int I_IN = 16 * (NIN / 64), I_P = 16 * 16;
        for (int it = gw; it < I_IN + 3 * I_P; it += NGW) {
            int r = it;
            if (r < I_IN) { const int nblk = NIN / 64, kb = r / nblk, nb = r % nblk; transpose_item(p.w_in, NIN, 64 * kb, 64 * nb, WINT, 1024, [](int n) { return zcol_of(n); }, scr, lane); continue; } r -= I_IN;
            const int kb = (r % I_P) / 16, nb = (r % I_P) % 16, which = r / I_P;
            if (which == 0) transpose_item(p.w_proj_rnn, 1024, 64 * kb, 64 * nb, WMIX, 2048, [](int n) { return n; }, scr, lane);
            else if (which == 1) transpose_item(p.w_proj_na, 1024, 64 * kb, 64 * nb, WMIX + 1024, 2048, [](int n) { return n; }, scr, lane);
            else transpose_item(p.w_out, 1024, 64 * kb, 64 * nb, WOUT, 1024, [](int n) { return n; }, scr, lane);
        }
    }
    __syncthreads();
    {
        LAS float* sS = (LAS float*)lds;
        LAS float* red = sS + 9 * 1024;
        float* MOD = (float*)(ws + WS_MOD);
        if (blockIdx.x < 192) {
            for (int e = tid; e < 9 * 1024; e += NTHREADS) { const int r = e >> 10, k = e & 1023; const float v = (r < 8) ? p.c[r * 1024 + k] : p.c_ctx[k]; sS[e] = v * sigmoidf_(v); }
            __syncthreads();
        }
        for (int it = blockIdx.x; it < 192; it += G) {
            const int n0 = it * 32, kk = tid >> 3, c4 = tid & 7;
            f32x4 a[9];
#pragma unroll
            for (int r = 0; r < 9; ++r) a[r] = (f32x4){0.f, 0.f, 0.f, 0.f};
#pragma unroll 4
            for (int i = 0; i < 16; ++i) { const int k = kk + 64 * i; const f32x4 w = *(const f32x4*)(p.w_mod + (size_t)k * 6144 + n0 + 4 * c4);
#pragma unroll
                for (int r = 0; r < 9; ++r) a[r] += w * sS[r * 1024 + k]; }
#pragma unroll
            for (int r = 0; r < 9; ++r) *(LAS f32x4*)(red + (kk * 9 + r) * 32 + 4 * c4) = a[r];
            __syncthreads();
            if (tid < 288) { const int r = tid >> 5, col = tid & 31; float sum = p.b_mod[n0 + col];
                for (int q = 0; q < 64; ++q) sum += red[(q * 9 + r) * 32 + col];
                MOD[r * 6144 + n0 + col] = sum; }
            __syncthreads();
        }
    }
    {
        float* ROPE = (float*)(ws + WS_ROPE); float* BINZ = (float*)(ws + WS_BINZ);
        const int gt = blockIdx.x * NTHREADS + tid, NGT = G * NTHREADS;
        for (int e = gt; e < 64 * 16; e += NGT) { const int pos = e >> 4, j = e & 15; const float inv = powf(10000.0f, -(float)j / 16.0f); const float ang = (float)pos * inv; ROPE[2 * e] = cosf(ang); ROPE[2 * e + 1] = sinf(ang); }
        for (int n = gt; n < NIN; n += NGT) BINZ[zcol_of(n)] = p.b_in[n];
    }
}

__device__ __forceinline__ const float* norm1_row(const Params& p, int row) { return row >= MLAT ? p.ctx + (size_t)(row - MLAT) * DM : p.x + (size_t)row * DM; }
__device__ __forceinline__ void phase_norm1(const Params& p, LAS unsigned char* lds) {
    const int tid = threadIdx.x, lane = tid & 63, wave = tid >> 6, G = gridDim.x;
    unsigned char* ws = p.ws;
    const float* MOD = (const float*)(ws + WS_MOD);
    bf16_t* XN = (bf16_t*)(ws + WS_XN);
    const int gw = blockIdx.x * NWAVES + wave, NGW = G * NWAVES;
    constexpr int NROW = MLAT + MCTX;
    const int per = (NROW + NGW - 1) / NGW, r_lo = gw * per, r_hi = min(r_lo + per, NROW);
    if (r_lo >= r_hi) return;
    f32x4 nx[4], shv[4], scv[4]; int mcur = -1;
    { const f32x4* xr = (const f32x4*)norm1_row(p, r_lo) + lane;
#pragma unroll
      for (int j = 0; j < 4; ++j) nx[j] = xr[64 * j]; }
    for (int row = r_lo; row < r_hi; ++row) {
        const int mr = (row >= MLAT) ? 8 : (row >> 12);
        if (mr != mcur) { mcur = mr; const float* sh = MOD + (size_t)mr * 6144;
#pragma unroll
            for (int j = 0; j < 4; ++j) { shv[j] = *(const f32x4*)(sh + 4 * lane + 256 * j); scv[j] = *(const f32x4*)(sh + 1024 + 4 * lane + 256 * j) + 1.0f; } }
        f32x4 v[4]; float s = 0.f;
#pragma unroll
        for (int j = 0; j < 4; ++j) { v[j] = nx[j]; s += (v[j].x * v[j].x + v[j].y * v[j].y) + (v[j].z * v[j].z + v[j].w * v[j].w); }
        if (row + 1 < r_hi) { const f32x4* xr = (const f32x4*)norm1_row(p, row + 1) + lane;
#pragma unroll
            for (int j = 0; j < 4; ++j) nx[j] = xr[64 * j]; }
        const float rs = 1.0f / sqrtf(wave_sum(s) * (1.0f / DM) + 1e-6f);
        unsigned long long* o8 = (unsigned long long*)(XN + (size_t)row * DM) + lane;
#pragma unroll
        for (int j = 0; j < 4; ++j) { const f32x4 y = v[j] * rs * scv[j] + shv[j];
            o8[64 * j] = (unsigned long long)pk2(y.x, y.y) | ((unsigned long long)pk2(y.z, y.w) << 32); }
    }
}

typedef float f32x16 __attribute__((ext_vector_type(16)));
constexpr int RN_XS = 144;
constexpr int RN_XC = 0, RN_WT = 256 * RN_XS, RN_SEG = RN_WT + 64 * RN_XS, RN_ST = RN_SEG + 4096;
__device__ __forceinline__ void phase_rnn(const Params& p, LAS unsigned char* lds, const bool dry) {
    const int tid = threadIdx.x, lane = tid & 63, wave = __builtin_amdgcn_readfirstlane(tid >> 6), G = gridDim.x;
    unsigned char* ws = p.ws;
    bf16_t* Z = (bf16_t*)(ws + WS_Z); const bf16_t* ZCb = (const bf16_t*)(ws + WS_ZC); bf16_t* HF = (bf16_t*)(ws + WS_XN);
    LAS unsigned char* xcb = lds + RN_XC;
    LAS unsigned char* wtb = lds + RN_WT;
    LAS float* segA = (LAS float*)(lds + RN_SEG);
    LAS float* segB = segA + 512;
    LAS unsigned char* stg = lds + RN_ST;
    const int c = lane & 31, hh = lane >> 5;
    const int taur = 16 * ((c >> 2) & 1) + 4 * (c >> 3) + (c & 3);
    const int cg8 = tid & 7, run = tid >> 3;
    for (int it = blockIdx.x; it < 256; it += G) {
        const int b = it >> 5, g = (it >> 1) & 15, half = it & 1;
        const int ch = 64 * g + 32 * half + c;
        const int ch0 = 64 * g + 32 * half;
        float cw[4][8], cbv[8];
#pragma unroll
        for (int j = 0; j < 8; ++j) { cbv[j] = p.conv_b[64 * g + 8 * cg8 + j];
#pragma unroll
            for (int k = 0; k < 4; ++k) cw[k][j] = p.conv_w[k * 1024 + 64 * g + 8 * cg8 + j]; }
        const bf16_t* srcL = Z + (size_t)b * SEQ * LDZ + ZC_XR + 64 * g + 8 * cg8;
        const bf16_t* srcC = ZCb + (size_t)b * CTX * LDC + CC_XR + 64 * g + 8 * cg8;
        for (int dir = 0; dir < 2; ++dir) {
            u32x4 xr[7];
#pragma unroll
            for (int q = 0; q < 7; ++q) { const int ts = 4 * run - 2 + q; xr[q] = (ts >= 0 && ts < CTX) ? *(const u32x4*)(srcC + (size_t)ts * LDC) : (u32x4){0u, 0u, 0u, 0u}; }
            __syncthreads();
            for (int e = tid; e < 2 * 64 * 32; e += NTHREADS) { const int mat = e >> 11, i = (e >> 5) & 63, cc = e & 31;
                const float* src = mat ? p.lru_wi : p.lru_wa;
                *(LAS bf16_t*)(wtb + (mat * 32 + cc) * RN_XS + i * 2) = (bf16_t)f2bf(src[(((size_t)dir * 16 + g) * 64 + i) * 64 + 32 * half + cc]); }
            __syncthreads();
            bf16x8 Bw[2][4];
#pragma unroll
            for (int mat = 0; mat < 2; ++mat)
#pragma unroll
                for (int s4 = 0; s4 < 4; ++s4) Bw[mat][s4] = *(const LAS bf16x8*)(wtb + (mat * 32 + c) * RN_XS + (16 * s4 + 8 * hh) * 2);
            const float ba = p.lru_ba[dir * 1024 + ch], bi = p.lru_bi[dir * 1024 + ch];
            const float lam = p.lru_lambda[dir * 1024 + ch];
            const float sp = (lam > 15.f) ? expf(-lam) : log1pf(expf(-lam));
            const float clam = -8.0f * sp * LOG2E;
            float hc = 0.f;
            for (int step = 0; step < 17; ++step) {
                const bool isctx = (step == 0);
                const int t0 = isctx ? 0 : 256 * (dir == 0 ? step - 1 : 16 - step);
                {
                    float xf[7][8];
#pragma unroll
                    for (int q = 0; q < 7; ++q) { xf[q][0] = bf2f(xr[q].x & 0xffffu); xf[q][1] = bf2f(xr[q].x >> 16); xf[q][2] = bf2f(xr[q].y & 0xffffu); xf[q][3] = bf2f(xr[q].y >> 16);
                        xf[q][4] = bf2f(xr[q].z & 0xffffu); xf[q][5] = bf2f(xr[q].z >> 16); xf[q][6] = bf2f(xr[q].w & 0xffffu); xf[q][7] = bf2f(xr[q].w >> 16); }
#pragma unroll
                    for (int i = 0; i < 4; ++i) { float a[8];
#pragma unroll
                        for (int j = 0; j < 8; ++j) a[j] = cbv[j] + cw[0][j] * xf[i][j] + cw[1][j] * xf[i + 1][j] + cw[2][j] * xf[i + 2][j] + cw[3][j] * xf[i + 3][j];
                        u32x4 w; w.x = cvt_pk_bf16(a[0], a[1]); w.y = cvt_pk_bf16(a[2], a[3]); w.z = cvt_pk_bf16(a[4], a[5]); w.w = cvt_pk_bf16(a[6], a[7]);
                        *(LAS u32x4*)(xcb + (4 * run + i) * RN_XS + cg8 * 16) = w; }
                }
                if (step < 16) { const int tn = 256 * (dir == 0 ? step : 15 - step);
#pragma unroll
                    for (int q = 0; q < 7; ++q) { const int ts = tn + 4 * run - 2 + q; xr[q] = (ts >= 0 && ts < SEQ) ? *(const u32x4*)(srcL + (size_t)ts * LDZ) : (u32x4){0u, 0u, 0u, 0u}; } }
                u32x4 hfr[2], ygr[2];
                const size_t tb = (size_t)b * SEQ + t0;
                if (!isctx && dir == 1) {
#pragma unroll
                    for (int i = 0; i < 2; ++i) { const int pid = tid + NTHREADS * i, tk = pid >> 2, part = pid & 3;
                        hfr[i] = *(const u32x4*)(HF + (tb + tk) * DM + ch0 + 8 * part); ygr[i] = *(const u32x4*)(Z + (tb + tk) * LDZ + ZC_YG + ch0 + 8 * part); } }
                __syncthreads();
                f32x16 ar, ai;
#pragma unroll
                for (int j = 0; j < 16; ++j) { ar[j] = 0.f; ai[j] = 0.f; }
                const LAS unsigned char* arow = xcb + (32 * wave + taur) * RN_XS + 16 * hh;
#pragma unroll
                for (int s4 = 0; s4 < 4; ++s4) { const bf16x8 af = *(const LAS bf16x8*)(arow + 32 * s4);
                    ar = __builtin_amdgcn_mfma_f32_32x32x16_bf16(af, Bw[0][s4], ar, 0, 0, 0);
                    ai = __builtin_amdgcn_mfma_f32_32x32x16_bf16(af, Bw[1][s4], ai, 0, 0, 0); }
                const LAS unsigned char* xcol = xcb + (32 * wave + 16 * hh) * RN_XS + (32 * half + c) * 2;
#pragma unroll
                for (int j = 0; j < 16; ++j) {
                    const float r = sigmoidf_(ar[j] + ba), ig = sigmoidf_(ai[j] + bi);
                    const float l2 = r * clam;
                    const float a = __builtin_amdgcn_exp2f(l2);
                    const float x = 1.3862943611198906f * l2;
                    const float om = -x * (1.0f + x * (0.5f + x * (0.16666667f + x * (0.041666668f + x * (0.0083333338f + x * 0.0013888889f)))));
                    const float xv = bf2f(*(const LAS bf16_t*)(xcol + j * RN_XS));
                    ar[j] = a; ai[j] = __builtin_amdgcn_sqrtf(fmaxf(om, 0.f)) * ig * xv;
                }
                float P = 1.f, H = 0.f;
                if (dir == 0) {
#pragma unroll
                    for (int j = 0; j < 16; ++j) { H = ar[j] * H + ai[j]; P *= ar[j]; }
                } else {
#pragma unroll
                    for (int j = 15; j >= 0; --j) { H = ar[j] * H + ai[j]; P *= ar[j]; }
                }
                const int s = 2 * wave + hh;
                segA[s * 32 + c] = P; segB[s * 32 + c] = H;
                __syncthreads();
                float h = hc, hin = 0.f;
                if (dir == 0) {
#pragma unroll
                    for (int q = 0; q < 16; ++q) { if (q == s) hin = h; h = segA[q * 32 + c] * h + segB[q * 32 + c]; } }
                else {
#pragma unroll
                    for (int q = 15; q >= 0; --q) { if (q == s) hin = h; h = segA[q * 32 + c] * h + segB[q * 32 + c]; } }
                hc = h;
                if (!isctx) {
                    LAS float* sp0 = (LAS float*)(stg + (32 * wave + 16 * hh) * RN_XS) + c;
                    h = hin;
                    if (dir == 0) {
#pragma unroll
                        for (int j = 0; j < 16; ++j) { h = ar[j] * h + ai[j]; sp0[j * (RN_XS / 4)] = h; }
                    } else {
#pragma unroll
                        for (int j = 15; j >= 0; --j) { h = ar[j] * h + ai[j]; sp0[j * (RN_XS / 4)] = h; }
                    }
                    __syncthreads();
#pragma unroll
                    for (int i = 0; i < 2; ++i) { const int pid = tid + NTHREADS * i, tk = pid >> 2, part = pid & 3;
                        const LAS f32x4* sr = (const LAS f32x4*)(stg + tk * RN_XS + part * 32);
                        f32x4 h0 = sr[0], h1 = sr[1];
                        if (dir == 1) {
                            const u32x4 f = hfr[i], y = ygr[i];
                            h0 = (h0 + (f32x4){bf2f(f.x & 0xffffu), bf2f(f.x >> 16), bf2f(f.y & 0xffffu), bf2f(f.y >> 16)}) * (f32x4){bf2f(y.x & 0xffffu), bf2f(y.x >> 16), bf2f(y.y & 0xffffu), bf2f(y.y >> 16)};
                            h1 = (h1 + (f32x4){bf2f(f.z & 0xffffu), bf2f(f.z >> 16), bf2f(f.w & 0xffffu), bf2f(f.w >> 16)}) * (f32x4){bf2f(y.z & 0xffffu), bf2f(y.z >> 16), bf2f(y.w & 0xffffu), bf2f(y.w >> 16)};
                        }
                        u32x4 w; w.x = cvt_pk_bf16(h0[0], h0[1]); w.y = cvt_pk_bf16(h0[2], h0[3]); w.z = cvt_pk_bf16(h1[0], h1[1]); w.w = cvt_pk_bf16(h1[2], h1[3]);
                        if (!dry) { if (dir == 0) *(u32x4*)(HF + (tb + tk) * DM + ch0 + 8 * part) = w; else *(u32x4*)(Z + (tb + tk) * LDZ + ZC_YG + ch0 + 8 * part) = w; }
                    }
                }
            }
        }
    }
}

constexpr int AT_KS = 144, AT_VS = 160, AT_KB = 64 * AT_KS, AT_VB = 64 * AT_VS, AT_SLOT = AT_KB + AT_VB, AT_BIAS = 2 * AT_SLOT;
typedef short s16x4 __attribute__((ext_vector_type(4)));
struct QBlk { bf16x8 q[2]; f32x4 o[4]; float l; };
template <bool LOCAL, bool DOA, bool DOB>
__device__ __forceinline__ void attn_proc32(QBlk& A, QBlk& B, const LAS unsigned char* Kc, const LAS unsigned char* Vc, int kc0, int lane, unsigned vmask, const LAS float* browA, const LAS float* browB, int dc0) {
    const int i = lane & 15, kq = lane >> 4;
    f32x4 a0 = (f32x4){0.f, 0.f, 0.f, 0.f}, a1 = a0, b0 = a0, b1 = a0;
#pragma unroll
    for (int ks = 0; ks < 2; ++ks) {
        const bf16x8 k0 = *(const LAS bf16x8*)(Kc + (kc0 + i) * AT_KS + ks * 64 + kq * 16);
        const bf16x8 k1 = *(const LAS bf16x8*)(Kc + (kc0 + 16 + i) * AT_KS + ks * 64 + kq * 16);
        if (DOA) { a0 = __builtin_amdgcn_mfma_f32_16x16x32_bf16(k0, A.q[ks], a0, 0, 0, 0); a1 = __builtin_amdgcn_mfma_f32_16x16x32_bf16(k1, A.q[ks], a1, 0, 0, 0); }
        if (DOB) { b0 = __builtin_amdgcn_mfma_f32_16x16x32_bf16(k0, B.q[ks], b0, 0, 0, 0); b1 = __builtin_amdgcn_mfma_f32_16x16x32_bf16(k1, B.q[ks], b1, 0, 0, 0); }
    }
    if (LOCAL) {
#pragma unroll
        for (int r = 0; r < 4; ++r) {
            const int d0 = min(max(dc0 + r, 0), 30), d1 = min(max(dc0 + 16 + r, 0), 30);
            if (DOA) { a0[r] += browA[d0]; a1[r] += browA[d1]; }
            if (DOB) { b0[r] += browB[d0]; b1[r] += browB[d1]; }
        }
    }
    float psA = 0.f, psB = 0.f;
#pragma unroll
    for (int r = 0; r < 4; ++r) {
        if (DOA) { float e0 = __builtin_amdgcn_exp2f(a0[r]), e1 = __builtin_amdgcn_exp2f(a1[r]); if (LOCAL) { e0 = (vmask >> r) & 1u ? e0 : 0.f; e1 = (vmask >> (4 + r)) & 1u ? e1 : 0.f; } a0[r] = e0; a1[r] = e1; psA += e0 + e1; }
        if (DOB) { float e0 = __builtin_amdgcn_exp2f(b0[r]), e1 = __builtin_amdgcn_exp2f(b1[r]); if (LOCAL) { e0 = (vmask >> r) & 1u ? e0 : 0.f; e1 = (vmask >> (4 + r)) & 1u ? e1 : 0.f; } b0[r] = e0; b1[r] = e1; psB += e0 + e1; }
    }
    bf16x8 pA, pB;
    if (DOA) { A.l += psA; const u32x4 w = (u32x4){cvt_pk_bf16(a0[0], a0[1]), cvt_pk_bf16(a0[2], a0[3]), cvt_pk_bf16(a1[0], a1[1]), cvt_pk_bf16(a1[2], a1[3])}; pA = __builtin_bit_cast(bf16x8, w); }
    if (DOB) { B.l += psB; const u32x4 w = (u32x4){cvt_pk_bf16(b0[0], b0[1]), cvt_pk_bf16(b0[2], b0[3]), cvt_pk_bf16(b1[0], b1[1]), cvt_pk_bf16(b1[2], b1[3])}; pB = __builtin_bit_cast(bf16x8, w); }
    const LAS unsigned char* vp = Vc + (kc0 + 4 * kq + ((lane & 15) >> 2)) * AT_VS + (lane & 3) * 8;
#pragma unroll
    for (int dt = 0; dt < 4; ++dt) {
        const s16x4 lo4 = __builtin_bit_cast(s16x4, __builtin_amdgcn_ds_read_tr16_b64_v4i16((LAS s16x4*)(vp + dt * 32)));
        const s16x4 hi4 = __builtin_bit_cast(s16x4, __builtin_amdgcn_ds_read_tr16_b64_v4i16((LAS s16x4*)(vp + dt * 32 + 16 * AT_VS)));
        const bf16x8 av = (bf16x8){lo4[0], lo4[1], lo4[2], lo4[3], hi4[0], hi4[1], hi4[2], hi4[3]};
        if (DOA) A.o[dt] = __builtin_amdgcn_mfma_f32_16x16x32_bf16(av, pA, A.o[dt], 0, 0, 0);
        if (DOB) B.o[dt] = __builtin_amdgcn_mfma_f32_16x16x32_bf16(av, pB, B.o[dt], 0, 0, 0);
    }
}
__device__ __forceinline__ void phase_attn(const Params& p, LAS unsigned char* lds, const bool dry) {
    const int tid = threadIdx.x, lane = tid & 63, wave = __builtin_amdgcn_readfirstlane(tid >> 6), G = gridDim.x;
    unsigned char* ws = p.ws;
    bf16_t* Z = (bf16_t*)(ws + WS_Z); const bf16_t* ZCb = (const bf16_t*)(ws + WS_ZC);
    LAS float* btab = (LAS float*)(lds + AT_BIAS);
    const int j = wave & 3, c16 = lane & 15, fq = lane >> 4;
    const int cq = 16 * j + c16, cst = min(max(cq - 8, 0), 48), kst = min(max(16 * j - 8, 0), 32);
    const int lo = cst - kst - 4 * fq;
    unsigned vmask = 0u;
#pragma unroll
    for (int q = 0; q < 8; ++q) { const int li = 16 * (q >> 2) + (q & 3); if (li >= lo && li < lo + 16) vmask |= 1u << q; }
    const int dc0 = kst + 4 * fq - cq + 15;
    const int lkey = tid >> 3, lpc = tid & 7;
    for (int u = blockIdx.x; u < NB * 16 * 16; u += G) {
        const int b = u >> 8, h = (u >> 4) & 15, r0 = 4 * (u & 15);
        const int kr_lo = min(max(r0 - 4, 0), 56), kr_hi = min(max(r0 - 1, 0), 56) + 7, nloc = kr_hi - kr_lo + 1, nch = nloc + 4;
        const int rA = r0 + (wave >> 2), rB = rA + 2, rsA = min(max(rA - 4, 0), 56), rsB = min(max(rB - 4, 0), 56);
        bf16_t* qA = Z + ((size_t)b * SEQ + rA * 64 + cq) * LDZ + ZC_Q + h * 64;
        bf16_t* qB = Z + ((size_t)b * SEQ + rB * 64 + cq) * LDZ + ZC_Q + h * 64;
        QBlk A, Bq;
#pragma unroll
        for (int ks = 0; ks < 2; ++ks) { A.q[ks] = *(const bf16x8*)(qA + ks * 32 + fq * 8); Bq.q[ks] = *(const bf16x8*)(qB + ks * 32 + fq * 8); }
#pragma unroll
        for (int dt = 0; dt < 4; ++dt) { A.o[dt] = (f32x4){0.f, 0.f, 0.f, 0.f}; Bq.o[dt] = (f32x4){0.f, 0.f, 0.f, 0.f}; }
        A.l = 0.f; Bq.l = 0.f;
        for (int e = tid; e < 15 * 31; e += NTHREADS) btab[e] = p.na_rpb[(size_t)h * 465 + e] * LOG2E;
        const bf16_t* kbase = Z + ((size_t)b * SEQ + lkey) * LDZ + ZC_K + h * 64 + lpc * 8;
        const bf16_t* cbase = ZCb + ((size_t)b * CTX + lkey) * LDC + CC_K + h * 64 + lpc * 8;
        u32x4 kreg, vreg;
        { const bf16_t* src = kbase + (size_t)kr_lo * 64 * LDZ; kreg = *(const u32x4*)src; vreg = *(const u32x4*)(src + (ZC_V - ZC_K)); }
        *(LAS u32x4*)(lds + lkey * AT_KS + lpc * 16) = kreg; *(LAS u32x4*)(lds + AT_KB + lkey * AT_VS + lpc * 16) = vreg;
        __syncthreads();
        for (int c = 0; c < nch; ++c) {
            if (c + 1 < nch) {
                if (c + 1 < nloc) { const bf16_t* src = kbase + (size_t)(kr_lo + c + 1) * 64 * LDZ; kreg = *(const u32x4*)src; vreg = *(const u32x4*)(src + (ZC_V - ZC_K)); }
                else { const bf16_t* src = cbase + (size_t)(c + 1 - nloc) * 64 * LDC; kreg = *(const u32x4*)src; vreg = *(const u32x4*)(src + (CC_V - CC_K)); }
            }
            const LAS unsigned char* Kc = lds + (c & 1) * AT_SLOT; const LAS unsigned char* Vc = Kc + AT_KB;
            if (c < nloc) {
                const int kr = kr_lo + c;
                const bool vA = (kr >= rsA && kr < rsA + 8), vB = (kr >= rsB && kr < rsB + 8);
                const LAS float* bA = btab + min(max(kr - rA + 7, 0), 14) * 31; const LAS float* bB = btab + min(max(kr - rB + 7, 0), 14) * 31;
                if (vA && vB) attn_proc32<true, true, true>(A, Bq, Kc, Vc, kst, lane, vmask, bA, bB, dc0);
                else if (vA) attn_proc32<true, true, false>(A, Bq, Kc, Vc, kst, lane, vmask, bA, bB, dc0);
                else if (vB) attn_proc32<true, false, true>(A, Bq, Kc, Vc, kst, lane, vmask, bA, bB, dc0);
            } else {
                attn_proc32<false, true, true>(A, Bq, Kc, Vc, 0, lane, 0u, btab, btab, 0);
                attn_proc32<false, true, true>(A, Bq, Kc, Vc, 32, lane, 0u, btab, btab, 0);
            }
            if (c + 1 < nch) { LAS unsigned char* d = lds + ((c + 1) & 1) * AT_SLOT; *(LAS u32x4*)(d + lkey * AT_KS + lpc * 16) = kreg; *(LAS u32x4*)(d + AT_KB + lkey * AT_VS + lpc * 16) = vreg; }
            __syncthreads();
        }
        {
            float l = A.l; l += __shfl_xor(l, 16); l += __shfl_xor(l, 32); const float il = 1.0f / l;
#pragma unroll
            for (int dt = 0; dt < 4; ++dt) { const f32x4 o = A.o[dt] * il; u32x2 w; w.x = cvt_pk_bf16(o[0], o[1]); w.y = cvt_pk_bf16(o[2], o[3]); if (!dry) *(u32x2*)(qA + dt * 16 + fq * 4) = w; }
            l = Bq.l; l += __shfl_xor(l, 16); l += __shfl_xor(l, 32); const float il2 = 1.0f / l;
#pragma unroll
            for (int dt = 0; dt < 4; ++dt) { const f32x4 o = Bq.o[dt] * il2; u32x2 w; w.x = cvt_pk_bf16(o[0], o[1]); w.y = cvt_pk_bf16(o[2], o[3]); if (!dry) *(u32x2*)(qB + dt * 16 + fq * 4) = w; }
        }
    }
}

__device__ __forceinline__ void phase_norm2(const Params& p, LAS unsigned char* lds) {
    const int tid = threadIdx.x, lane = tid & 63, wave = tid >> 6, G = gridDim.x;
    unsigned char* ws = p.ws;
    const float* MOD = (const float*)(ws + WS_MOD); unsigned char* XN2 = ws + WS_XN2; float* AFF = (float*)(ws + WS_AFF);
    const bf16_t* X1 = (const bf16_t*)(ws + WS_X1);
    LAS float* wrT = (LAS float*)lds;
    for (int e = tid; e < 16 * 1024; e += NTHREADS) wrT[(e & 15) * 1024 + (e >> 4)] = p.w_router[e];
    __syncthreads();
    const int gw = blockIdx.x * NWAVES + wave, NGW = G * NWAVES;
    const bool b5 = lane & 32, b4 = lane & 16, b3 = lane & 8, b2 = lane & 4;
    const int myex = (b5 ? 8 : 0) + (b4 ? 4 : 0) + (b3 ? 2 : 0) + (b2 ? 1 : 0);
    const int per = (MLAT + NGW - 1) / NGW, r_lo = gw * per, r_hi = min(r_lo + per, MLAT);
    u32x2 nx[4]; f32x4 shv[4], scv[4]; int bcur = -1;
    if (r_lo < r_hi) { const u32x2* xr = (const u32x2*)(X1 + (size_t)r_lo * DM) + lane;
#pragma unroll
        for (int j = 0; j < 4; ++j) nx[j] = xr[64 * j]; }
    for (int row = r_lo; row < r_hi; ++row) {
        const int b = row >> 12;
        if (b != bcur) { bcur = b;
#pragma unroll
            for (int j = 0; j < 4; ++j) { const int c0 = 4 * lane + 256 * j; shv[j] = *(const f32x4*)(MOD + (size_t)b * 6144 + 3072 + c0); scv[j] = *(const f32x4*)(MOD + (size_t)b * 6144 + 4096 + c0) + 1.0f; } }
        f32x4 v[4]; float s = 0.f;
#pragma unroll
        for (int j = 0; j < 4; ++j) { v[j] = (f32x4){bf2f(nx[j].x & 0xffffu), bf2f(nx[j].x >> 16), bf2f(nx[j].y & 0xffffu), bf2f(nx[j].y >> 16)}; s += (v[j].x * v[j].x + v[j].y * v[j].y) + (v[j].z * v[j].z + v[j].w * v[j].w); }
        if (row + 1 < r_hi) { const u32x2* xr = (const u32x2*)(X1 + (size_t)(row + 1) * DM) + lane;
#pragma unroll
            for (int j = 0; j < 4; ++j) nx[j] = xr[64 * j]; }
        const float rs = 1.0f / sqrtf(wave_sum(s) * (1.0f / DM) + 1e-6f);
        unsigned* o4 = (unsigned*)(XN2 + (size_t)row * DM) + lane;
#pragma unroll
        for (int j = 0; j < 4; ++j) { v[j] = v[j] * rs * scv[j] + shv[j]; o4[64 * j] = pk4_fp8(v[j].x, v[j].y, v[j].z, v[j].w); }
        float lg[16];
#pragma unroll
        for (int e = 0; e < 16; ++e) { float a = 0.f;
#pragma unroll
            for (int j = 0; j < 4; ++j) { const f32x4 w = *(const LAS f32x4*)(wrT + e * 1024 + 4 * lane + 256 * j); a += (v[j].x * w.x + v[j].y * w.y) + (v[j].z * w.z + v[j].w * w.w); }
            lg[e] = a; if (e & 1) asm volatile("" ::: "memory"); }
        float t8[8], t4[4], t2[2], t1;
#pragma unroll
        for (int i = 0; i < 8; ++i) { const float snd = b5 ? lg[i] : lg[i + 8], kp = b5 ? lg[i + 8] : lg[i]; t8[i] = kp + __shfl_xor(snd, 32); }
#pragma unroll
        for (int i = 0; i < 4; ++i) { const float snd = b4 ? t8[i] : t8[i + 4], kp = b4 ? t8[i + 4] : t8[i]; t4[i] = kp + __shfl_xor(snd, 16); }
#pragma unroll
        for (int i = 0; i < 2; ++i) { const float snd = b3 ? t4[i] : t4[i + 2], kp = b3 ? t4[i + 2] : t4[i]; t2[i] = kp + __shfl_xor(snd, 8); }
        { const float snd = b2 ? t2[0] : t2[1], kp = b2 ? t2[1] : t2[0]; t1 = kp + __shfl_xor(snd, 4); }
        t1 += __shfl_xor(t1, 2); t1 += __shfl_xor(t1, 1);
        float mx = t1;
        mx = fmaxf(mx, __shfl_xor(mx, 4)); mx = fmaxf(mx, __shfl_xor(mx, 8)); mx = fmaxf(mx, __shfl_xor(mx, 16)); mx = fmaxf(mx, __shfl_xor(mx, 32));
        const float ex = expf(t1 - mx);
        float sum = ex;
        sum += __shfl_xor(sum, 4); sum += __shfl_xor(sum, 8); sum += __shfl_xor(sum, 16); sum += __shfl_xor(sum, 32);
        if ((lane & 3) == 0) AFF[(size_t)row * 16 + myex] = ex / sum;
    }
}

__device__ __forceinline__ void phase_topk(const Params& p, LAS unsigned char* lds) {
    const int tid = threadIdx.x, lane = tid & 63, wave = tid >> 6, G = gridDim.x;
    unsigned char* ws = p.ws;
    const float* AFF = (const float*)(ws + WS_AFF); int* SELIDX = (int*)(ws + WS_SELIDX); float* SELG = (float*)(ws + WS_SELG); int* SLOT = (int*)(ws + WS_SLOT);
    LAS unsigned* hist = (LAS unsigned*)lds;
    LAS unsigned* ctl = hist + 256;
    LAS unsigned* wtot = hist + 264;
    for (int it = blockIdx.x; it < NB * NEXP; it += G) {
        const int b = it >> 4, e = it & 15;
        unsigned v[8];
#pragma unroll
        for (int j = 0; j < 8; ++j) v[j] = __builtin_bit_cast(unsigned, AFF[((size_t)b * SEQ + tid * 8 + j) * 16 + e]);
        unsigned prefix = 0u, mask = 0u, need = CAP;
        for (int shift = 24; shift >= 0; shift -= 8) {
            __syncthreads();
            if (tid < 256) hist[tid] = 0u;
            __syncthreads();
#pragma unroll
            for (int j = 0; j < 8; ++j) if ((v[j] & mask) == prefix) atomicAdd((unsigned*)&hist[(v[j] >> shift) & 255u], 1u);
            __syncthreads();
            if (tid < 64) {
                unsigned cb[4], tot = 0u;
#pragma unroll
                for (int k = 0; k < 4; ++k) { cb[k] = hist[255 - 4 * lane - k]; tot += cb[k]; }
                unsigned inc = tot;
#pragma unroll
                for (int o = 1; o < 64; o <<= 1) { const unsigned a = __shfl_up(inc, o); if (lane >= o) inc += a; }
                unsigned cum = inc - tot;
#pragma unroll
                for (int k = 0; k < 4; ++k) { if (cum < need && need <= cum + cb[k]) { ctl[0] = (unsigned)(255 - 4 * lane - k); ctl[1] = need - cum; } cum += cb[k]; }
            }
            __syncthreads();
            prefix |= ctl[0] << shift; mask |= 255u << shift; need = ctl[1];
        }
        unsigned ngt = 0u, neq = 0u;
#pragma unroll
        for (int j = 0; j < 8; ++j) { ngt += (v[j] > prefix) ? 1u : 0u; neq += (v[j] == prefix) ? 1u : 0u; }
        unsigned sg = ngt, se = neq;
#pragma unroll
        for (int o = 1; o < 64; o <<= 1) { const unsigned a = __shfl_up(sg, o), c2 = __shfl_up(se, o); if (lane >= o) { sg += a; se += c2; } }
        __syncthreads();
        if (lane == 63) { wtot[wave] = sg; wtot[8 + wave] = se; }
        __syncthreads();
        unsigned og = sg - ngt, oe = se - neq, totg = 0u;
        for (int w = 0; w < 8; ++w) { const unsigned a = wtot[w], c2 = wtot[8 + w]; if (w < wave) { og += a; oe += c2; } totg += a; }
#pragma unroll
        for (int j = 0; j < 8; ++j) {
            const int tkn = tid * 8 + j; int slot = -1;
            if (v[j] > prefix) slot = (int)og++;
            else if (v[j] == prefix) { if (oe < need) slot = (int)(totg + oe); ++oe; }
            const int erow = b * CAP + slot;
            SLOT[((size_t)b * SEQ + tkn) * 16 + e] = (slot >= 0) ? erow : -1;
            if (slot >= 0) { SELIDX[e * EROWS + erow] = b * SEQ + tkn; SELG[e * EROWS + erow] = __builtin_bit_cast(float, v[j]); }
        }
    }
    __syncthreads();
    {
        LAS float* scr = (LAS float*)(lds + wave * TR_SCR);
        unsigned char* WGU = ws + WS_WGU; unsigned char* WD = ws + WS_WD;
        const int gw = blockIdx.x * NWAVES + wave, NGW = G * NWAVES;
        constexpr int I_G = 16 * 32, I_D = 32 * 16;
        for (int it = gw; it < 16 * (2 * I_G + I_D); it += NGW) {
            const int e = it / (2 * I_G + I_D); int r = it % (2 * I_G + I_D);
            if (r < 2 * I_G) { const int up = r / I_G; r %= I_G; const int kb = r / 32, nb = r % 32;
                const float* W = (up ? p.w_exp_up : p.w_exp_gate) + (size_t)e * 1024 * 2048;
                transpose_item_f8(W, 2048, 64 * kb, 64 * nb, WGU + (size_t)e * 4096 * 1024, 1024, [up](int n) { return 256 * (n >> 7) + 128 * up + (n & 127); }, scr, lane); }
            else { r -= 2 * I_G; const int kb = r / 16, nb = r % 16;
                transpose_item_f8(p.w_exp_down + (size_t)e * 2048 * 1024, 1024, 64 * kb, 64 * nb, WD + (size_t)e * 1024 * 2048, 2048, [](int n) { return n; }, scr, lane); }
        }
    }
}

__device__ __forceinline__ void phase_final(const Params& p, LAS unsigned char* lds, const bool dry) {
    const int tid = threadIdx.x, lane = tid & 63, wave = tid >> 6, G = gridDim.x;
    unsigned char* ws = p.ws;
    const float* MOD = (const float*)(ws + WS_MOD); const int* SLOT = (const int*)(ws + WS_SLOT); const bf16_t* YE = (const bf16_t*)(ws + WS_YE); const float* SELG = (const float*)(ws + WS_SELG);
    const int gw = blockIdx.x * NWAVES + wave, NGW = G * NWAVES;
    const int per = (MLAT + NGW - 1) / NGW, r_lo = gw * per, r_hi = min(r_lo + per, MLAT);
    if (r_lo >= r_hi) return;
    const bf16_t* X1 = (const bf16_t*)(ws + WS_X1);
    u32x2 nx[4]; f32x4 g2v[4], fnv[4]; int nslot = -1, bcur = -1; float ngate = 0.f;
    { const u32x2* xr = (const u32x2*)(X1 + (size_t)r_lo * DM) + lane;
#pragma unroll
      for (int j = 0; j < 4; ++j) { nx[j] = xr[64 * j]; fnv[j] = *(const f32x4*)(p.final_norm + 4 * lane + 256 * j); }
      if (lane < 16) { nslot = SLOT[(size_t)r_lo * 16 + lane]; if (nslot >= 0) ngate = SELG[lane * EROWS + nslot]; } }
    for (int row = r_lo; row < r_hi; ++row) {
        const int b = row >> 12;
        if (b != bcur) { bcur = b;
#pragma unroll
            for (int j = 0; j < 4; ++j) g2v[j] = *(const f32x4*)(MOD + (size_t)b * 6144 + 5120 + 4 * lane + 256 * j); }
        f32x4* xr = (f32x4*)(p.out + (size_t)row * DM) + lane;
        f32x4 v[4], mo[4];
#pragma unroll
        for (int j = 0; j < 4; ++j) { v[j] = (f32x4){bf2f(nx[j].x & 0xffffu), bf2f(nx[j].x >> 16), bf2f(nx[j].y & 0xffffu), bf2f(nx[j].y >> 16)}; mo[j] = (f32x4){0.f, 0.f, 0.f, 0.f}; }
        const int myslot = nslot; const float mygate = ngate;
        if (row + 1 < r_hi) { const u32x2* xn = (const u32x2*)(X1 + (size_t)(row + 1) * DM) + lane;
#pragma unroll
            for (int j = 0; j < 4; ++j) nx[j] = xn[64 * j];
            nslot = -1; ngate = 0.f;
            if (lane < 16) { nslot = SLOT[(size_t)(row + 1) * 16 + lane]; if (nslot >= 0) ngate = SELG[lane * EROWS + nslot]; } }
        unsigned long long live = __ballot(myslot >= 0);
        while (live) {
            const int e = __builtin_ctzll(live); live &= live - 1;
            const int sl = __shfl(myslot, e); const float gt = __shfl(mygate, e);
            const unsigned long long* yp = (const unsigned long long*)(YE + ((size_t)e * EROWS + sl) * DM) + lane;
#pragma unroll
            for (int j = 0; j < 4; ++j) { const unsigned long long w = yp[64 * j]; const unsigned lo = (unsigned)w, hi = (unsigned)(w >> 32);
                mo[j].x += gt * bf2f(lo & 0xffffu); mo[j].y += gt * bf2f(lo >> 16); mo[j].z += gt * bf2f(hi & 0xffffu); mo[j].w += gt * bf2f(hi >> 16); }
        }
        float s = 0.f;
#pragma unroll
        for (int j = 0; j < 4; ++j) { v[j] = v[j] + g2v[j] * mo[j]; s += (v[j].x * v[j].x + v[j].y * v[j].y) + (v[j].z * v[j].z + v[j].w * v[j].w); }
        const float rs = 1.0f / sqrtf(wave_sum(s) * (1.0f / DM) + 1e-6f);
#pragma unroll
        for (int j = 0; j < 4; ++j) { if (!dry) xr[64 * j] = v[j] * rs * fnv[j]; }
    }
}

#define XB_TMO      128
#define XB_XCNT(j)  (256  + 64 * (j))
#define XB_XSUB(j)  (1280 + 64 * (j))
#define XB_XGEN(j)  (2304 + 64 * (j))
#define XB_TOP      3328
#define XB_TOPGEN   3392
#define XCD_BAR_WORDS 3456
#define XB_SPIN_CAP (1u << 20)
__device__ __forceinline__ unsigned xb_ld(unsigned* p)              { return __hip_atomic_load(p, __ATOMIC_RELAXED, __HIP_MEMORY_SCOPE_AGENT); }
__device__ __forceinline__ unsigned xb_add(unsigned* p, unsigned v) { return __hip_atomic_fetch_add(p, v, __ATOMIC_RELAXED, __HIP_MEMORY_SCOPE_AGENT); }
__device__ __forceinline__ unsigned xb_xcc_id() { return (unsigned)__builtin_amdgcn_s_getreg((3 << 11) | 20) & 0xFu; }
#define XB_SPIN(cond, bar) do { unsigned _sp = 0; while (cond) { __builtin_amdgcn_s_sleep(1); \
    if ((++_sp & 255u) == 0u) { if (xb_ld(&(bar)[XB_TMO])) break; if (_sp > XB_SPIN_CAP) { atomicAdd(&(bar)[XB_TMO], 1u); break; } } } } while (0)
struct XcdBarrier { unsigned* bar; unsigned x; volatile LAS unsigned* st; };
__device__ __forceinline__ XcdBarrier xcd_barrier_post(unsigned* bar, volatile LAS unsigned* st) {
    XcdBarrier b; b.bar = bar; b.x = xb_xcc_id(); b.st = st;
    if (threadIdx.x == 0) (void)xb_add(&bar[XB_XCNT(b.x)], 1u);
    return b;
}
__device__ __forceinline__ void xcd_barrier_complete(unsigned* bar, unsigned x, unsigned& nloc, unsigned& nx) {
    const unsigned G = gridDim.x * gridDim.y * gridDim.z;
    unsigned sum, cnt, mine, sp = 0u;
    for (;;) {
        sum = 0u; cnt = 0u; mine = 0u;
#pragma unroll
        for (unsigned j = 0; j < 16; ++j) { const unsigned c = xb_ld(&bar[XB_XCNT(j)]); sum += c; cnt += (c > 0u) ? 1u : 0u; mine = (j == x) ? c : mine; }
        if (sum == G) break;
        __builtin_amdgcn_s_sleep(1);
        if ((++sp & 255u) == 0u) { if (xb_ld(&bar[XB_TMO])) break; if (sp > XB_SPIN_CAP) { atomicAdd(&bar[XB_TMO], 1u); break; } }
    }
    nloc = mine > 0u ? mine : 1u; nx = cnt > 0u ? cnt : 1u;
}
__device__ __forceinline__ void xcd_barrier(const XcdBarrier& b) {
    asm volatile("s_waitcnt vmcnt(0)" ::: "memory");
    __syncthreads();
    if (threadIdx.x == 0) {
        unsigned* bar = b.bar;
        __builtin_amdgcn_s_waitcnt(0);
        unsigned nloc = b.st[0], nx = b.st[1];
        if (nloc == 0u) { xcd_barrier_complete(bar, b.x, nloc, nx); b.st[0] = nloc; b.st[1] = nx; }
        const unsigned old = xb_add(&bar[XB_XSUB(b.x)], 1u);
        const unsigned gen = old / nloc;
        if (old + 1u == (gen + 1u) * nloc) {
            __builtin_amdgcn_fence(__ATOMIC_RELEASE, "agent");
            asm volatile("s_waitcnt vmcnt(0)" ::: "memory");
            const unsigned og = xb_add(&bar[XB_TOP], 1u);
            const unsigned tg = og / nx;
            if (og + 1u == (tg + 1u) * nx) xb_add(&bar[XB_TOPGEN], 1u);
            else XB_SPIN(xb_ld(&bar[XB_TOPGEN]) == tg, bar);
            __builtin_amdgcn_fence(__ATOMIC_ACQUIRE, "agent");
            xb_add(&bar[XB_XGEN(b.x)], 1u);
            asm volatile("s_waitcnt vmcnt(0)" ::: "memory");
        } else {
            XB_SPIN(xb_ld(&bar[XB_XGEN(b.x)]) == gen, bar);
            __builtin_amdgcn_fence(__ATOMIC_ACQUIRE, "agent");
            asm volatile("s_waitcnt vmcnt(0)" ::: "memory");
        }
    }
    __syncthreads();
}

constexpr int NPHASE = 12;
__global__ void __launch_bounds__(NTHREADS, 2) mk_fwd(Params p) {
    extern __shared__ __attribute__((aligned(16))) unsigned char lds_raw[];
    LAS unsigned char* lds = (LAS unsigned char*)lds_raw;
    cg::grid_group grid = cg::this_grid();
    unsigned char* ws = p.ws;
    const int G = gridDim.x, cblk = blockIdx.x;
#ifndef PH_MASK
#define PH_MASK 0xfff
#endif
#define IN(k) (((PH_MASK >> (k)) & 1) && p.ph_lo <= (k) && (k) < p.ph_hi)
    { volatile LAS unsigned* st0 = (volatile LAS unsigned*)(lds + LDS_BYTES - 256); if (threadIdx.x < 64) st0[threadIdx.x] = 0u; }
    __syncthreads();
    XcdBarrier xbar = xcd_barrier_post((unsigned*)(ws + WS_CTL) + 4096, (volatile LAS unsigned*)(lds + LDS_BYTES - 256));
    if (p.ph_lo < 0) grid.sync();
#define SEAM(k) do { if (IN(k) && IN((k) + 1)) xcd_barrier(xbar); } while (0)
    if (IN(0)) phase_prep(p, lds);
    SEAM(0);
    if (IN(1)) phase_norm1(p, lds);
    SEAM(1);
    if (IN(2)) {
        InprojSched S{(const bf16_t*)(ws + WS_XN), (const bf16_t*)(ws + WS_WINT), G, cblk, 1024, 1024, 1024};
        EpiInproj<false> E{(bf16_t*)(ws + WS_Z), (bf16_t*)(ws + WS_ZC), (const float*)(ws + WS_BINZ), (const float*)(ws + WS_ROPE)};
        if (p.probe & 4) { EpiInproj<true> E2{(bf16_t*)(ws + WS_Z), (bf16_t*)(ws + WS_ZC), (const float*)(ws + WS_BINZ), (const float*)(ws + WS_ROPE)}; pg8::gemm_phase<EpiInproj<true>, InprojSched>(lds, S, E2); xcd_barrier(xbar); }
        if (p.probe & 32768) { pg8::gemm_phase<EpiInproj<false>, InprojSched>(lds, S, E); xcd_barrier(xbar); }
        pg8::gemm_phase<EpiInproj<false>, InprojSched>(lds, S, E);
    }
    SEAM(2);
    if (IN(3)) { if (p.probe & 8) { phase_rnn(p, lds, true); __syncthreads(); } phase_rnn(p, lds, false); }
    if (IN(3) && IN(4)) __syncthreads();
    if (IN(4)) { if (p.probe & 16) { phase_attn(p, lds, true); __syncthreads(); } phase_attn(p, lds, false); }
    SEAM(4);
    if (IN(5)) {
        MixSched S{(const bf16_t*)(ws + WS_Z), (const bf16_t*)(ws + WS_WMIX), G, cblk, LDZ, 2048, 2048};
        EpiMix E{(bf16_t*)(ws + WS_Z)};
        pg8::gemm_phase<EpiMix, MixSched>(lds, S, E);
    }
    SEAM(5);
    if (IN(6)) {
        WoutSched S{(const bf16_t*)(ws + WS_Z), (const bf16_t*)(ws + WS_WOUT), G, cblk, LDZ, 1024, 1024};
        EpiWout E{p.x, (bf16_t*)(ws + WS_X1), (const float*)(ws + WS_MOD)};
        pg8::gemm_phase<EpiWout, WoutSched>(lds, S, E);
    }
    SEAM(6);
    if (IN(7)) phase_norm2(p, lds);
    SEAM(7);
    if (IN(8)) phase_topk(p, lds);
    SEAM(8);
    if (IN(9)) {
        Moe1Sched S{ws + WS_XN2, ws + WS_WGU, (const int*)(ws + WS_SELIDX), G, cblk, 1024, 1024, 1024};
        EpiMoe1 E{ws + WS_HID};
        pg8::gemm_phase<EpiMoe1, Moe1Sched, true>(lds, S, E);
    }
    SEAM(9);
    if (IN(10)) {
        Moe2Sched S{ws + WS_HID, ws + WS_WD, G, cblk, 2048, 2048, 2048};
        EpiMoe2 E{(bf16_t*)(ws + WS_YE), (const float*)(ws + WS_SELG)};
        pg8::gemm_phase<EpiMoe2, Moe2Sched, true>(lds, S, E);
    }
    SEAM(10);
    if (IN(11)) { if (p.probe & 2048) { phase_final(p, lds, true); __syncthreads(); } phase_final(p, lds, false); }
#undef IN
#undef SEAM
}

#ifndef MK_SINGLE
#define MK_SINGLE 1
#endif
extern "C" void kernel_launch(void* const* d_in, const int* in_sizes, int n_in, void* d_out, int out_size, void* d_ws, size_t ws_size, hipStream_t stream) {
    static int grid = 0;
    if (grid == 0) {
        int dev = 0, cus = 0, per_cu = 0;
        if (n_in != 24 || out_size != MLAT * DM || ws_size < WS_END) { fprintf(stderr, "kernel_launch: unexpected problem (n_in %d, out %d, ws %zu < %zu)\n", n_in, out_size, ws_size, (size_t)WS_END); grid = -1; return; }
        if (hipGetDevice(&dev) != hipSuccess || hipDeviceGetAttribute(&cus, hipDeviceAttributeMultiprocessorCount, dev) != hipSuccess) { grid = -1; return; }
        if (hipFuncSetAttribute((const void*)mk_fwd, hipFuncAttributeMaxDynamicSharedMemorySize, LDS_BYTES) != hipSuccess) { fprintf(stderr, "kernel_launch: hipFuncSetAttribute failed\n"); grid = -1; return; }
        if (hipOccupancyMaxActiveBlocksPerMultiprocessor(&per_cu, (const void*)mk_fwd, NTHREADS, LDS_BYTES) != hipSuccess || per_cu < 1) { fprintf(stderr, "kernel_launch: occupancy query says %d\n", per_cu); grid = -1; return; }
        grid = cus;
    }
    if (grid < 0) return;
    (void)hipMemsetAsync((char*)d_ws + WS_CTL, 0, 1 * MiB, stream);
    Params p{};
    const float** pp = (const float**)&p;
    for (int i = 0; i < 24; ++i) pp[i] = (const float*)d_in[i];
#ifndef PROBE_MASK
#define PROBE_MASK 0
#endif
    p.out = (float*)d_out; p.ws = (unsigned char*)d_ws; p.probe = PROBE_MASK;
#if MK_SINGLE
    p.ph_lo = 0; p.ph_hi = NPHASE;
    void* args[] = {&p};
    hipError_t e = hipLaunchCooperativeKernel((const void*)mk_fwd, dim3(grid), dim3(NTHREADS), args, LDS_BYTES, stream);
    if (e != hipSuccess) fprintf(stderr, "kernel_launch: cooperative launch failed: %s (grid %d)\n", hipGetErrorString(e), grid);
#else
#ifndef REP_MASK
#define REP_MASK 0
#endif
    for (int ph = 0; ph < NPHASE; ++ph) {
        p.ph_lo = ph; p.ph_hi = ph + 1;
        for (int rep = 0; rep < 1 + ((REP_MASK >> ph) & 1); ++rep) hipLaunchKernelGGL(mk_fwd, dim3(grid), dim3(NTHREADS), LDS_BYTES, stream, p);
    }
#endif
}
```

```cpp
#include <hip/hip_runtime.h>
#include <hip/hip_cooperative_groups.h>
#include <cstdio>
#include <cstdint>
namespace cg = cooperative_groups;

#define LAS __attribute__((address_space(3)))
typedef unsigned short bf16_t;
typedef short bf16x8 __attribute__((ext_vector_type(8)));
typedef float f32x4 __attribute__((ext_vector_type(4)));
typedef float f32x2 __attribute__((ext_vector_type(2)));
typedef unsigned u32x4 __attribute__((ext_vector_type(4)));
typedef unsigned u32x2 __attribute__((ext_vector_type(2)));

constexpr int NB = 8, SEQ = 4096, DM = 1024, CTX = 256;
constexpr int MLAT = NB * SEQ, MCTX = NB * CTX;
constexpr int NIN = 7168, NEXP = 16, DEXP = 2048, CAP = 512, EROWS = NB * CAP;
constexpr int LDZ = 7168, ZC_YG = 0, ZC_Q = 1024, ZC_XR = 2048, ZC_K = 3072, ZC_V = 4096, ZC_GR = 5120, ZC_GN = 6144;
constexpr int LDC = 3072, CC_XR = 0, CC_K = 1024, CC_V = 2048;
constexpr float LOG2E = 1.4426950408889634f;
constexpr float QSCALE = 0.125f * LOG2E;

constexpr size_t MiB = 1u << 20;
constexpr size_t WS_CTL = 0;
constexpr size_t WS_MOD = 1 * MiB;
constexpr size_t WS_MODP = 2 * MiB;
constexpr size_t WS_ROPE = 9 * MiB;
constexpr size_t WS_BINZ = 9 * MiB + 65536;
constexpr size_t WS_AFF = 10 * MiB;
constexpr size_t WS_SELIDX = 12 * MiB;
constexpr size_t WS_SELG = 12 * MiB + 262144;
constexpr size_t WS_SLOT = 13 * MiB;
constexpr size_t WS_WINT = 16 * MiB;
constexpr size_t WS_WMIX = 30 * MiB;
constexpr size_t WS_WOUT = 34 * MiB;
constexpr size_t WS_ZC = 36 * MiB;
constexpr size_t WS_XN = 48 * MiB;
constexpr size_t WS_Z = 116 * MiB;
constexpr size_t WS_WGU = 116 * MiB;
constexpr size_t WS_WD = 180 * MiB;
constexpr size_t WS_HID = 212 * MiB;
constexpr size_t WS_YE = 340 * MiB;
constexpr size_t WS_X1 = 48 * MiB;
constexpr size_t WS_XN2 = 468 * MiB;
constexpr size_t WS_END = 564 * MiB;

constexpr int NTHREADS = 512, NWAVES = 8;
constexpr int LDS_BYTES = 147456;

__device__ __forceinline__ unsigned f2bf(float f) { unsigned u = __builtin_bit_cast(unsigned, f); return (u + 0x7fffu + ((u >> 16) & 1u)) >> 16; }
__device__ __forceinline__ float bf2f(unsigned h) { return __builtin_bit_cast(float, h << 16); }
__device__ __forceinline__ unsigned pk2(float lo, float hi) { return f2bf(lo) | (f2bf(hi) << 16); }
__device__ __forceinline__ unsigned cvt_pk_bf16(float lo, float hi) { unsigned r; asm volatile("v_cvt_pk_bf16_f32 %0, %1, %2" : "=v"(r) : "v"(lo), "v"(hi)); return r; }
__device__ __forceinline__ float wave_sum(float v) {
#pragma unroll
    for (int o = 1; o < 64; o <<= 1) v += __shfl_xor(v, o);
    return v;
}
__device__ __forceinline__ float sigmoidf_(float x) { return __builtin_amdgcn_rcpf(1.0f + __builtin_amdgcn_exp2f(-x * LOG2E)); }
__device__ __forceinline__ float gelu_tanh(float x) { const float u = 0.7978845608028654f * (x + 0.044715f * x * x * x); return x * __builtin_amdgcn_rcpf(1.0f + __builtin_amdgcn_exp2f(-2.0f * LOG2E * u)); }
#define LDS_WAIT() asm volatile("s_waitcnt lgkmcnt(0)" ::: "memory")

namespace pg8 {
constexpr int BM = 256, BK = 64, HALF = 128, HTB = HALF * BK * 2, STAGE_BYTES = 8 * HTB, NXCD = 8, WGM = 8;
__host__ __device__ __forceinline__ int swz_f(int r) { const int u = (r >> 1) & 7; return (u & 3) | ((((u >> 1) ^ (u >> 2)) & 1) << 2); }
__host__ __device__ __forceinline__ int lds_byte(int r, int c) { return r * 128 + ((((c >> 3) ^ swz_f(r)) << 4) | ((c & 7) * 2)); }
__host__ __device__ __forceinline__ void stage_rc(int b, int& R, int& C) { R = b >> 7; C = (((b >> 4) & 7) ^ swz_f(R)) * 8; }
__host__ __device__ __forceinline__ int perm32(int rho) { const int n = rho >> 4, i = rho & 15; return 8 * (i >> 2) + 4 * n + (i & 3); }

struct Unit { int pm, pb, x0, x1; };

__device__ __forceinline__ void tile_of(int L, int nM, int nN, int& pm, int& pn) {
    const int nwg = nM * nN; int wgid = L;
    { const int q = nwg / NXCD, r = nwg % NXCD, xcd = wgid % NXCD, off = wgid / NXCD; wgid = (xcd < r ? xcd * (q + 1) : r * (q + 1) + (xcd - r) * q) + off; }
    const int nig = WGM * nN, gid = wgid / nig, fm = gid * WGM, gsz = (nM - fm) < WGM ? (nM - fm) : WGM;
    pm = fm + ((wgid % nig) % gsz); pn = (wgid % nig) / gsz;
}

typedef int i32x8 __attribute__((ext_vector_type(8)));
constexpr int F8_SCALE_W = 0x79797979, F8_SCALE_X = 0x7f7f7f7f;
template <class Epi, class Sched, bool F8 = false>
__device__ __forceinline__ void gemm_phase(LAS unsigned char* lds, const Sched& S, const Epi& E) {
    const int tid = threadIdx.x, wid = __builtin_amdgcn_readfirstlane(tid >> 6), lane = tid & 63, wr = wid >> 2, wc = wid & 3, fr = lane & 15, fq = lane >> 4;
    constexpr int ESZ = F8 ? 1 : 2;
    const int K = S.K, nt = K * ESZ / (BK * 2);
    int Rl[2], Cl[2];
    unsigned voffA[2][2], voffB[2];
#pragma unroll
    for (int i = 0; i < 2; ++i) { stage_rc(tid * 16 + i * 8192, Rl[i], Cl[i]); const int Rb = Epi::PERM ? ((Rl[i] & ~31) + perm32(Rl[i] & 31)) : Rl[i];
        voffB[i] = (unsigned)(Rb * S.ldb * ESZ + Cl[i] * 2); }
    const size_t kstep = (size_t)(BK * 2);
    const size_t hstepB = (size_t)HALF * S.ldb * ESZ, hstepA = (size_t)HALF * S.lda * ESZ;
    const unsigned ldsw = (unsigned)wid * 1024u;
    const int aof0 = F8 ? lds_byte(wr * 64 + fr, fq * 16) : lds_byte(wr * 64 + fr, fq * 8), aof1 = F8 ? lds_byte(wr * 64 + fr, fq * 16 + 8) : lds_byte(wr * 64 + fr, 32 + fq * 8);
    const int bof0 = F8 ? lds_byte(wc * 32 + fr, fq * 16) : lds_byte(wc * 32 + fr, fq * 8), bof1 = F8 ? lds_byte(wc * 32 + fr, fq * 16 + 8) : lds_byte(wc * 32 + fr, 32 + fq * 8);
#define PG8_SA(b, h) (((b) * 2 + (h)) * HTB)
#define PG8_SB(b, h) ((4 + (b) * 2 + (h)) * HTB)
#define PG8_STAGEB(bufoff, gbase) do { _Pragma("unroll") for (int _i = 0; _i < 2; ++_i) \
        __builtin_amdgcn_global_load_lds((const unsigned*)((const char*)(gbase) + voffB[_i]), (LAS unsigned*)(lds + (bufoff) + ldsw + _i * 8192), 16, 0, 0); } while (0)
#define PG8_STAGEA(bufoff, gbase, h, vo) do { _Pragma("unroll") for (int _i = 0; _i < 2; ++_i) { \
        if constexpr (Sched::GATHER) __builtin_amdgcn_global_load_lds((const unsigned*)((const char*)(gbase) + (vo)[h][_i]), (LAS unsigned*)(lds + (bufoff) + ldsw + _i * 8192), 16, 0, 0); \
        else __builtin_amdgcn_global_load_lds((const unsigned*)((const char*)(gbase) + (h) * hstepA + (vo)[0][_i]), (LAS unsigned*)(lds + (bufoff) + ldsw + _i * 8192), 16, 0, 0); } } while (0)
#define PG8_LD8(d, alo, ahi) do { const u32x4 lo_ = *(const LAS u32x4*)(alo), hi_ = *(const LAS u32x4*)(ahi); d = (i32x8){(int)lo_.x, (int)lo_.y, (int)lo_.z, (int)lo_.w, (int)hi_.x, (int)hi_.y, (int)hi_.z, (int)hi_.w}; } while (0)
#define PG8_LDA(dst, b, h) do { if constexpr (F8) { _Pragma("unroll") for (int m = 0; m < 4; ++m) PG8_LD8(dst##8[m], lds + PG8_SA(b, h) + aof0 + m * 2048, lds + PG8_SA(b, h) + aof1 + m * 2048); } \
        else { _Pragma("unroll") for (int m = 0; m < 4; ++m) _Pragma("unroll") for (int k = 0; k < 2; ++k) dst[m][k] = *(const LAS bf16x8*)(lds + PG8_SA(b, h) + (k ? aof1 : aof0) + m * 2048); } } while (0)
#define PG8_LDB(dst, b, h) do { if constexpr (F8) { _Pragma("unroll") for (int n = 0; n < 2; ++n) PG8_LD8(dst##8[n], lds + PG8_SB(b, h) + bof0 + n * 2048, lds + PG8_SB(b, h) + bof1 + n * 2048); } \
        else { _Pragma("unroll") for (int n = 0; n < 2; ++n) _Pragma("unroll") for (int k = 0; k < 2; ++k) dst[n][k] = *(const LAS bf16x8*)(lds + PG8_SB(b, h) + (k ? bof1 : bof0) + n * 2048); } } while (0)
#define PG8_MMA(ai, bj, At, Bt) do { __builtin_amdgcn_s_setprio(1); _Pragma("unroll") for (int m = 0; m < 4; ++m) _Pragma("unroll") for (int n = 0; n < 2; ++n) { \
        if constexpr (F8) acc[ai][bj][m][n] = __builtin_amdgcn_mfma_scale_f32_16x16x128_f8f6f4(Bt##8[n], At##8[m], acc[ai][bj][m][n], 0, 0, 0, F8_SCALE_W, 0, F8_SCALE_X); \
        else { _Pragma("unroll") for (int k = 0; k < 2; ++k) acc[ai][bj][m][n] = __builtin_amdgcn_mfma_f32_16x16x32_bf16(Bt[n][k], At[m][k], acc[ai][bj][m][n], 0, 0, 0); } } \
        __builtin_amdgcn_s_setprio(0); } while (0)
#define PG8_WAIT_V(n) asm volatile("s_waitcnt vmcnt(" #n ")" ::: "memory")
#define PG8_WAIT_L(n) asm volatile("s_waitcnt lgkmcnt(" #n ")" ::: "memory")
#define PG8_BAR __builtin_amdgcn_s_barrier()
#define PG8_SCHED __builtin_amdgcn_sched_barrier(0)
#define PG8_SETVO(vo, u) do { _Pragma("unroll") for (int _h = 0; _h < 2; ++_h) _Pragma("unroll") for (int _i = 0; _i < 2; ++_i) { \
        if constexpr (Sched::GATHER) (vo)[_h][_i] = (unsigned)(S.row_of(u, _h * HALF + Rl[_i]) * S.lda * ESZ + Cl[_i] * 2); \
        else (vo)[_h][_i] = (unsigned)((_h * HALF + Rl[_i]) * S.lda * ESZ + Cl[_i] * 2); } } while (0)
#define PG8_TRIP_BODY \
            const bool last = (t == nt - 2); \
            const char* a1 = cA + (size_t)(t + 1) * kstep; \
            const char* a2 = last ? nA : cA + (size_t)(t + 2) * kstep; const char* b2 = last ? nB : cB + (size_t)(t + 2) * kstep; \
            const char* a3 = a2 + kstep; const char* b3 = b2 + kstep; \
            PG8_LDB(B0, 0, 0); PG8_LDB(B1, 0, 1); PG8_SCHED; PG8_LDA(At, 0, 0); PG8_STAGEA(PG8_SA(1, 1), a1, 1, voffA); \
            if (last && has_next) { PG8_SETVO(voffA, nxt); asm volatile("" : "+v"(voffA[0][0]), "+v"(voffA[0][1]), "+v"(voffA[1][0]), "+v"(voffA[1][1])); } \
            PG8_WAIT_V(8); PG8_WAIT_L(0); PG8_BAR; PG8_MMA(0, 0, At, B0); PG8_MMA(0, 1, At, B1); PG8_BAR; PG8_SCHED; \
            PG8_LDA(At, 0, 1); PG8_STAGEB(PG8_SB(0, 0), b2); PG8_STAGEB(PG8_SB(0, 1), b2 + hstepB); PG8_STAGEA(PG8_SA(0, 0), a2, 0, voffA); \
            PG8_WAIT_V(8); PG8_WAIT_L(0); PG8_BAR; PG8_MMA(1, 0, At, B0); PG8_MMA(1, 1, At, B1); PG8_BAR; PG8_SCHED; \
            PG8_LDB(B0, 1, 0); PG8_LDB(B1, 1, 1); PG8_SCHED; PG8_LDA(At, 1, 0); PG8_STAGEA(PG8_SA(0, 1), a2, 1, voffA); \
            PG8_WAIT_V(8); PG8_WAIT_L(0); PG8_BAR; PG8_MMA(0, 0, At, B0); PG8_MMA(0, 1, At, B1); PG8_BAR; PG8_SCHED; \
            PG8_LDA(At, 1, 1); PG8_STAGEB(PG8_SB(1, 0), b3); PG8_STAGEB(PG8_SB(1, 1), b3 + hstepB); PG8_STAGEA(PG8_SA(1, 0), a3, 0, voffA); \
            PG8_WAIT_V(8); PG8_WAIT_L(0); PG8_BAR; PG8_MMA(1, 0, At, B0); PG8_MMA(1, 1, At, B1); PG8_BAR; PG8_SCHED; \

    Unit cur, nxt; int ui = 0;
    if (!S.next(0, cur)) return;
    f32x4 acc[2][2][4][2];
#pragma unroll
    for (int a = 0; a < 2; ++a)
#pragma unroll
        for (int b = 0; b < 2; ++b)
#pragma unroll
            for (int m = 0; m < 4; ++m)
#pragma unroll
                for (int n = 0; n < 2; ++n) acc[a][b][m][n] = (f32x4){0.f, 0.f, 0.f, 0.f};
    bf16x8 At[4][2], B0[2][2], B1[2][2];
    i32x8 At8[4], B08[2], B18[2];
    const char* cA = S.a_ptr(cur); const char* cB = S.b_ptr(cur);
    PG8_SETVO(voffA, cur);
    PG8_STAGEB(PG8_SB(0, 0), cB); PG8_STAGEB(PG8_SB(0, 1), cB + hstepB); PG8_STAGEA(PG8_SA(0, 0), cA, 0, voffA); PG8_STAGEA(PG8_SA(0, 1), cA, 1, voffA);
    if (wr == 1) PG8_BAR;
    PG8_WAIT_V(2); PG8_BAR;
    PG8_STAGEB(PG8_SB(1, 0), cB + kstep); PG8_STAGEA(PG8_SA(1, 0), cA + kstep, 0, voffA); PG8_STAGEB(PG8_SB(1, 1), cB + hstepB + kstep);
    PG8_WAIT_V(6); PG8_BAR;
    for (;;) {
        const bool has_next = S.next(ui + 1, nxt);
        const char* nA = has_next ? S.a_ptr(nxt) : cA; const char* nB = has_next ? S.b_ptr(nxt) : cB;
        if constexpr (Epi::MID) {
#pragma unroll 1
            for (int t = 0; t < (nt >> 1); t += 2) { PG8_TRIP_BODY }
            PG8_SCHED; E.mid(acc, cur, wr, wc, fr, fq); PG8_SCHED;
#pragma unroll 1
            for (int t = (nt >> 1); t < nt; t += 2) { PG8_TRIP_BODY }
        } else {
#pragma unroll 1
            for (int t = 0; t < nt; t += 2) { PG8_TRIP_BODY }
        }
        if (wr == 0) PG8_BAR;
        E(acc, cur, wr, wc, fr, fq);
        if (!has_next) break;
#pragma unroll
        for (int a = 0; a < 2; ++a)
#pragma unroll
            for (int b = 0; b < 2; ++b)
#pragma unroll
                for (int m = 0; m < 4; ++m)
#pragma unroll
                    for (int n = 0; n < 2; ++n) acc[a][b][m][n] = (f32x4){0.f, 0.f, 0.f, 0.f};
        cur = nxt; cA = nA; cB = nB; ++ui;
        if (wr == 1) PG8_BAR;
    }
    PG8_WAIT_V(0);
    PG8_BAR;
#undef PG8_SA
#undef PG8_SB
#undef PG8_STAGEA
#undef PG8_STAGEB
#undef PG8_LDA
#undef PG8_LDB
#undef PG8_MMA
#undef PG8_LD8
#undef PG8_WAIT_V
#undef PG8_WAIT_L
#undef PG8_BAR
#undef PG8_SCHED
#undef PG8_SETVO
#undef PG8_TRIP_BODY
}
}

struct InprojSched {
    static constexpr bool GATHER = false;
    const bf16_t* XN; const bf16_t* W; int G, c; int lda, ldb, K;
    __device__ __forceinline__ bool next(int i, pg8::Unit& u) const {
        const int L = i * G + c;
        if (L < 128 * 28) { int pm, pn; pg8::tile_of(L, 128, 28, pm, pn); u.pm = pm; u.pb = pn; u.x0 = 0; u.x1 = 0; return true; }
        const int idx = L - 128 * 28; if (idx >= 96) return false;
        u.pm = 128 + (idx & 7); u.pb = 8 + (idx >> 3); u.x0 = 1; u.x1 = 0; return true;
    }
    __device__ __forceinline__ const char* a_ptr(const pg8::Unit& u) const { return (const char*)XN + (size_t)u.pm * 256 * 1024 * 2; }
    __device__ __forceinline__ const char* b_ptr(const pg8::Unit& u) const { return (const char*)W + (size_t)u.pb * 256 * 1024 * 2; }
    __device__ __forceinline__ int row_of(const pg8::Unit&, int r) const { return r; }
};
struct MixSched {
    static constexpr bool GATHER = false;
    const bf16_t* Z; const bf16_t* W; int G, c; int lda, ldb, K;
    __device__ __forceinline__ bool next(int i, pg8::Unit& u) const {
        const int L = i * G + c; if (L >= 128 * 4) return false;
        int pm, pn; pg8::tile_of(L, 128, 4, pm, pn); u.pm = pm; u.pb = pn; u.x0 = pn; u.x1 = 0; return true;
    }
    __device__ __forceinline__ const char* a_ptr(const pg8::Unit& u) const { return (const char*)Z + (size_t)u.pm * 256 * LDZ * 2; }
    __device__ __forceinline__ const char* b_ptr(const pg8::Unit& u) const { return (const char*)W + (size_t)u.pb * 256 * 2048 * 2; }
    __device__ __forceinline__ int row_of(const pg8::Unit&, int r) const { return r; }
};
struct WoutSched {
    static constexpr bool GATHER = false;
    const bf16_t* Z; const bf16_t* W; int G, c; int lda, ldb, K;
    __device__ __forceinline__ bool next(int i, pg8::Unit& u) const {
        const int L = i * G + c; if (L >= 128 * 4) return false;
        int pm, pn; pg8::tile_of(L, 128, 4, pm, pn); u.pm = pm; u.pb = pn; u.x0 = pn; u.x1 = 0; return true;
    }
    __device__ __forceinline__ const char* a_ptr(const pg8::Unit& u) const { return (const char*)Z + ((size_t)u.pm * 256 * LDZ + ZC_XR) * 2; }
    __device__ __forceinline__ const char* b_ptr(const pg8::Unit& u) const { return (const char*)W + (size_t)u.pb * 256 * 1024 * 2; }
    __device__ __forceinline__ int row_of(const pg8::Unit&, int r) const { return r; }
};
struct Moe1Sched {
    static constexpr bool GATHER = true;
    const unsigned char* XN2; const unsigned char* W; const int* selidx; int G, c; int lda, ldb, K;
    __device__ __forceinline__ bool next(int i, pg8::Unit& u) const {
        const int L = i * G + c; if (L >= 16 * 256) return false;
        const int e = L >> 8, w = L & 255, x = w & 7, j = w >> 3;
        const int mt = (x & 3) * 4 + (j & 3), nt = (x >> 2) * 8 + (j >> 2);
        u.pm = e * 16 + mt; u.pb = e * 16 + nt; u.x0 = nt; u.x1 = e; return true;
    }
    __device__ __forceinline__ const char* a_ptr(const pg8::Unit&) const { return (const char*)XN2; }
    __device__ __forceinline__ const char* b_ptr(const pg8::Unit& u) const { return (const char*)W + (size_t)u.pb * 256 * 1024; }
    __device__ __forceinline__ int row_of(const pg8::Unit& u, int r) const { return selidx[u.pm * 256 + r]; }
};
struct Moe2Sched {
    static constexpr bool GATHER = true;
    const unsigned char* HID; const unsigned char* W; int G, c; int lda, ldb, K;
    __device__ __forceinline__ bool next(int i, pg8::Unit& u) const {
        const int L = i * G + c; if (L >= 16 * 64) return false;
        const int x = L & 7, j = (L >> 3) & 31, e = ((L >> 8) << 2) + (j >> 3), r = j & 7, mt = 2 * x + (r >> 2), pn = r & 3;
        u.pm = e * 16 + mt; u.pb = e * 4 + pn; u.x0 = pn; u.x1 = e; return true;
    }
    __device__ __forceinline__ const char* a_ptr(const pg8::Unit& u) const { return (const char*)HID + (size_t)u.pm * 256 * 2048; }
    __device__ __forceinline__ const char* b_ptr(const pg8::Unit& u) const { return (const char*)W + (size_t)u.pb * 256 * 2048; }
    __device__ __forceinline__ int row_of(const pg8::Unit&, int r) const { return r; }
};

typedef const f32x4 (&AccRef)[2][2][4][2];
template <bool PLAIN = false> struct EpiInproj {
    static constexpr bool PERM = true, MID = false;
    bf16_t* Z; bf16_t* ZC; const float* binz; const float* rope;
    __device__ __forceinline__ void operator()(AccRef acc, const pg8::Unit& u, int wr, int wc, int fr, int fq) const {
        const bool isctx = u.x0 != 0;
        const int seg = PLAIN ? 2 : (u.pb >> 2), colt = u.pb * 256, cl = wc * 32 + 8 * fq;
        f32x4 bv[2][2];
#pragma unroll
        for (int bj = 0; bj < 2; ++bj)
#pragma unroll
            for (int n = 0; n < 2; ++n) bv[bj][n] = *(const f32x4*)(binz + colt + bj * 128 + cl + 4 * n);
        bf16_t* base; int ld, row0;
        if (!isctx) { base = Z + colt; ld = LDZ; row0 = u.pm * 256; } else { base = ZC + (colt - 2048); ld = LDC; row0 = (u.pm - 128) * 256; }
        const bool dorope = (seg == 1) || (seg == 3 && !isctx);
        const float qs = (seg == 1) ? QSCALE : 1.0f;
#pragma unroll
        for (int ai = 0; ai < 2; ++ai)
#pragma unroll
            for (int m = 0; m < 4; ++m) {
                const int r = row0 + ai * 128 + wr * 64 + m * 16 + fr;
                bf16_t* rowp = base + (size_t)r * ld + cl;
                f32x4 cs0 = (f32x4){1.f, 0.f, 1.f, 0.f}, cs1 = cs0;
                if (dorope) { const int t = r & 4095; const int pos = (wc & 1) ? (t & 63) : (t >> 6); const float* cp = rope + (pos * 16 + 4 * fq) * 2; cs0 = *(const f32x4*)cp; cs1 = *(const f32x4*)(cp + 4); }
#pragma unroll
                for (int bj = 0; bj < 2; ++bj) {
                    f32x4 v0 = acc[ai][bj][m][0] + bv[bj][0], v1 = acc[ai][bj][m][1] + bv[bj][1];
                    if (seg == 0) {
#pragma unroll
                        for (int j = 0; j < 4; ++j) { v0[j] = gelu_tanh(v0[j]); v1[j] = gelu_tanh(v1[j]); }
                    } else if (seg >= 5) {
                        unsigned q[8];
#pragma unroll
                        for (int j = 0; j < 4; ++j) { q[j] = (unsigned)__builtin_rintf(255.0f * sigmoidf_(v0[j])); q[4 + j] = (unsigned)__builtin_rintf(255.0f * sigmoidf_(v1[j])); }
                        u32x2 w8; w8.x = q[0] | (q[1] << 8) | (q[2] << 16) | (q[3] << 24); w8.y = q[4] | (q[5] << 8) | (q[6] << 16) | (q[7] << 24);
                        *(u32x2*)((unsigned char*)(Z + (size_t)r * LDZ) + 2 * ZC_GR + 1024 * (seg - 5) + ((u.pb & 3) * 256 + cl + bj * 128)) = w8;
                        continue;
                    } else if (dorope) {
                        const float c[4] = {cs0[0], cs0[2], cs1[0], cs1[2]}, s[4] = {cs0[1], cs0[3], cs1[1], cs1[3]};
#pragma unroll
                        for (int j = 0; j < 4; ++j) { const float x1 = v0[j], x2 = v1[j]; v0[j] = (x1 * c[j] - x2 * s[j]) * qs; v1[j] = (x1 * s[j] + x2 * c[j]) * qs; }
                    }
                    u32x4 w; w.x = cvt_pk_bf16(v0[0], v0[1]); w.y = cvt_pk_bf16(v0[2], v0[3]); w.z = cvt_pk_bf16(v1[0], v1[1]); w.w = cvt_pk_bf16(v1[2], v1[3]);
                    *(u32x4*)(rowp + bj * 128) = w;
                }
            }
    }
};
__device__ __forceinline__ void unpack_u8x8(u32x2 g, f32x4& lo, f32x4& hi) {
    const float k = 1.0f / 255.0f;
    lo = (f32x4){(float)(g.x & 0xffu), (float)((g.x >> 8) & 0xffu), (float)((g.x >> 16) & 0xffu), (float)(g.x >> 24)} * k;
    hi = (f32x4){(float)(g.y & 0xffu), (float)((g.y >> 8) & 0xffu), (float)((g.y >> 16) & 0xffu), (float)(g.y >> 24)} * k;
}
struct EpiMix {
    static constexpr bool PERM = true, MID = true;
    bf16_t* Z;
    __device__ __forceinline__ void mid(f32x4 (&acc)[2][2][4][2], const pg8::Unit& u, int wr, int wc, int fr, int fq) const {
        const int colt = u.x0 * 256, cl = wc * 32 + 8 * fq;
        int r0 = u.pm * 256 + wr * 64 + fr; asm volatile("" : "+v"(r0));
#pragma unroll
        for (int ai = 0; ai < 2; ++ai)
#pragma unroll
            for (int m = 0; m < 4; ++m) {
                const unsigned char* rowg = (const unsigned char*)(Z + (size_t)(r0 + ai * 128 + m * 16) * LDZ) + 2 * ZC_GR + colt + cl;
#pragma unroll
                for (int bj = 0; bj < 2; ++bj) {
                    const u32x2 gr = *(const u32x2*)(rowg + bj * 128), gn = *(const u32x2*)(rowg + 1024 + bj * 128);
                    f32x4 r0v, r1v, n0v, n1v; unpack_u8x8(gr, r0v, r1v); unpack_u8x8(gn, n0v, n1v);
#pragma unroll
                    for (int j = 0; j < 4; ++j) { acc[ai][bj][m][0][j] *= r0v[j] * __builtin_amdgcn_rcpf(fmaxf(n0v[j], 1.0f / 255.0f)); acc[ai][bj][m][1][j] *= r1v[j] * __builtin_amdgcn_rcpf(fmaxf(n1v[j], 1.0f / 255.0f)); }
                    asm volatile("" : "+v"(acc[ai][bj][m][0]), "+v"(acc[ai][bj][m][1]) :: "memory");
                }
            }
    }
    __device__ __forceinline__ void operator()(AccRef acc, const pg8::Unit& u, int wr, int wc, int fr, int fq) const {
        const int colt = u.x0 * 256, cl = wc * 32 + 8 * fq;
        int r0 = u.pm * 256 + wr * 64 + fr; asm volatile("" : "+v"(r0));
#pragma unroll
        for (int ai = 0; ai < 2; ++ai)
#pragma unroll
            for (int m = 0; m < 4; ++m) {
                bf16_t* rowz = Z + (size_t)(r0 + ai * 128 + m * 16) * LDZ + colt + cl;
                const unsigned char* rowg = (const unsigned char*)(Z + (size_t)(r0 + ai * 128 + m * 16) * LDZ) + 2 * ZC_GR + 1024 + colt + cl;
#pragma unroll
                for (int bj = 0; bj < 2; ++bj) {
                    f32x4 n0v, n1v; unpack_u8x8(*(const u32x2*)(rowg + bj * 128), n0v, n1v);
                    n0v = __builtin_elementwise_max(n0v, (f32x4){1.0f / 255.0f, 1.0f / 255.0f, 1.0f / 255.0f, 1.0f / 255.0f}); n1v = __builtin_elementwise_max(n1v, (f32x4){1.0f / 255.0f, 1.0f / 255.0f, 1.0f / 255.0f, 1.0f / 255.0f});
                    const f32x4 v0 = acc[ai][bj][m][0] * n0v, v1 = acc[ai][bj][m][1] * n1v;
                    u32x4 w; w.x = cvt_pk_bf16(v0[0], v0[1]); w.y = cvt_pk_bf16(v0[2], v0[3]); w.z = cvt_pk_bf16(v1[0], v1[1]); w.w = cvt_pk_bf16(v1[2], v1[3]);
                    *(u32x4*)(rowz + ZC_XR + bj * 128) = w;
                }
            }
    }
};
struct EpiWout {
    static constexpr bool PERM = true, MID = false;
    const float* x; bf16_t* x1; const float* mod;
    __device__ __forceinline__ void operator()(AccRef acc, const pg8::Unit& u, int wr, int wc, int fr, int fq) const {
        const int col0 = u.x0 * 256 + wc * 32 + 8 * fq;
        const float* g1p = mod + (size_t)(u.pm >> 4) * 6144 + 2048 + col0;
        f32x4 gv[2][2];
#pragma unroll
        for (int bj = 0; bj < 2; ++bj)
#pragma unroll
            for (int n = 0; n < 2; ++n) gv[bj][n] = *(const f32x4*)(g1p + bj * 128 + n * 4);
#pragma unroll
        for (int ai = 0; ai < 2; ++ai)
#pragma unroll
            for (int m = 0; m < 4; ++m) {
                const size_t off = (size_t)(u.pm * 256 + ai * 128 + wr * 64 + m * 16 + fr) * DM + col0;
#pragma unroll
                for (int bj = 0; bj < 2; ++bj) {
                    const f32x4 x0 = *(const f32x4*)(x + off + bj * 128), x4 = *(const f32x4*)(x + off + bj * 128 + 4);
                    const f32x4 v0 = x0 + gv[bj][0] * acc[ai][bj][m][0], v1 = x4 + gv[bj][1] * acc[ai][bj][m][1];
                    u32x4 w; w.x = cvt_pk_bf16(v0[0], v0[1]); w.y = cvt_pk_bf16(v0[2], v0[3]); w.z = cvt_pk_bf16(v1[0], v1[1]); w.w = cvt_pk_bf16(v1[2], v1[3]);
                    *(u32x4*)(x1 + off + bj * 128) = w;
                }
            }
    }
};
__device__ __forceinline__ unsigned pk4_fp8(float a, float b, float c, float d) { int w = 0; w = __builtin_amdgcn_cvt_pk_fp8_f32(a, b, w, false); w = __builtin_amdgcn_cvt_pk_fp8_f32(c, d, w, true); return (unsigned)w; }
struct EpiMoe1 {
    static constexpr bool PERM = true, MID = false;
    unsigned char* HID;
    __device__ __forceinline__ void operator()(AccRef acc, const pg8::Unit& u, int wr, int wc, int fr, int fq) const {
        const int col0 = u.x0 * 128 + wc * 32 + 8 * fq;
#pragma unroll
        for (int ai = 0; ai < 2; ++ai)
#pragma unroll
            for (int m = 0; m < 4; ++m) {
                const size_t r = (size_t)u.pm * 256 + ai * 128 + wr * 64 + m * 16 + fr;
                f32x4 h0, h1;
#pragma unroll
                for (int j = 0; j < 4; ++j) { const float g0 = acc[ai][0][m][0][j], g1 = acc[ai][0][m][1][j];
                    h0[j] = g0 * sigmoidf_(g0) * acc[ai][1][m][0][j]; h1[j] = g1 * sigmoidf_(g1) * acc[ai][1][m][1][j]; }
                u32x2 w; w.x = pk4_fp8(h0[0], h0[1], h0[2], h0[3]); w.y = pk4_fp8(h1[0], h1[1], h1[2], h1[3]);
                *(u32x2*)(HID + r * DEXP + col0) = w;
            }
    }
};
struct EpiMoe2 {
    static constexpr bool PERM = true, MID = false;
    unsigned char* YE;
    __device__ __forceinline__ void operator()(AccRef acc, const pg8::Unit& u, int wr, int wc, int fr, int fq) const {
        const int col0 = u.x0 * 256 + wc * 32 + 8 * fq;
        const size_t r0 = (size_t)u.pm * 256 + wr * 64 + fr;
        unsigned char* base = YE + r0 * DM + col0;
#pragma unroll
        for (int ai = 0; ai < 2; ++ai)
#pragma unroll
            for (int m = 0; m < 4; ++m) {
                unsigned char* rowp = base + (size_t)(ai * 128 + m * 16) * DM;
#pragma unroll
                for (int bj = 0; bj < 2; ++bj) {
                    const f32x4 v0 = acc[ai][bj][m][0], v1 = acc[ai][bj][m][1];
                    u32x2 w; w.x = pk4_fp8(v0[0], v0[1], v0[2], v0[3]); w.y = pk4_fp8(v1[0], v1[1], v1[2], v1[3]);
                    *(u32x2*)(rowp + bj * 128) = w;
                }
            }
    }
};

struct Params {
    const float *x, *c, *ctx, *c_ctx, *w_mod, *b_mod, *w_in, *b_in, *conv_w, *conv_b, *lru_wa, *lru_ba, *lru_wi, *lru_bi, *lru_lambda, *na_rpb,
                *w_proj_rnn, *w_proj_na, *w_out, *w_router, *w_exp_gate, *w_exp_up, *w_exp_down, *final_norm;
    float* out; unsigned char* ws;
    int ph_lo, ph_hi, probe, pad;
};

__device__ __forceinline__ int zcol_of(int n) {
    const int seg = n >> 10, o = n & 1023;
    if (seg == 0) return ZC_YG + o;
    if (seg == 1) return ZC_XR + o;
    if (seg == 4) return ZC_V + o;
    if (seg == 5) return ZC_GR + o;
    if (seg == 6) return ZC_GN + o;
    const int hh = o >> 6, d = o & 63, g2 = d >> 5, dd = d & 31, nn = dd >> 4, j = dd & 15, a = j >> 2, jj = j & 3;
    return (seg == 2 ? ZC_Q : ZC_K) + hh * 64 + g2 * 32 + 8 * a + 4 * nn + jj;
}
constexpr int TR_SCR = 64 * 65 * 4;
template <class RowMap>
__device__ __forceinline__ void transpose_item(const float* W, int ldw, int k0, int n0, bf16_t* WT, int ldk, RowMap rowmap, LAS float* scr, int lane) {
    const int ln = lane & 15, lk = lane >> 4;
    f32x4 v[16];
#pragma unroll
    for (int i = 0; i < 16; ++i) v[i] = *(const f32x4*)(W + (size_t)(k0 + 4 * i + lk) * ldw + n0 + 4 * ln);
#pragma unroll
    for (int i = 0; i < 16; ++i) { LAS float* d = scr + (4 * i + lk) * 65 + 4 * ln; d[0] = v[i].x; d[1] = v[i].y; d[2] = v[i].z; d[3] = v[i].w; }
    LDS_WAIT(); asm volatile("" ::: "memory");
    const int kg = lane & 7;
#pragma unroll
    for (int j = 0; j < 8; ++j) { const int n = (lane >> 3) + 8 * j; const LAS float* sp = scr + (8 * kg) * 65 + n;
        u32x4 o; o.x = cvt_pk_bf16(sp[0 * 65], sp[1 * 65]); o.y = cvt_pk_bf16(sp[2 * 65], sp[3 * 65]); o.z = cvt_pk_bf16(sp[4 * 65], sp[5 * 65]); o.w = cvt_pk_bf16(sp[6 * 65], sp[7 * 65]);
        *(u32x4*)(WT + (size_t)rowmap(n0 + n) * ldk + k0 + 8 * kg) = o; }
    LDS_WAIT(); asm volatile("" ::: "memory");
}
template <class RowMap>
__device__ __forceinline__ void transpose_item_f8(const float* W, int ldw, int k0, int n0, unsigned char* WT, int ldk, RowMap rowmap, LAS float* scr, int lane) {
    const int ln = lane & 15, lk = lane >> 4;
    f32x4 v[16];
#pragma unroll
    for (int i = 0; i < 16; ++i) v[i] = *(const f32x4*)(W + (size_t)(k0 + 4 * i + lk) * ldw + n0 + 4 * ln);
#pragma unroll
    for (int i = 0; i < 16; ++i) { LAS float* d = scr + (4 * i + lk) * 65 + 4 * ln; d[0] = v[i].x * 64.f; d[1] = v[i].y * 64.f; d[2] = v[i].z * 64.f; d[3] = v[i].w * 64.f; }
    LDS_WAIT(); asm volatile("" ::: "memory");
    const int kq = lane & 3;
#pragma unroll
    for (int j = 0; j < 4; ++j) { const int n = (lane >> 2) + 16 * j; const LAS float* sp = scr + (16 * kq) * 65 + n;
        u32x4 o; o.x = pk4_fp8(sp[0 * 65], sp[1 * 65], sp[2 * 65], sp[3 * 65]); o.y = pk4_fp8(sp[4 * 65], sp[5 * 65], sp[6 * 65], sp[7 * 65]);
        o.z = pk4_fp8(sp[8 * 65], sp[9 * 65], sp[10 * 65], sp[11 * 65]); o.w = pk4_fp8(sp[12 * 65], sp[13 * 65], sp[14 * 65], sp[15 * 65]);
        *(u32x4*)(WT + (size_t)rowmap(n0 + n) * ldk + k0 + 16 * kq) = o; }
    LDS_WAIT(); asm volatile("" ::: "memory");
}
__device__ __forceinline__ void phase_prep(const Params& p, LAS unsigned char* lds) {
    const int tid = threadIdx.x, lane = tid & 63, wave = tid >> 6, G = gridDim.x;
    unsigned char* ws = p.ws;
    {
        LAS float* sS = (LAS float*)lds;
        LAS float* red = sS + 9 * 1024;
        float* MOD = (float*)(ws + WS_MOD);
        if (blockIdx.x < 192) {
            for (int e = tid; e < 9 * 1024; e += NTHREADS) { const int r = e >> 10, k = e & 1023; const float v = (r < 8) ? p.c[r * 1024 + k] : p.c_ctx[k]; sS[e] = v * sigmoidf_(v); }
            __syncthreads();
        }
        for (int it = blockIdx.x; it < 192; it += G) {
            const int n0 = it * 32, kk = tid >> 3, c4 = tid & 7;
            f32x4 a[9];
#pragma unroll
            for (int r = 0; r < 9; ++r) a[r] = (f32x4){0.f, 0.f, 0.f, 0.f};
#pragma unroll 4
            for (int i = 0; i < 16; ++i) { const int k = kk + 64 * i; const f32x4 w = *(const f32x4*)(p.w_mod + (size_t)k * 6144 + n0 + 4 * c4);
#pragma unroll
                for (int r = 0; r < 9; ++r) a[r] += w * sS[r * 1024 + k]; }
#pragma unroll
            for (int r = 0; r < 9; ++r) *(LAS f32x4*)(red + (kk * 9 + r) * 32 + 4 * c4) = a[r];
            __syncthreads();
            if (tid < 288) { const int r = tid >> 5, col = tid & 31; float sum = p.b_mod[n0 + col];
                for (int q = 0; q < 64; ++q) sum += red[(q * 9 + r) * 32 + col];
                MOD[r * 6144 + n0 + col] = sum; }
            __syncthreads();
        }
    }
    {
        float* ROPE = (float*)(ws + WS_ROPE); float* BINZ = (float*)(ws + WS_BINZ);
        const int gt = blockIdx.x * NTHREADS + tid, NGT = G * NTHREADS;
        for (int e = gt; e < 64 * 16; e += NGT) { const int pos = e >> 4, j = e & 15; const float inv = powf(10000.0f, -(float)j / 16.0f); const float ang = (float)pos * inv; ROPE[2 * e] = cosf(ang); ROPE[2 * e + 1] = sinf(ang); }
        for (int n = gt; n < NIN; n += NGT) BINZ[zcol_of(n)] = p.b_in[n];
    }
}
__device__ __forceinline__ void phase_prep_weights(const Params& p, LAS unsigned char* lds) {
    const int tid = threadIdx.x, lane = tid & 63, wave = tid >> 6, G = gridDim.x;
    unsigned char* ws = p.ws;
    {
        LAS float* scr = (LAS float*)(lds + wave * TR_SCR);
        bf16_t* WINT = (bf16_t*)(ws + WS_WINT); bf16_t* WMIX = (bf16_t*)(ws + WS_WMIX); bf16_t* WOUT = (bf16_t*)(ws + WS_WOUT);
        const int gw = blockIdx.x * NWAVES + wave, NGW = G * NWAVES;
        constexpr int I_IN = 16 * (NIN / 64), I_P = 16 * 16;
        for (int it = gw; it < I_IN + 3 * I_P; it += NGW) {
            int r = it;
            if (r < I_IN) { const int nblk = NIN / 64, kb = r / nblk, nb = r % nblk; transpose_item(p.w_in, NIN, 64 * kb, 64 * nb, WINT, 1024, [](int n) { return zcol_of(n); }, scr, lane); continue; } r -= I_IN;
            const int kb = (r % I_P) / 16, nb = (r % I_P) % 16, which = r / I_P;
            if (which == 0) transpose_item(p.w_proj_rnn, 1024, 64 * kb, 64 * nb, WMIX, 2048, [](int n) { return n; }, scr, lane);
            else if (which == 1) transpose_item(p.w_proj_na, 1024, 64 * kb, 64 * nb, WMIX + 1024, 2048, [](int n) { return n; }, scr, lane);
            else transpose_item(p.w_out, 1024, 64 * kb, 64 * nb, WOUT, 1024, [](int n) { return n; }, scr, lane);
        }
    }
}

__device__ __forceinline__ const float* norm1_row(const Params& p, int row) { return row >= MLAT ? p.ctx + (size_t)(row - MLAT) * DM : p.x + (size_t)row * DM; }
__device__ __forceinline__ void phase_norm1(const Params& p, LAS unsigned char* lds) {
    const int tid = threadIdx.x, lane = tid & 63, wave = tid >> 6, G = gridDim.x;
    unsigned char* ws = p.ws;
    const float* MOD = (const float*)(ws + WS_MOD);
    bf16_t* XN = (bf16_t*)(ws + WS_XN);
    const int gw = blockIdx.x * NWAVES + wave, NGW = G * NWAVES;
    constexpr int NROW = MLAT + MCTX;
    const int per = (NROW + NGW - 1) / NGW, r_lo = gw * per, r_hi = min(r_lo + per, NROW);
    if (r_lo >= r_hi) return;
    f32x4 nx[4], ny[4], shv[4], scv[4]; int mcur = -1;
    { const f32x4* xr = (const f32x4*)norm1_row(p, r_lo) + lane;
#pragma unroll
      for (int j = 0; j < 4; ++j) nx[j] = xr[64 * j];
      if (r_lo + 1 < r_hi) { const f32x4* xs = (const f32x4*)norm1_row(p, r_lo + 1) + lane;
#pragma unroll
          for (int j = 0; j < 4; ++j) ny[j] = xs[64 * j]; } }
    for (int row = r_lo; row < r_hi; ++row) {
        const int mr = (row >= MLAT) ? 8 : (row >> 12);
        if (mr != mcur) { mcur = mr; const float* sh = MOD + (size_t)mr * 6144;
#pragma unroll
            for (int j = 0; j < 4; ++j) { shv[j] = *(const f32x4*)(sh + 4 * lane + 256 * j); scv[j] = *(const f32x4*)(sh + 1024 + 4 * lane + 256 * j) + 1.0f; } }
        f32x4 v[4]; float s = 0.f;
#pragma unroll
        for (int j = 0; j < 4; ++j) { v[j] = nx[j]; nx[j] = ny[j]; s += (v[j].x * v[j].x + v[j].y * v[j].y) + (v[j].z * v[j].z + v[j].w * v[j].w); }
        if (row + 2 < r_hi) { const f32x4* xr = (const f32x4*)norm1_row(p, row + 2) + lane;
#pragma unroll
            for (int j = 0; j < 4; ++j) ny[j] = xr[64 * j]; }
        const float rs = 1.0f / sqrtf(wave_sum(s) * (1.0f / DM) + 1e-6f);
        unsigned long long* o8 = (unsigned long long*)(XN + (size_t)row * DM) + lane;
#pragma unroll
        for (int j = 0; j < 4; ++j) { const f32x4 y = v[j] * rs * scv[j] + shv[j];
            o8[64 * j] = (unsigned long long)pk2(y.x, y.y) | ((unsigned long long)pk2(y.z, y.w) << 32); }
    }
}

typedef float f32x16 __attribute__((ext_vector_type(16)));
constexpr int RN_XS = 144;
constexpr int RN_XC = 0, RN_WT = 256 * RN_XS, RN_SEG = RN_WT + 64 * RN_XS, RN_ST = RN_SEG + 10240;
__device__ __forceinline__ void phase_rnn(const Params& p, LAS unsigned char* lds, const bool dry) {
    const int tid = threadIdx.x, lane = tid & 63, wave = __builtin_amdgcn_readfirstlane(tid >> 6), G = gridDim.x;
    unsigned char* ws = p.ws;
    bf16_t* Z = (bf16_t*)(ws + WS_Z); const bf16_t* ZCb = (const bf16_t*)(ws + WS_ZC); bf16_t* HF = (bf16_t*)(ws + WS_XN);
    LAS unsigned char* xcb = lds + RN_XC;
    LAS unsigned char* wtb = lds + RN_WT;
    LAS float* seg0 = (LAS float*)(lds + RN_SEG);
    LAS unsigned char* stg = lds + RN_ST;
    const int c = lane & 31, hh = lane >> 5;
    const int taur = 16 * ((c >> 2) & 1) + 4 * (c >> 3) + (c & 3);
    const int cg8 = tid & 7, run = tid >> 3;
    for (int it = blockIdx.x; it < 256; it += G) {
        const int b = it >> 5, g = (it >> 1) & 15, half = it & 1;
        const int ch = 64 * g + 32 * half + c;
        const int ch0 = 64 * g + 32 * half;
        f32x2 cw2[4][4], cb2[4];
#pragma unroll
        for (int j = 0; j < 4; ++j) { cb2[j] = *(const f32x2*)(p.conv_b + 64 * g + 8 * cg8 + 2 * j);
#pragma unroll
            for (int k = 0; k < 4; ++k) cw2[k][j] = *(const f32x2*)(p.conv_w + k * 1024 + 64 * g + 8 * cg8 + 2 * j); }
        const bf16_t* srcL = Z + (size_t)b * SEQ * LDZ + ZC_XR + 64 * g + 8 * cg8;
        const bf16_t* srcC = ZCb + (size_t)b * CTX * LDC + CC_XR + 64 * g + 8 * cg8;
        for (int dir = 0; dir < 2; ++dir) {
            u32x4 xr[7];
#pragma unroll
            for (int q = 0; q < 7; ++q) { const int ts = 4 * run - 2 + q; xr[q] = (ts >= 0 && ts < CTX) ? *(const u32x4*)(srcC + (size_t)ts * LDC) : (u32x4){0u, 0u, 0u, 0u}; }
            __syncthreads();
            for (int e = tid; e < 2 * 64 * 32; e += NTHREADS) { const int mat = e >> 11, i = (e >> 5) & 63, cc = e & 31;
                const float* src = mat ? p.lru_wi : p.lru_wa;
                *(LAS bf16_t*)(wtb + (mat * 32 + cc) * RN_XS + i * 2) = (bf16_t)f2bf(src[(((size_t)dir * 16 + g) * 64 + i) * 64 + 32 * half + cc]); }
            __syncthreads();
            const float nbaL = -LOG2E * p.lru_ba[dir * 1024 + ch], nbiL = -LOG2E * p.lru_bi[dir * 1024 + ch];
            const float lam = p.lru_lambda[dir * 1024 + ch];
            const float sp = (lam > 15.f) ? expf(-lam) : log1pf(expf(-lam));
            const float clam = -8.0f * sp * LOG2E;
            float hc = 0.f;
            for (int step = 0; step < 17; ++step) {
                const bool isctx = (step == 0);
                const int t0 = isctx ? 0 : 256 * (dir == 0 ? step - 1 : 16 - step);
                {
                    f32x2 ac[4][4];
#pragma unroll
                    for (int i = 0; i < 4; ++i)
#pragma unroll
                        for (int j = 0; j < 4; ++j) ac[i][j] = cb2[j];
#pragma unroll
                    for (int q = 0; q < 7; ++q) {
                        f32x2 x2[4];
                        x2[0] = (f32x2){bf2f(xr[q].x & 0xffffu), bf2f(xr[q].x >> 16)}; x2[1] = (f32x2){bf2f(xr[q].y & 0xffffu), bf2f(xr[q].y >> 16)};
                        x2[2] = (f32x2){bf2f(xr[q].z & 0xffffu), bf2f(xr[q].z >> 16)}; x2[3] = (f32x2){bf2f(xr[q].w & 0xffffu), bf2f(xr[q].w >> 16)};
#pragma unroll
                        for (int i = 0; i < 4; ++i) { const int k = q - i; if (k >= 0 && k < 4) {
#pragma unroll
                            for (int j = 0; j < 4; ++j) ac[i][j] = __builtin_elementwise_fma(cw2[k][j], x2[j], ac[i][j]); } }
                    }
#pragma unroll
                    for (int i = 0; i < 4; ++i) { u32x4 w; w.x = cvt_pk_bf16(ac[i][0].x, ac[i][0].y); w.y = cvt_pk_bf16(ac[i][1].x, ac[i][1].y); w.z = cvt_pk_bf16(ac[i][2].x, ac[i][2].y); w.w = cvt_pk_bf16(ac[i][3].x, ac[i][3].y);
                        *(LAS u32x4*)(xcb + (4 * run + i) * RN_XS + cg8 * 16) = w; }
                }
                if (step < 16) { const int tn = 256 * (dir == 0 ? step : 15 - step);
                    if (tn >= 2 && tn + 258 <= SEQ) {
                        const bf16_t* rp = srcL + (size_t)(tn + 4 * run - 2) * LDZ;
#pragma unroll
                        for (int q = 0; q < 7; ++q) xr[q] = *(const u32x4*)(rp + (size_t)q * LDZ);
                    } else {
#pragma unroll
                        for (int q = 0; q < 7; ++q) { const int ts = tn + 4 * run - 2 + q; xr[q] = (ts >= 0 && ts < SEQ) ? *(const u32x4*)(srcL + (size_t)ts * LDZ) : (u32x4){0u, 0u, 0u, 0u}; } } }
                u32x4 hfr[2], ygr[2];
                const size_t tb = (size_t)b * SEQ + t0;
                if (!isctx && dir == 1) {
#pragma unroll
                    for (int i = 0; i < 2; ++i) { const int pl = lane + 64 * i, tk = 32 * wave + (pl >> 2), part = pl & 3;
                        hfr[i] = *(const u32x4*)(HF + (tb + tk) * DM + ch0 + 8 * part); ygr[i] = *(const u32x4*)(Z + (tb + tk) * LDZ + ZC_YG + ch0 + 8 * part); } }
                f32x16 ar, ai;
#pragma unroll
                for (int j = 0; j < 16; ++j) { ar[j] = 0.f; ai[j] = 0.f; }
                const LAS unsigned char* arow = xcb + (32 * wave + taur) * RN_XS + 16 * hh;
#pragma unroll
                for (int s4 = 0; s4 < 4; ++s4) { const bf16x8 af = *(const LAS bf16x8*)(arow + 32 * s4);
                    const bf16x8 bw0 = *(const LAS bf16x8*)(wtb + c * RN_XS + (16 * s4 + 8 * hh) * 2), bw1 = *(const LAS bf16x8*)(wtb + (32 + c) * RN_XS + (16 * s4 + 8 * hh) * 2);
                    ar = __builtin_amdgcn_mfma_f32_32x32x16_bf16(af, bw0, ar, 0, 0, 0);
                    ai = __builtin_amdgcn_mfma_f32_32x32x16_bf16(af, bw1, ai, 0, 0, 0); }
                const LAS unsigned char* xcol = xcb + (32 * wave + 16 * hh) * RN_XS + (32 * half + c) * 2;
#pragma unroll
                for (int j = 0; j < 16; ++j) {
                    const float r = __builtin_amdgcn_rcpf(1.0f + __builtin_amdgcn_exp2f(__builtin_fmaf(ar[j], -LOG2E, nbaL))), ig = __builtin_amdgcn_rcpf(1.0f + __builtin_amdgcn_exp2f(__builtin_fmaf(ai[j], -LOG2E, nbiL)));
                    const float a = __builtin_amdgcn_exp2f(r * clam);
                    const float om = __builtin_fmaf(-a, a, 1.0f);
                    const float xv = bf2f(*(const LAS bf16_t*)(xcol + j * RN_XS));
                    ar[j] = a; ai[j] = __builtin_amdgcn_sqrtf(om) * ig * xv;
                }
                float P = 1.f, H = 0.f;
                if (dir == 0) {
#pragma unroll
                    for (int j = 0; j < 16; ++j) { H = ar[j] * H + ai[j]; P *= ar[j]; }
                } else {
#pragma unroll
                    for (int j = 15; j >= 0; --j) { H = ar[j] * H + ai[j]; P *= ar[j]; }
                }
                const int s = 2 * wave + hh;
                LAS float* segA = seg0 + (step & 1) * 1280; LAS float* segB = segA + 640;
                segA[c * 20 + s] = P; segB[c * 20 + s] = H;
                __syncthreads();
                float h = hc, hin;
                {   f32x4 sa[4], sb[4];
#pragma unroll
                    for (int q4 = 0; q4 < 4; ++q4) { sa[q4] = *(const LAS f32x4*)(segA + c * 20 + 4 * q4); sb[q4] = *(const LAS f32x4*)(segB + c * 20 + 4 * q4); }
                    float h0v = 0.f, h1v = 0.f;
                    if (dir == 0) {
#pragma unroll
                        for (int q = 0; q < 16; ++q) { if (q == 2 * wave) h0v = h; if (q == 2 * wave + 1) h1v = h; h = sa[q >> 2][q & 3] * h + sb[q >> 2][q & 3]; } }
                    else {
#pragma unroll
                        for (int q = 15; q >= 0; --q) { if (q == 2 * wave) h0v = h; if (q == 2 * wave + 1) h1v = h; h = sa[q >> 2][q & 3] * h + sb[q >> 2][q & 3]; } }
                    hin = hh ? h1v : h0v;
                }
                hc = h;
                if (!isctx) {
                    LAS float* sp0 = (LAS float*)(stg + (32 * wave + 16 * hh) * RN_XS) + c;
                    h = hin;
                    if (dir == 0) {
#pragma unroll
                        for (int j = 0; j < 16; ++j) { h = ar[j] * h + ai[j]; sp0[j * (RN_XS / 4)] = h; }
                    } else {
#pragma unroll
                        for (int j = 15; j >= 0; --j) { h = ar[j] * h + ai[j]; sp0[j * (RN_XS / 4)] = h; }
                    }
#pragma unroll
                    for (int i = 0; i < 2; ++i) { const int pl = lane + 64 * i, tk = 32 * wave + (pl >> 2), part = pl & 3;
                        const LAS f32x4* sr = (const LAS f32x4*)(stg + tk * RN_XS + part * 32);
                        f32x4 h0 = sr[0], h1 = sr[1];
                        if (dir == 1) {
                            const u32x4 f = hfr[i], y = ygr[i];
                            h0 = (h0 + (f32x4){bf2f(f.x & 0xffffu), bf2f(f.x >> 16), bf2f(f.y & 0xffffu), bf2f(f.y >> 16)}) * (f32x4){bf2f(y.x & 0xffffu), bf2f(y.x >> 16), bf2f(y.y & 0xffffu), bf2f(y.y >> 16)};
                            h1 = (h1 + (f32x4){bf2f(f.z & 0xffffu), bf2f(f.z >> 16), bf2f(f.w & 0xffffu), bf2f(f.w >> 16)}) * (f32x4){bf2f(y.z & 0xffffu), bf2f(y.z >> 16), bf2f(y.w & 0xffffu), bf2f(y.w >> 16)};
                        }
                        u32x4 w; w.x = cvt_pk_bf16(h0[0], h0[1]); w.y = cvt_pk_bf16(h0[2], h0[3]); w.z = cvt_pk_bf16(h1[0], h1[1]); w.w = cvt_pk_bf16(h1[2], h1[3]);
                        if (!dry) { if (dir == 0) *(u32x4*)(HF + (tb + tk) * DM + ch0 + 8 * part) = w; else *(u32x4*)(Z + (tb + tk) * LDZ + ZC_YG + ch0 + 8 * part) = w; }
                    }
                }
            }
        }
    }
}

constexpr int AT_SLOT = 16384, AT_NS = 4, AT_BIAS = AT_NS * AT_SLOT;
__device__ __forceinline__ void glds16(const void* gsrc, unsigned lds_dst) { unsigned keep;
    asm volatile("s_mov_b32 %0, m0\n\ts_mov_b32 m0, %2\n\ts_nop 0\n\tglobal_load_lds_dwordx4 %1, off\n\ts_mov_b32 m0, %0" : "=&s"(keep) : "v"(gsrc), "s"(lds_dst) : "memory"); }
typedef short s16x4 __attribute__((ext_vector_type(4)));
struct QBlk { bf16x8 q[2]; f32x4 o[4]; float l; };
template <bool LOCAL, bool DOA, bool DOB>
__device__ __forceinline__ void attn_proc32(QBlk& A, QBlk& B, const LAS unsigned char* Kc, int kc0, const int (&koff)[2][2], const int (&voff)[4][2], const int (&cidx)[8], const LAS unsigned char* browA, const LAS unsigned char* browB) {
    const LAS unsigned char* Kb = Kc + kc0 * 128; const LAS unsigned char* Vb = Kc + 8192 + kc0 * 128;
    f32x4 a0 = (f32x4){0.f, 0.f, 0.f, 0.f}, a1 = a0, b0 = a0, b1 = a0;
#pragma unroll
    for (int ks = 0; ks < 2; ++ks) {
        const bf16x8 k0 = *(const LAS bf16x8*)(Kb + koff[0][ks]);
        const bf16x8 k1 = *(const LAS bf16x8*)(Kb + koff[1][ks]);
        if (DOA) { a0 = __builtin_amdgcn_mfma_f32_16x16x32_bf16(k0, A.q[ks], a0, 0, 0, 0); a1 = __builtin_amdgcn_mfma_f32_16x16x32_bf16(k1, A.q[ks], a1, 0, 0, 0); }
        if (DOB) { b0 = __builtin_amdgcn_mfma_f32_16x16x32_bf16(k0, B.q[ks], b0, 0, 0, 0); b1 = __builtin_amdgcn_mfma_f32_16x16x32_bf16(k1, B.q[ks], b1, 0, 0, 0); }
    }
    if (LOCAL) {
#pragma unroll
        for (int r = 0; r < 4; ++r) {
            if (DOA) { a0[r] += *(const LAS float*)(browA + cidx[r]); a1[r] += *(const LAS float*)(browA + cidx[4 + r]); }
            if (DOB) { b0[r] += *(const LAS float*)(browB + cidx[r]); b1[r] += *(const LAS float*)(browB + cidx[4 + r]); }
        }
    }
    float psA = 0.f, psB = 0.f;
#pragma unroll
    for (int r = 0; r < 4; ++r) {
        if (DOA) { a0[r] = __builtin_amdgcn_exp2f(a0[r]); a1[r] = __builtin_amdgcn_exp2f(a1[r]); psA += a0[r] + a1[r]; }
        if (DOB) { b0[r] = __builtin_amdgcn_exp2f(b0[r]); b1[r] = __builtin_amdgcn_exp2f(b1[r]); psB += b0[r] + b1[r]; }
    }
    bf16x8 pA, pB;
    if (DOA) { A.l += psA; const u32x4 w = (u32x4){cvt_pk_bf16(a0[0], a0[1]), cvt_pk_bf16(a0[2], a0[3]), cvt_pk_bf16(a1[0], a1[1]), cvt_pk_bf16(a1[2], a1[3])}; pA = __builtin_bit_cast(bf16x8, w); }
    if (DOB) { B.l += psB; const u32x4 w = (u32x4){cvt_pk_bf16(b0[0], b0[1]), cvt_pk_bf16(b0[2], b0[3]), cvt_pk_bf16(b1[0], b1[1]), cvt_pk_bf16(b1[2], b1[3])}; pB = __builtin_bit_cast(bf16x8, w); }
#pragma unroll
    for (int dt = 0; dt < 4; ++dt) {
        const s16x4 lo4 = __builtin_bit_cast(s16x4, __builtin_amdgcn_ds_read_tr16_b64_v4i16((LAS s16x4*)(Vb + voff[dt][0])));
        const s16x4 hi4 = __builtin_bit_cast(s16x4, __builtin_amdgcn_ds_read_tr16_b64_v4i16((LAS s16x4*)(Vb + voff[dt][1])));
        const bf16x8 av = (bf16x8){lo4[0], lo4[1], lo4[2], lo4[3], hi4[0], hi4[1], hi4[2], hi4[3]};
        if (DOA) A.o[dt] = __builtin_amdgcn_mfma_f32_16x16x32_bf16(av, pA, A.o[dt], 0, 0, 0);
        if (DOB) B.o[dt] = __builtin_amdgcn_mfma_f32_16x16x32_bf16(av, pB, B.o[dt], 0, 0, 0);
    }
}
__device__ __forceinline__ void phase_attn(const Params& p, LAS unsigned char* lds, const bool dry) {
    const int tid = threadIdx.x, lane = tid & 63, wave = __builtin_amdgcn_readfirstlane(tid >> 6), G = gridDim.x;
    unsigned char* ws = p.ws;
    bf16_t* Z = (bf16_t*)(ws + WS_Z); const bf16_t* ZCb = (const bf16_t*)(ws + WS_ZC);
    LAS float* btab = (LAS float*)(lds + AT_BIAS);
    const int j = wave & 3, c16 = lane & 15, fq = lane >> 4;
    const int cq = 16 * j + c16, cst = min(max(cq - 8, 0), 48), kst = min(max(16 * j - 8, 0), 32);
    const int lo = cst - kst - 4 * fq;
    const int dc0 = kst + 4 * fq - cq + 15;
    int cidx[8];
#pragma unroll
    for (int q = 0; q < 8; ++q) { const int li = 16 * (q >> 2) + (q & 3); cidx[q] = 4 * ((li >= lo && li < lo + 16) ? min(max(dc0 + li, 0), 30) : 31); }
    int koff[2][2], voff[4][2];
    { const int i = lane & 15, kq = lane >> 4, jj = (lane & 15) >> 2, q = lane & 3, vr = 4 * kq + jj;
#pragma unroll
      for (int t = 0; t < 2; ++t)
#pragma unroll
          for (int ks = 0; ks < 2; ++ks) koff[t][ks] = (16 * t + i) * 128 + (((4 * ks + kq) ^ (i & 7)) << 4);
#pragma unroll
      for (int dt = 0; dt < 4; ++dt)
#pragma unroll
          for (int t = 0; t < 2; ++t) voff[dt][t] = (16 * t + vr) * 128 + (((2 * dt + (q >> 1)) ^ (vr & 7)) << 4) + 8 * (q & 1); }
    const int drow = 8 * wave + (lane >> 3), dpc = (lane & 7) ^ (lane >> 3);
    const unsigned lds0 = (unsigned)(uintptr_t)lds;
    for (int u = blockIdx.x; u < NB * 16 * 16; u += G) {
        const int b = u >> 8, h = (u >> 4) & 15, r0 = 4 * (u & 15);
        const int kr_lo = min(max(r0 - 4, 0), 56), kr_hi = min(max(r0 - 1, 0), 56) + 7, nloc = kr_hi - kr_lo + 1, nch = nloc + 4;
        const int rA = r0 + (wave >> 2), rB = rA + 2, rsA = min(max(rA - 4, 0), 56), rsB = min(max(rB - 4, 0), 56);
        bf16_t* qA = Z + ((size_t)b * SEQ + rA * 64 + cq) * LDZ + ZC_Q + h * 64;
        bf16_t* qB = Z + ((size_t)b * SEQ + rB * 64 + cq) * LDZ + ZC_Q + h * 64;
        QBlk A, Bq;
#pragma unroll
        for (int ks = 0; ks < 2; ++ks) { A.q[ks] = *(const bf16x8*)(qA + ks * 32 + fq * 8); Bq.q[ks] = *(const bf16x8*)(qB + ks * 32 + fq * 8); }
#pragma unroll
        for (int dt = 0; dt < 4; ++dt) { A.o[dt] = (f32x4){0.f, 0.f, 0.f, 0.f}; Bq.o[dt] = (f32x4){0.f, 0.f, 0.f, 0.f}; }
        A.l = 0.f; Bq.l = 0.f;
        if (u == (int)blockIdx.x) { for (int e = tid; e < 15 * 32; e += NTHREADS) btab[e] = ((e & 31) < 31) ? p.na_rpb[(size_t)h * 465 + (e >> 5) * 31 + (e & 31)] * LOG2E : -1e30f; }
        asm volatile("" :: "v"(A.q[0]), "v"(A.q[1]), "v"(Bq.q[0]), "v"(Bq.q[1]));
        const bf16_t* kbase = Z + ((size_t)b * SEQ + drow) * LDZ + ZC_K + h * 64 + dpc * 8;
        const bf16_t* cbase = ZCb + ((size_t)b * CTX + drow) * LDC + CC_K + h * 64 + dpc * 8;
#define AT_DMA(c_) do { const int c__ = (c_); const unsigned d_ = (unsigned)__builtin_amdgcn_readfirstlane((int)(lds0 + (unsigned)((c__ & (AT_NS - 1)) * AT_SLOT + wave * 1024))); \
            if (c__ < nloc) { const bf16_t* s_ = kbase + (size_t)(kr_lo + c__) * 64 * LDZ; glds16(s_, d_); glds16(s_ + (ZC_V - ZC_K), d_ + 8192u); } \
            else { const bf16_t* s_ = cbase + (size_t)(c__ - nloc) * 64 * LDC; glds16(s_, d_); glds16(s_ + (CC_V - CC_K), d_ + 8192u); } } while (0)
        AT_DMA(0); AT_DMA(1); AT_DMA(2);
        asm volatile("s_waitcnt vmcnt(4) lgkmcnt(0)" ::: "memory"); __builtin_amdgcn_s_barrier(); asm volatile("" ::: "memory");
        for (int c = 0; c < nch; ++c) {
            if (c + 3 < nch) AT_DMA(c + 3);
            { const int nrem = min(nch - 1, c + 3) - (c + 1);
              if (nrem >= 2) asm volatile("s_waitcnt vmcnt(4)" ::: "memory"); else if (nrem == 1) asm volatile("s_waitcnt vmcnt(2)" ::: "memory"); else asm volatile("s_waitcnt vmcnt(0)" ::: "memory"); }
            const LAS unsigned char* Kc = lds + (c & (AT_NS - 1)) * AT_SLOT;
            if (c < nloc) {
                const int kr = kr_lo + c;
                const bool vA = (kr >= rsA && kr < rsA + 8), vB = (kr >= rsB && kr < rsB + 8);
                const LAS unsigned char* bA = (const LAS unsigned char*)btab + min(max(kr - rA + 7, 0), 14) * 128; const LAS unsigned char* bB = (const LAS unsigned char*)btab + min(max(kr - rB + 7, 0), 14) * 128;
                if (vA && vB) attn_proc32<true, true, true>(A, Bq, Kc, kst, koff, voff, cidx, bA, bB);
                else if (vA) attn_proc32<true, true, false>(A, Bq, Kc, kst, koff, voff, cidx, bA, bB);
                else if (vB) attn_proc32<true, false, true>(A, Bq, Kc, kst, koff, voff, cidx, bA, bB);
            } else {
                attn_proc32<false, true, true>(A, Bq, Kc, 0, koff, voff, cidx, (const LAS unsigned char*)btab, (const LAS unsigned char*)btab);
                attn_proc32<false, true, true>(A, Bq, Kc, 32, koff, voff, cidx, (const LAS unsigned char*)btab, (const LAS unsigned char*)btab);
            }
            asm volatile("s_waitcnt lgkmcnt(0)" ::: "memory"); __builtin_amdgcn_s_barrier(); asm volatile("" ::: "memory");
        }
#undef AT_DMA
        {
            float l = A.l; l += __shfl_xor(l, 16); l += __shfl_xor(l, 32); const float il = 1.0f / l;
#pragma unroll
            for (int dt = 0; dt < 4; ++dt) { const f32x4 o = A.o[dt] * il; u32x2 w; w.x = cvt_pk_bf16(o[0], o[1]); w.y = cvt_pk_bf16(o[2], o[3]); if (!dry) *(u32x2*)(qA + dt * 16 + fq * 4) = w; }
            l = Bq.l; l += __shfl_xor(l, 16); l += __shfl_xor(l, 32); const float il2 = 1.0f / l;
#pragma unroll
            for (int dt = 0; dt < 4; ++dt) { const f32x4 o = Bq.o[dt] * il2; u32x2 w; w.x = cvt_pk_bf16(o[0], o[1]); w.y = cvt_pk_bf16(o[2], o[3]); if (!dry) *(u32x2*)(qB + dt * 16 + fq * 4) = w; }
        }
    }
}

constexpr int N2_WRP = 0, N2_CP = 65536, N2_CV = N2_CP + 2048, N2_RS = N2_CV + 64;
__device__ __forceinline__ void phase_norm2(const Params& p, LAS unsigned char* lds) {
    const int tid = threadIdx.x, lane = tid & 63, wave = __builtin_amdgcn_readfirstlane(tid >> 6), G = gridDim.x;
    unsigned char* ws = p.ws;
    const float* MOD = (const float*)(ws + WS_MOD); unsigned char* XN2 = ws + WS_XN2; float* AFF = (float*)(ws + WS_AFF);
    const bf16_t* X1 = (const bf16_t*)(ws + WS_X1);
    LAS float* wrp = (LAS float*)(lds + N2_WRP); LAS float* cpart = (LAS float*)(lds + N2_CP); LAS float* cvec = (LAS float*)(lds + N2_CV); LAS float* rsw = (LAS float*)(lds + N2_RS) + wave * 16;
    const int r16 = lane & 15, kq = lane >> 4;
    int bcur = -1; f32x4 shv[4], scv[4];
    for (int blk = blockIdx.x; blk < MLAT / 128; blk += G) {
        const int b = blk >> 5;
        if (b != bcur) { bcur = b;
            const float* sh2 = MOD + (size_t)b * 6144 + 3072; const float* sc2 = MOD + (size_t)b * 6144 + 4096;
            __syncthreads();
            for (int e = tid; e < 16 * 1024; e += NTHREADS) wrp[e] = (1.0f + sc2[e >> 4]) * p.w_router[e];
            { const int e = tid & 15, part = tid >> 4; float a = 0.f;
              for (int i = 0; i < 32; ++i) { const int k = part + 32 * i; a += sh2[k] * p.w_router[k * 16 + e]; }
              cpart[part * 16 + e] = a; }
#pragma unroll
            for (int j = 0; j < 4; ++j) { shv[j] = *(const f32x4*)(sh2 + 4 * lane + 256 * j); scv[j] = *(const f32x4*)(sc2 + 4 * lane + 256 * j) + 1.0f; }
            __syncthreads();
            if (tid < 16) { float a = 0.f; for (int q = 0; q < 32; ++q) a += cpart[q * 16 + tid]; cvec[tid] = a; }
            __syncthreads();
        }
        const int row0 = blk * 128 + wave * 16;
        f32x4 acc = (f32x4){0.f, 0.f, 0.f, 0.f}; float ss = 0.f;
        const u32x2* xp = (const u32x2*)(X1 + (size_t)(row0 + r16) * DM + 4 * kq);
        const LAS float* wp = wrp + (4 * kq) * 16 + r16;
        u32x2 xa[8], xb[8];
#pragma unroll
        for (int u = 0; u < 8; ++u) xa[u] = xp[4 * u];
#pragma unroll 1
        for (int t0 = 0; t0 < 64; t0 += 16) {
#pragma unroll
            for (int u = 0; u < 8; ++u) xb[u] = xp[4 * (t0 + 8 + u)];
#pragma unroll
            for (int u = 0; u < 8; ++u) { const float x0 = bf2f(xa[u].x & 0xffffu), x1v = bf2f(xa[u].x >> 16), x2 = bf2f(xa[u].y & 0xffffu), x3 = bf2f(xa[u].y >> 16);
                ss += (x0 * x0 + x1v * x1v) + (x2 * x2 + x3 * x3);
                const LAS float* w = wp + (t0 + u) * 256;
                acc = __builtin_amdgcn_mfma_f32_16x16x4f32(x0, w[0], acc, 0, 0, 0); acc = __builtin_amdgcn_mfma_f32_16x16x4f32(x1v, w[16], acc, 0, 0, 0);
                acc = __builtin_amdgcn_mfma_f32_16x16x4f32(x2, w[32], acc, 0, 0, 0); acc = __builtin_amdgcn_mfma_f32_16x16x4f32(x3, w[48], acc, 0, 0, 0); }
            if (t0 + 16 < 64) {
#pragma unroll
                for (int u = 0; u < 8; ++u) xa[u] = xp[4 * (t0 + 16 + u)]; }
#pragma unroll
            for (int u = 0; u < 8; ++u) { const float x0 = bf2f(xb[u].x & 0xffffu), x1v = bf2f(xb[u].x >> 16), x2 = bf2f(xb[u].y & 0xffffu), x3 = bf2f(xb[u].y >> 16);
                ss += (x0 * x0 + x1v * x1v) + (x2 * x2 + x3 * x3);
                const LAS float* w = wp + (t0 + 8 + u) * 256;
                acc = __builtin_amdgcn_mfma_f32_16x16x4f32(x0, w[0], acc, 0, 0, 0); acc = __builtin_amdgcn_mfma_f32_16x16x4f32(x1v, w[16], acc, 0, 0, 0);
                acc = __builtin_amdgcn_mfma_f32_16x16x4f32(x2, w[32], acc, 0, 0, 0); acc = __builtin_amdgcn_mfma_f32_16x16x4f32(x3, w[48], acc, 0, 0, 0); }
        }
        ss += __shfl_xor(ss, 16); ss += __shfl_xor(ss, 32);
        const float rs = 1.0f / sqrtf(ss * (1.0f / DM) + 1e-6f);
        if (lane < 16) rsw[lane] = rs;
        LDS_WAIT(); asm volatile("" ::: "memory");
        { const float cv = cvec[r16]; float lg[4], mx[4], ex[4], sm[4];
#pragma unroll
          for (int q = 0; q < 4; ++q) { lg[q] = rsw[4 * kq + q] * acc[q] + cv; mx[q] = lg[q]; }
#pragma unroll
          for (int o = 1; o < 16; o <<= 1)
#pragma unroll
              for (int q = 0; q < 4; ++q) mx[q] = fmaxf(mx[q], __shfl_xor(mx[q], o));
#pragma unroll
          for (int q = 0; q < 4; ++q) { ex[q] = expf(lg[q] - mx[q]); sm[q] = ex[q]; }
#pragma unroll
          for (int o = 1; o < 16; o <<= 1)
#pragma unroll
              for (int q = 0; q < 4; ++q) sm[q] += __shfl_xor(sm[q], o);
#pragma unroll
          for (int q = 0; q < 4; ++q) AFF[(size_t)(row0 + 4 * kq + q) * 16 + r16] = ex[q] / sm[q]; }
        u32x2 nx[4], ny[4];
        { const u32x2* xr = (const u32x2*)(X1 + (size_t)row0 * DM) + lane;
#pragma unroll
          for (int j = 0; j < 4; ++j) { nx[j] = xr[64 * j]; ny[j] = xr[64 * j + 256]; } }
        for (int q = 0; q < 16; ++q) {
            const float rq = rsw[q];
            f32x4 v[4];
#pragma unroll
            for (int j = 0; j < 4; ++j) { v[j] = (f32x4){bf2f(nx[j].x & 0xffffu), bf2f(nx[j].x >> 16), bf2f(nx[j].y & 0xffffu), bf2f(nx[j].y >> 16)}; nx[j] = ny[j]; }
            if (q + 2 < 16) { const u32x2* xr = (const u32x2*)(X1 + (size_t)(row0 + q + 2) * DM) + lane;
#pragma unroll
                for (int j = 0; j < 4; ++j) ny[j] = xr[64 * j]; }
            unsigned* o4 = (unsigned*)(XN2 + (size_t)(row0 + q) * DM) + lane;
#pragma unroll
            for (int j = 0; j < 4; ++j) { v[j] = v[j] * rq * scv[j] + shv[j]; o4[64 * j] = pk4_fp8(v[j].x, v[j].y, v[j].z, v[j].w); }
        }
    }
}

__device__ __forceinline__ void phase_topk(const Params& p, LAS unsigned char* lds) {
    const int tid = threadIdx.x, lane = tid & 63, wave = tid >> 6, G = gridDim.x;
    unsigned char* ws = p.ws;
    const float* AFF = (const float*)(ws + WS_AFF); int* SELIDX = (int*)(ws + WS_SELIDX); float* SELG = (float*)(ws + WS_SELG); int* SLOT = (int*)(ws + WS_SLOT);
    LAS unsigned* hist = (LAS unsigned*)lds;
    LAS unsigned* ctl = hist + 256;
    LAS unsigned* wtot = hist + 264;
    for (int it = blockIdx.x; it < NB * NEXP; it += G) {
        const int b = it >> 4, e = it & 15;
        unsigned v[8];
#pragma unroll
        for (int j = 0; j < 8; ++j) v[j] = __builtin_bit_cast(unsigned, AFF[((size_t)b * SEQ + tid * 8 + j) * 16 + e]);
        unsigned prefix = 0u, mask = 0u, need = CAP;
        for (int shift = 24; shift >= 0; shift -= 8) {
            __syncthreads();
            if (tid < 256) hist[tid] = 0u;
            __syncthreads();
#pragma unroll
            for (int j = 0; j < 8; ++j) if ((v[j] & mask) == prefix) atomicAdd((unsigned*)&hist[(v[j] >> shift) & 255u], 1u);
            __syncthreads();
            if (tid < 64) {
                unsigned cb[4], tot = 0u;
#pragma unroll
                for (int k = 0; k < 4; ++k) { cb[k] = hist[255 - 4 * lane - k]; tot += cb[k]; }
                unsigned inc = tot;
#pragma unroll
                for (int o = 1; o < 64; o <<= 1) { const unsigned a = __shfl_up(inc, o); if (lane >= o) inc += a; }
                unsigned cum = inc - tot;
#pragma unroll
                for (int k = 0; k < 4; ++k) { if (cum < need && need <= cum + cb[k]) { ctl[0] = (unsigned)(255 - 4 * lane - k); ctl[1] = need - cum; } cum += cb[k]; }
            }
            __syncthreads();
            prefix |= ctl[0] << shift; mask |= 255u << shift; need = ctl[1];
        }
        unsigned ngt = 0u, neq = 0u;
#pragma unroll
        for (int j = 0; j < 8; ++j) { ngt += (v[j] > prefix) ? 1u : 0u; neq += (v[j] == prefix) ? 1u : 0u; }
        unsigned sg = ngt, se = neq;
#pragma unroll
        for (int o = 1; o < 64; o <<= 1) { const unsigned a = __shfl_up(sg, o), c2 = __shfl_up(se, o); if (lane >= o) { sg += a; se += c2; } }
        __syncthreads();
        if (lane == 63) { wtot[wave] = sg; wtot[8 + wave] = se; }
        __syncthreads();
        unsigned og = sg - ngt, oe = se - neq, totg = 0u;
        for (int w = 0; w < 8; ++w) { const unsigned a = wtot[w], c2 = wtot[8 + w]; if (w < wave) { og += a; oe += c2; } totg += a; }
#pragma unroll
        for (int j = 0; j < 8; ++j) {
            const int tkn = tid * 8 + j; int slot = -1;
            if (v[j] > prefix) slot = (int)og++;
            else if (v[j] == prefix) { if (oe < need) slot = (int)(totg + oe); ++oe; }
            const int erow = b * CAP + slot;
            SLOT[((size_t)b * SEQ + tkn) * 16 + e] = (slot >= 0) ? erow : -1;
            if (slot >= 0) { SELIDX[e * EROWS + erow] = b * SEQ + tkn; SELG[e * EROWS + erow] = __builtin_bit_cast(float, v[j]); }
        }
    }
    __syncthreads();
    {
        LAS float* scr = (LAS float*)(lds + wave * TR_SCR);
        unsigned char* WGU = ws + WS_WGU; unsigned char* WD = ws + WS_WD;
        const int gw = blockIdx.x * NWAVES + wave, NGW = G * NWAVES;
        constexpr int I_G = 16 * 32, I_D = 32 * 16;
        for (int it = gw; it < 16 * (2 * I_G + I_D); it += NGW) {
            const int e = it / (2 * I_G + I_D); int r = it % (2 * I_G + I_D);
            if (r < 2 * I_G) { const int up = r / I_G; r %= I_G; const int kb = r / 32, nb = r % 32;
                const float* W = (up ? p.w_exp_up : p.w_exp_gate) + (size_t)e * 1024 * 2048;
                transpose_item_f8(W, 2048, 64 * kb, 64 * nb, WGU + (size_t)e * 4096 * 1024, 1024, [up](int n) { return 256 * (n >> 7) + 128 * up + (n & 127); }, scr, lane); }
            else { r -= 2 * I_G; const int kb = r / 16, nb = r % 16;
                transpose_item_f8(p.w_exp_down + (size_t)e * 2048 * 1024, 1024, 64 * kb, 64 * nb, WD + (size_t)e * 1024 * 2048, 2048, [](int n) { return n; }, scr, lane); }
        }
    }
}

__device__ __forceinline__ void phase_final(const Params& p, LAS unsigned char* lds, const bool dry) {
    const int tid = threadIdx.x, lane = tid & 63, wave = tid >> 6, G = gridDim.x;
    unsigned char* ws = p.ws;
    const float* MOD = (const float*)(ws + WS_MOD); const int* SLOT = (const int*)(ws + WS_SLOT); const unsigned char* YE = ws + WS_YE; const float* SELG = (const float*)(ws + WS_SELG);
    const bf16_t* X1 = (const bf16_t*)(ws + WS_X1);
    const int gw = blockIdx.x * NWAVES + wave, NGW = G * NWAVES;
    const int per = (MLAT + NGW - 1) / NGW, r_lo = gw * per, r_hi = min(r_lo + per, MLAT);
    if (r_lo >= r_hi) return;
    f32x4 g2v[4], fnv[4]; int bcur = -1;
#pragma unroll
    for (int j = 0; j < 4; ++j) fnv[j] = *(const f32x4*)(p.final_norm + 4 * lane + 256 * j);
    u32x2 nx[2][4]; int nslot[2]; float ngate[2];
#define FN_PREFETCH(r_) do { _Pragma("unroll") for (int t = 0; t < 2; ++t) { const int rr = (r_) + t; nslot[t] = -1; ngate[t] = 0.f; \
        if (rr < r_hi) { const u32x2* xr_ = (const u32x2*)(X1 + (size_t)rr * DM) + lane; _Pragma("unroll") for (int j = 0; j < 4; ++j) nx[t][j] = xr_[64 * j]; \
            if (lane < 16) { nslot[t] = SLOT[(size_t)rr * 16 + lane]; if (nslot[t] >= 0) ngate[t] = SELG[lane * EROWS + nslot[t]]; } } } } while (0)
    FN_PREFETCH(r_lo);
    for (int row = r_lo; row < r_hi; row += 2) {
        const int b = row >> 12;
        if (b != bcur) { bcur = b;
#pragma unroll
            for (int j = 0; j < 4; ++j) g2v[j] = *(const f32x4*)(MOD + (size_t)b * 6144 + 5120 + 4 * lane + 256 * j); }
        u32x2 cx[2][4]; int myslot[2]; float mygate[2]; unsigned long long live[2]; unsigned yv[2][4][4]; float gt[2][4];
#pragma unroll
        for (int t = 0; t < 2; ++t) { myslot[t] = nslot[t]; mygate[t] = ngate[t]; live[t] = __ballot(myslot[t] >= 0);
#pragma unroll
            for (int j = 0; j < 4; ++j) cx[t][j] = nx[t][j]; }
#pragma unroll
        for (int t = 0; t < 2; ++t)
#pragma unroll
            for (int q = 0; q < 4; ++q) {
                const bool on = live[t] != 0ull; const int e = on ? __builtin_ctzll(live[t]) : 0; live[t] &= live[t] - 1ull;
                const int sl = __shfl(myslot[t], e); gt[t][q] = on ? __shfl(mygate[t], e) : 0.f;
                const unsigned* yp = (const unsigned*)(YE + ((size_t)e * EROWS + (on ? sl : 0)) * DM) + lane;
                if (on) {
#pragma unroll
                    for (int j = 0; j < 4; ++j) yv[t][q][j] = yp[64 * j];
                } else {
#pragma unroll
                    for (int j = 0; j < 4; ++j) yv[t][q][j] = 0u;
                }
            }
        FN_PREFETCH(row + 2);
#pragma unroll
        for (int t = 0; t < 2; ++t) {
            if (row + t >= r_hi) break;
            f32x4 v[4], mo[4];
#pragma unroll
            for (int j = 0; j < 4; ++j) { v[j] = (f32x4){bf2f(cx[t][j].x & 0xffffu), bf2f(cx[t][j].x >> 16), bf2f(cx[t][j].y & 0xffffu), bf2f(cx[t][j].y >> 16)}; mo[j] = (f32x4){0.f, 0.f, 0.f, 0.f}; }
#pragma unroll
            for (int q = 0; q < 4; ++q)
#pragma unroll
                for (int j = 0; j < 4; ++j) { const f32x2 lo = __builtin_amdgcn_cvt_pk_f32_fp8((int)yv[t][q][j], false), hi = __builtin_amdgcn_cvt_pk_f32_fp8((int)yv[t][q][j], true);
                    mo[j].x += gt[t][q] * lo.x; mo[j].y += gt[t][q] * lo.y; mo[j].z += gt[t][q] * hi.x; mo[j].w += gt[t][q] * hi.y; }
            while (live[t]) {
                const int e = __builtin_ctzll(live[t]); live[t] &= live[t] - 1ull;
                const int sl = __shfl(myslot[t], e); const float g1 = __shfl(mygate[t], e);
                const unsigned* yp = (const unsigned*)(YE + ((size_t)e * EROWS + sl) * DM) + lane;
#pragma unroll
                for (int j = 0; j < 4; ++j) { const int w = (int)yp[64 * j]; const f32x2 lo = __builtin_amdgcn_cvt_pk_f32_fp8(w, false), hi = __builtin_amdgcn_cvt_pk_f32_fp8(w, true);
                    mo[j].x += g1 * lo.x; mo[j].y += g1 * lo.y; mo[j].z += g1 * hi.x; mo[j].w += g1 * hi.y; }
            }
            float ss = 0.f;
#pragma unroll
            for (int j = 0; j < 4; ++j) { v[j] = v[j] + g2v[j] * mo[j]; ss += (v[j].x * v[j].x + v[j].y * v[j].y) + (v[j].z * v[j].z + v[j].w * v[j].w); }
            const float rs = 1.0f / sqrtf(wave_sum(ss) * (1.0f / DM) + 1e-6f);
            f32x4* xo = (f32x4*)(p.out + (size_t)(row + t) * DM) + lane;
#pragma unroll
            for (int j = 0; j < 4; ++j) { if (!dry) xo[64 * j] = v[j] * rs * fnv[j]; }
        }
    }
#undef FN_PREFETCH
}

#define XB_TMO      128
#define XB_XCNT(j)  (256  + 64 * (j))
#define XB_XSUB(j)  (1280 + 64 * (j))
#define XB_XGEN(j)  (2304 + 64 * (j))
#define XB_TOP      3328
#define XB_TOPGEN   3392
#define XCD_BAR_WORDS 3456
#define XB_SPIN_CAP (1u << 20)
__device__ __forceinline__ unsigned xb_ld(unsigned* p)              { return __hip_atomic_load(p, __ATOMIC_RELAXED, __HIP_MEMORY_SCOPE_AGENT); }
__device__ __forceinline__ unsigned xb_add(unsigned* p, unsigned v) { return __hip_atomic_fetch_add(p, v, __ATOMIC_RELAXED, __HIP_MEMORY_SCOPE_AGENT); }
__device__ __forceinline__ unsigned xb_xcc_id() { return (unsigned)__builtin_amdgcn_s_getreg((3 << 11) | 20) & 0xFu; }
#define XB_SPIN(cond, bar) do { unsigned _sp = 0; while (cond) { __builtin_amdgcn_s_sleep(1); \
    if ((++_sp & 255u) == 0u) { if (xb_ld(&(bar)[XB_TMO])) break; if (_sp > XB_SPIN_CAP) { atomicAdd(&(bar)[XB_TMO], 1u); break; } } } } while (0)
struct XcdBarrier { unsigned* bar; unsigned x; volatile LAS unsigned* st; };
__device__ __forceinline__ XcdBarrier xcd_barrier_post(unsigned* bar, volatile LAS unsigned* st) {
    XcdBarrier b; b.bar = bar; b.x = xb_xcc_id(); b.st = st;
    if (threadIdx.x == 0) (void)xb_add(&bar[XB_XCNT(b.x)], 1u);
    return b;
}
__device__ __forceinline__ void xcd_barrier_complete(unsigned* bar, unsigned x, unsigned& nloc, unsigned& nx) {
    const unsigned G = gridDim.x * gridDim.y * gridDim.z;
    unsigned sum, cnt, mine, sp = 0u;
    for (;;) {
        sum = 0u; cnt = 0u; mine = 0u;
#pragma unroll
        for (unsigned j = 0; j < 16; ++j) { const unsigned c = xb_ld(&bar[XB_XCNT(j)]); sum += c; cnt += (c > 0u) ? 1u : 0u; mine = (j == x) ? c : mine; }
        if (sum == G) break;
        __builtin_amdgcn_s_sleep(1);
        if ((++sp & 255u) == 0u) { if (xb_ld(&bar[XB_TMO])) break; if (sp > XB_SPIN_CAP) { atomicAdd(&bar[XB_TMO], 1u); break; } }
    }
    nloc = mine > 0u ? mine : 1u; nx = cnt > 0u ? cnt : 1u;
}
__device__ __forceinline__ void xcd_barrier(const XcdBarrier& b) {
    asm volatile("s_waitcnt vmcnt(0)" ::: "memory");
    __syncthreads();
    if (threadIdx.x == 0) {
        unsigned* bar = b.bar;
        __builtin_amdgcn_s_waitcnt(0);
        unsigned nloc = b.st[0], nx = b.st[1];
        if (nloc == 0u) { xcd_barrier_complete(bar, b.x, nloc, nx); b.st[0] = nloc; b.st[1] = nx; }
        const unsigned old = xb_add(&bar[XB_XSUB(b.x)], 1u);
        const unsigned gen = old / nloc;
        if (old + 1u == (gen + 1u) * nloc) {
            __builtin_amdgcn_fence(__ATOMIC_RELEASE, "agent");
            asm volatile("s_waitcnt vmcnt(0)" ::: "memory");
            const unsigned og = xb_add(&bar[XB_TOP], 1u);
            const unsigned tg = og / nx;
            if (og + 1u == (tg + 1u) * nx) xb_add(&bar[XB_TOPGEN], 1u);
            else XB_SPIN(xb_ld(&bar[XB_TOPGEN]) == tg, bar);
            __builtin_amdgcn_fence(__ATOMIC_ACQUIRE, "agent");
            xb_add(&bar[XB_XGEN(b.x)], 1u);
            asm volatile("s_waitcnt vmcnt(0)" ::: "memory");
        } else {
            XB_SPIN(xb_ld(&bar[XB_XGEN(b.x)]) == gen, bar);
            __builtin_amdgcn_fence(__ATOMIC_ACQUIRE, "agent");
            asm volatile("s_waitcnt vmcnt(0)" ::: "memory");
        }
    }
    __syncthreads();
}

constexpr int NPHASE = 12;
__global__ void __launch_bounds__(NTHREADS, 2) mk_fwd(Params p) {
    extern __shared__ __attribute__((aligned(16))) unsigned char lds_raw[];
    LAS unsigned char* lds = (LAS unsigned char*)lds_raw;
    cg::grid_group grid = cg::this_grid();
    unsigned char* ws = p.ws;
    const int G = gridDim.x, cblk = blockIdx.x;
#ifndef PH_MASK
#define PH_MASK 0xfff
#endif
#define IN(k) (((PH_MASK >> (k)) & 1) && p.ph_lo <= (k) && (k) < p.ph_hi)
    { volatile LAS unsigned* st0 = (volatile LAS unsigned*)(lds + LDS_BYTES - 256); if (threadIdx.x < 64) st0[threadIdx.x] = 0u; }
    __syncthreads();
    XcdBarrier xbar = xcd_barrier_post((unsigned*)(ws + WS_CTL) + 4096, (volatile LAS unsigned*)(lds + LDS_BYTES - 256));
    if (p.ph_lo < 0) grid.sync();
#define SEAM(k) do { if (IN(k) && IN((k) + 1)) xcd_barrier(xbar); } while (0)
    if (IN(0)) phase_prep(p, lds);
    SEAM(0);
    if (IN(1)) { phase_prep_weights(p, lds); phase_norm1(p, lds); }
    SEAM(1);
    if (IN(2)) {
        InprojSched S{(const bf16_t*)(ws + WS_XN), (const bf16_t*)(ws + WS_WINT), G, cblk, 1024, 1024, 1024};
        EpiInproj<false> E{(bf16_t*)(ws + WS_Z), (bf16_t*)(ws + WS_ZC), (const float*)(ws + WS_BINZ), (const float*)(ws + WS_ROPE)};
        if (p.probe & 4) { EpiInproj<true> E2{(bf16_t*)(ws + WS_Z), (bf16_t*)(ws + WS_ZC), (const float*)(ws + WS_BINZ), (const float*)(ws + WS_ROPE)}; pg8::gemm_phase<EpiInproj<true>, InprojSched>(lds, S, E2); xcd_barrier(xbar); }
        if (p.probe & 32768) { pg8::gemm_phase<EpiInproj<false>, InprojSched>(lds, S, E); xcd_barrier(xbar); }
        pg8::gemm_phase<EpiInproj<false>, InprojSched>(lds, S, E);
    }
    SEAM(2);
    if (IN(3)) { if (p.probe & 8) { phase_rnn(p, lds, true); __syncthreads(); } phase_rnn(p, lds, false); }
    if (IN(3) && IN(4)) __syncthreads();
    if (IN(4)) { if (p.probe & 16) { phase_attn(p, lds, true); __syncthreads(); } phase_attn(p, lds, false); }
    SEAM(4);
    if (IN(5)) {
        MixSched S{(const bf16_t*)(ws + WS_Z), (const bf16_t*)(ws + WS_WMIX), G, cblk, LDZ, 2048, 2048};
        EpiMix E{(bf16_t*)(ws + WS_Z)};
        pg8::gemm_phase<EpiMix, MixSched>(lds, S, E);
    }
    SEAM(5);
    if (IN(6)) {
        WoutSched S{(const bf16_t*)(ws + WS_Z), (const bf16_t*)(ws + WS_WOUT), G, cblk, LDZ, 1024, 1024};
        EpiWout E{p.x, (bf16_t*)(ws + WS_X1), (const float*)(ws + WS_MOD)};
        pg8::gemm_phase<EpiWout, WoutSched>(lds, S, E);
    }
    SEAM(6);
    if (IN(7)) phase_norm2(p, lds);
    SEAM(7);
    if (IN(8)) phase_topk(p, lds);
    SEAM(8);
    if (IN(9)) {
        Moe1Sched S{ws + WS_XN2, ws + WS_WGU, (const int*)(ws + WS_SELIDX), G, cblk, 1024, 1024, 1024};
        EpiMoe1 E{ws + WS_HID};
        pg8::gemm_phase<EpiMoe1, Moe1Sched, true>(lds, S, E);
    }
    SEAM(9);
    if (IN(10)) {
        Moe2Sched S{ws + WS_HID, ws + WS_WD, G, cblk, 2048, 2048, 2048};
        EpiMoe2 E{ws + WS_YE};
        pg8::gemm_phase<EpiMoe2, Moe2Sched, true>(lds, S, E);
    }
    SEAM(10);
    if (IN(11)) { if (p.probe & 2048) { phase_final(p, lds, true); __syncthreads(); } phase_final(p, lds, false); }
#undef IN
#undef SEAM
}

#ifndef MK_SINGLE
#define MK_SINGLE 1
#endif
extern "C" void kernel_launch(void* const* d_in, const int* in_sizes, int n_in, void* d_out, int out_size, void* d_ws, size_t ws_size, hipStream_t stream) {
    static int grid = 0;
    if (grid == 0) {
        int dev = 0, cus = 0, per_cu = 0;
        if (n_in != 24 || out_size != MLAT * DM || ws_size < WS_END) { fprintf(stderr, "kernel_launch: unexpected problem (n_in %d, out %d, ws %zu < %zu)\n", n_in, out_size, ws_size, (size_t)WS_END); grid = -1; return; }
        if (hipGetDevice(&dev) != hipSuccess || hipDeviceGetAttribute(&cus, hipDeviceAttributeMultiprocessorCount, dev) != hipSuccess) { grid = -1; return; }
        if (hipFuncSetAttribute((const void*)mk_fwd, hipFuncAttributeMaxDynamicSharedMemorySize, LDS_BYTES) != hipSuccess) { fprintf(stderr, "kernel_launch: hipFuncSetAttribute failed\n"); grid = -1; return; }
        if (hipOccupancyMaxActiveBlocksPerMultiprocessor(&per_cu, (const void*)mk_fwd, NTHREADS, LDS_BYTES) != hipSuccess || per_cu < 1) { fprintf(stderr, "kernel_launch: occupancy query says %d\n", per_cu); grid = -1; return; }
        grid = cus;
    }
    if (grid < 0) return;
    (void)hipMemsetAsync((char*)d_ws + WS_CTL, 0, 1 * MiB, stream);
    Params p{};
    const float** pp = (const float**)&p;
    for (int i = 0; i < 24; ++i) pp[i] = (const float*)d_in[i];
#ifndef PROBE_MASK
#define PROBE_MASK 0
#endif
    p.out = (float*)d_out; p.ws = (unsigned char*)d_ws; p.probe = PROBE_MASK;
#if MK_SINGLE
    p.ph_lo = 0; p.ph_hi = NPHASE;
    void* args[] = {&p};
    hipError_t e = hipLaunchCooperativeKernel((const void*)mk_fwd, dim3(grid), dim3(NTHREADS), args, LDS_BYTES, stream);
    if (e != hipSuccess) fprintf(stderr, "kernel_launch: cooperative launch failed: %s (grid %d)\n", hipGetErrorString(e), grid);
#else
#ifndef REP_MASK
#define REP_MASK 0
#endif
    for (int ph = 0; ph < NPHASE; ++ph) {
        p.ph_lo = ph; p.ph_hi = ph + 1;
        for (int rep = 0; rep < 1 + ((REP_MASK >> ph) & 1); ++rep) hipLaunchKernelGGL(mk_fwd, dim3(grid), dim3(NTHREADS), LDS_BYTES, stream, p);
    }
#endif
}
```

```cpp
#include <hip/hip_runtime.h>
#include <hip/hip_cooperative_groups.h>
#include <cstdio>
#include <cstdint>
namespace cg = cooperative_groups;

#define LAS __attribute__((address_space(3)))
typedef unsigned short bf16_t;
typedef short bf16x8 __attribute__((ext_vector_type(8)));
typedef float f32x4 __attribute__((ext_vector_type(4)));
typedef float f32x2 __attribute__((ext_vector_type(2)));
typedef unsigned u32x4 __attribute__((ext_vector_type(4)));
typedef unsigned u32x2 __attribute__((ext_vector_type(2)));

constexpr int NB = 8, SEQ = 4096, DM = 1024, CTX = 256;
constexpr int MLAT = NB * SEQ, MCTX = NB * CTX;
constexpr int NIN = 7168, NEXP = 16, DEXP = 2048, CAP = 512, EROWS = NB * CAP;
constexpr int LDZ = 7168, ZC_YG = 0, ZC_Q = 1024, ZC_XR = 2048, ZC_K = 3072, ZC_V = 4096, ZC_GR = 5120, ZC_GN = 6144;
constexpr int LDC = 3072, CC_XR = 0, CC_K = 1024, CC_V = 2048;
constexpr float LOG2E = 1.4426950408889634f;
constexpr float QSCALE = 0.125f * LOG2E;

constexpr size_t MiB = 1u << 20;
constexpr size_t WS_CTL = 0;
constexpr size_t WS_MOD = 1 * MiB;
constexpr size_t WS_MODP = 2 * MiB;
constexpr size_t WS_ROPE = 9 * MiB;
constexpr size_t WS_BINZ = 9 * MiB + 65536;
constexpr size_t WS_AFF = 10 * MiB;
constexpr size_t WS_SELIDX = 12 * MiB;
constexpr size_t WS_SELG = 12 * MiB + 262144;
constexpr size_t WS_SLOT = 13 * MiB;
constexpr size_t WS_WINT = 16 * MiB;
constexpr size_t WS_WMIX = 30 * MiB;
constexpr size_t WS_WOUT = 34 * MiB;
constexpr size_t WS_ZC = 36 * MiB;
constexpr size_t WS_XN = 48 * MiB;
constexpr size_t WS_Z = 116 * MiB;
constexpr size_t WS_WGU = 116 * MiB;
constexpr size_t WS_WD = 180 * MiB;
constexpr size_t WS_HID = 212 * MiB;
constexpr size_t WS_YE = 340 * MiB;
constexpr size_t WS_X1 = 48 * MiB;
constexpr size_t WS_XN2 = 468 * MiB;
constexpr size_t WS_END = 564 * MiB;

constexpr int NTHREADS = 512, NWAVES = 8;
constexpr int LDS_BYTES = 147456;

__device__ __forceinline__ unsigned f2bf(float f) { unsigned u = __builtin_bit_cast(unsigned, f); return (u + 0x7fffu + ((u >> 16) & 1u)) >> 16; }
__device__ __forceinline__ float bf2f(unsigned h) { return __builtin_bit_cast(float, h << 16); }
__device__ __forceinline__ unsigned pk2(float lo, float hi) { return f2bf(lo) | (f2bf(hi) << 16); }
__device__ __forceinline__ unsigned cvt_pk_bf16(float lo, float hi) { unsigned r; asm volatile("v_cvt_pk_bf16_f32 %0, %1, %2" : "=v"(r) : "v"(lo), "v"(hi)); return r; }
__device__ __forceinline__ float wave_sum(float v) {
#pragma unroll
    for (int o = 1; o < 64; o <<= 1) v += __shfl_xor(v, o);
    return v;
}
__device__ __forceinline__ float sigmoidf_(float x) { return __builtin_amdgcn_rcpf(1.0f + __builtin_amdgcn_exp2f(-x * LOG2E)); }
__device__ __forceinline__ float gelu_tanh(float x) { const float u = 0.7978845608028654f * (x + 0.044715f * x * x * x); return x * __builtin_amdgcn_rcpf(1.0f + __builtin_amdgcn_exp2f(-2.0f * LOG2E * u)); }
#define LDS_WAIT() asm volatile("s_waitcnt lgkmcnt(0)" ::: "memory")

namespace pg8 {
constexpr int BM = 256, BK = 64, HALF = 128, HTB = HALF * BK * 2, STAGE_BYTES = 8 * HTB, NXCD = 8, WGM = 8;
__host__ __device__ __forceinline__ int swz_f(int r) { const int u = (r >> 1) & 7; return (u & 3) | ((((u >> 1) ^ (u >> 2)) & 1) << 2); }
__host__ __device__ __forceinline__ int lds_byte(int r, int c) { return r * 128 + ((((c >> 3) ^ swz_f(r)) << 4) | ((c & 7) * 2)); }
__host__ __device__ __forceinline__ void stage_rc(int b, int& R, int& C) { R = b >> 7; C = (((b >> 4) & 7) ^ swz_f(R)) * 8; }
__host__ __device__ __forceinline__ int perm32(int rho) { const int n = rho >> 4, i = rho & 15; return 8 * (i >> 2) + 4 * n + (i & 3); }

struct Unit { int pm, pb, x0, x1; };

__device__ __forceinline__ void tile_of(int L, int nM, int nN, int& pm, int& pn) {
    const int nwg = nM * nN; int wgid = L;
    { const int q = nwg / NXCD, r = nwg % NXCD, xcd = wgid % NXCD, off = wgid / NXCD; wgid = (xcd < r ? xcd * (q + 1) : r * (q + 1) + (xcd - r) * q) + off; }
    const int nig = WGM * nN, gid = wgid / nig, fm = gid * WGM, gsz = (nM - fm) < WGM ? (nM - fm) : WGM;
    pm = fm + ((wgid % nig) % gsz); pn = (wgid % nig) / gsz;
}

typedef int i32x8 __attribute__((ext_vector_type(8)));
constexpr int F8_SCALE_W = 0x79797979, F8_SCALE_X = 0x7f7f7f7f;
template <class Epi, class Sched, bool F8 = false>
__device__ __forceinline__ void gemm_phase(LAS unsigned char* lds, const Sched& S, const Epi& E) {
    const int tid = threadIdx.x, wid = __builtin_amdgcn_readfirstlane(tid >> 6), lane = tid & 63, wr = wid >> 2, wc = wid & 3, fr = lane & 15, fq = lane >> 4;
    constexpr int ESZ = F8 ? 1 : 2;
    const int K = S.K, nt = K * ESZ / (BK * 2);
    int Rl[2], Cl[2];
    unsigned voffA[2][2], voffB[2];
#pragma unroll
    for (int i = 0; i < 2; ++i) { stage_rc(tid * 16 + i * 8192, Rl[i], Cl[i]); const int Rb = Epi::PERM ? ((Rl[i] & ~31) + perm32(Rl[i] & 31)) : Rl[i];
        voffB[i] = (unsigned)(Rb * S.ldb * ESZ + Cl[i] * 2); }
    const size_t kstep = (size_t)(BK * 2);
    const size_t hstepB = (size_t)HALF * S.ldb * ESZ, hstepA = (size_t)HALF * S.lda * ESZ;
    const unsigned ldsw = (unsigned)wid * 1024u;
    const int aof0 = F8 ? lds_byte(wr * 64 + fr, fq * 16) : lds_byte(wr * 64 + fr, fq * 8), aof1 = F8 ? lds_byte(wr * 64 + fr, fq * 16 + 8) : lds_byte(wr * 64 + fr, 32 + fq * 8);
    const int bof0 = F8 ? lds_byte(wc * 32 + fr, fq * 16) : lds_byte(wc * 32 + fr, fq * 8), bof1 = F8 ? lds_byte(wc * 32 + fr, fq * 16 + 8) : lds_byte(wc * 32 + fr, 32 + fq * 8);
#define PG8_SA(b, h) (((b) * 2 + (h)) * HTB)
#define PG8_SB(b, h) ((4 + (b) * 2 + (h)) * HTB)
#define PG8_STAGEB(bufoff, gbase) do { _Pragma("unroll") for (int _i = 0; _i < 2; ++_i) \
        __builtin_amdgcn_global_load_lds((const unsigned*)((const char*)(gbase) + voffB[_i]), (LAS unsigned*)(lds + (bufoff) + ldsw + _i * 8192), 16, 0, 0); } while (0)
#define PG8_STAGEA(bufoff, gbase, h, vo) do { _Pragma("unroll") for (int _i = 0; _i < 2; ++_i) { \
        if constexpr (Sched::GATHER) __builtin_amdgcn_global_load_lds((const unsigned*)((const char*)(gbase) + (vo)[h][_i]), (LAS unsigned*)(lds + (bufoff) + ldsw + _i * 8192), 16, 0, 0); \
        else __builtin_amdgcn_global_load_lds((const unsigned*)((const char*)(gbase) + (h) * hstepA + (vo)[0][_i]), (LAS unsigned*)(lds + (bufoff) + ldsw + _i * 8192), 16, 0, 0); } } while (0)
#define PG8_LD8(d, alo, ahi) do { const u32x4 lo_ = *(const LAS u32x4*)(alo), hi_ = *(const LAS u32x4*)(ahi); d = (i32x8){(int)lo_.x, (int)lo_.y, (int)lo_.z, (int)lo_.w, (int)hi_.x, (int)hi_.y, (int)hi_.z, (int)hi_.w}; } while (0)
#define PG8_LDA(dst, b, h) do { if constexpr (F8) { _Pragma("unroll") for (int m = 0; m < 4; ++m) PG8_LD8(dst##8[m], lds + PG8_SA(b, h) + aof0 + m * 2048, lds + PG8_SA(b, h) + aof1 + m * 2048); } \
        else { _Pragma("unroll") for (int m = 0; m < 4; ++m) _Pragma("unroll") for (int k = 0; k < 2; ++k) dst[m][k] = *(const LAS bf16x8*)(lds + PG8_SA(b, h) + (k ? aof1 : aof0) + m * 2048); } } while (0)
#define PG8_LDB(dst, b, h) do { if constexpr (F8) { _Pragma("unroll") for (int n = 0; n < 2; ++n) PG8_LD8(dst##8[n], lds + PG8_SB(b, h) + bof0 + n * 2048, lds + PG8_SB(b, h) + bof1 + n * 2048); } \
        else { _Pragma("unroll") for (int n = 0; n < 2; ++n) _Pragma("unroll") for (int k = 0; k < 2; ++k) dst[n][k] = *(const LAS bf16x8*)(lds + PG8_SB(b, h) + (k ? bof1 : bof0) + n * 2048); } } while (0)
#define PG8_MMA(ai, bj, At, Bt) do { __builtin_amdgcn_s_setprio(1); _Pragma("unroll") for (int m = 0; m < 4; ++m) _Pragma("unroll") for (int n = 0; n < 2; ++n) { \
        if constexpr (F8) acc[ai][bj][m][n] = __builtin_amdgcn_mfma_scale_f32_16x16x128_f8f6f4(Bt##8[n], At##8[m], acc[ai][bj][m][n], 0, 0, 0, F8_SCALE_W, 0, F8_SCALE_X); \
        else { _Pragma("unroll") for (int k = 0; k < 2; ++k) acc[ai][bj][m][n] = __builtin_amdgcn_mfma_f32_16x16x32_bf16(Bt[n][k], At[m][k], acc[ai][bj][m][n], 0, 0, 0); } } \
        __builtin_amdgcn_s_setprio(0); } while (0)
#define PG8_WAIT_V(n) asm volatile("s_waitcnt vmcnt(" #n ")" ::: "memory")
#define PG8_WAIT_L(n) asm volatile("s_waitcnt lgkmcnt(" #n ")" ::: "memory")
#define PG8_BAR __builtin_amdgcn_s_barrier()
#define PG8_SCHED __builtin_amdgcn_sched_barrier(0)
#define PG8_SETVO(vo, u) do { _Pragma("unroll") for (int _h = 0; _h < 2; ++_h) _Pragma("unroll") for (int _i = 0; _i < 2; ++_i) { \
        if constexpr (Sched::GATHER) (vo)[_h][_i] = (unsigned)(S.row_of(u, _h * HALF + Rl[_i]) * S.lda * ESZ + Cl[_i] * 2); \
        else (vo)[_h][_i] = (unsigned)((_h * HALF + Rl[_i]) * S.lda * ESZ + Cl[_i] * 2); } } while (0)
#define PG8_TRIP_BODY \
            const bool last = (t == nt - 2); \
            const char* a1 = cA + (size_t)(t + 1) * kstep; \
            const char* a2 = last ? nA : cA + (size_t)(t + 2) * kstep; const char* b2 = last ? nB : cB + (size_t)(t + 2) * kstep; \
            const char* a3 = a2 + kstep; const char* b3 = b2 + kstep; \
            PG8_LDB(B0, 0, 0); PG8_LDB(B1, 0, 1); PG8_SCHED; PG8_LDA(At, 0, 0); PG8_STAGEA(PG8_SA(1, 1), a1, 1, voffA); \
            if (last && has_next) { PG8_SETVO(voffA, nxt); asm volatile("" : "+v"(voffA[0][0]), "+v"(voffA[0][1]), "+v"(voffA[1][0]), "+v"(voffA[1][1])); } \
            PG8_WAIT_V(8); PG8_WAIT_L(0); PG8_BAR; PG8_MMA(0, 0, At, B0); PG8_MMA(0, 1, At, B1); PG8_BAR; PG8_SCHED; \
            PG8_LDA(At, 0, 1); PG8_STAGEB(PG8_SB(0, 0), b2); PG8_STAGEB(PG8_SB(0, 1), b2 + hstepB); PG8_STAGEA(PG8_SA(0, 0), a2, 0, voffA); \
            PG8_WAIT_V(8); PG8_WAIT_L(0); PG8_BAR; PG8_MMA(1, 0, At, B0); PG8_MMA(1, 1, At, B1); PG8_BAR; PG8_SCHED; \
            PG8_LDB(B0, 1, 0); PG8_LDB(B1, 1, 1); PG8_SCHED; PG8_LDA(At, 1, 0); PG8_STAGEA(PG8_SA(0, 1), a2, 1, voffA); \
            PG8_WAIT_V(8); PG8_WAIT_L(0); PG8_BAR; PG8_MMA(0, 0, At, B0); PG8_MMA(0, 1, At, B1); PG8_BAR; PG8_SCHED; \
            PG8_LDA(At, 1, 1); PG8_STAGEB(PG8_SB(1, 0), b3); PG8_STAGEB(PG8_SB(1, 1), b3 + hstepB); PG8_STAGEA(PG8_SA(1, 0), a3, 0, voffA); \
            PG8_WAIT_V(8); PG8_WAIT_L(0); PG8_BAR; PG8_MMA(1, 0, At, B0); PG8_MMA(1, 1, At, B1); PG8_BAR; PG8_SCHED; \

    Unit cur, nxt; int ui = 0;
    if (!S.next(0, cur)) return;
    f32x4 acc[2][2][4][2];
#pragma unroll
    for (int a = 0; a < 2; ++a)
#pragma unroll
        for (int b = 0; b < 2; ++b)
#pragma unroll
            for (int m = 0; m < 4; ++m)
#pragma unroll
                for (int n = 0; n < 2; ++n) acc[a][b][m][n] = (f32x4){0.f, 0.f, 0.f, 0.f};
    bf16x8 At[4][2], B0[2][2], B1[2][2];
    i32x8 At8[4], B08[2], B18[2];
    const char* cA = S.a_ptr(cur); const char* cB = S.b_ptr(cur);
    PG8_SETVO(voffA, cur);
    PG8_STAGEB(PG8_SB(0, 0), cB); PG8_STAGEB(PG8_SB(0, 1), cB + hstepB); PG8_STAGEA(PG8_SA(0, 0), cA, 0, voffA); PG8_STAGEA(PG8_SA(0, 1), cA, 1, voffA);
    if (wr == 1) PG8_BAR;
    PG8_WAIT_V(2); PG8_BAR;
    PG8_STAGEB(PG8_SB(1, 0), cB + kstep); PG8_STAGEA(PG8_SA(1, 0), cA + kstep, 0, voffA); PG8_STAGEB(PG8_SB(1, 1), cB + hstepB + kstep);
    PG8_WAIT_V(6); PG8_BAR;
    for (;;) {
        const bool has_next = S.next(ui + 1, nxt);
        const char* nA = has_next ? S.a_ptr(nxt) : cA; const char* nB = has_next ? S.b_ptr(nxt) : cB;
        if constexpr (Epi::MID) {
#pragma unroll 1
            for (int t = 0; t < (nt >> 1); t += 2) { PG8_TRIP_BODY }
            PG8_SCHED; E.mid(acc, cur, wr, wc, fr, fq); PG8_SCHED;
#pragma unroll 1
            for (int t = (nt >> 1); t < nt; t += 2) { PG8_TRIP_BODY }
        } else {
#pragma unroll 1
            for (int t = 0; t < nt; t += 2) { PG8_TRIP_BODY }
        }
        if (wr == 0) PG8_BAR;
        E(acc, cur, wr, wc, fr, fq);
        if (!has_next) break;
#pragma unroll
        for (int a = 0; a < 2; ++a)
#pragma unroll
            for (int b = 0; b < 2; ++b)
#pragma unroll
                for (int m = 0; m < 4; ++m)
#pragma unroll
                    for (int n = 0; n < 2; ++n) acc[a][b][m][n] = (f32x4){0.f, 0.f, 0.f, 0.f};
        cur = nxt; cA = nA; cB = nB; ++ui;
        if (wr == 1) PG8_BAR;
    }
    PG8_WAIT_V(0);
    PG8_BAR;
#undef PG8_SA
#undef PG8_SB
#undef PG8_STAGEA
#undef PG8_STAGEB
#undef PG8_LDA
#undef PG8_LDB
#undef PG8_MMA
#undef PG8_LD8
#undef PG8_WAIT_V
#undef PG8_WAIT_L
#undef PG8_BAR
#undef PG8_SCHED
#undef PG8_SETVO
#undef PG8_TRIP_BODY
}
}

struct InprojSched {
    static constexpr bool GATHER = false;
    const bf16_t* XN; const bf16_t* W; int G, c; int lda, ldb, K;
    __device__ __forceinline__ bool next(int i, pg8::Unit& u) const {
        const int L = i * G + c;
        if (L < 128 * 28) { int pm, pn; pg8::tile_of(L, 128, 28, pm, pn); u.pm = pm; u.pb = pn; u.x0 = 0; u.x1 = 0; return true; }
        const int idx = L - 128 * 28; if (idx >= 96) return false;
        u.pm = 128 + (idx & 7); u.pb = 8 + (idx >> 3); u.x0 = 1; u.x1 = 0; return true;
    }
    __device__ __forceinline__ const char* a_ptr(const pg8::Unit& u) const { return (const char*)XN + (size_t)u.pm * 256 * 1024 * 2; }
    __device__ __forceinline__ const char* b_ptr(const pg8::Unit& u) const { return (const char*)W + (size_t)u.pb * 256 * 1024 * 2; }
    __device__ __forceinline__ int row_of(const pg8::Unit&, int r) const { return r; }
};
struct MixSched {
    static constexpr bool GATHER = false;
    const bf16_t* Z; const bf16_t* W; int G, c; int lda, ldb, K;
    __device__ __forceinline__ bool next(int i, pg8::Unit& u) const {
        const int L = i * G + c; if (L >= 128 * 4) return false;
        int pm, pn; pg8::tile_of(L, 128, 4, pm, pn); u.pm = pm; u.pb = pn; u.x0 = pn; u.x1 = 0; return true;
    }
    __device__ __forceinline__ const char* a_ptr(const pg8::Unit& u) const { return (const char*)Z + (size_t)u.pm * 256 * LDZ * 2; }
    __device__ __forceinline__ const char* b_ptr(const pg8::Unit& u) const { return (const char*)W + (size_t)u.pb * 256 * 2048 * 2; }
    __device__ __forceinline__ int row_of(const pg8::Unit&, int r) const { return r; }
};
struct WoutSched {
    static constexpr bool GATHER = false;
    const bf16_t* Z; const bf16_t* W; int G, c; int lda, ldb, K;
    __device__ __forceinline__ bool next(int i, pg8::Unit& u) const {
        const int L = i * G + c; if (L >= 128 * 4) return false;
        int pm, pn; pg8::tile_of(L, 128, 4, pm, pn); u.pm = pm; u.pb = pn; u.x0 = pn; u.x1 = 0; return true;
    }
    __device__ __forceinline__ const char* a_ptr(const pg8::Unit& u) const { return (const char*)Z + ((size_t)u.pm * 256 * LDZ + ZC_XR) * 2; }
    __device__ __forceinline__ const char* b_ptr(const pg8::Unit& u) const { return (const char*)W + (size_t)u.pb * 256 * 1024 * 2; }
    __device__ __forceinline__ int row_of(const pg8::Unit&, int r) const { return r; }
};
struct Moe1Sched {
    static constexpr bool GATHER = true;
    const unsigned char* XN2; const unsigned char* W; const int* selidx; int G, c; int lda, ldb, K;
    __device__ __forceinline__ bool next(int i, pg8::Unit& u) const {
        const int L = i * G + c; if (L >= 16 * 256) return false;
        const int e = L >> 8, w = L & 255, x = w & 7, j = w >> 3;
        const int mt = (x & 3) * 4 + (j & 3), nt = (x >> 2) * 8 + (j >> 2);
        u.pm = e * 16 + mt; u.pb = e * 16 + nt; u.x0 = nt; u.x1 = e; return true;
    }
    __device__ __forceinline__ const char* a_ptr(const pg8::Unit&) const { return (const char*)XN2; }
    __device__ __forceinline__ const char* b_ptr(const pg8::Unit& u) const { return (const char*)W + (size_t)u.pb * 256 * 1024; }
    __device__ __forceinline__ int row_of(const pg8::Unit& u, int r) const { return selidx[u.pm * 256 + r]; }
};
struct Moe2Sched {
    static constexpr bool GATHER = true;
    const unsigned char* HID; const unsigned char* W; int G, c; int lda, ldb, K;
    __device__ __forceinline__ bool next(int i, pg8::Unit& u) const {
        const int L = i * G + c; if (L >= 16 * 64) return false;
        const int x = L & 7, j = (L >> 3) & 31, e = ((L >> 8) << 2) + (j >> 3), r = j & 7, mt = 2 * x + (r >> 2), pn = r & 3;
        u.pm = e * 16 + mt; u.pb = e * 4 + pn; u.x0 = pn; u.x1 = e; return true;
    }
    __device__ __forceinline__ const char* a_ptr(const pg8::Unit& u) const { return (const char*)HID + (size_t)u.pm * 256 * 2048; }
    __device__ __forceinline__ const char* b_ptr(const pg8::Unit& u) const { return (const char*)W + (size_t)u.pb * 256 * 2048; }
    __device__ __forceinline__ int row_of(const pg8::Unit&, int r) const { return r; }
};

typedef const f32x4 (&AccRef)[2][2][4][2];
template <bool PLAIN = false> struct EpiInproj {
    static constexpr bool PERM = true, MID = false;
    bf16_t* Z; bf16_t* ZC; const float* binz; const float* rope;
    __device__ __forceinline__ void operator()(AccRef acc, const pg8::Unit& u, int wr, int wc, int fr, int fq) const {
        const bool isctx = u.x0 != 0;
        const int seg = PLAIN ? 2 : (u.pb >> 2), colt = u.pb * 256, cl = wc * 32 + 8 * fq;
        f32x4 bv[2][2];
#pragma unroll
        for (int bj = 0; bj < 2; ++bj)
#pragma unroll
            for (int n = 0; n < 2; ++n) bv[bj][n] = *(const f32x4*)(binz + colt + bj * 128 + cl + 4 * n);
        bf16_t* base; int ld, row0;
        if (!isctx) { base = Z + colt; ld = LDZ; row0 = u.pm * 256; } else { base = ZC + (colt - 2048); ld = LDC; row0 = (u.pm - 128) * 256; }
        const bool dorope = (seg == 1) || (seg == 3 && !isctx);
        const float qs = (seg == 1) ? QSCALE : 1.0f;
#pragma unroll
        for (int ai = 0; ai < 2; ++ai)
#pragma unroll
            for (int m = 0; m < 4; ++m) {
                const int r = row0 + ai * 128 + wr * 64 + m * 16 + fr;
                bf16_t* rowp = base + (size_t)r * ld + cl;
                f32x4 cs0 = (f32x4){1.f, 0.f, 1.f, 0.f}, cs1 = cs0;
                if (dorope) { const int t = r & 4095; const int pos = (wc & 1) ? (t & 63) : (t >> 6); const float* cp = rope + (pos * 16 + 4 * fq) * 2; cs0 = *(const f32x4*)cp; cs1 = *(const f32x4*)(cp + 4); }
#pragma unroll
                for (int bj = 0; bj < 2; ++bj) {
                    f32x4 v0 = acc[ai][bj][m][0] + bv[bj][0], v1 = acc[ai][bj][m][1] + bv[bj][1];
                    if (seg == 0) {
#pragma unroll
                        for (int j = 0; j < 4; ++j) { v0[j] = gelu_tanh(v0[j]); v1[j] = gelu_tanh(v1[j]); }
                    } else if (seg >= 5) {
                        unsigned q[8];
#pragma unroll
                        for (int j = 0; j < 4; ++j) { q[j] = (unsigned)__builtin_rintf(255.0f * sigmoidf_(v0[j])); q[4 + j] = (unsigned)__builtin_rintf(255.0f * sigmoidf_(v1[j])); }
                        u32x2 w8; w8.x = q[0] | (q[1] << 8) | (q[2] << 16) | (q[3] << 24); w8.y = q[4] | (q[5] << 8) | (q[6] << 16) | (q[7] << 24);
                        *(u32x2*)((unsigned char*)(Z + (size_t)r * LDZ) + 2 * ZC_GR + 1024 * (seg - 5) + ((u.pb & 3) * 256 + cl + bj * 128)) = w8;
                        continue;
                    } else if (dorope) {
                        const float c[4] = {cs0[0], cs0[2], cs1[0], cs1[2]}, s[4] = {cs0[1], cs0[3], cs1[1], cs1[3]};
#pragma unroll
                        for (int j = 0; j < 4; ++j) { const float x1 = v0[j], x2 = v1[j]; v0[j] = (x1 * c[j] - x2 * s[j]) * qs; v1[j] = (x1 * s[j] + x2 * c[j]) * qs; }
                    }
                    u32x4 w; w.x = cvt_pk_bf16(v0[0], v0[1]); w.y = cvt_pk_bf16(v0[2], v0[3]); w.z = cvt_pk_bf16(v1[0], v1[1]); w.w = cvt_pk_bf16(v1[2], v1[3]);
                    *(u32x4*)(rowp + bj * 128) = w;
                }
            }
    }
};
__device__ __forceinline__ void unpack_u8x8(u32x2 g, f32x4& lo, f32x4& hi) {
    const float k = 1.0f / 255.0f;
    lo = (f32x4){(float)(g.x & 0xffu), (float)((g.x >> 8) & 0xffu), (float)((g.x >> 16) & 0xffu), (float)(g.x >> 24)} * k;
    hi = (f32x4){(float)(g.y & 0xffu), (float)((g.y >> 8) & 0xffu), (float)((g.y >> 16) & 0xffu), (float)(g.y >> 24)} * k;
}
struct EpiMix {
    static constexpr bool PERM = true, MID = true;
    bf16_t* Z;
    __device__ __forceinline__ void mid(f32x4 (&acc)[2][2][4][2], const pg8::Unit& u, int wr, int wc, int fr, int fq) const {
        const int colt = u.x0 * 256, cl = wc * 32 + 8 * fq;
        int r0 = u.pm * 256 + wr * 64 + fr; asm volatile("" : "+v"(r0));
#pragma unroll
        for (int ai = 0; ai < 2; ++ai)
#pragma unroll
            for (int m = 0; m < 4; ++m) {
                const unsigned char* rowg = (const unsigned char*)(Z + (size_t)(r0 + ai * 128 + m * 16) * LDZ) + 2 * ZC_GR + colt + cl;
#pragma unroll
                for (int bj = 0; bj < 2; ++bj) {
                    const u32x2 gr = *(const u32x2*)(rowg + bj * 128), gn = *(const u32x2*)(rowg + 1024 + bj * 128);
                    f32x4 r0v, r1v, n0v, n1v; unpack_u8x8(gr, r0v, r1v); unpack_u8x8(gn, n0v, n1v);
#pragma unroll
                    for (int j = 0; j < 4; ++j) { acc[ai][bj][m][0][j] *= r0v[j] * __builtin_amdgcn_rcpf(fmaxf(n0v[j], 1.0f / 255.0f)); acc[ai][bj][m][1][j] *= r1v[j] * __builtin_amdgcn_rcpf(fmaxf(n1v[j], 1.0f / 255.0f)); }
                    asm volatile("" : "+v"(acc[ai][bj][m][0]), "+v"(acc[ai][bj][m][1]) :: "memory");
                }
            }
    }
    __device__ __forceinline__ void operator()(AccRef acc, const pg8::Unit& u, int wr, int wc, int fr, int fq) const {
        const int colt = u.x0 * 256, cl = wc * 32 + 8 * fq;
        int r0 = u.pm * 256 + wr * 64 + fr; asm volatile("" : "+v"(r0));
#pragma unroll
        for (int ai = 0; ai < 2; ++ai)
#pragma unroll
            for (int m = 0; m < 4; ++m) {
                bf16_t* rowz = Z + (size_t)(r0 + ai * 128 + m * 16) * LDZ + colt + cl;
                const unsigned char* rowg = (const unsigned char*)(Z + (size_t)(r0 + ai * 128 + m * 16) * LDZ) + 2 * ZC_GR + 1024 + colt + cl;
#pragma unroll
                for (int bj = 0; bj < 2; ++bj) {
                    f32x4 n0v, n1v; unpack_u8x8(*(const u32x2*)(rowg + bj * 128), n0v, n1v);
                    n0v = __builtin_elementwise_max(n0v, (f32x4){1.0f / 255.0f, 1.0f / 255.0f, 1.0f / 255.0f, 1.0f / 255.0f}); n1v = __builtin_elementwise_max(n1v, (f32x4){1.0f / 255.0f, 1.0f / 255.0f, 1.0f / 255.0f, 1.0f / 255.0f});
                    const f32x4 v0 = acc[ai][bj][m][0] * n0v, v1 = acc[ai][bj][m][1] * n1v;
                    u32x4 w; w.x = cvt_pk_bf16(v0[0], v0[1]); w.y = cvt_pk_bf16(v0[2], v0[3]); w.z = cvt_pk_bf16(v1[0], v1[1]); w.w = cvt_pk_bf16(v1[2], v1[3]);
                    *(u32x4*)(rowz + ZC_XR + bj * 128) = w;
                }
            }
    }
};
struct EpiWout {
    static constexpr bool PERM = true, MID = false;
    const float* x; bf16_t* x1; const float* mod;
    __device__ __forceinline__ void operator()(AccRef acc, const pg8::Unit& u, int wr, int wc, int fr, int fq) const {
        const int col0 = u.x0 * 256 + wc * 32 + 8 * fq;
        const float* g1p = mod + (size_t)(u.pm >> 4) * 6144 + 2048 + col0;
        f32x4 gv[2][2];
#pragma unroll
        for (int bj = 0; bj < 2; ++bj)
#pragma unroll
            for (int n = 0; n < 2; ++n) gv[bj][n] = *(const f32x4*)(g1p + bj * 128 + n * 4);
#pragma unroll
        for (int ai = 0; ai < 2; ++ai)
#pragma unroll
            for (int m = 0; m < 4; ++m) {
                const size_t off = (size_t)(u.pm * 256 + ai * 128 + wr * 64 + m * 16 + fr) * DM + col0;
#pragma unroll
                for (int bj = 0; bj < 2; ++bj) {
                    const f32x4 x0 = *(const f32x4*)(x + off + bj * 128), x4 = *(const f32x4*)(x + off + bj * 128 + 4);
                    const f32x4 v0 = x0 + gv[bj][0] * acc[ai][bj][m][0], v1 = x4 + gv[bj][1] * acc[ai][bj][m][1];
                    u32x4 w; w.x = cvt_pk_bf16(v0[0], v0[1]); w.y = cvt_pk_bf16(v0[2], v0[3]); w.z = cvt_pk_bf16(v1[0], v1[1]); w.w = cvt_pk_bf16(v1[2], v1[3]);
                    *(u32x4*)(x1 + off + bj * 128) = w;
                }
            }
    }
};
__device__ __forceinline__ unsigned pk4_fp8(float a, float b, float c, float d) { int w = 0; w = __builtin_amdgcn_cvt_pk_fp8_f32(a, b, w, false); w = __builtin_amdgcn_cvt_pk_fp8_f32(c, d, w, true); return (unsigned)w; }
struct EpiMoe1 {
    static constexpr bool PERM = true, MID = false;
    unsigned char* HID;
    __device__ __forceinline__ void operator()(AccRef acc, const pg8::Unit& u, int wr, int wc, int fr, int fq) const {
        const int col0 = u.x0 * 128 + wc * 32 + 8 * fq;
#pragma unroll
        for (int ai = 0; ai < 2; ++ai)
#pragma unroll
            for (int m = 0; m < 4; ++m) {
                const size_t r = (size_t)u.pm * 256 + ai * 128 + wr * 64 + m * 16 + fr;
                f32x4 h0, h1;
#pragma unroll
                for (int j = 0; j < 4; ++j) { const float g0 = acc[ai][0][m][0][j], g1 = acc[ai][0][m][1][j];
                    h0[j] = g0 * sigmoidf_(g0) * acc[ai][1][m][0][j]; h1[j] = g1 * sigmoidf_(g1) * acc[ai][1][m][1][j]; }
                u32x2 w; w.x = pk4_fp8(h0[0], h0[1], h0[2], h0[3]); w.y = pk4_fp8(h1[0], h1[1], h1[2], h1[3]);
                *(u32x2*)(HID + r * DEXP + col0) = w;
            }
    }
};
struct EpiMoe2 {
    static constexpr bool PERM = true, MID = false;
    unsigned char* YE;
    __device__ __forceinline__ void operator()(AccRef acc, const pg8::Unit& u, int wr, int wc, int fr, int fq) const {
        const int col0 = u.x0 * 256 + wc * 32 + 8 * fq;
        const size_t r0 = (size_t)u.pm * 256 + wr * 64 + fr;
        unsigned char* base = YE + r0 * DM + col0;
#pragma unroll
        for (int ai = 0; ai < 2; ++ai)
#pragma unroll
            for (int m = 0; m < 4; ++m) {
                unsigned char* rowp = base + (size_t)(ai * 128 + m * 16) * DM;
#pragma unroll
                for (int bj = 0; bj < 2; ++bj) {
                    const f32x4 v0 = acc[ai][bj][m][0], v1 = acc[ai][bj][m][1];
                    u32x2 w; w.x = pk4_fp8(v0[0], v0[1], v0[2], v0[3]); w.y = pk4_fp8(v1[0], v1[1], v1[2], v1[3]);
                    *(u32x2*)(rowp + bj * 128) = w;
                }
            }
    }
};

struct Params {
    const float *x, *c, *ctx, *c_ctx, *w_mod, *b_mod, *w_in, *b_in, *conv_w, *conv_b, *lru_wa, *lru_ba, *lru_wi, *lru_bi, *lru_lambda, *na_rpb,
                *w_proj_rnn, *w_proj_na, *w_out, *w_router, *w_exp_gate, *w_exp_up, *w_exp_down, *final_norm;
    float* out; unsigned char* ws;
    int ph_lo, ph_hi, probe, pad;
};

__device__ __forceinline__ int zcol_of(int n) {
    const int seg = n >> 10, o = n & 1023;
    if (seg == 0) return ZC_YG + o;
    if (seg == 1) return ZC_XR + o;
    if (seg == 4) return ZC_V + o;
    if (seg == 5) return ZC_GR + o;
    if (seg == 6) return ZC_GN + o;
    const int hh = o >> 6, d = o & 63, g2 = d >> 5, dd = d & 31, nn = dd >> 4, j = dd & 15, a = j >> 2, jj = j & 3;
    return (seg == 2 ? ZC_Q : ZC_K) + hh * 64 + g2 * 32 + 8 * a + 4 * nn + jj;
}
constexpr int TR_SCR = 64 * 65 * 4;
template <class RowMap>
__device__ __forceinline__ void transpose_item(const float* W, int ldw, int k0, int n0, bf16_t* WT, int ldk, RowMap rowmap, LAS float* scr, int lane) {
    const int ln = lane & 15, lk = lane >> 4;
    f32x4 v[16];
#pragma unroll
    for (int i = 0; i < 16; ++i) v[i] = *(const f32x4*)(W + (size_t)(k0 + 4 * i + lk) * ldw + n0 + 4 * ln);
#pragma unroll
    for (int i = 0; i < 16; ++i) { LAS float* d = scr + (4 * i + lk) * 65 + 4 * ln; d[0] = v[i].x; d[1] = v[i].y; d[2] = v[i].z; d[3] = v[i].w; }
    LDS_WAIT(); asm volatile("" ::: "memory");
    const int kg = lane & 7;
#pragma unroll
    for (int j = 0; j < 8; ++j) { const int n = (lane >> 3) + 8 * j; const LAS float* sp = scr + (8 * kg) * 65 + n;
        u32x4 o; o.x = cvt_pk_bf16(sp[0 * 65], sp[1 * 65]); o.y = cvt_pk_bf16(sp[2 * 65], sp[3 * 65]); o.z = cvt_pk_bf16(sp[4 * 65], sp[5 * 65]); o.w = cvt_pk_bf16(sp[6 * 65], sp[7 * 65]);
        *(u32x4*)(WT + (size_t)rowmap(n0 + n) * ldk + k0 + 8 * kg) = o; }
    LDS_WAIT(); asm volatile("" ::: "memory");
}
template <class RowMap>
__device__ __forceinline__ void transpose_item_f8(const float* W, int ldw, int k0, int n0, unsigned char* WT, int ldk, RowMap rowmap, LAS float* scr, int lane) {
    const int ln = lane & 15, lk = lane >> 4;
    f32x4 v[16];
#pragma unroll
    for (int i = 0; i < 16; ++i) v[i] = *(const f32x4*)(W + (size_t)(k0 + 4 * i + lk) * ldw + n0 + 4 * ln);
#pragma unroll
    for (int i = 0; i < 16; ++i) { LAS float* d = scr + (4 * i + lk) * 65 + 4 * ln; d[0] = v[i].x * 64.f; d[1] = v[i].y * 64.f; d[2] = v[i].z * 64.f; d[3] = v[i].w * 64.f; }
    LDS_WAIT(); asm volatile("" ::: "memory");
    const int kq = lane & 3;
#pragma unroll
    for (int j = 0; j < 4; ++j) { const int n = (lane >> 2) + 16 * j; const LAS float* sp = scr + (16 * kq) * 65 + n;
        u32x4 o; o.x = pk4_fp8(sp[0 * 65], sp[1 * 65], sp[2 * 65], sp[3 * 65]); o.y = pk4_fp8(sp[4 * 65], sp[5 * 65], sp[6 * 65], sp[7 * 65]);
        o.z = pk4_fp8(sp[8 * 65], sp[9 * 65], sp[10 * 65], sp[11 * 65]); o.w = pk4_fp8(sp[12 * 65], sp[13 * 65], sp[14 * 65], sp[15 * 65]);
        *(u32x4*)(WT + (size_t)rowmap(n0 + n) * ldk + k0 + 16 * kq) = o; }
    LDS_WAIT(); asm volatile("" ::: "memory");
}
struct TrItem { const float* src; unsigned char* dst; int ldw, ldk, n0, up; };
__device__ __forceinline__ void tr_load(const TrItem& t, int lane, f32x4 (&v)[16]) {
    const int ln = lane & 15, lk = lane >> 4;
#pragma unroll
    for (int i = 0; i < 16; ++i) v[i] = *(const f32x4*)(t.src + (size_t)(4 * i + lk) * t.ldw + 4 * ln);
}
__device__ __forceinline__ void tr_store_f8(const TrItem& t, const f32x4 (&v)[16], LAS float* scr, int lane) {
    const int ln = lane & 15, lk = lane >> 4;
#pragma unroll
    for (int i = 0; i < 16; ++i) { LAS float* d = scr + (4 * i + lk) * 65 + 4 * ln; d[0] = v[i].x * 64.f; d[1] = v[i].y * 64.f; d[2] = v[i].z * 64.f; d[3] = v[i].w * 64.f; }
    LDS_WAIT(); asm volatile("" ::: "memory");
    const int kq = lane & 3;
#pragma unroll
    for (int j = 0; j < 4; ++j) { const int n = (lane >> 2) + 16 * j, na = t.n0 + n; const LAS float* sp = scr + (16 * kq) * 65 + n;
        const int row = t.up < 0 ? na : 256 * (na >> 7) + 128 * t.up + (na & 127);
        u32x4 o; o.x = pk4_fp8(sp[0 * 65], sp[1 * 65], sp[2 * 65], sp[3 * 65]); o.y = pk4_fp8(sp[4 * 65], sp[5 * 65], sp[6 * 65], sp[7 * 65]);
        o.z = pk4_fp8(sp[8 * 65], sp[9 * 65], sp[10 * 65], sp[11 * 65]); o.w = pk4_fp8(sp[12 * 65], sp[13 * 65], sp[14 * 65], sp[15 * 65]);
        *(u32x4*)(t.dst + (size_t)row * t.ldk + 16 * kq) = o; }
    LDS_WAIT(); asm volatile("" ::: "memory");
}
__device__ __forceinline__ void phase_prep(const Params& p, LAS unsigned char* lds) {
    const int tid = threadIdx.x, lane = tid & 63, wave = tid >> 6, G = gridDim.x;
    unsigned char* ws = p.ws;
    {
        LAS float* sS = (LAS float*)lds;
        LAS float* red = sS + 9 * 1024;
        float* MOD = (float*)(ws + WS_MOD);
        if (blockIdx.x < 192) {
            for (int e = tid; e < 9 * 1024; e += NTHREADS) { const int r = e >> 10, k = e & 1023; const float v = (r < 8) ? p.c[r * 1024 + k] : p.c_ctx[k]; sS[e] = v * sigmoidf_(v); }
            __syncthreads();
        }
        for (int it = blockIdx.x; it < 192; it += G) {
            const int n0 = it * 32, kk = tid >> 3, c4 = tid & 7;
            f32x4 a[9];
#pragma unroll
            for (int r = 0; r < 9; ++r) a[r] = (f32x4){0.f, 0.f, 0.f, 0.f};
#pragma unroll 4
            for (int i = 0; i < 16; ++i) { const int k = kk + 64 * i; const f32x4 w = *(const f32x4*)(p.w_mod + (size_t)k * 6144 + n0 + 4 * c4);
#pragma unroll
                for (int r = 0; r < 9; ++r) a[r] += w * sS[r * 1024 + k]; }
#pragma unroll
            for (int r = 0; r < 9; ++r) *(LAS f32x4*)(red + (kk * 9 + r) * 32 + 4 * c4) = a[r];
            __syncthreads();
            if (tid < 288) { const int r = tid >> 5, col = tid & 31; float sum = p.b_mod[n0 + col];
                for (int q = 0; q < 64; ++q) sum += red[(q * 9 + r) * 32 + col];
                MOD[r * 6144 + n0 + col] = sum; }
            __syncthreads();
        }
    }
    {
        float* ROPE = (float*)(ws + WS_ROPE); float* BINZ = (float*)(ws + WS_BINZ);
        const int gt = blockIdx.x * NTHREADS + tid, NGT = G * NTHREADS;
        for (int e = gt; e < 64 * 16; e += NGT) { const int pos = e >> 4, j = e & 15; const float inv = powf(10000.0f, -(float)j / 16.0f); const float ang = (float)pos * inv; ROPE[2 * e] = cosf(ang); ROPE[2 * e + 1] = sinf(ang); }
        for (int n = gt; n < NIN; n += NGT) BINZ[zcol_of(n)] = p.b_in[n];
    }
}
__device__ __forceinline__ void phase_prep_weights(const Params& p, LAS unsigned char* lds) {
    const int tid = threadIdx.x, lane = tid & 63, wave = tid >> 6, G = gridDim.x;
    unsigned char* ws = p.ws;
    {
        LAS float* scr = (LAS float*)(lds + wave * TR_SCR);
        bf16_t* WINT = (bf16_t*)(ws + WS_WINT); bf16_t* WMIX = (bf16_t*)(ws + WS_WMIX); bf16_t* WOUT = (bf16_t*)(ws + WS_WOUT);
        const int gw = blockIdx.x * NWAVES + wave, NGW = G * NWAVES;
        constexpr int I_IN = 16 * (NIN / 64), I_P = 16 * 16;
        for (int it = gw; it < I_IN + 3 * I_P; it += NGW) {
            int r = it;
            if (r < I_IN) { const int nblk = NIN / 64, kb = r / nblk, nb = r % nblk; transpose_item(p.w_in, NIN, 64 * kb, 64 * nb, WINT, 1024, [](int n) { return zcol_of(n); }, scr, lane); continue; } r -= I_IN;
            const int kb = (r % I_P) / 16, nb = (r % I_P) % 16, which = r / I_P;
            if (which == 0) transpose_item(p.w_proj_rnn, 1024, 64 * kb, 64 * nb, WMIX, 2048, [](int n) { return n; }, scr, lane);
            else if (which == 1) transpose_item(p.w_proj_na, 1024, 64 * kb, 64 * nb, WMIX + 1024, 2048, [](int n) { return n; }, scr, lane);
            else transpose_item(p.w_out, 1024, 64 * kb, 64 * nb, WOUT, 1024, [](int n) { return n; }, scr, lane);
        }
    }
}

__device__ __forceinline__ const float* norm1_row(const Params& p, int row) { return row >= MLAT ? p.ctx + (size_t)(row - MLAT) * DM : p.x + (size_t)row * DM; }
__device__ __forceinline__ void phase_norm1(const Params& p, LAS unsigned char* lds) {
    const int tid = threadIdx.x, lane = tid & 63, wave = tid >> 6, G = gridDim.x;
    unsigned char* ws = p.ws;
    const float* MOD = (const float*)(ws + WS_MOD);
    bf16_t* XN = (bf16_t*)(ws + WS_XN);
    const int gw = blockIdx.x * NWAVES + wave, NGW = G * NWAVES;
    constexpr int NROW = MLAT + MCTX;
    const int per = (NROW + NGW - 1) / NGW, r_lo = gw * per, r_hi = min(r_lo + per, NROW);
    if (r_lo >= r_hi) return;
    f32x4 nx[4], ny[4], shv[4], scv[4]; int mcur = -1;
    { const f32x4* xr = (const f32x4*)norm1_row(p, r_lo) + lane;
#pragma unroll
      for (int j = 0; j < 4; ++j) nx[j] = xr[64 * j];
      if (r_lo + 1 < r_hi) { const f32x4* xs = (const f32x4*)norm1_row(p, r_lo + 1) + lane;
#pragma unroll
          for (int j = 0; j < 4; ++j) ny[j] = xs[64 * j]; } }
    for (int row = r_lo; row < r_hi; ++row) {
        const int mr = (row >= MLAT) ? 8 : (row >> 12);
        if (mr != mcur) { mcur = mr; const float* sh = MOD + (size_t)mr * 6144;
#pragma unroll
            for (int j = 0; j < 4; ++j) { shv[j] = *(const f32x4*)(sh + 4 * lane + 256 * j); scv[j] = *(const f32x4*)(sh + 1024 + 4 * lane + 256 * j) + 1.0f; } }
        f32x4 v[4]; float s = 0.f;
#pragma unroll
        for (int j = 0; j < 4; ++j) { v[j] = nx[j]; nx[j] = ny[j]; s += (v[j].x * v[j].x + v[j].y * v[j].y) + (v[j].z * v[j].z + v[j].w * v[j].w); }
        if (row + 2 < r_hi) { const f32x4* xr = (const f32x4*)norm1_row(p, row + 2) + lane;
#pragma unroll
            for (int j = 0; j < 4; ++j) ny[j] = xr[64 * j]; }
        const float rs = 1.0f / sqrtf(wave_sum(s) * (1.0f / DM) + 1e-6f);
        unsigned long long* o8 = (unsigned long long*)(XN + (size_t)row * DM) + lane;
#pragma unroll
        for (int j = 0; j < 4; ++j) { const f32x4 y = v[j] * rs * scv[j] + shv[j];
            o8[64 * j] = (unsigned long long)pk2(y.x, y.y) | ((unsigned long long)pk2(y.z, y.w) << 32); }
    }
}

typedef float f32x16 __attribute__((ext_vector_type(16)));
constexpr int RN_XS = 144;
constexpr int RN_XC = 0, RN_WT = 256 * RN_XS, RN_SEG = RN_WT + 64 * RN_XS, RN_ST = RN_SEG + 10240;
__device__ __forceinline__ void phase_rnn(const Params& p, LAS unsigned char* lds, const bool dry) {
    const int tid = threadIdx.x, lane = tid & 63, wave = __builtin_amdgcn_readfirstlane(tid >> 6), G = gridDim.x;
    unsigned char* ws = p.ws;
    bf16_t* Z = (bf16_t*)(ws + WS_Z); const bf16_t* ZCb = (const bf16_t*)(ws + WS_ZC); bf16_t* HF = (bf16_t*)(ws + WS_XN);
    LAS unsigned char* xcb = lds + RN_XC;
    LAS unsigned char* wtb = lds + RN_WT;
    LAS float* seg0 = (LAS float*)(lds + RN_SEG);
    LAS unsigned char* stg = lds + RN_ST;
    const int c = lane & 31, hh = lane >> 5;
    const int taur = 16 * ((c >> 2) & 1) + 4 * (c >> 3) + (c & 3);
    const int cg8 = tid & 7, run = tid >> 3;
    for (int it = blockIdx.x; it < 256; it += G) {
        const int b = it >> 5, g = (it >> 1) & 15, half = it & 1;
        const int ch = 64 * g + 32 * half + c;
        const int ch0 = 64 * g + 32 * half;
        f32x2 cw2[4][4], cb2[4];
#pragma unroll
        for (int j = 0; j < 4; ++j) { cb2[j] = *(const f32x2*)(p.conv_b + 64 * g + 8 * cg8 + 2 * j);
#pragma unroll
            for (int k = 0; k < 4; ++k) cw2[k][j] = *(const f32x2*)(p.conv_w + k * 1024 + 64 * g + 8 * cg8 + 2 * j); }
        const bf16_t* srcL = Z + (size_t)b * SEQ * LDZ + ZC_XR + 64 * g + 8 * cg8;
        const bf16_t* srcC = ZCb + (size_t)b * CTX * LDC + CC_XR + 64 * g + 8 * cg8;
        for (int dir = 0; dir < 2; ++dir) {
            u32x4 xr[7];
#pragma unroll
            for (int q = 0; q < 7; ++q) { const int ts = 4 * run - 2 + q; xr[q] = (ts >= 0 && ts < CTX) ? *(const u32x4*)(srcC + (size_t)ts * LDC) : (u32x4){0u, 0u, 0u, 0u}; }
            __syncthreads();
            for (int e = tid; e < 2 * 64 * 32; e += NTHREADS) { const int mat = e >> 11, i = (e >> 5) & 63, cc = e & 31;
                const float* src = mat ? p.lru_wi : p.lru_wa;
                *(LAS bf16_t*)(wtb + (mat * 32 + cc) * RN_XS + i * 2) = (bf16_t)f2bf(src[(((size_t)dir * 16 + g) * 64 + i) * 64 + 32 * half + cc]); }
            __syncthreads();
            const float nbaL = -LOG2E * p.lru_ba[dir * 1024 + ch], nbiL = -LOG2E * p.lru_bi[dir * 1024 + ch];
            const float lam = p.lru_lambda[dir * 1024 + ch];
            const float sp = (lam > 15.f) ? expf(-lam) : log1pf(expf(-lam));
            const float clam = -8.0f * sp * LOG2E;
            float hc = 0.f;
            for (int step = 0; step < 17; ++step) {
                const bool isctx = (step == 0);
                const int t0 = isctx ? 0 : 256 * (dir == 0 ? step - 1 : 16 - step);
                {
                    f32x2 ac[4][4];
#pragma unroll
                    for (int i = 0; i < 4; ++i)
#pragma unroll
                        for (int j = 0; j < 4; ++j) ac[i][j] = cb2[j];
#pragma unroll
                    for (int q = 0; q < 7; ++q) {
                        f32x2 x2[4];
                        x2[0] = (f32x2){bf2f(xr[q].x & 0xffffu), bf2f(xr[q].x >> 16)}; x2[1] = (f32x2){bf2f(xr[q].y & 0xffffu), bf2f(xr[q].y >> 16)};
                        x2[2] = (f32x2){bf2f(xr[q].z & 0xffffu), bf2f(xr[q].z >> 16)}; x2[3] = (f32x2){bf2f(xr[q].w & 0xffffu), bf2f(xr[q].w >> 16)};
#pragma unroll
                        for (int i = 0; i < 4; ++i) { const int k = q - i; if (k >= 0 && k < 4) {
#pragma unroll
                            for (int j = 0; j < 4; ++j) ac[i][j] = __builtin_elementwise_fma(cw2[k][j], x2[j], ac[i][j]); } }
                    }
#pragma unroll
                    for (int i = 0; i < 4; ++i) { u32x4 w; w.x = cvt_pk_bf16(ac[i][0].x, ac[i][0].y); w.y = cvt_pk_bf16(ac[i][1].x, ac[i][1].y); w.z = cvt_pk_bf16(ac[i][2].x, ac[i][2].y); w.w = cvt_pk_bf16(ac[i][3].x, ac[i][3].y);
                        *(LAS u32x4*)(xcb + (4 * run + i) * RN_XS + cg8 * 16) = w; }
                }
                if (step < 16) { const int tn = 256 * (dir == 0 ? step : 15 - step);
                    if (tn >= 2 && tn + 258 <= SEQ) {
                        const bf16_t* rp = srcL + (size_t)(tn + 4 * run - 2) * LDZ;
#pragma unroll
                        for (int q = 0; q < 7; ++q) xr[q] = *(const u32x4*)(rp + (size_t)q * LDZ);
                    } else {
#pragma unroll
                        for (int q = 0; q < 7; ++q) { const int ts = tn + 4 * run - 2 + q; xr[q] = (ts >= 0 && ts < SEQ) ? *(const u32x4*)(srcL + (size_t)ts * LDZ) : (u32x4){0u, 0u, 0u, 0u}; } } }
                u32x4 hfr[2], ygr[2];
                const size_t tb = (size_t)b * SEQ + t0;
                if (!isctx && dir == 1) {
#pragma unroll
                    for (int i = 0; i < 2; ++i) { const int pl = lane + 64 * i, tk = 32 * wave + (pl >> 2), part = pl & 3;
                        hfr[i] = *(const u32x4*)(HF + (tb + tk) * DM + ch0 + 8 * part); ygr[i] = *(const u32x4*)(Z + (tb + tk) * LDZ + ZC_YG + ch0 + 8 * part); } }
                f32x16 ar, ai;
#pragma unroll
                for (int j = 0; j < 16; ++j) { ar[j] = 0.f; ai[j] = 0.f; }
                const LAS unsigned char* arow = xcb + (32 * wave + taur) * RN_XS + 16 * hh;
#pragma unroll
                for (int s4 = 0; s4 < 4; ++s4) { const bf16x8 af = *(const LAS bf16x8*)(arow + 32 * s4);
                    const bf16x8 bw0 = *(const LAS bf16x8*)(wtb + c * RN_XS + (16 * s4 + 8 * hh) * 2), bw1 = *(const LAS bf16x8*)(wtb + (32 + c) * RN_XS + (16 * s4 + 8 * hh) * 2);
                    ar = __builtin_amdgcn_mfma_f32_32x32x16_bf16(af, bw0, ar, 0, 0, 0);
                    ai = __builtin_amdgcn_mfma_f32_32x32x16_bf16(af, bw1, ai, 0, 0, 0); }
                const LAS unsigned char* xcol = xcb + (32 * wave + 16 * hh) * RN_XS + (32 * half + c) * 2;
#pragma unroll
                for (int j = 0; j < 16; ++j) {
                    const float r = __builtin_amdgcn_rcpf(1.0f + __builtin_amdgcn_exp2f(__builtin_fmaf(ar[j], -LOG2E, nbaL))), ig = __builtin_amdgcn_rcpf(1.0f + __builtin_amdgcn_exp2f(__builtin_fmaf(ai[j], -LOG2E, nbiL)));
                    const float a = __builtin_amdgcn_exp2f(r * clam);
                    const float om = __builtin_fmaf(-a, a, 1.0f);
                    const float xv = bf2f(*(const LAS bf16_t*)(xcol + j * RN_XS));
                    ar[j] = a; ai[j] = __builtin_amdgcn_sqrtf(om) * ig * xv;
                }
                float P = 1.f, H = 0.f;
                if (dir == 0) {
#pragma unroll
                    for (int j = 0; j < 16; ++j) { H = ar[j] * H + ai[j]; P *= ar[j]; }
                } else {
#pragma unroll
                    for (int j = 15; j >= 0; --j) { H = ar[j] * H + ai[j]; P *= ar[j]; }
                }
                const int s = 2 * wave + hh;
                LAS float* segA = seg0 + (step & 1) * 1280; LAS float* segB = segA + 640;
                segA[c * 20 + s] = P; segB[c * 20 + s] = H;
                __syncthreads();
                float h = hc, hin;
                {   f32x4 sa[4], sb[4];
#pragma unroll
                    for (int q4 = 0; q4 < 4; ++q4) { sa[q4] = *(const LAS f32x4*)(segA + c * 20 + 4 * q4); sb[q4] = *(const LAS f32x4*)(segB + c * 20 + 4 * q4); }
                    float h0v = 0.f, h1v = 0.f;
                    if (dir == 0) {
#pragma unroll
                        for (int q = 0; q < 16; ++q) { if (q == 2 * wave) h0v = h; if (q == 2 * wave + 1) h1v = h; h = sa[q >> 2][q & 3] * h + sb[q >> 2][q & 3]; } }
                    else {
#pragma unroll
                        for (int q = 15; q >= 0; --q) { if (q == 2 * wave) h0v = h; if (q == 2 * wave + 1) h1v = h; h = sa[q >> 2][q & 3] * h + sb[q >> 2][q & 3]; } }
                    hin = hh ? h1v : h0v;
                }
                hc = h;
                if (!isctx) {
                    LAS float* sp0 = (LAS float*)(stg + (32 * wave + 16 * hh) * RN_XS) + c;
                    h = hin;
                    if (dir == 0) {
#pragma unroll
                        for (int j = 0; j < 16; ++j) { h = ar[j] * h + ai[j]; sp0[j * (RN_XS / 4)] = h; }
                    } else {
#pragma unroll
                        for (int j = 15; j >= 0; --j) { h = ar[j] * h + ai[j]; sp0[j * (RN_XS / 4)] = h; }
                    }
#pragma unroll
                    for (int i = 0; i < 2; ++i) { const int pl = lane + 64 * i, tk = 32 * wave + (pl >> 2), part = pl & 3;
                        const LAS f32x4* sr = (const LAS f32x4*)(stg + tk * RN_XS + part * 32);
                        f32x4 h0 = sr[0], h1 = sr[1];
                        if (dir == 1) {
                            const u32x4 f = hfr[i], y = ygr[i];
                            h0 = (h0 + (f32x4){bf2f(f.x & 0xffffu), bf2f(f.x >> 16), bf2f(f.y & 0xffffu), bf2f(f.y >> 16)}) * (f32x4){bf2f(y.x & 0xffffu), bf2f(y.x >> 16), bf2f(y.y & 0xffffu), bf2f(y.y >> 16)};
                            h1 = (h1 + (f32x4){bf2f(f.z & 0xffffu), bf2f(f.z >> 16), bf2f(f.w & 0xffffu), bf2f(f.w >> 16)}) * (f32x4){bf2f(y.z & 0xffffu), bf2f(y.z >> 16), bf2f(y.w & 0xffffu), bf2f(y.w >> 16)};
                        }
                        u32x4 w; w.x = cvt_pk_bf16(h0[0], h0[1]); w.y = cvt_pk_bf16(h0[2], h0[3]); w.z = cvt_pk_bf16(h1[0], h1[1]); w.w = cvt_pk_bf16(h1[2], h1[3]);
                        if (!dry) { if (dir == 0) *(u32x4*)(HF + (tb + tk) * DM + ch0 + 8 * part) = w; else *(u32x4*)(Z + (tb + tk) * LDZ + ZC_YG + ch0 + 8 * part) = w; }
                    }
                }
            }
        }
    }
}

constexpr int AT_SLOT = 16384, AT_NS = 4, AT_BIAS = AT_NS * AT_SLOT;
__device__ __forceinline__ void glds16(const void* gsrc, unsigned lds_dst) { unsigned keep;
    asm volatile("s_mov_b32 %0, m0\n\ts_mov_b32 m0, %2\n\ts_nop 0\n\tglobal_load_lds_dwordx4 %1, off\n\ts_mov_b32 m0, %0" : "=&s"(keep) : "v"(gsrc), "s"(lds_dst) : "memory"); }
typedef short s16x4 __attribute__((ext_vector_type(4)));
struct QBlk { bf16x8 q[2]; f32x4 o[4]; float l; };
template <bool LOCAL, bool DOA, bool DOB>
__device__ __forceinline__ void attn_proc32(QBlk& A, QBlk& B, const LAS unsigned char* Kc, int kc0, const int (&koff)[2][2], const int (&voff)[4][2], const int (&cidx)[8], const LAS unsigned char* browA, const LAS unsigned char* browB) {
    const LAS unsigned char* Kb = Kc + kc0 * 128; const LAS unsigned char* Vb = Kc + 8192 + kc0 * 128;
    f32x4 a0 = (f32x4){0.f, 0.f, 0.f, 0.f}, a1 = a0, b0 = a0, b1 = a0;
#pragma unroll
    for (int ks = 0; ks < 2; ++ks) {
        const bf16x8 k0 = *(const LAS bf16x8*)(Kb + koff[0][ks]);
        const bf16x8 k1 = *(const LAS bf16x8*)(Kb + koff[1][ks]);
        if (DOA) { a0 = __builtin_amdgcn_mfma_f32_16x16x32_bf16(k0, A.q[ks], a0, 0, 0, 0); a1 = __builtin_amdgcn_mfma_f32_16x16x32_bf16(k1, A.q[ks], a1, 0, 0, 0); }
        if (DOB) { b0 = __builtin_amdgcn_mfma_f32_16x16x32_bf16(k0, B.q[ks], b0, 0, 0, 0); b1 = __builtin_amdgcn_mfma_f32_16x16x32_bf16(k1, B.q[ks], b1, 0, 0, 0); }
    }
    if (LOCAL) {
#pragma unroll
        for (int r = 0; r < 4; ++r) {
            if (DOA) { a0[r] += *(const LAS float*)(browA + cidx[r]); a1[r] += *(const LAS float*)(browA + cidx[4 + r]); }
            if (DOB) { b0[r] += *(const LAS float*)(browB + cidx[r]); b1[r] += *(const LAS float*)(browB + cidx[4 + r]); }
        }
    }
    float psA = 0.f, psB = 0.f;
#pragma unroll
    for (int r = 0; r < 4; ++r) {
        if (DOA) { a0[r] = __builtin_amdgcn_exp2f(a0[r]); a1[r] = __builtin_amdgcn_exp2f(a1[r]); psA += a0[r] + a1[r]; }
        if (DOB) { b0[r] = __builtin_amdgcn_exp2f(b0[r]); b1[r] = __builtin_amdgcn_exp2f(b1[r]); psB += b0[r] + b1[r]; }
    }
    bf16x8 pA, pB;
    if (DOA) { A.l += psA; const u32x4 w = (u32x4){cvt_pk_bf16(a0[0], a0[1]), cvt_pk_bf16(a0[2], a0[3]), cvt_pk_bf16(a1[0], a1[1]), cvt_pk_bf16(a1[2], a1[3])}; pA = __builtin_bit_cast(bf16x8, w); }
    if (DOB) { B.l += psB; const u32x4 w = (u32x4){cvt_pk_bf16(b0[0], b0[1]), cvt_pk_bf16(b0[2], b0[3]), cvt_pk_bf16(b1[0], b1[1]), cvt_pk_bf16(b1[2], b1[3])}; pB = __builtin_bit_cast(bf16x8, w); }
#pragma unroll
    for (int dt = 0; dt < 4; ++dt) {
        const s16x4 lo4 = __builtin_bit_cast(s16x4, __builtin_amdgcn_ds_read_tr16_b64_v4i16((LAS s16x4*)(Vb + voff[dt][0])));
        const s16x4 hi4 = __builtin_bit_cast(s16x4, __builtin_amdgcn_ds_read_tr16_b64_v4i16((LAS s16x4*)(Vb + voff[dt][1])));
        const bf16x8 av = (bf16x8){lo4[0], lo4[1], lo4[2], lo4[3], hi4[0], hi4[1], hi4[2], hi4[3]};
        if (DOA) A.o[dt] = __builtin_amdgcn_mfma_f32_16x16x32_bf16(av, pA, A.o[dt], 0, 0, 0);
        if (DOB) B.o[dt] = __builtin_amdgcn_mfma_f32_16x16x32_bf16(av, pB, B.o[dt], 0, 0, 0);
    }
}
__device__ __forceinline__ void phase_attn(const Params& p, LAS unsigned char* lds, const bool dry) {
    const int tid = threadIdx.x, lane = tid & 63, wave = __builtin_amdgcn_readfirstlane(tid >> 6), G = gridDim.x;
    unsigned char* ws = p.ws;
    bf16_t* Z = (bf16_t*)(ws + WS_Z); const bf16_t* ZCb = (const bf16_t*)(ws + WS_ZC);
    LAS float* btab = (LAS float*)(lds + AT_BIAS);
    const int j = wave & 3, c16 = lane & 15, fq = lane >> 4;
    const int cq = 16 * j + c16, cst = min(max(cq - 8, 0), 48), kst = min(max(16 * j - 8, 0), 32);
    const int lo = cst - kst - 4 * fq;
    const int dc0 = kst + 4 * fq - cq + 15;
    int cidx[8];
#pragma unroll
    for (int q = 0; q < 8; ++q) { const int li = 16 * (q >> 2) + (q & 3); cidx[q] = 4 * ((li >= lo && li < lo + 16) ? min(max(dc0 + li, 0), 30) : 31); }
    int koff[2][2], voff[4][2];
    { const int i = lane & 15, kq = lane >> 4, jj = (lane & 15) >> 2, q = lane & 3, vr = 4 * kq + jj;
#pragma unroll
      for (int t = 0; t < 2; ++t)
#pragma unroll
          for (int ks = 0; ks < 2; ++ks) koff[t][ks] = (16 * t + i) * 128 + (((4 * ks + kq) ^ (i & 7)) << 4);
#pragma unroll
      for (int dt = 0; dt < 4; ++dt)
#pragma unroll
          for (int t = 0; t < 2; ++t) voff[dt][t] = (16 * t + vr) * 128 + (((2 * dt + (q >> 1)) ^ (vr & 7)) << 4) + 8 * (q & 1); }
    const int drow = 8 * wave + (lane >> 3), dpc = (lane & 7) ^ (lane >> 3);
    const unsigned lds0 = (unsigned)(uintptr_t)lds;
    for (int u = blockIdx.x; u < NB * 16 * 16; u += G) {
        const int b = u >> 8, h = (u >> 4) & 15, r0 = 4 * (u & 15);
        const int kr_lo = min(max(r0 - 4, 0), 56), kr_hi = min(max(r0 - 1, 0), 56) + 7, nloc = kr_hi - kr_lo + 1, nch = nloc + 4;
        const int rA = r0 + (wave >> 2), rB = rA + 2, rsA = min(max(rA - 4, 0), 56), rsB = min(max(rB - 4, 0), 56);
        bf16_t* qA = Z + ((size_t)b * SEQ + rA * 64 + cq) * LDZ + ZC_Q + h * 64;
        bf16_t* qB = Z + ((size_t)b * SEQ + rB * 64 + cq) * LDZ + ZC_Q + h * 64;
        QBlk A, Bq;
#pragma unroll
        for (int ks = 0; ks < 2; ++ks) { A.q[ks] = *(const bf16x8*)(qA + ks * 32 + fq * 8); Bq.q[ks] = *(const bf16x8*)(qB + ks * 32 + fq * 8); }
#pragma unroll
        for (int dt = 0; dt < 4; ++dt) { A.o[dt] = (f32x4){0.f, 0.f, 0.f, 0.f}; Bq.o[dt] = (f32x4){0.f, 0.f, 0.f, 0.f}; }
        A.l = 0.f; Bq.l = 0.f;
        if (u == (int)blockIdx.x) { for (int e = tid; e < 15 * 32; e += NTHREADS) btab[e] = ((e & 31) < 31) ? p.na_rpb[(size_t)h * 465 + (e >> 5) * 31 + (e & 31)] * LOG2E : -1e30f; }
        asm volatile("" :: "v"(A.q[0]), "v"(A.q[1]), "v"(Bq.q[0]), "v"(Bq.q[1]));
        const bf16_t* kbase = Z + ((size_t)b * SEQ + drow) * LDZ + ZC_K + h * 64 + dpc * 8;
        const bf16_t* cbase = ZCb + ((size_t)b * CTX + drow) * LDC + CC_K + h * 64 + dpc * 8;
#define AT_DMA(c_) do { const int c__ = (c_); const unsigned d_ = (unsigned)__builtin_amdgcn_readfirstlane((int)(lds0 + (unsigned)((c__ & (AT_NS - 1)) * AT_SLOT + wave * 1024))); \
            if (c__ < nloc) { const bf16_t* s_ = kbase + (size_t)(kr_lo + c__) * 64 * LDZ; glds16(s_, d_); glds16(s_ + (ZC_V - ZC_K), d_ + 8192u); } \
            else { const bf16_t* s_ = cbase + (size_t)(c__ - nloc) * 64 * LDC; glds16(s_, d_); glds16(s_ + (CC_V - CC_K), d_ + 8192u); } } while (0)
        AT_DMA(0); AT_DMA(1); AT_DMA(2);
        asm volatile("s_waitcnt vmcnt(4) lgkmcnt(0)" ::: "memory"); __builtin_amdgcn_s_barrier(); asm volatile("" ::: "memory");
        for (int c = 0; c < nch; ++c) {
            if (c + 3 < nch) AT_DMA(c + 3);
            { const int nrem = min(nch - 1, c + 3) - (c + 1);
              if (nrem >= 2) asm volatile("s_waitcnt vmcnt(4)" ::: "memory"); else if (nrem == 1) asm volatile("s_waitcnt vmcnt(2)" ::: "memory"); else asm volatile("s_waitcnt vmcnt(0)" ::: "memory"); }
            const LAS unsigned char* Kc = lds + (c & (AT_NS - 1)) * AT_SLOT;
            if (c < nloc) {
                const int kr = kr_lo + c;
                const bool vA = (kr >= rsA && kr < rsA + 8), vB = (kr >= rsB && kr < rsB + 8);
                const LAS unsigned char* bA = (const LAS unsigned char*)btab + min(max(kr - rA + 7, 0), 14) * 128; const LAS unsigned char* bB = (const LAS unsigned char*)btab + min(max(kr - rB + 7, 0), 14) * 128;
                if (vA && vB) attn_proc32<true, true, true>(A, Bq, Kc, kst, koff, voff, cidx, bA, bB);
                else if (vA) attn_proc32<true, true, false>(A, Bq, Kc, kst, koff, voff, cidx, bA, bB);
                else if (vB) attn_proc32<true, false, true>(A, Bq, Kc, kst, koff, voff, cidx, bA, bB);
            } else {
                attn_proc32<false, true, true>(A, Bq, Kc, 0, koff, voff, cidx, (const LAS unsigned char*)btab, (const LAS unsigned char*)btab);
                attn_proc32<false, true, true>(A, Bq, Kc, 32, koff, voff, cidx, (const LAS unsigned char*)btab, (const LAS unsigned char*)btab);
            }
            asm volatile("s_waitcnt lgkmcnt(0)" ::: "memory"); __builtin_amdgcn_s_barrier(); asm volatile("" ::: "memory");
        }
#undef AT_DMA
        {
            float l = A.l; l += __shfl_xor(l, 16); l += __shfl_xor(l, 32); const float il = 1.0f / l;
#pragma unroll
            for (int dt = 0; dt < 4; ++dt) { const f32x4 o = A.o[dt] * il; u32x2 w; w.x = cvt_pk_bf16(o[0], o[1]); w.y = cvt_pk_bf16(o[2], o[3]); if (!dry) *(u32x2*)(qA + dt * 16 + fq * 4) = w; }
            l = Bq.l; l += __shfl_xor(l, 16); l += __shfl_xor(l, 32); const float il2 = 1.0f / l;
#pragma unroll
            for (int dt = 0; dt < 4; ++dt) { const f32x4 o = Bq.o[dt] * il2; u32x2 w; w.x = cvt_pk_bf16(o[0], o[1]); w.y = cvt_pk_bf16(o[2], o[3]); if (!dry) *(u32x2*)(qB + dt * 16 + fq * 4) = w; }
        }
    }
}

constexpr int N2_WRP = 0, N2_CP = 65536, N2_CV = N2_CP + 2048, N2_RS = N2_CV + 64;
__device__ __forceinline__ void phase_norm2(const Params& p, LAS unsigned char* lds) {
    const int tid = threadIdx.x, lane = tid & 63, wave = __builtin_amdgcn_readfirstlane(tid >> 6), G = gridDim.x;
    unsigned char* ws = p.ws;
    const float* MOD = (const float*)(ws + WS_MOD); unsigned char* XN2 = ws + WS_XN2; float* AFF = (float*)(ws + WS_AFF);
    const bf16_t* X1 = (const bf16_t*)(ws + WS_X1);
    LAS float* wrp = (LAS float*)(lds + N2_WRP); LAS float* cpart = (LAS float*)(lds + N2_CP); LAS float* cvec = (LAS float*)(lds + N2_CV); LAS float* rsw = (LAS float*)(lds + N2_RS) + wave * 16;
    const int r16 = lane & 15, kq = lane >> 4;
    int bcur = -1; f32x4 shv[4], scv[4];
    for (int blk = blockIdx.x; blk < MLAT / 128; blk += G) {
        const int b = blk >> 5;
        if (b != bcur) { bcur = b;
            const float* sh2 = MOD + (size_t)b * 6144 + 3072; const float* sc2 = MOD + (size_t)b * 6144 + 4096;
            __syncthreads();
            for (int e = tid; e < 16 * 1024; e += NTHREADS) wrp[e] = (1.0f + sc2[e >> 4]) * p.w_router[e];
            { const int e = tid & 15, part = tid >> 4; float a = 0.f;
              for (int i = 0; i < 32; ++i) { const int k = part + 32 * i; a += sh2[k] * p.w_router[k * 16 + e]; }
              cpart[part * 16 + e] = a; }
#pragma unroll
            for (int j = 0; j < 4; ++j) { shv[j] = *(const f32x4*)(sh2 + 4 * lane + 256 * j); scv[j] = *(const f32x4*)(sc2 + 4 * lane + 256 * j) + 1.0f; }
            __syncthreads();
            if (tid < 16) { float a = 0.f; for (int q = 0; q < 32; ++q) a += cpart[q * 16 + tid]; cvec[tid] = a; }
            __syncthreads();
        }
        const int row0 = blk * 128 + wave * 16;
        f32x4 acc = (f32x4){0.f, 0.f, 0.f, 0.f}; float ss = 0.f;
        const u32x2* xp = (const u32x2*)(X1 + (size_t)(row0 + r16) * DM + 4 * kq);
        const LAS float* wp = wrp + (4 * kq) * 16 + r16;
        u32x2 xa[8], xb[8];
#pragma unroll
        for (int u = 0; u < 8; ++u) xa[u] = xp[4 * u];
#pragma unroll 1
        for (int t0 = 0; t0 < 64; t0 += 16) {
#pragma unroll
            for (int u = 0; u < 8; ++u) xb[u] = xp[4 * (t0 + 8 + u)];
#pragma unroll
            for (int u = 0; u < 8; ++u) { const float x0 = bf2f(xa[u].x & 0xffffu), x1v = bf2f(xa[u].x >> 16), x2 = bf2f(xa[u].y & 0xffffu), x3 = bf2f(xa[u].y >> 16);
                ss += (x0 * x0 + x1v * x1v) + (x2 * x2 + x3 * x3);
                const LAS float* w = wp + (t0 + u) * 256;
                acc = __builtin_amdgcn_mfma_f32_16x16x4f32(x0, w[0], acc, 0, 0, 0); acc = __builtin_amdgcn_mfma_f32_16x16x4f32(x1v, w[16], acc, 0, 0, 0);
                acc = __builtin_amdgcn_mfma_f32_16x16x4f32(x2, w[32], acc, 0, 0, 0); acc = __builtin_amdgcn_mfma_f32_16x16x4f32(x3, w[48], acc, 0, 0, 0); }
            if (t0 + 16 < 64) {
#pragma unroll
                for (int u = 0; u < 8; ++u) xa[u] = xp[4 * (t0 + 16 + u)]; }
#pragma unroll
            for (int u = 0; u < 8; ++u) { const float x0 = bf2f(xb[u].x & 0xffffu), x1v = bf2f(xb[u].x >> 16), x2 = bf2f(xb[u].y & 0xffffu), x3 = bf2f(xb[u].y >> 16);
                ss += (x0 * x0 + x1v * x1v) + (x2 * x2 + x3 * x3);
                const LAS float* w = wp + (t0 + 8 + u) * 256;
                acc = __builtin_amdgcn_mfma_f32_16x16x4f32(x0, w[0], acc, 0, 0, 0); acc = __builtin_amdgcn_mfma_f32_16x16x4f32(x1v, w[16], acc, 0, 0, 0);
                acc = __builtin_amdgcn_mfma_f32_16x16x4f32(x2, w[32], acc, 0, 0, 0); acc = __builtin_amdgcn_mfma_f32_16x16x4f32(x3, w[48], acc, 0, 0, 0); }
        }
        ss += __shfl_xor(ss, 16); ss += __shfl_xor(ss, 32);
        const float rs = 1.0f / sqrtf(ss * (1.0f / DM) + 1e-6f);
        if (lane < 16) rsw[lane] = rs;
        LDS_WAIT(); asm volatile("" ::: "memory");
        { const float cv = cvec[r16]; float lg[4], mx[4], ex[4], sm[4];
#pragma unroll
          for (int q = 0; q < 4; ++q) { lg[q] = rsw[4 * kq + q] * acc[q] + cv; mx[q] = lg[q]; }
#pragma unroll
          for (int o = 1; o < 16; o <<= 1)
#pragma unroll
              for (int q = 0; q < 4; ++q) mx[q] = fmaxf(mx[q], __shfl_xor(mx[q], o));
#pragma unroll
          for (int q = 0; q < 4; ++q) { ex[q] = expf(lg[q] - mx[q]); sm[q] = ex[q]; }
#pragma unroll
          for (int o = 1; o < 16; o <<= 1)
#pragma unroll
              for (int q = 0; q < 4; ++q) sm[q] += __shfl_xor(sm[q], o);
#pragma unroll
          for (int q = 0; q < 4; ++q) AFF[(size_t)(row0 + 4 * kq + q) * 16 + r16] = ex[q] / sm[q]; }
        u32x2 nx[4], ny[4];
        { const u32x2* xr = (const u32x2*)(X1 + (size_t)row0 * DM) + lane;
#pragma unroll
          for (int j = 0; j < 4; ++j) { nx[j] = xr[64 * j]; ny[j] = xr[64 * j + 256]; } }
        for (int q = 0; q < 16; ++q) {
            const float rq = rsw[q];
            f32x4 v[4];
#pragma unroll
            for (int j = 0; j < 4; ++j) { v[j] = (f32x4){bf2f(nx[j].x & 0xffffu), bf2f(nx[j].x >> 16), bf2f(nx[j].y & 0xffffu), bf2f(nx[j].y >> 16)}; nx[j] = ny[j]; }
            if (q + 2 < 16) { const u32x2* xr = (const u32x2*)(X1 + (size_t)(row0 + q + 2) * DM) + lane;
#pragma unroll
                for (int j = 0; j < 4; ++j) ny[j] = xr[64 * j]; }
            unsigned* o4 = (unsigned*)(XN2 + (size_t)(row0 + q) * DM) + lane;
#pragma unroll
            for (int j = 0; j < 4; ++j) { v[j] = v[j] * rq * scv[j] + shv[j]; o4[64 * j] = pk4_fp8(v[j].x, v[j].y, v[j].z, v[j].w); }
        }
    }
}

__device__ __forceinline__ void phase_topk(const Params& p, LAS unsigned char* lds) {
    const int tid = threadIdx.x, lane = tid & 63, wave = tid >> 6, G = gridDim.x;
    unsigned char* ws = p.ws;
    const float* AFF = (const float*)(ws + WS_AFF); int* SELIDX = (int*)(ws + WS_SELIDX); float* SELG = (float*)(ws + WS_SELG); int* SLOT = (int*)(ws + WS_SLOT);
    LAS unsigned* hist = (LAS unsigned*)lds;
    LAS unsigned* ctl = hist + 256;
    LAS unsigned* wtot = hist + 264;
    for (int it = blockIdx.x; it < NB * NEXP; it += G) {
        const int b = it >> 4, e = it & 15;
        unsigned v[8];
#pragma unroll
        for (int j = 0; j < 8; ++j) v[j] = __builtin_bit_cast(unsigned, AFF[((size_t)b * SEQ + tid * 8 + j) * 16 + e]);
        unsigned prefix = 0u, mask = 0u, need = CAP;
        for (int shift = 24; shift >= 0; shift -= 8) {
            __syncthreads();
            if (tid < 256) hist[tid] = 0u;
            __syncthreads();
#pragma unroll
            for (int j = 0; j < 8; ++j) if ((v[j] & mask) == prefix) atomicAdd((unsigned*)&hist[(v[j] >> shift) & 255u], 1u);
            __syncthreads();
            if (tid < 64) {
                unsigned cb[4], tot = 0u;
#pragma unroll
                for (int k = 0; k < 4; ++k) { cb[k] = hist[255 - 4 * lane - k]; tot += cb[k]; }
                unsigned inc = tot;
#pragma unroll
                for (int o = 1; o < 64; o <<= 1) { const unsigned a = __shfl_up(inc, o); if (lane >= o) inc += a; }
                unsigned cum = inc - tot;
#pragma unroll
                for (int k = 0; k < 4; ++k) { if (cum < need && need <= cum + cb[k]) { ctl[0] = (unsigned)(255 - 4 * lane - k); ctl[1] = need - cum; } cum += cb[k]; }
            }
            __syncthreads();
            prefix |= ctl[0] << shift; mask |= 255u << shift; need = ctl[1];
        }
        unsigned ngt = 0u, neq = 0u;
#pragma unroll
        for (int j = 0; j < 8; ++j) { ngt += (v[j] > prefix) ? 1u : 0u; neq += (v[j] == prefix) ? 1u : 0u; }
        unsigned sg = ngt, se = neq;
#pragma unroll
        for (int o = 1; o < 64; o <<= 1) { const unsigned a = __shfl_up(sg, o), c2 = __shfl_up(se, o); if (lane >= o) { sg += a; se += c2; } }
        __syncthreads();
        if (lane == 63) { wtot[wave] = sg; wtot[8 + wave] = se; }
        __syncthreads();
        unsigned og = sg - ngt, oe = se - neq, totg = 0u;
        for (int w = 0; w < 8; ++w) { const unsigned a = wtot[w], c2 = wtot[8 + w]; if (w < wave) { og += a; oe += c2; } totg += a; }
#pragma unroll
        for (int j = 0; j < 8; ++j) {
            const int tkn = tid * 8 + j; int slot = -1;
            if (v[j] > prefix) slot = (int)og++;
            else if (v[j] == prefix) { if (oe < need) slot = (int)(totg + oe); ++oe; }
            const int erow = b * CAP + slot;
            SLOT[((size_t)b * SEQ + tkn) * 16 + e] = (slot >= 0) ? erow : -1;
            if (slot >= 0) { SELIDX[e * EROWS + erow] = b * SEQ + tkn; SELG[e * EROWS + erow] = __builtin_bit_cast(float, v[j]); }
        }
    }
    __syncthreads();
    {
        LAS float* scr = (LAS float*)(lds + wave * TR_SCR);
        unsigned char* WGU = ws + WS_WGU; unsigned char* WD = ws + WS_WD;
        const int gw = blockIdx.x * NWAVES + wave, NGW = G * NWAVES;
        constexpr int I_G = 16 * 32, I_D = 32 * 16, NIT = 16 * (2 * I_G + I_D);
        auto decode = [&](int it, TrItem& t) {
            const int e = it / (2 * I_G + I_D); int r = it % (2 * I_G + I_D);
            if (r < 2 * I_G) { const int up = r / I_G; r %= I_G; const int kb = r / 32, nb = r % 32;
                t.src = (up ? p.w_exp_up : p.w_exp_gate) + (size_t)e * 1024 * 2048 + (size_t)(64 * kb) * 2048 + 64 * nb; t.ldw = 2048;
                t.dst = WGU + (size_t)e * 4096 * 1024 + 64 * kb; t.ldk = 1024; t.n0 = 64 * nb; t.up = up; }
            else { r -= 2 * I_G; const int kb = r / 16, nb = r % 16;
                t.src = p.w_exp_down + (size_t)e * 2048 * 1024 + (size_t)(64 * kb) * 1024 + 64 * nb; t.ldw = 1024;
                t.dst = WD + (size_t)e * 1024 * 2048 + 64 * kb; t.ldk = 2048; t.n0 = 64 * nb; t.up = -1; }
        };
        TrItem ta, tb; f32x4 va[16], vb[16];
        int it = gw;
        if (it < NIT) { decode(it, ta); tr_load(ta, lane, va); }
        while (it < NIT) {
            decode(it + NGW < NIT ? it + NGW : it, tb); tr_load(tb, lane, vb);
            tr_store_f8(ta, va, scr, lane);
            it += NGW; if (it >= NIT) break;
            decode(it + NGW < NIT ? it + NGW : it, ta); tr_load(ta, lane, va);
            tr_store_f8(tb, vb, scr, lane);
            it += NGW;
        }
    }
}

__device__ __forceinline__ void phase_final(const Params& p, LAS unsigned char* lds, const bool dry) {
    const int tid = threadIdx.x, lane = tid & 63, wave = tid >> 6, G = gridDim.x;
    unsigned char* ws = p.ws;
    const float* MOD = (const float*)(ws + WS_MOD); const int* SLOT = (const int*)(ws + WS_SLOT); const unsigned char* YE = ws + WS_YE; const float* SELG = (const float*)(ws + WS_SELG);
    const bf16_t* X1 = (const bf16_t*)(ws + WS_X1);
    const int gw = blockIdx.x * NWAVES + wave, NGW = G * NWAVES;
    const int per = (MLAT + NGW - 1) / NGW, r_lo = gw * per, r_hi = min(r_lo + per, MLAT);
    if (r_lo >= r_hi) return;
    f32x4 g2v[4], fnv[4]; int bcur = -1;
#pragma unroll
    for (int j = 0; j < 4; ++j) fnv[j] = *(const f32x4*)(p.final_norm + 4 * lane + 256 * j);
    u32x2 nx[2][4]; int nslot[2]; float ngate[2];
#define FN_PREFETCH(r_) do { _Pragma("unroll") for (int t = 0; t < 2; ++t) { const int rr = (r_) + t; nslot[t] = -1; ngate[t] = 0.f; \
        if (rr < r_hi) { const u32x2* xr_ = (const u32x2*)(X1 + (size_t)rr * DM) + lane; _Pragma("unroll") for (int j = 0; j < 4; ++j) nx[t][j] = xr_[64 * j]; \
            if (lane < 16) { nslot[t] = SLOT[(size_t)rr * 16 + lane]; if (nslot[t] >= 0) ngate[t] = SELG[lane * EROWS + nslot[t]]; } } } } while (0)
    FN_PREFETCH(r_lo);
    for (int row = r_lo; row < r_hi; row += 2) {
        const int b = row >> 12;
        if (b != bcur) { bcur = b;
#pragma unroll
            for (int j = 0; j < 4; ++j) g2v[j] = *(const f32x4*)(MOD + (size_t)b * 6144 + 5120 + 4 * lane + 256 * j); }
        u32x2 cx[2][4]; int myslot[2]; float mygate[2]; unsigned long long live[2]; unsigned yv[2][4][4]; float gt[2][4];
#pragma unroll
        for (int t = 0; t < 2; ++t) { myslot[t] = nslot[t]; mygate[t] = ngate[t]; live[t] = __ballot(myslot[t] >= 0);
#pragma unroll
            for (int j = 0; j < 4; ++j) cx[t][j] = nx[t][j]; }
#pragma unroll
        for (int t = 0; t < 2; ++t)
#pragma unroll
            for (int q = 0; q < 4; ++q) {
                const bool on = live[t] != 0ull; const int e = on ? __builtin_ctzll(live[t]) : 0; live[t] &= live[t] - 1ull;
                const int sl = __shfl(myslot[t], e); gt[t][q] = on ? __shfl(mygate[t], e) : 0.f;
                const unsigned* yp = (const unsigned*)(YE + ((size_t)e * EROWS + (on ? sl : 0)) * DM) + lane;
                if (on) {
#pragma unroll
                    for (int j = 0; j < 4; ++j) yv[t][q][j] = yp[64 * j];
                } else {
#pragma unroll
                    for (int j = 0; j < 4; ++j) yv[t][q][j] = 0u;
                }
            }
        FN_PREFETCH(row + 2);
#pragma unroll
        for (int t = 0; t < 2; ++t) {
            if (row + t >= r_hi) break;
            f32x4 v[4], mo[4];
#pragma unroll
            for (int j = 0; j < 4; ++j) { v[j] = (f32x4){bf2f(cx[t][j].x & 0xffffu), bf2f(cx[t][j].x >> 16), bf2f(cx[t][j].y & 0xffffu), bf2f(cx[t][j].y >> 16)}; mo[j] = (f32x4){0.f, 0.f, 0.f, 0.f}; }
#pragma unroll
            for (int q = 0; q < 4; ++q)
#pragma unroll
                for (int j = 0; j < 4; ++j) { const f32x2 lo = __builtin_amdgcn_cvt_pk_f32_fp8((int)yv[t][q][j], false), hi = __builtin_amdgcn_cvt_pk_f32_fp8((int)yv[t][q][j], true);
                    mo[j].x += gt[t][q] * lo.x; mo[j].y += gt[t][q] * lo.y; mo[j].z += gt[t][q] * hi.x; mo[j].w += gt[t][q] * hi.y; }
            while (live[t]) {
                const int e = __builtin_ctzll(live[t]); live[t] &= live[t] - 1ull;
                const int sl = __shfl(myslot[t], e); const float g1 = __shfl(mygate[t], e);
                const unsigned* yp = (const unsigned*)(YE + ((size_t)e * EROWS + sl) * DM) + lane;
#pragma unroll
                for (int j = 0; j < 4; ++j) { const int w = (int)yp[64 * j]; const f32x2 lo = __builtin_amdgcn_cvt_pk_f32_fp8(w, false), hi = __builtin_amdgcn_cvt_pk_f32_fp8(w, true);
                    mo[j].x += g1 * lo.x; mo[j].y += g1 * lo.y; mo[j].z += g1 * hi.x; mo[j].w += g1 * hi.y; }
            }
            float ss = 0.f;
#pragma unroll
            for (int j = 0; j < 4; ++j) { v[j] = v[j] + g2v[j] * mo[j]; ss += (v[j].x * v[j].x + v[j].y * v[j].y) + (v[j].z * v[j].z + v[j].w * v[j].w); }
            const float rs = 1.0f / sqrtf(wave_sum(ss) * (1.0f / DM) + 1e-6f);
            f32x4* xo = (f32x4*)(p.out + (size_t)(row + t) * DM) + lane;
#pragma unroll
            for (int j = 0; j < 4; ++j) { if (!dry) xo[64 * j] = v[j] * rs * fnv[j]; }
        }
    }
#undef FN_PREFETCH
}

#define XB_TMO      128
#define XB_XCNT(j)  (256  + 64 * (j))
#define XB_XSUB(j)  (1280 + 64 * (j))
#define XB_XGEN(j)  (2304 + 64 * (j))
#define XB_TOP      3328
#define XB_TOPGEN   3392
#define XCD_BAR_WORDS 3456
#define XB_SPIN_CAP (1u << 20)
__device__ __forceinline__ unsigned xb_ld(unsigned* p)              { return __hip_atomic_load(p, __ATOMIC_RELAXED, __HIP_MEMORY_SCOPE_AGENT); }
__device__ __forceinline__ unsigned xb_add(unsigned* p, unsigned v) { return __hip_atomic_fetch_add(p, v, __ATOMIC_RELAXED, __HIP_MEMORY_SCOPE_AGENT); }
__device__ __forceinline__ unsigned xb_xcc_id() { return (unsigned)__builtin_amdgcn_s_getreg((3 << 11) | 20) & 0xFu; }
#define XB_SPIN(cond, bar) do { unsigned _sp = 0; while (cond) { __builtin_amdgcn_s_sleep(1); \
    if ((++_sp & 255u) == 0u) { if (xb_ld(&(bar)[XB_TMO])) break; if (_sp > XB_SPIN_CAP) { atomicAdd(&(bar)[XB_TMO], 1u); break; } } } } while (0)
struct XcdBarrier { unsigned* bar; unsigned x; volatile LAS unsigned* st; };
__device__ __forceinline__ XcdBarrier xcd_barrier_post(unsigned* bar, volatile LAS unsigned* st) {
    XcdBarrier b; b.bar = bar; b.x = xb_xcc_id(); b.st = st;
    if (threadIdx.x == 0) (void)xb_add(&bar[XB_XCNT(b.x)], 1u);
    return b;
}
__device__ __forceinline__ void xcd_barrier_complete(unsigned* bar, unsigned x, unsigned& nloc, unsigned& nx) {
    const unsigned G = gridDim.x * gridDim.y * gridDim.z;
    unsigned sum, cnt, mine, sp = 0u;
    for (;;) {
        sum = 0u; cnt = 0u; mine = 0u;
#pragma unroll
        for (unsigned j = 0; j < 16; ++j) { const unsigned c = xb_ld(&bar[XB_XCNT(j)]); sum += c; cnt += (c > 0u) ? 1u : 0u; mine = (j == x) ? c : mine; }
        if (sum == G) break;
        __builtin_amdgcn_s_sleep(1);
        if ((++sp & 255u) == 0u) { if (xb_ld(&bar[XB_TMO])) break; if (sp > XB_SPIN_CAP) { atomicAdd(&bar[XB_TMO], 1u); break; } }
    }
    nloc = mine > 0u ? mine : 1u; nx = cnt > 0u ? cnt : 1u;
}
__device__ __forceinline__ void xcd_barrier(const XcdBarrier& b) {
    asm volatile("s_waitcnt vmcnt(0)" ::: "memory");
    __syncthreads();
    if (threadIdx.x == 0) {
        unsigned* bar = b.bar;
        __builtin_amdgcn_s_waitcnt(0);
        unsigned nloc = b.st[0], nx = b.st[1];
        if (nloc == 0u) { xcd_barrier_complete(bar, b.x, nloc, nx); b.st[0] = nloc; b.st[1] = nx; }
        const unsigned old = xb_add(&bar[XB_XSUB(b.x)], 1u);
        const unsigned gen = old / nloc;
        if (old + 1u == (gen + 1u) * nloc) {
            __builtin_amdgcn_fence(__ATOMIC_RELEASE, "agent");
            asm volatile("s_waitcnt vmcnt(0)" ::: "memory");
            const unsigned og = xb_add(&bar[XB_TOP], 1u);
            const unsigned tg = og / nx;
            if (og + 1u == (tg + 1u) * nx) xb_add(&bar[XB_TOPGEN], 1u);
            else XB_SPIN(xb_ld(&bar[XB_TOPGEN]) == tg, bar);
            __builtin_amdgcn_fence(__ATOMIC_ACQUIRE, "agent");
            xb_add(&bar[XB_XGEN(b.x)], 1u);
            asm volatile("s_waitcnt vmcnt(0)" ::: "memory");
        } else {
            XB_SPIN(xb_ld(&bar[XB_XGEN(b.x)]) == gen, bar);
            __builtin_amdgcn_fence(__ATOMIC_ACQUIRE, "agent");
            asm volatile("s_waitcnt vmcnt(0)" ::: "memory");
        }
    }
    __syncthreads();
}

constexpr int NPHASE = 12;
__global__ void __launch_bounds__(NTHREADS, 2) mk_fwd(Params p) {
    extern __shared__ __attribute__((aligned(16))) unsigned char lds_raw[];
    LAS unsigned char* lds = (LAS unsigned char*)lds_raw;
    cg::grid_group grid = cg::this_grid();
    unsigned char* ws = p.ws;
    const int G = gridDim.x, cblk = blockIdx.x;
#ifndef PH_MASK
#define PH_MASK 0xfff
#endif
#define IN(k) (((PH_MASK >> (k)) & 1) && p.ph_lo <= (k) && (k) < p.ph_hi)
    { volatile LAS unsigned* st0 = (volatile LAS unsigned*)(lds + LDS_BYTES - 256); if (threadIdx.x < 64) st0[threadIdx.x] = 0u; }
    __syncthreads();
    XcdBarrier xbar = xcd_barrier_post((unsigned*)(ws + WS_CTL) + 4096, (volatile LAS unsigned*)(lds + LDS_BYTES - 256));
    if (p.ph_lo < 0) grid.sync();
#define SEAM(k) do { if (IN(k) && IN((k) + 1)) xcd_barrier(xbar); } while (0)
    if (IN(0)) phase_prep(p, lds);
    SEAM(0);
    if (IN(1)) { phase_prep_weights(p, lds); phase_norm1(p, lds); }
    SEAM(1);
    if (IN(2)) {
        InprojSched S{(const bf16_t*)(ws + WS_XN), (const bf16_t*)(ws + WS_WINT), G, cblk, 1024, 1024, 1024};
        EpiInproj<false> E{(bf16_t*)(ws + WS_Z), (bf16_t*)(ws + WS_ZC), (const float*)(ws + WS_BINZ), (const float*)(ws + WS_ROPE)};
        if (p.probe & 4) { EpiInproj<true> E2{(bf16_t*)(ws + WS_Z), (bf16_t*)(ws + WS_ZC), (const float*)(ws + WS_BINZ), (const float*)(ws + WS_ROPE)}; pg8::gemm_phase<EpiInproj<true>, InprojSched>(lds, S, E2); xcd_barrier(xbar); }
        if (p.probe & 32768) { pg8::gemm_phase<EpiInproj<false>, InprojSched>(lds, S, E); xcd_barrier(xbar); }
        pg8::gemm_phase<EpiInproj<false>, InprojSched>(lds, S, E);
    }
    SEAM(2);
    if (IN(3)) { if (p.probe & 8) { phase_rnn(p, lds, true); __syncthreads(); } phase_rnn(p, lds, false); }
    if (IN(3) && IN(4)) __syncthreads();
    if (IN(4)) { if (p.probe & 16) { phase_attn(p, lds, true); __syncthreads(); } phase_attn(p, lds, false); }
    SEAM(4);
    if (IN(5)) {
        MixSched S{(const bf16_t*)(ws + WS_Z), (const bf16_t*)(ws + WS_WMIX), G, cblk, LDZ, 2048, 2048};
        EpiMix E{(bf16_t*)(ws + WS_Z)};
        pg8::gemm_phase<EpiMix, MixSched>(lds, S, E);
    }
    SEAM(5);
    if (IN(6)) {
        WoutSched S{(const bf16_t*)(ws + WS_Z), (const bf16_t*)(ws + WS_WOUT), G, cblk, LDZ, 1024, 1024};
        EpiWout E{p.x, (bf16_t*)(ws + WS_X1), (const float*)(ws + WS_MOD)};
        pg8::gemm_phase<EpiWout, WoutSched>(lds, S, E);
    }
    SEAM(6);
    if (IN(7)) phase_norm2(p, lds);
    SEAM(7);
    if (IN(8)) phase_topk(p, lds);
    SEAM(8);
    if (IN(9)) {
        Moe1Sched S{ws + WS_XN2, ws + WS_WGU, (const int*)(ws + WS_SELIDX), G, cblk, 1024, 1024, 1024};
        EpiMoe1 E{ws + WS_HID};
        pg8::gemm_phase<EpiMoe1, Moe1Sched, true>(lds, S, E);
    }
    SEAM(9);
    if (IN(10)) {
        Moe2Sched S{ws + WS_HID, ws + WS_WD, G, cblk, 2048, 2048, 2048};
        EpiMoe2 E{ws + WS_YE};
        pg8::gemm_phase<EpiMoe2, Moe2Sched, true>(lds, S, E);
    }
    SEAM(10);
    if (IN(11)) { if (p.probe & 2048) { phase_final(p, lds, true); __syncthreads(); } phase_final(p, lds, false); }
#undef IN
#undef SEAM
}

#ifndef MK_SINGLE
#define MK_SINGLE 1
#endif
extern "C" void kernel_launch(void* const* d_in, const int* in_sizes, int n_in, void* d_out, int out_size, void* d_ws, size_t ws_size, hipStream_t stream) {
    static int grid = 0;
    if (grid == 0) {
        int dev = 0, cus = 0, per_cu = 0;
        if (n_in != 24 || out_size != MLAT * DM || ws_size < WS_END) { fprintf(stderr, "kernel_launch: unexpected problem (n_in %d, out %d, ws %zu < %zu)\n", n_in, out_size, ws_size, (size_t)WS_END); grid = -1; return; }
        if (hipGetDevice(&dev) != hipSuccess || hipDeviceGetAttribute(&cus, hipDeviceAttributeMultiprocessorCount, dev) != hipSuccess) { grid = -1; return; }
        if (hipFuncSetAttribute((const void*)mk_fwd, hipFuncAttributeMaxDynamicSharedMemorySize, LDS_BYTES) != hipSuccess) { fprintf(stderr, "kernel_launch: hipFuncSetAttribute failed\n"); grid = -1; return; }
        if (hipOccupancyMaxActiveBlocksPerMultiprocessor(&per_cu, (const void*)mk_fwd, NTHREADS, LDS_BYTES) != hipSuccess || per_cu < 1) { fprintf(stderr, "kernel_launch: occupancy query says %d\n", per_cu); grid = -1; return; }
        grid = cus;
    }
    if (grid < 0) return;
    (void)hipMemsetAsync((char*)d_ws + WS_CTL, 0, 1 * MiB, stream);
    Params p{};
    const float** pp = (const float**)&p;
    for (int i = 0; i < 24; ++i) pp[i] = (const float*)d_in[i];
#ifndef PROBE_MASK
#define PROBE_MASK 0
#endif
    p.out = (float*)d_out; p.ws = (unsigned char*)d_ws; p.probe = PROBE_MASK;
#if MK_SINGLE
    p.ph_lo = 0; p.ph_hi = NPHASE;
    void* args[] = {&p};
    hipError_t e = hipLaunchCooperativeKernel((const void*)mk_fwd, dim3(grid), dim3(NTHREADS), args, LDS_BYTES, stream);
    if (e != hipSuccess) fprintf(stderr, "kernel_launch: cooperative launch failed: %s (grid %d)\n", hipGetErrorString(e), grid);
#else
#ifndef REP_MASK
#define REP_MASK 0
#endif
    for (int ph = 0; ph < NPHASE; ++ph) {
        p.ph_lo = ph; p.ph_hi = ph + 1;
        for (int rep = 0; rep < 1 + ((REP_MASK >> ph) & 1); ++rep) hipLaunchKernelGGL(mk_fwd, dim3(grid), dim3(NTHREADS), LDS_BYTES, stream, p);
    }
#endif
}
```

```cpp
#include <hip/hip_runtime.h>
#include <hip/hip_cooperative_groups.h>
#include <cstdio>
#include <cstdint>
namespace cg = cooperative_groups;

#define LAS __attribute__((address_space(3)))
typedef unsigned short bf16_t;
typedef short bf16x8 __attribute__((ext_vector_type(8)));
typedef float f32x4 __attribute__((ext_vector_type(4)));
typedef float f32x2 __attribute__((ext_vector_type(2)));
typedef unsigned u32x4 __attribute__((ext_vector_type(4)));
typedef unsigned u32x2 __attribute__((ext_vector_type(2)));

constexpr int NB = 8, SEQ = 4096, DM = 1024, CTX = 256;
constexpr int MLAT = NB * SEQ, MCTX = NB * CTX;
constexpr int NIN = 7168, NEXP = 16, DEXP = 2048, CAP = 512, EROWS = NB * CAP;
constexpr int LDZ = 7168, ZC_YG = 0, ZC_Q = 1024, ZC_XR = 2048, ZC_K = 3072, ZC_V = 4096, ZC_GR = 5120, ZC_GN = 6144;
constexpr int LDC = 3072, CC_XR = 0, CC_K = 1024, CC_V = 2048;
constexpr float LOG2E = 1.4426950408889634f;
constexpr float QSCALE = 0.125f * LOG2E;

constexpr size_t MiB = 1u << 20;
constexpr size_t WS_CTL = 0;
constexpr size_t WS_MOD = 1 * MiB;
constexpr size_t WS_MODP = 2 * MiB;
constexpr size_t WS_ROPE = 9 * MiB;
constexpr size_t WS_BINZ = 9 * MiB + 65536;
constexpr size_t WS_AFF = 10 * MiB;
constexpr size_t WS_SELIDX = 12 * MiB;
constexpr size_t WS_SELG = 12 * MiB + 262144;
constexpr size_t WS_SLOT = 13 * MiB;
constexpr size_t WS_WINT = 16 * MiB;
constexpr size_t WS_WMIX = 30 * MiB;
constexpr size_t WS_WOUT = 34 * MiB;
constexpr size_t WS_ZC = 36 * MiB;
constexpr size_t WS_XN = 48 * MiB;
constexpr size_t WS_Z = 116 * MiB;
constexpr size_t WS_WGU = 116 * MiB;
constexpr size_t WS_WD = 180 * MiB;
constexpr size_t WS_HID = 212 * MiB;
constexpr size_t WS_YE = 340 * MiB;
constexpr size_t WS_X1 = 48 * MiB;
constexpr size_t WS_XN2 = 468 * MiB;
constexpr size_t WS_END = 564 * MiB;

constexpr int NTHREADS = 512, NWAVES = 8;
constexpr int LDS_BYTES = 147456;

__device__ __forceinline__ unsigned f2bf(float f) { unsigned u = __builtin_bit_cast(unsigned, f); return (u + 0x7fffu + ((u >> 16) & 1u)) >> 16; }
__device__ __forceinline__ float bf2f(unsigned h) { return __builtin_bit_cast(float, h << 16); }
__device__ __forceinline__ unsigned pk2(float lo, float hi) { return f2bf(lo) | (f2bf(hi) << 16); }
__device__ __forceinline__ unsigned cvt_pk_bf16(float lo, float hi) { unsigned r; asm volatile("v_cvt_pk_bf16_f32 %0, %1, %2" : "=v"(r) : "v"(lo), "v"(hi)); return r; }
__device__ __forceinline__ float wave_sum(float v) {
#pragma unroll
    for (int o = 1; o < 64; o <<= 1) v += __shfl_xor(v, o);
    return v;
}
__device__ __forceinline__ float sigmoidf_(float x) { return __builtin_amdgcn_rcpf(1.0f + __builtin_amdgcn_exp2f(-x * LOG2E)); }
__device__ __forceinline__ float gelu_tanh(float x) { const float u = 0.7978845608028654f * (x + 0.044715f * x * x * x); return x * __builtin_amdgcn_rcpf(1.0f + __builtin_amdgcn_exp2f(-2.0f * LOG2E * u)); }
#define LDS_WAIT() asm volatile("s_waitcnt lgkmcnt(0)" ::: "memory")

namespace pg8 {
constexpr int BM = 256, BK = 64, HALF = 128, HTB = HALF * BK * 2, STAGE_BYTES = 8 * HTB, NXCD = 8, WGM = 8;
__host__ __device__ __forceinline__ int swz_f(int r) { const int u = (r >> 1) & 7; return (u & 3) | ((((u >> 1) ^ (u >> 2)) & 1) << 2); }
__host__ __device__ __forceinline__ int lds_byte(int r, int c) { return r * 128 + ((((c >> 3) ^ swz_f(r)) << 4) | ((c & 7) * 2)); }
__host__ __device__ __forceinline__ void stage_rc(int b, int& R, int& C) { R = b >> 7; C = (((b >> 4) & 7) ^ swz_f(R)) * 8; }
__host__ __device__ __forceinline__ int perm32(int rho) { const int n = rho >> 4, i = rho & 15; return 8 * (i >> 2) + 4 * n + (i & 3); }

struct Unit { int pm, pb, x0, x1; };

__device__ __forceinline__ void tile_of(int L, int nM, int nN, int& pm, int& pn) {
    const int nwg = nM * nN; int wgid = L;
    { const int q = nwg / NXCD, r = nwg % NXCD, xcd = wgid % NXCD, off = wgid / NXCD; wgid = (xcd < r ? xcd * (q + 1) : r * (q + 1) + (xcd - r) * q) + off; }
    const int nig = WGM * nN, gid = wgid / nig, fm = gid * WGM, gsz = (nM - fm) < WGM ? (nM - fm) : WGM;
    pm = fm + ((wgid % nig) % gsz); pn = (wgid % nig) / gsz;
}

typedef int i32x8 __attribute__((ext_vector_type(8)));
constexpr int F8_SCALE_W = 0x79797979, F8_SCALE_X = 0x7f7f7f7f;
template <class Epi, class Sched, bool F8 = false>
__device__ __forceinline__ void gemm_phase(LAS unsigned char* lds, const Sched& S, const Epi& E) {
    const int tid = threadIdx.x, wid = __builtin_amdgcn_readfirstlane(tid >> 6), lane = tid & 63, wr = wid >> 2, wc = wid & 3, fr = lane & 15, fq = lane >> 4;
    constexpr int ESZ = F8 ? 1 : 2;
    const int K = S.K, nt = K * ESZ / (BK * 2);
    int Rl[2], Cl[2];
    unsigned voffA[2][2], voffB[2];
#pragma unroll
    for (int i = 0; i < 2; ++i) { stage_rc(tid * 16 + i * 8192, Rl[i], Cl[i]); const int Rb = Epi::PERM ? ((Rl[i] & ~31) + perm32(Rl[i] & 31)) : Rl[i];
        voffB[i] = (unsigned)(Rb * S.ldb * ESZ + Cl[i] * 2); }
    const size_t kstep = (size_t)(BK * 2);
    const size_t hstepB = (size_t)HALF * S.ldb * ESZ, hstepA = (size_t)HALF * S.lda * ESZ;
    const unsigned ldsw = (unsigned)wid * 1024u;
    const int aof0 = F8 ? lds_byte(wr * 64 + fr, fq * 16) : lds_byte(wr * 64 + fr, fq * 8), aof1 = F8 ? lds_byte(wr * 64 + fr, fq * 16 + 8) : lds_byte(wr * 64 + fr, 32 + fq * 8);
    const int bof0 = F8 ? lds_byte(wc * 32 + fr, fq * 16) : lds_byte(wc * 32 + fr, fq * 8), bof1 = F8 ? lds_byte(wc * 32 + fr, fq * 16 + 8) : lds_byte(wc * 32 + fr, 32 + fq * 8);
#define PG8_SA(b, h) (((b) * 2 + (h)) * HTB)
#define PG8_SB(b, h) ((4 + (b) * 2 + (h)) * HTB)
#define PG8_STAGEB(bufoff, gbase) do { _Pragma("unroll") for (int _i = 0; _i < 2; ++_i) \
        __builtin_amdgcn_global_load_lds((const unsigned*)((const char*)(gbase) + voffB[_i]), (LAS unsigned*)(lds + (bufoff) + ldsw + _i * 8192), 16, 0, 0); } while (0)
#define PG8_STAGEA(bufoff, gbase, h, vo) do { _Pragma("unroll") for (int _i = 0; _i < 2; ++_i) { \
        if constexpr (Sched::GATHER) __builtin_amdgcn_global_load_lds((const unsigned*)((const char*)(gbase) + (vo)[h][_i]), (LAS unsigned*)(lds + (bufoff) + ldsw + _i * 8192), 16, 0, 0); \
        else __builtin_amdgcn_global_load_lds((const unsigned*)((const char*)(gbase) + (h) * hstepA + (vo)[0][_i]), (LAS unsigned*)(lds + (bufoff) + ldsw + _i * 8192), 16, 0, 0); } } while (0)
#define PG8_LD8(d, alo, ahi) do { const u32x4 lo_ = *(const LAS u32x4*)(alo), hi_ = *(const LAS u32x4*)(ahi); d = (i32x8){(int)lo_.x, (int)lo_.y, (int)lo_.z, (int)lo_.w, (int)hi_.x, (int)hi_.y, (int)hi_.z, (int)hi_.w}; } while (0)
#define PG8_LDA(dst, b, h) do { if constexpr (F8) { _Pragma("unroll") for (int m = 0; m < 4; ++m) PG8_LD8(dst##8[m], lds + PG8_SA(b, h) + aof0 + m * 2048, lds + PG8_SA(b, h) + aof1 + m * 2048); } \
        else { _Pragma("unroll") for (int m = 0; m < 4; ++m) _Pragma("unroll") for (int k = 0; k < 2; ++k) dst[m][k] = *(const LAS bf16x8*)(lds + PG8_SA(b, h) + (k ? aof1 : aof0) + m * 2048); } } while (0)
#define PG8_LDB(dst, b, h) do { if constexpr (F8) { _Pragma("unroll") for (int n = 0; n < 2; ++n) PG8_LD8(dst##8[n], lds + PG8_SB(b, h) + bof0 + n * 2048, lds + PG8_SB(b, h) + bof1 + n * 2048); } \
        else { _Pragma("unroll") for (int n = 0; n < 2; ++n) _Pragma("unroll") for (int k = 0; k < 2; ++k) dst[n][k] = *(const LAS bf16x8*)(lds + PG8_SB(b, h) + (k ? bof1 : bof0) + n * 2048); } } while (0)
#define PG8_MMA(ai, bj, At, Bt) do { __builtin_amdgcn_s_setprio(1); _Pragma("unroll") for (int m = 0; m < 4; ++m) _Pragma("unroll") for (int n = 0; n < 2; ++n) { \
        if constexpr (F8) acc[ai][bj][m][n] = __builtin_amdgcn_mfma_scale_f32_16x16x128_f8f6f4(Bt##8[n], At##8[m], acc[ai][bj][m][n], 0, 0, 0, F8_SCALE_W, 0, F8_SCALE_X); \
        else { _Pragma("unroll") for (int k = 0; k < 2; ++k) acc[ai][bj][m][n] = __builtin_amdgcn_mfma_f32_16x16x32_bf16(Bt[n][k], At[m][k], acc[ai][bj][m][n], 0, 0, 0); } } \
        __builtin_amdgcn_s_setprio(0); } while (0)
#define PG8_WAIT_V(n) asm volatile("s_waitcnt vmcnt(" #n ")" ::: "memory")
#define PG8_WAIT_L(n) asm volatile("s_waitcnt lgkmcnt(" #n ")" ::: "memory")
#define PG8_BAR __builtin_amdgcn_s_barrier()
#define PG8_SCHED __builtin_amdgcn_sched_barrier(0)
#define PG8_SETVO(vo, u) do { _Pragma("unroll") for (int _h = 0; _h < 2; ++_h) _Pragma("unroll") for (int _i = 0; _i < 2; ++_i) { \
        if constexpr (Sched::GATHER) (vo)[_h][_i] = (unsigned)(S.row_of(u, _h * HALF + Rl[_i]) * S.lda * ESZ + Cl[_i] * 2); \
        else (vo)[_h][_i] = (unsigned)((_h * HALF + Rl[_i]) * S.lda * ESZ + Cl[_i] * 2); } } while (0)
#define PG8_TRIP_BODY \
            const bool last = (t == nt - 2); \
            const char* a1 = cA + (size_t)(t + 1) * kstep; \
            const char* a2 = last ? nA : cA + (size_t)(t + 2) * kstep; const char* b2 = last ? nB : cB + (size_t)(t + 2) * kstep; \
            const char* a3 = a2 + kstep; const char* b3 = b2 + kstep; \
            PG8_LDB(B0, 0, 0); PG8_LDB(B1, 0, 1); PG8_SCHED; PG8_LDA(At, 0, 0); PG8_STAGEA(PG8_SA(1, 1), a1, 1, voffA); \
            if (last && has_next) { PG8_SETVO(voffA, nxt); asm volatile("" : "+v"(voffA[0][0]), "+v"(voffA[0][1]), "+v"(voffA[1][0]), "+v"(voffA[1][1])); } \
            PG8_WAIT_V(8); PG8_WAIT_L(0); PG8_BAR; PG8_MMA(0, 0, At, B0); PG8_MMA(0, 1, At, B1); PG8_BAR; PG8_SCHED; \
            PG8_LDA(At, 0, 1); PG8_STAGEB(PG8_SB(0, 0), b2); PG8_STAGEB(PG8_SB(0, 1), b2 + hstepB); PG8_STAGEA(PG8_SA(0, 0), a2, 0, voffA); \
            PG8_WAIT_V(8); PG8_WAIT_L(0); PG8_BAR; PG8_MMA(1, 0, At, B0); PG8_MMA(1, 1, At, B1); PG8_BAR; PG8_SCHED; \
            PG8_LDB(B0, 1, 0); PG8_LDB(B1, 1, 1); PG8_SCHED; PG8_LDA(At, 1, 0); PG8_STAGEA(PG8_SA(0, 1), a2, 1, voffA); \
            PG8_WAIT_V(8); PG8_WAIT_L(0); PG8_BAR; PG8_MMA(0, 0, At, B0); PG8_MMA(0, 1, At, B1); PG8_BAR; PG8_SCHED; \
            PG8_LDA(At, 1, 1); PG8_STAGEB(PG8_SB(1, 0), b3); PG8_STAGEB(PG8_SB(1, 1), b3 + hstepB); PG8_STAGEA(PG8_SA(1, 0), a3, 0, voffA); \
            PG8_WAIT_V(8); PG8_WAIT_L(0); PG8_BAR; PG8_MMA(1, 0, At, B0); PG8_MMA(1, 1, At, B1); PG8_BAR; PG8_SCHED; \

    Unit cur, nxt; int ui = 0;
    if (!S.next(0, cur)) return;
    f32x4 acc[2][2][4][2];
#pragma unroll
    for (int a = 0; a < 2; ++a)
#pragma unroll
        for (int b = 0; b < 2; ++b)
#pragma unroll
            for (int m = 0; m < 4; ++m)
#pragma unroll
                for (int n = 0; n < 2; ++n) acc[a][b][m][n] = (f32x4){0.f, 0.f, 0.f, 0.f};
    bf16x8 At[4][2], B0[2][2], B1[2][2];
    i32x8 At8[4], B08[2], B18[2];
    const char* cA = S.a_ptr(cur); const char* cB = S.b_ptr(cur);
    PG8_SETVO(voffA, cur);
    PG8_STAGEB(PG8_SB(0, 0), cB); PG8_STAGEB(PG8_SB(0, 1), cB + hstepB); PG8_STAGEA(PG8_SA(0, 0), cA, 0, voffA); PG8_STAGEA(PG8_SA(0, 1), cA, 1, voffA);
    if (wr == 1) PG8_BAR;
    PG8_WAIT_V(2); PG8_BAR;
    PG8_STAGEB(PG8_SB(1, 0), cB + kstep); PG8_STAGEA(PG8_SA(1, 0), cA + kstep, 0, voffA); PG8_STAGEB(PG8_SB(1, 1), cB + hstepB + kstep);
    PG8_WAIT_V(6); PG8_BAR;
    for (;;) {
        const bool has_next = S.next(ui + 1, nxt);
        const char* nA = has_next ? S.a_ptr(nxt) : cA; const char* nB = has_next ? S.b_ptr(nxt) : cB;
        if constexpr (Epi::MID) {
#pragma unroll 1
            for (int t = 0; t < (nt >> 1); t += 2) { PG8_TRIP_BODY }
            PG8_SCHED; E.mid(acc, cur, wr, wc, fr, fq); PG8_SCHED;
#pragma unroll 1
            for (int t = (nt >> 1); t < nt; t += 2) { PG8_TRIP_BODY }
        } else {
#pragma unroll 1
            for (int t = 0; t < nt; t += 2) { PG8_TRIP_BODY }
        }
        if (wr == 0) PG8_BAR;
        E(acc, cur, wr, wc, fr, fq);
        if (!has_next) break;
#pragma unroll
        for (int a = 0; a < 2; ++a)
#pragma unroll
            for (int b = 0; b < 2; ++b)
#pragma unroll
                for (int m = 0; m < 4; ++m)
#pragma unroll
                    for (int n = 0; n < 2; ++n) acc[a][b][m][n] = (f32x4){0.f, 0.f, 0.f, 0.f};
        cur = nxt; cA = nA; cB = nB; ++ui;
        if (wr == 1) PG8_BAR;
    }
    PG8_WAIT_V(0);
    PG8_BAR;
#undef PG8_SA
#undef PG8_SB
#undef PG8_STAGEA
#undef PG8_STAGEB
#undef PG8_LDA
#undef PG8_LDB
#undef PG8_MMA
#undef PG8_LD8
#undef PG8_WAIT_V
#undef PG8_WAIT_L
#undef PG8_BAR
#undef PG8_SCHED
#undef PG8_SETVO
#undef PG8_TRIP_BODY
}
}

struct InprojSched {
    static constexpr bool GATHER = false;
    const bf16_t* XN; const bf16_t* W; int G, c; int lda, ldb, K;
    __device__ __forceinline__ bool next(int i, pg8::Unit& u) const {
        const int L = i * G + c;
        if (L < 128 * 28) { int pm, pn; pg8::tile_of(L, 128, 28, pm, pn); u.pm = pm; u.pb = pn; u.x0 = 0; u.x1 = 0; return true; }
        const int idx = L - 128 * 28; if (idx >= 96) return false;
        u.pm = 128 + (idx & 7); u.pb = 8 + (idx >> 3); u.x0 = 1; u.x1 = 0; return true;
    }
    __device__ __forceinline__ const char* a_ptr(const pg8::Unit& u) const { return (const char*)XN + (size_t)u.pm * 256 * 1024 * 2; }
    __device__ __forceinline__ const char* b_ptr(const pg8::Unit& u) const { return (const char*)W + (size_t)u.pb * 256 * 1024 * 2; }
    __device__ __forceinline__ int row_of(const pg8::Unit&, int r) const { return r; }
};
struct MixSched {
    static constexpr bool GATHER = false;
    const bf16_t* Z; const bf16_t* W; int G, c; int lda, ldb, K;
    __device__ __forceinline__ bool next(int i, pg8::Unit& u) const {
        const int L = i * G + c; if (L >= 128 * 4) return false;
        int pm, pn; pg8::tile_of(L, 128, 4, pm, pn); u.pm = pm; u.pb = pn; u.x0 = pn; u.x1 = 0; return true;
    }
    __device__ __forceinline__ const char* a_ptr(const pg8::Unit& u) const { return (const char*)Z + (size_t)u.pm * 256 * LDZ * 2; }
    __device__ __forceinline__ const char* b_ptr(const pg8::Unit& u) const { return (const char*)W + (size_t)u.pb * 256 * 2048 * 2; }
    __device__ __forceinline__ int row_of(const pg8::Unit&, int r) const { return r; }
};
struct WoutSched {
    static constexpr bool GATHER = false;
    const bf16_t* Z; const bf16_t* W; int G, c; int lda, ldb, K;
    __device__ __forceinline__ bool next(int i, pg8::Unit& u) const {
        const int L = i * G + c; if (L >= 128 * 4) return false;
        int pm, pn; pg8::tile_of(L, 128, 4, pm, pn); u.pm = pm; u.pb = pn; u.x0 = pn; u.x1 = 0; return true;
    }
    __device__ __forceinline__ const char* a_ptr(const pg8::Unit& u) const { return (const char*)Z + ((size_t)u.pm * 256 * LDZ + ZC_XR) * 2; }
    __device__ __forceinline__ const char* b_ptr(const pg8::Unit& u) const { return (const char*)W + (size_t)u.pb * 256 * 1024 * 2; }
    __device__ __forceinline__ int row_of(const pg8::Unit&, int r) const { return r; }
};
struct Moe1Sched {
    static constexpr bool GATHER = true;
    const unsigned char* XN2; const unsigned char* W; const int* selidx; int G, c; int lda, ldb, K;
    __device__ __forceinline__ bool next(int i, pg8::Unit& u) const {
        const int L = i * G + c; if (L >= 16 * 256) return false;
        const int e = L >> 8, w = L & 255, x = w & 7, j = w >> 3;
        const int mt = (x & 3) * 4 + (j & 3), nt = (x >> 2) * 8 + (j >> 2);
        u.pm = e * 16 + mt; u.pb = e * 16 + nt; u.x0 = nt; u.x1 = e; return true;
    }
    __device__ __forceinline__ const char* a_ptr(const pg8::Unit&) const { return (const char*)XN2; }
    __device__ __forceinline__ const char* b_ptr(const pg8::Unit& u) const { return (const char*)W + (size_t)u.pb * 256 * 1024; }
    __device__ __forceinline__ int row_of(const pg8::Unit& u, int r) const { return selidx[u.pm * 256 + r]; }
};
struct Moe2Sched {
    static constexpr bool GATHER = true;
    const unsigned char* HID; const unsigned char* W; int G, c; int lda, ldb, K;
    __device__ __forceinline__ bool next(int i, pg8::Unit& u) const {
        const int L = i * G + c; if (L >= 16 * 64) return false;
        const int x = L & 7, j = (L >> 3) & 31, e = ((L >> 8) << 2) + (j >> 3), r = j & 7, mt = 2 * x + (r >> 2), pn = r & 3;
        u.pm = e * 16 + mt; u.pb = e * 4 + pn; u.x0 = pn; u.x1 = e; return true;
    }
    __device__ __forceinline__ const char* a_ptr(const pg8::Unit& u) const { return (const char*)HID + (size_t)u.pm * 256 * 2048; }
    __device__ __forceinline__ const char* b_ptr(const pg8::Unit& u) const { return (const char*)W + (size_t)u.pb * 256 * 2048; }
    __device__ __forceinline__ int row_of(const pg8::Unit&, int r) const { return r; }
};

typedef const f32x4 (&AccRef)[2][2][4][2];
template <bool PLAIN = false> struct EpiInproj {
    static constexpr bool PERM = true, MID = false;
    bf16_t* Z; bf16_t* ZC; const float* binz; const float* rope;
    __device__ __forceinline__ void operator()(AccRef acc, const pg8::Unit& u, int wr, int wc, int fr, int fq) const {
        const bool isctx = u.x0 != 0;
        const int seg = PLAIN ? 2 : (u.pb >> 2), colt = u.pb * 256, cl = wc * 32 + 8 * fq;
        f32x4 bv[2][2];
#pragma unroll
        for (int bj = 0; bj < 2; ++bj)
#pragma unroll
            for (int n = 0; n < 2; ++n) bv[bj][n] = *(const f32x4*)(binz + colt + bj * 128 + cl + 4 * n);
        bf16_t* base; int ld, row0;
        if (!isctx) { base = Z + colt; ld = LDZ; row0 = u.pm * 256; } else { base = ZC + (colt - 2048); ld = LDC; row0 = (u.pm - 128) * 256; }
        const bool dorope = (seg == 1) || (seg == 3 && !isctx);
        const float qs = (seg == 1) ? QSCALE : 1.0f;
#pragma unroll
        for (int ai = 0; ai < 2; ++ai)
#pragma unroll
            for (int m = 0; m < 4; ++m) {
                const int r = row0 + ai * 128 + wr * 64 + m * 16 + fr;
                bf16_t* rowp = base + (size_t)r * ld + cl;
                f32x4 cs0 = (f32x4){1.f, 0.f, 1.f, 0.f}, cs1 = cs0;
                if (dorope) { const int t = r & 4095; const int pos = (wc & 1) ? (t & 63) : (t >> 6); const float* cp = rope + (pos * 16 + 4 * fq) * 2; cs0 = *(const f32x4*)cp; cs1 = *(const f32x4*)(cp + 4); }
#pragma unroll
                for (int bj = 0; bj < 2; ++bj) {
                    f32x4 v0 = acc[ai][bj][m][0] + bv[bj][0], v1 = acc[ai][bj][m][1] + bv[bj][1];
                    if (seg == 0) {
#pragma unroll
                        for (int j = 0; j < 4; ++j) { v0[j] = gelu_tanh(v0[j]); v1[j] = gelu_tanh(v1[j]); }
                    } else if (seg >= 5) {
                        unsigned q[8];
#pragma unroll
                        for (int j = 0; j < 4; ++j) { q[j] = (unsigned)__builtin_rintf(255.0f * sigmoidf_(v0[j])); q[4 + j] = (unsigned)__builtin_rintf(255.0f * sigmoidf_(v1[j])); }
                        u32x2 w8; w8.x = q[0] | (q[1] << 8) | (q[2] << 16) | (q[3] << 24); w8.y = q[4] | (q[5] << 8) | (q[6] << 16) | (q[7] << 24);
                        *(u32x2*)((unsigned char*)(Z + (size_t)r * LDZ) + 2 * ZC_GR + 1024 * (seg - 5) + ((u.pb & 3) * 256 + cl + bj * 128)) = w8;
                        continue;
                    } else if (dorope) {
                        const float c[4] = {cs0[0], cs0[2], cs1[0], cs1[2]}, s[4] = {cs0[1], cs0[3], cs1[1], cs1[3]};
#pragma unroll
                        for (int j = 0; j < 4; ++j) { const float x1 = v0[j], x2 = v1[j]; v0[j] = (x1 * c[j] - x2 * s[j]) * qs; v1[j] = (x1 * s[j] + x2 * c[j]) * qs; }
                    }
                    u32x4 w; w.x = cvt_pk_bf16(v0[0], v0[1]); w.y = cvt_pk_bf16(v0[2], v0[3]); w.z = cvt_pk_bf16(v1[0], v1[1]); w.w = cvt_pk_bf16(v1[2], v1[3]);
                    *(u32x4*)(rowp + bj * 128) = w;
                }
            }
    }
};
__device__ __forceinline__ void unpack_u8x8(u32x2 g, f32x4& lo, f32x4& hi) {
    const float k = 1.0f / 255.0f;
    lo = (f32x4){(float)(g.x & 0xffu), (float)((g.x >> 8) & 0xffu), (float)((g.x >> 16) & 0xffu), (float)(g.x >> 24)} * k;
    hi = (f32x4){(float)(g.y & 0xffu), (float)((g.y >> 8) & 0xffu), (float)((g.y >> 16) & 0xffu), (float)(g.y >> 24)} * k;
}
struct EpiMix {
    static constexpr bool PERM = true, MID = true;
    bf16_t* Z;
    __device__ __forceinline__ void mid(f32x4 (&acc)[2][2][4][2], const pg8::Unit& u, int wr, int wc, int fr, int fq) const {
        const int colt = u.x0 * 256, cl = wc * 32 + 8 * fq;
        int r0 = u.pm * 256 + wr * 64 + fr; asm volatile("" : "+v"(r0));
#pragma unroll
        for (int ai = 0; ai < 2; ++ai)
#pragma unroll
            for (int m = 0; m < 4; ++m) {
                const unsigned char* rowg = (const unsigned char*)(Z + (size_t)(r0 + ai * 128 + m * 16) * LDZ) + 2 * ZC_GR + colt + cl;
#pragma unroll
                for (int bj = 0; bj < 2; ++bj) {
                    const u32x2 gr = *(const u32x2*)(rowg + bj * 128), gn = *(const u32x2*)(rowg + 1024 + bj * 128);
                    f32x4 r0v, r1v, n0v, n1v; unpack_u8x8(gr, r0v, r1v); unpack_u8x8(gn, n0v, n1v);
#pragma unroll
                    for (int j = 0; j < 4; ++j) { acc[ai][bj][m][0][j] *= r0v[j] * __builtin_amdgcn_rcpf(fmaxf(n0v[j], 1.0f / 255.0f)); acc[ai][bj][m][1][j] *= r1v[j] * __builtin_amdgcn_rcpf(fmaxf(n1v[j], 1.0f / 255.0f)); }
                    asm volatile("" : "+v"(acc[ai][bj][m][0]), "+v"(acc[ai][bj][m][1]) :: "memory");
                }
            }
    }
    __device__ __forceinline__ void operator()(AccRef acc, const pg8::Unit& u, int wr, int wc, int fr, int fq) const {
        const int colt = u.x0 * 256, cl = wc * 32 + 8 * fq;
        int r0 = u.pm * 256 + wr * 64 + fr; asm volatile("" : "+v"(r0));
#pragma unroll
        for (int ai = 0; ai < 2; ++ai)
#pragma unroll
            for (int m = 0; m < 4; ++m) {
                bf16_t* rowz = Z + (size_t)(r0 + ai * 128 + m * 16) * LDZ + colt + cl;
                const unsigned char* rowg = (const unsigned char*)(Z + (size_t)(r0 + ai * 128 + m * 16) * LDZ) + 2 * ZC_GR + 1024 + colt + cl;
#pragma unroll
                for (int bj = 0; bj < 2; ++bj) {
                    f32x4 n0v, n1v; unpack_u8x8(*(const u32x2*)(rowg + bj * 128), n0v, n1v);
                    n0v = __builtin_elementwise_max(n0v, (f32x4){1.0f / 255.0f, 1.0f / 255.0f, 1.0f / 255.0f, 1.0f / 255.0f}); n1v = __builtin_elementwise_max(n1v, (f32x4){1.0f / 255.0f, 1.0f / 255.0f, 1.0f / 255.0f, 1.0f / 255.0f});
                    const f32x4 v0 = acc[ai][bj][m][0] * n0v, v1 = acc[ai][bj][m][1] * n1v;
                    u32x4 w; w.x = cvt_pk_bf16(v0[0], v0[1]); w.y = cvt_pk_bf16(v0[2], v0[3]); w.z = cvt_pk_bf16(v1[0], v1[1]); w.w = cvt_pk_bf16(v1[2], v1[3]);
                    *(u32x4*)(rowz + ZC_XR + bj * 128) = w;
                }
            }
    }
};
struct EpiWout {
    static constexpr bool PERM = true, MID = false;
    const float* x; bf16_t* x1; const float* mod;
    __device__ __forceinline__ void operator()(AccRef acc, const pg8::Unit& u, int wr, int wc, int fr, int fq) const {
        const int col0 = u.x0 * 256 + wc * 32 + 8 * fq;
        const float* g1p = mod + (size_t)(u.pm >> 4) * 6144 + 2048 + col0;
        f32x4 gv[2][2];
#pragma unroll
        for (int bj = 0; bj < 2; ++bj)
#pragma unroll
            for (int n = 0; n < 2; ++n) gv[bj][n] = *(const f32x4*)(g1p + bj * 128 + n * 4);
#pragma unroll
        for (int ai = 0; ai < 2; ++ai)
#pragma unroll
            for (int m = 0; m < 4; ++m) {
                const size_t off = (size_t)(u.pm * 256 + ai * 128 + wr * 64 + m * 16 + fr) * DM + col0;
#pragma unroll
                for (int bj = 0; bj < 2; ++bj) {
                    const f32x4 x0 = *(const f32x4*)(x + off + bj * 128), x4 = *(const f32x4*)(x + off + bj * 128 + 4);
                    const f32x4 v0 = x0 + gv[bj][0] * acc[ai][bj][m][0], v1 = x4 + gv[bj][1] * acc[ai][bj][m][1];
                    u32x4 w; w.x = cvt_pk_bf16(v0[0], v0[1]); w.y = cvt_pk_bf16(v0[2], v0[3]); w.z = cvt_pk_bf16(v1[0], v1[1]); w.w = cvt_pk_bf16(v1[2], v1[3]);
                    *(u32x4*)(x1 + off + bj * 128) = w;
                }
            }
    }
};
__device__ __forceinline__ unsigned pk4_fp8(float a, float b, float c, float d) { int w = 0; w = __builtin_amdgcn_cvt_pk_fp8_f32(a, b, w, false); w = __builtin_amdgcn_cvt_pk_fp8_f32(c, d, w, true); return (unsigned)w; }
struct EpiMoe1 {
    static constexpr bool PERM = true, MID = false;
    unsigned char* HID;
    __device__ __forceinline__ void operator()(AccRef acc, const pg8::Unit& u, int wr, int wc, int fr, int fq) const {
        const int col0 = u.x0 * 128 + wc * 32 + 8 * fq;
#pragma unroll
        for (int ai = 0; ai < 2; ++ai)
#pragma unroll
            for (int m = 0; m < 4; ++m) {
                const size_t r = (size_t)u.pm * 256 + ai * 128 + wr * 64 + m * 16 + fr;
                f32x4 h0, h1;
#pragma unroll
                for (int j = 0; j < 4; ++j) { const float g0 = acc[ai][0][m][0][j], g1 = acc[ai][0][m][1][j];
                    h0[j] = g0 * sigmoidf_(g0) * acc[ai][1][m][0][j]; h1[j] = g1 * sigmoidf_(g1) * acc[ai][1][m][1][j]; }
                u32x2 w; w.x = pk4_fp8(h0[0], h0[1], h0[2], h0[3]); w.y = pk4_fp8(h1[0], h1[1], h1[2], h1[3]);
                *(u32x2*)(HID + r * DEXP + col0) = w;
            }
    }
};
struct EpiMoe2 {
    static constexpr bool PERM = true, MID = false;
    unsigned char* YE;
    __device__ __forceinline__ void operator()(AccRef acc, const pg8::Unit& u, int wr, int wc, int fr, int fq) const {
        const int col0 = u.x0 * 256 + wc * 32 + 8 * fq;
        const size_t r0 = (size_t)u.pm * 256 + wr * 64 + fr;
        unsigned char* base = YE + r0 * DM + col0;
#pragma unroll
        for (int ai = 0; ai < 2; ++ai)
#pragma unroll
            for (int m = 0; m < 4; ++m) {
                unsigned char* rowp = base + (size_t)(ai * 128 + m * 16) * DM;
#pragma unroll
                for (int bj = 0; bj < 2; ++bj) {
                    const f32x4 v0 = acc[ai][bj][m][0], v1 = acc[ai][bj][m][1];
                    u32x2 w; w.x = pk4_fp8(v0[0], v0[1], v0[2], v0[3]); w.y = pk4_fp8(v1[0], v1[1], v1[2], v1[3]);
                    *(u32x2*)(rowp + bj * 128) = w;
                }
            }
    }
};

struct Params {
    const float *x, *c, *ctx, *c_ctx, *w_mod, *b_mod, *w_in, *b_in, *conv_w, *conv_b, *lru_wa, *lru_ba, *lru_wi, *lru_bi, *lru_lambda, *na_rpb,
                *w_proj_rnn, *w_proj_na, *w_out, *w_router, *w_exp_gate, *w_exp_up, *w_exp_down, *final_norm;
    float* out; unsigned char* ws;
    int ph_lo, ph_hi, probe, pad;
};

__device__ __forceinline__ int zcol_of(int n) {
    const int seg = n >> 10, o = n & 1023;
    if (seg == 0) return ZC_YG + o;
    if (seg == 1) return ZC_XR + o;
    if (seg == 4) return ZC_V + o;
    if (seg == 5) return ZC_GR + o;
    if (seg == 6) return ZC_GN + o;
    const int hh = o >> 6, d = o & 63, g2 = d >> 5, dd = d & 31, nn = dd >> 4, j = dd & 15, a = j >> 2, jj = j & 3;
    return (seg == 2 ? ZC_Q : ZC_K) + hh * 64 + g2 * 32 + 8 * a + 4 * nn + jj;
}
constexpr int TR_SCR = 64 * 65 * 4;
template <class RowMap>
__device__ __forceinline__ void transpose_item(const float* W, int ldw, int k0, int n0, bf16_t* WT, int ldk, RowMap rowmap, LAS float* scr, int lane) {
    const int ln = lane & 15, lk = lane >> 4;
    f32x4 v[16];
#pragma unroll
    for (int i = 0; i < 16; ++i) v[i] = *(const f32x4*)(W + (size_t)(k0 + 4 * i + lk) * ldw + n0 + 4 * ln);
#pragma unroll
    for (int i = 0; i < 16; ++i) { LAS float* d = scr + (4 * i + lk) * 65 + 4 * ln; d[0] = v[i].x; d[1] = v[i].y; d[2] = v[i].z; d[3] = v[i].w; }
    LDS_WAIT(); asm volatile("" ::: "memory");
    const int kg = lane & 7;
#pragma unroll
    for (int j = 0; j < 8; ++j) { const int n = (lane >> 3) + 8 * j; const LAS float* sp = scr + (8 * kg) * 65 + n;
        u32x4 o; o.x = cvt_pk_bf16(sp[0 * 65], sp[1 * 65]); o.y = cvt_pk_bf16(sp[2 * 65], sp[3 * 65]); o.z = cvt_pk_bf16(sp[4 * 65], sp[5 * 65]); o.w = cvt_pk_bf16(sp[6 * 65], sp[7 * 65]);
        *(u32x4*)(WT + (size_t)rowmap(n0 + n) * ldk + k0 + 8 * kg) = o; }
    LDS_WAIT(); asm volatile("" ::: "memory");
}
template <class RowMap>
__device__ __forceinline__ void transpose_item_f8(const float* W, int ldw, int k0, int n0, unsigned char* WT, int ldk, RowMap rowmap, LAS float* scr, int lane) {
    const int ln = lane & 15, lk = lane >> 4;
    f32x4 v[16];
#pragma unroll
    for (int i = 0; i < 16; ++i) v[i] = *(const f32x4*)(W + (size_t)(k0 + 4 * i + lk) * ldw + n0 + 4 * ln);
#pragma unroll
    for (int i = 0; i < 16; ++i) { LAS float* d = scr + (4 * i + lk) * 65 + 4 * ln; d[0] = v[i].x * 64.f; d[1] = v[i].y * 64.f; d[2] = v[i].z * 64.f; d[3] = v[i].w * 64.f; }
    LDS_WAIT(); asm volatile("" ::: "memory");
    const int kq = lane & 3;
#pragma unroll
    for (int j = 0; j < 4; ++j) { const int n = (lane >> 2) + 16 * j; const LAS float* sp = scr + (16 * kq) * 65 + n;
        u32x4 o; o.x = pk4_fp8(sp[0 * 65], sp[1 * 65], sp[2 * 65], sp[3 * 65]); o.y = pk4_fp8(sp[4 * 65], sp[5 * 65], sp[6 * 65], sp[7 * 65]);
        o.z = pk4_fp8(sp[8 * 65], sp[9 * 65], sp[10 * 65], sp[11 * 65]); o.w = pk4_fp8(sp[12 * 65], sp[13 * 65], sp[14 * 65], sp[15 * 65]);
        *(u32x4*)(WT + (size_t)rowmap(n0 + n) * ldk + k0 + 16 * kq) = o; }
    LDS_WAIT(); asm volatile("" ::: "memory");
}
struct TrItem { const float* src; unsigned char* dst; int ldw, ldk, n0, up; };
__device__ __forceinline__ void tr_load(const TrItem& t, int lane, f32x4 (&v)[16]) {
    const int ln = lane & 15, lk = lane >> 4;
#pragma unroll
    for (int i = 0; i < 16; ++i) v[i] = *(const f32x4*)(t.src + (size_t)(4 * i + lk) * t.ldw + 4 * ln);
}
__device__ __forceinline__ void tr_store_f8(const TrItem& t, const f32x4 (&v)[16], LAS float* scr, int lane) {
    const int ln = lane & 15, lk = lane >> 4;
#pragma unroll
    for (int i = 0; i < 16; ++i) { LAS float* d = scr + (4 * i + lk) * 65 + 4 * ln; d[0] = v[i].x * 64.f; d[1] = v[i].y * 64.f; d[2] = v[i].z * 64.f; d[3] = v[i].w * 64.f; }
    LDS_WAIT(); asm volatile("" ::: "memory");
    const int kq = lane & 3;
#pragma unroll
    for (int j = 0; j < 4; ++j) { const int n = (lane >> 2) + 16 * j, na = t.n0 + n; const LAS float* sp = scr + (16 * kq) * 65 + n;
        const int row = t.up < 0 ? na : 256 * (na >> 7) + 128 * t.up + (na & 127);
        u32x4 o; o.x = pk4_fp8(sp[0 * 65], sp[1 * 65], sp[2 * 65], sp[3 * 65]); o.y = pk4_fp8(sp[4 * 65], sp[5 * 65], sp[6 * 65], sp[7 * 65]);
        o.z = pk4_fp8(sp[8 * 65], sp[9 * 65], sp[10 * 65], sp[11 * 65]); o.w = pk4_fp8(sp[12 * 65], sp[13 * 65], sp[14 * 65], sp[15 * 65]);
        *(u32x4*)(t.dst + (size_t)row * t.ldk + 16 * kq) = o; }
    LDS_WAIT(); asm volatile("" ::: "memory");
}
__device__ __forceinline__ void phase_prep(const Params& p, LAS unsigned char* lds) {
    const int tid = threadIdx.x, lane = tid & 63, wave = tid >> 6, G = gridDim.x;
    unsigned char* ws = p.ws;
    {
        LAS float* sS = (LAS float*)lds;
        LAS float* red = sS + 9 * 1024;
        float* MOD = (float*)(ws + WS_MOD);
        if (blockIdx.x < 192) {
            for (int e = tid; e < 9 * 1024; e += NTHREADS) { const int r = e >> 10, k = e & 1023; const float v = (r < 8) ? p.c[r * 1024 + k] : p.c_ctx[k]; sS[e] = v * sigmoidf_(v); }
            __syncthreads();
        }
        for (int it = blockIdx.x; it < 192; it += G) {
            const int n0 = it * 32, kk = tid >> 3, c4 = tid & 7;
            f32x4 a[9];
#pragma unroll
            for (int r = 0; r < 9; ++r) a[r] = (f32x4){0.f, 0.f, 0.f, 0.f};
#pragma unroll 4
            for (int i = 0; i < 16; ++i) { const int k = kk + 64 * i; const f32x4 w = *(const f32x4*)(p.w_mod + (size_t)k * 6144 + n0 + 4 * c4);
#pragma unroll
                for (int r = 0; r < 9; ++r) a[r] += w * sS[r * 1024 + k]; }
#pragma unroll
            for (int r = 0; r < 9; ++r) *(LAS f32x4*)(red + (kk * 9 + r) * 32 + 4 * c4) = a[r];
            __syncthreads();
            if (tid < 288) { const int r = tid >> 5, col = tid & 31; float sum = p.b_mod[n0 + col];
                for (int q = 0; q < 64; ++q) sum += red[(q * 9 + r) * 32 + col];
                MOD[r * 6144 + n0 + col] = sum; }
            __syncthreads();
        }
    }
    {
        float* ROPE = (float*)(ws + WS_ROPE); float* BINZ = (float*)(ws + WS_BINZ);
        const int gt = blockIdx.x * NTHREADS + tid, NGT = G * NTHREADS;
        for (int e = gt; e < 64 * 16; e += NGT) { const int pos = e >> 4, j = e & 15; const float inv = powf(10000.0f, -(float)j / 16.0f); const float ang = (float)pos * inv; ROPE[2 * e] = cosf(ang); ROPE[2 * e + 1] = sinf(ang); }
        for (int n = gt; n < NIN; n += NGT) BINZ[zcol_of(n)] = p.b_in[n];
    }
}
__device__ __forceinline__ void phase_prep_weights(const Params& p, LAS unsigned char* lds) {
    const int tid = threadIdx.x, lane = tid & 63, wave = tid >> 6, G = gridDim.x;
    unsigned char* ws = p.ws;
    {
        LAS float* scr = (LAS float*)(lds + wave * TR_SCR);
        bf16_t* WINT = (bf16_t*)(ws + WS_WINT); bf16_t* WMIX = (bf16_t*)(ws + WS_WMIX); bf16_t* WOUT = (bf16_t*)(ws + WS_WOUT);
        const int gw = blockIdx.x * NWAVES + wave, NGW = G * NWAVES;
        constexpr int I_IN = 16 * (NIN / 64), I_P = 16 * 16;
        for (int it = gw; it < I_IN + 3 * I_P; it += NGW) {
            int r = it;
            if (r < I_IN) { const int nblk = NIN / 64, kb = r / nblk, nb = r % nblk; transpose_item(p.w_in, NIN, 64 * kb, 64 * nb, WINT, 1024, [](int n) { return zcol_of(n); }, scr, lane); continue; } r -= I_IN;
            const int kb = (r % I_P) / 16, nb = (r % I_P) % 16, which = r / I_P;
            if (which == 0) transpose_item(p.w_proj_rnn, 1024, 64 * kb, 64 * nb, WMIX, 2048, [](int n) { return n; }, scr, lane);
            else if (which == 1) transpose_item(p.w_proj_na, 1024, 64 * kb, 64 * nb, WMIX + 1024, 2048, [](int n) { return n; }, scr, lane);
            else transpose_item(p.w_out, 1024, 64 * kb, 64 * nb, WOUT, 1024, [](int n) { return n; }, scr, lane);
        }
    }
}

__device__ __forceinline__ const float* norm1_row(const Params& p, int row) { return row >= MLAT ? p.ctx + (size_t)(row - MLAT) * DM : p.x + (size_t)row * DM; }
__device__ __forceinline__ void phase_norm1(const Params& p, LAS unsigned char* lds) {
    const int tid = threadIdx.x, lane = tid & 63, wave = tid >> 6, G = gridDim.x;
    unsigned char* ws = p.ws;
    const float* MOD = (const float*)(ws + WS_MOD);
    bf16_t* XN = (bf16_t*)(ws + WS_XN);
    const int gw = blockIdx.x * NWAVES + wave, NGW = G * NWAVES;
    constexpr int NROW = MLAT + MCTX;
    const int per = (NROW + NGW - 1) / NGW, r_lo = gw * per, r_hi = min(r_lo + per, NROW);
    if (r_lo >= r_hi) return;
    f32x4 nx[4], ny[4], shv[4], scv[4]; int mcur = -1;
    { const f32x4* xr = (const f32x4*)norm1_row(p, r_lo) + lane;
#pragma unroll
      for (int j = 0; j < 4; ++j) nx[j] = xr[64 * j];
      if (r_lo + 1 < r_hi) { const f32x4* xs = (const f32x4*)norm1_row(p, r_lo + 1) + lane;
#pragma unroll
          for (int j = 0; j < 4; ++j) ny[j] = xs[64 * j]; } }
    for (int row = r_lo; row < r_hi; ++row) {
        const int mr = (row >= MLAT) ? 8 : (row >> 12);
        if (mr != mcur) { mcur = mr; const float* sh = MOD + (size_t)mr * 6144;
#pragma unroll
            for (int j = 0; j < 4; ++j) { shv[j] = *(const f32x4*)(sh + 4 * lane + 256 * j); scv[j] = *(const f32x4*)(sh + 1024 + 4 * lane + 256 * j) + 1.0f; } }
        f32x4 v[4]; float s = 0.f;
#pragma unroll
        for (int j = 0; j < 4; ++j) { v[j] = nx[j]; nx[j] = ny[j]; s += (v[j].x * v[j].x + v[j].y * v[j].y) + (v[j].z * v[j].z + v[j].w * v[j].w); }
        if (row + 2 < r_hi) { const f32x4* xr = (const f32x4*)norm1_row(p, row + 2) + lane;
#pragma unroll
            for (int j = 0; j < 4; ++j) ny[j] = xr[64 * j]; }
        const float rs = 1.0f / sqrtf(wave_sum(s) * (1.0f / DM) + 1e-6f);
        unsigned long long* o8 = (unsigned long long*)(XN + (size_t)row * DM) + lane;
#pragma unroll
        for (int j = 0; j < 4; ++j) { const f32x4 y = v[j] * rs * scv[j] + shv[j];
            o8[64 * j] = (unsigned long long)pk2(y.x, y.y) | ((unsigned long long)pk2(y.z, y.w) << 32); }
    }
}

typedef float f32x16 __attribute__((ext_vector_type(16)));
constexpr int RN_XS = 144;
constexpr int RN_XC = 0, RN_WT = 256 * RN_XS, RN_SEG = RN_WT + 64 * RN_XS, RN_ST = RN_SEG + 10240;
__device__ __forceinline__ void phase_rnn(const Params& p, LAS unsigned char* lds, const bool dry) {
    const int tid = threadIdx.x, lane = tid & 63, wave = __builtin_amdgcn_readfirstlane(tid >> 6), G = gridDim.x;
    unsigned char* ws = p.ws;
    bf16_t* Z = (bf16_t*)(ws + WS_Z); const bf16_t* ZCb = (const bf16_t*)(ws + WS_ZC); bf16_t* HF = (bf16_t*)(ws + WS_XN);
    LAS unsigned char* xcb = lds + RN_XC;
    LAS unsigned char* wtb = lds + RN_WT;
    LAS float* seg0 = (LAS float*)(lds + RN_SEG);
    LAS unsigned char* stg = lds + RN_ST;
    const int c = lane & 31, hh = lane >> 5;
    const int taur = 16 * ((c >> 2) & 1) + 4 * (c >> 3) + (c & 3);
    const int cg8 = tid & 7, run = tid >> 3;
    for (int it = blockIdx.x; it < 256; it += G) {
        const int b = it >> 5, g = (it >> 1) & 15, half = it & 1;
        const int ch = 64 * g + 32 * half + c;
        const int ch0 = 64 * g + 32 * half;
        f32x2 cw2[4][4], cb2[4];
#pragma unroll
        for (int j = 0; j < 4; ++j) { cb2[j] = *(const f32x2*)(p.conv_b + 64 * g + 8 * cg8 + 2 * j);
#pragma unroll
            for (int k = 0; k < 4; ++k) cw2[k][j] = *(const f32x2*)(p.conv_w + k * 1024 + 64 * g + 8 * cg8 + 2 * j); }
        const bf16_t* srcL = Z + (size_t)b * SEQ * LDZ + ZC_XR + 64 * g + 8 * cg8;
        const bf16_t* srcC = ZCb + (size_t)b * CTX * LDC + CC_XR + 64 * g + 8 * cg8;
        for (int dir = 0; dir < 2; ++dir) {
            u32x4 xr[7];
#pragma unroll
            for (int q = 0; q < 7; ++q) { const int ts = 4 * run - 2 + q; xr[q] = (ts >= 0 && ts < CTX) ? *(const u32x4*)(srcC + (size_t)ts * LDC) : (u32x4){0u, 0u, 0u, 0u}; }
            __syncthreads();
            for (int e = tid; e < 2 * 64 * 32; e += NTHREADS) { const int mat = e >> 11, i = (e >> 5) & 63, cc = e & 31;
                const float* src = mat ? p.lru_wi : p.lru_wa;
                *(LAS bf16_t*)(wtb + (mat * 32 + cc) * RN_XS + i * 2) = (bf16_t)f2bf(src[(((size_t)dir * 16 + g) * 64 + i) * 64 + 32 * half + cc]); }
            __syncthreads();
            const float nbaL = -LOG2E * p.lru_ba[dir * 1024 + ch], nbiL = -LOG2E * p.lru_bi[dir * 1024 + ch];
            const float lam = p.lru_lambda[dir * 1024 + ch];
            const float sp = (lam > 15.f) ? expf(-lam) : log1pf(expf(-lam));
            const float clam = -8.0f * sp * LOG2E;
            float hc = 0.f;
            for (int step = 0; step < 17; ++step) {
                const bool isctx = (step == 0);
                const int t0 = isctx ? 0 : 256 * (dir == 0 ? step - 1 : 16 - step);
                {
                    f32x2 ac[4][4];
#pragma unroll
                    for (int i = 0; i < 4; ++i)
#pragma unroll
                        for (int j = 0; j < 4; ++j) ac[i][j] = cb2[j];
#pragma unroll
                    for (int q = 0; q < 7; ++q) {
                        f32x2 x2[4];
                        x2[0] = (f32x2){bf2f(xr[q].x & 0xffffu), bf2f(xr[q].x >> 16)}; x2[1] = (f32x2){bf2f(xr[q].y & 0xffffu), bf2f(xr[q].y >> 16)};
                        x2[2] = (f32x2){bf2f(xr[q].z & 0xffffu), bf2f(xr[q].z >> 16)}; x2[3] = (f32x2){bf2f(xr[q].w & 0xffffu), bf2f(xr[q].w >> 16)};
#pragma unroll
                        for (int i = 0; i < 4; ++i) { const int k = q - i; if (k >= 0 && k < 4) {
#pragma unroll
                            for (int j = 0; j < 4; ++j) ac[i][j] = __builtin_elementwise_fma(cw2[k][j], x2[j], ac[i][j]); } }
                    }
#pragma unroll
                    for (int i = 0; i < 4; ++i) { u32x4 w; w.x = cvt_pk_bf16(ac[i][0].x, ac[i][0].y); w.y = cvt_pk_bf16(ac[i][1].x, ac[i][1].y); w.z = cvt_pk_bf16(ac[i][2].x, ac[i][2].y); w.w = cvt_pk_bf16(ac[i][3].x, ac[i][3].y);
                        *(LAS u32x4*)(xcb + (4 * run + i) * RN_XS + cg8 * 16) = w; }
                }
                if (step < 16) { const int tn = 256 * (dir == 0 ? step : 15 - step);
                    if (tn >= 2 && tn + 258 <= SEQ) {
                        const bf16_t* rp = srcL + (size_t)(tn + 4 * run - 2) * LDZ;
#pragma unroll
                        for (int q = 0; q < 7; ++q) xr[q] = *(const u32x4*)(rp + (size_t)q * LDZ);
                    } else {
#pragma unroll
                        for (int q = 0; q < 7; ++q) { const int ts = tn + 4 * run - 2 + q; xr[q] = (ts >= 0 && ts < SEQ) ? *(const u32x4*)(srcL + (size_t)ts * LDZ) : (u32x4){0u, 0u, 0u, 0u}; } } }
                u32x4 hfr[2], ygr[2];
                const size_t tb = (size_t)b * SEQ + t0;
                if (!isctx && dir == 1) {
#pragma unroll
                    for (int i = 0; i < 2; ++i) { const int pl = lane + 64 * i, tk = 32 * wave + (pl >> 2), part = pl & 3;
                        hfr[i] = *(const u32x4*)(HF + (tb + tk) * DM + ch0 + 8 * part); ygr[i] = *(const u32x4*)(Z + (tb + tk) * LDZ + ZC_YG + ch0 + 8 * part); } }
                f32x16 ar, ai;
#pragma unroll
                for (int j = 0; j < 16; ++j) { ar[j] = 0.f; ai[j] = 0.f; }
                const LAS unsigned char* arow = xcb + (32 * wave + taur) * RN_XS + 16 * hh;
#pragma unroll
                for (int s4 = 0; s4 < 4; ++s4) { const bf16x8 af = *(const LAS bf16x8*)(arow + 32 * s4);
                    const bf16x8 bw0 = *(const LAS bf16x8*)(wtb + c * RN_XS + (16 * s4 + 8 * hh) * 2), bw1 = *(const LAS bf16x8*)(wtb + (32 + c) * RN_XS + (16 * s4 + 8 * hh) * 2);
                    ar = __builtin_amdgcn_mfma_f32_32x32x16_bf16(af, bw0, ar, 0, 0, 0);
                    ai = __builtin_amdgcn_mfma_f32_32x32x16_bf16(af, bw1, ai, 0, 0, 0); }
                const LAS unsigned char* xcol = xcb + (32 * wave + 16 * hh) * RN_XS + (32 * half + c) * 2;
#pragma unroll
                for (int j = 0; j < 16; ++j) {
                    const float r = __builtin_amdgcn_rcpf(1.0f + __builtin_amdgcn_exp2f(__builtin_fmaf(ar[j], -LOG2E, nbaL))), ig = __builtin_amdgcn_rcpf(1.0f + __builtin_amdgcn_exp2f(__builtin_fmaf(ai[j], -LOG2E, nbiL)));
                    const float a = __builtin_amdgcn_exp2f(r * clam);
                    const float om = __builtin_fmaf(-a, a, 1.0f);
                    const float xv = bf2f(*(const LAS bf16_t*)(xcol + j * RN_XS));
                    ar[j] = a; ai[j] = __builtin_amdgcn_sqrtf(om) * ig * xv;
                }
                float P = 1.f, H = 0.f;
                if (dir == 0) {
#pragma unroll
                    for (int j = 0; j < 16; ++j) { H = ar[j] * H + ai[j]; P *= ar[j]; }
                } else {
#pragma unroll
                    for (int j = 15; j >= 0; --j) { H = ar[j] * H + ai[j]; P *= ar[j]; }
                }
                const int s = 2 * wave + hh;
                LAS float* segA = seg0 + (step & 1) * 1280; LAS float* segB = segA + 640;
                segA[c * 20 + s] = P; segB[c * 20 + s] = H;
                __syncthreads();
                float h = hc, hin;
                {   f32x4 sa[4], sb[4];
#pragma unroll
                    for (int q4 = 0; q4 < 4; ++q4) { sa[q4] = *(const LAS f32x4*)(segA + c * 20 + 4 * q4); sb[q4] = *(const LAS f32x4*)(segB + c * 20 + 4 * q4); }
                    float h0v = 0.f, h1v = 0.f;
                    if (dir == 0) {
#pragma unroll
                        for (int q = 0; q < 16; ++q) { if (q == 2 * wave) h0v = h; if (q == 2 * wave + 1) h1v = h; h = sa[q >> 2][q & 3] * h + sb[q >> 2][q & 3]; } }
                    else {
#pragma unroll
                        for (int q = 15; q >= 0; --q) { if (q == 2 * wave) h0v = h; if (q == 2 * wave + 1) h1v = h; h = sa[q >> 2][q & 3] * h + sb[q >> 2][q & 3]; } }
                    hin = hh ? h1v : h0v;
                }
                hc = h;
                if (!isctx) {
                    LAS float* sp0 = (LAS float*)(stg + (32 * wave + 16 * hh) * RN_XS) + c;
                    h = hin;
                    if (dir == 0) {
#pragma unroll
                        for (int j = 0; j < 16; ++j) { h = ar[j] * h + ai[j]; sp0[j * (RN_XS / 4)] = h; }
                    } else {
#pragma unroll
                        for (int j = 15; j >= 0; --j) { h = ar[j] * h + ai[j]; sp0[j * (RN_XS / 4)] = h; }
                    }
#pragma unroll
                    for (int i = 0; i < 2; ++i) { const int pl = lane + 64 * i, tk = 32 * wave + (pl >> 2), part = pl & 3;
                        const LAS f32x4* sr = (const LAS f32x4*)(stg + tk * RN_XS + part * 32);
                        f32x4 h0 = sr[0], h1 = sr[1];
                        if (dir == 1) {
                            const u32x4 f = hfr[i], y = ygr[i];
                            h0 = (h0 + (f32x4){bf2f(f.x & 0xffffu), bf2f(f.x >> 16), bf2f(f.y & 0xffffu), bf2f(f.y >> 16)}) * (f32x4){bf2f(y.x & 0xffffu), bf2f(y.x >> 16), bf2f(y.y & 0xffffu), bf2f(y.y >> 16)};
                            h1 = (h1 + (f32x4){bf2f(f.z & 0xffffu), bf2f(f.z >> 16), bf2f(f.w & 0xffffu), bf2f(f.w >> 16)}) * (f32x4){bf2f(y.z & 0xffffu), bf2f(y.z >> 16), bf2f(y.w & 0xffffu), bf2f(y.w >> 16)};
                        }
                        u32x4 w; w.x = cvt_pk_bf16(h0[0], h0[1]); w.y = cvt_pk_bf16(h0[2], h0[3]); w.z = cvt_pk_bf16(h1[0], h1[1]); w.w = cvt_pk_bf16(h1[2], h1[3]);
                        if (!dry) { if (dir == 0) *(u32x4*)(HF + (tb + tk) * DM + ch0 + 8 * part) = w; else *(u32x4*)(Z + (tb + tk) * LDZ + ZC_YG + ch0 + 8 * part) = w; }
                    }
                }
            }
        }
    }
}

constexpr int AT_SLOT = 16384, AT_NS = 4, AT_BIAS = AT_NS * AT_SLOT;
__device__ __forceinline__ void glds16(const void* gsrc, unsigned lds_dst) { unsigned keep;
    asm volatile("s_mov_b32 %0, m0\n\ts_mov_b32 m0, %2\n\ts_nop 0\n\tglobal_load_lds_dwordx4 %1, off\n\ts_mov_b32 m0, %0" : "=&s"(keep) : "v"(gsrc), "s"(lds_dst) : "memory"); }
typedef short s16x4 __attribute__((ext_vector_type(4)));
struct QBlk { bf16x8 q[2]; f32x4 o[4]; float l; };
template <bool LOCAL, bool DOA, bool DOB>
__device__ __forceinline__ void attn_proc32(QBlk& A, QBlk& B, const LAS unsigned char* Kc, int kc0, const int (&koff)[2][2], const int (&voff)[4][2], const int (&cidx)[8], const LAS unsigned char* browA, const LAS unsigned char* browB) {
    const LAS unsigned char* Kb = Kc + kc0 * 128; const LAS unsigned char* Vb = Kc + 8192 + kc0 * 128;
    f32x4 a0 = (f32x4){0.f, 0.f, 0.f, 0.f}, a1 = a0, b0 = a0, b1 = a0;
#pragma unroll
    for (int ks = 0; ks < 2; ++ks) {
        const bf16x8 k0 = *(const LAS bf16x8*)(Kb + koff[0][ks]);
        const bf16x8 k1 = *(const LAS bf16x8*)(Kb + koff[1][ks]);
        if (DOA) { a0 = __builtin_amdgcn_mfma_f32_16x16x32_bf16(k0, A.q[ks], a0, 0, 0, 0); a1 = __builtin_amdgcn_mfma_f32_16x16x32_bf16(k1, A.q[ks], a1, 0, 0, 0); }
        if (DOB) { b0 = __builtin_amdgcn_mfma_f32_16x16x32_bf16(k0, B.q[ks], b0, 0, 0, 0); b1 = __builtin_amdgcn_mfma_f32_16x16x32_bf16(k1, B.q[ks], b1, 0, 0, 0); }
    }
    if (LOCAL) {
#pragma unroll
        for (int r = 0; r < 4; ++r) {
            if (DOA) { a0[r] += *(const LAS float*)(browA + cidx[r]); a1[r] += *(const LAS float*)(browA + cidx[4 + r]); }
            if (DOB) { b0[r] += *(const LAS float*)(browB + cidx[r]); b1[r] += *(const LAS float*)(browB + cidx[4 + r]); }
        }
    }
    float psA = 0.f, psB = 0.f;
#pragma unroll
    for (int r = 0; r < 4; ++r) {
        if (DOA) { a0[r] = __builtin_amdgcn_exp2f(a0[r]); a1[r] = __builtin_amdgcn_exp2f(a1[r]); psA += a0[r] + a1[r]; }
        if (DOB) { b0[r] = __builtin_amdgcn_exp2f(b0[r]); b1[r] = __builtin_amdgcn_exp2f(b1[r]); psB += b0[r] + b1[r]; }
    }
    bf16x8 pA, pB;
    if (DOA) { A.l += psA; const u32x4 w = (u32x4){cvt_pk_bf16(a0[0], a0[1]), cvt_pk_bf16(a0[2], a0[3]), cvt_pk_bf16(a1[0], a1[1]), cvt_pk_bf16(a1[2], a1[3])}; pA = __builtin_bit_cast(bf16x8, w); }
    if (DOB) { B.l += psB; const u32x4 w = (u32x4){cvt_pk_bf16(b0[0], b0[1]), cvt_pk_bf16(b0[2], b0[3]), cvt_pk_bf16(b1[0], b1[1]), cvt_pk_bf16(b1[2], b1[3])}; pB = __builtin_bit_cast(bf16x8, w); }
#pragma unroll
    for (int dt = 0; dt < 4; ++dt) {
        const s16x4 lo4 = __builtin_bit_cast(s16x4, __builtin_amdgcn_ds_read_tr16_b64_v4i16((LAS s16x4*)(Vb + voff[dt][0])));
        const s16x4 hi4 = __builtin_bit_cast(s16x4, __builtin_amdgcn_ds_read_tr16_b64_v4i16((LAS s16x4*)(Vb + voff[dt][1])));
        const bf16x8 av = (bf16x8){lo4[0], lo4[1], lo4[2], lo4[3], hi4[0], hi4[1], hi4[2], hi4[3]};
        if (DOA) A.o[dt] = __builtin_amdgcn_mfma_f32_16x16x32_bf16(av, pA, A.o[dt], 0, 0, 0);
        if (DOB) B.o[dt] = __builtin_amdgcn_mfma_f32_16x16x32_bf16(av, pB, B.o[dt], 0, 0, 0);
    }
}
__device__ __forceinline__ void phase_attn(const Params& p, LAS unsigned char* lds, const bool dry) {
    const int tid = threadIdx.x, lane = tid & 63, wave = __builtin_amdgcn_readfirstlane(tid >> 6), G = gridDim.x;
    unsigned char* ws = p.ws;
    bf16_t* Z = (bf16_t*)(ws + WS_Z); const bf16_t* ZCb = (const bf16_t*)(ws + WS_ZC);
    LAS float* btab = (LAS float*)(lds + AT_BIAS);
    const int j = wave & 3, c16 = lane & 15, fq = lane >> 4;
    const int cq = 16 * j + c16, cst = min(max(cq - 8, 0), 48), kst = min(max(16 * j - 8, 0), 32);
    const int lo = cst - kst - 4 * fq;
    const int dc0 = kst + 4 * fq - cq + 15;
    int cidx[8];
#pragma unroll
    for (int q = 0; q < 8; ++q) { const int li = 16 * (q >> 2) + (q & 3); cidx[q] = 4 * ((li >= lo && li < lo + 16) ? min(max(dc0 + li, 0), 30) : 31); }
    int koff[2][2], voff[4][2];
    { const int i = lane & 15, kq = lane >> 4, jj = (lane & 15) >> 2, q = lane & 3, vr = 4 * kq + jj;
#pragma unroll
      for (int t = 0; t < 2; ++t)
#pragma unroll
          for (int ks = 0; ks < 2; ++ks) koff[t][ks] = (16 * t + i) * 128 + (((4 * ks + kq) ^ (i & 7)) << 4);
#pragma unroll
      for (int dt = 0; dt < 4; ++dt)
#pragma unroll
          for (int t = 0; t < 2; ++t) voff[dt][t] = (16 * t + vr) * 128 + (((2 * dt + (q >> 1)) ^ (vr & 7)) << 4) + 8 * (q & 1); }
    const int drow = 8 * wave + (lane >> 3), dpc = (lane & 7) ^ (lane >> 3);
    const unsigned lds0 = (unsigned)(uintptr_t)lds;
    for (int u = blockIdx.x; u < NB * 16 * 16; u += G) {
        const int b = u >> 8, h = (u >> 4) & 15, r0 = 4 * (u & 15);
        const int kr_lo = min(max(r0 - 4, 0), 56), kr_hi = min(max(r0 - 1, 0), 56) + 7, nloc = kr_hi - kr_lo + 1, nch = nloc + 4;
        const int rA = r0 + (wave >> 2), rB = rA + 2, rsA = min(max(rA - 4, 0), 56), rsB = min(max(rB - 4, 0), 56);
        bf16_t* qA = Z + ((size_t)b * SEQ + rA * 64 + cq) * LDZ + ZC_Q + h * 64;
        bf16_t* qB = Z + ((size_t)b * SEQ + rB * 64 + cq) * LDZ + ZC_Q + h * 64;
        QBlk A, Bq;
#pragma unroll
        for (int ks = 0; ks < 2; ++ks) { A.q[ks] = *(const bf16x8*)(qA + ks * 32 + fq * 8); Bq.q[ks] = *(const bf16x8*)(qB + ks * 32 + fq * 8); }
#pragma unroll
        for (int dt = 0; dt < 4; ++dt) { A.o[dt] = (f32x4){0.f, 0.f, 0.f, 0.f}; Bq.o[dt] = (f32x4){0.f, 0.f, 0.f, 0.f}; }
        A.l = 0.f; Bq.l = 0.f;
        if (u == (int)blockIdx.x) { for (int e = tid; e < 15 * 32; e += NTHREADS) btab[e] = ((e & 31) < 31) ? p.na_rpb[(size_t)h * 465 + (e >> 5) * 31 + (e & 31)] * LOG2E : -1e30f; }
        asm volatile("" :: "v"(A.q[0]), "v"(A.q[1]), "v"(Bq.q[0]), "v"(Bq.q[1]));
        const bf16_t* kbase = Z + ((size_t)b * SEQ + drow) * LDZ + ZC_K + h * 64 + dpc * 8;
        const bf16_t* cbase = ZCb + ((size_t)b * CTX + drow) * LDC + CC_K + h * 64 + dpc * 8;
#define AT_DMA(c_) do { const int c__ = (c_); const unsigned d_ = (unsigned)__builtin_amdgcn_readfirstlane((int)(lds0 + (unsigned)((c__ & (AT_NS - 1)) * AT_SLOT + wave * 1024))); \
            if (c__ < nloc) { const bf16_t* s_ = kbase + (size_t)(kr_lo + c__) * 64 * LDZ; glds16(s_, d_); glds16(s_ + (ZC_V - ZC_K), d_ + 8192u); } \
            else { const bf16_t* s_ = cbase + (size_t)(c__ - nloc) * 64 * LDC; glds16(s_, d_); glds16(s_ + (CC_V - CC_K), d_ + 8192u); } } while (0)
        AT_DMA(0); AT_DMA(1); AT_DMA(2);
        asm volatile("s_waitcnt vmcnt(4) lgkmcnt(0)" ::: "memory"); __builtin_amdgcn_s_barrier(); asm volatile("" ::: "memory");
        for (int c = 0; c < nch; ++c) {
            if (c + 3 < nch) AT_DMA(c + 3);
            { const int nrem = min(nch - 1, c + 3) - (c + 1);
              if (nrem >= 2) asm volatile("s_waitcnt vmcnt(4)" ::: "memory"); else if (nrem == 1) asm volatile("s_waitcnt vmcnt(2)" ::: "memory"); else asm volatile("s_waitcnt vmcnt(0)" ::: "memory"); }
            const LAS unsigned char* Kc = lds + (c & (AT_NS - 1)) * AT_SLOT;
            if (c < nloc) {
                const int kr = kr_lo + c;
                const bool vA = (kr >= rsA && kr < rsA + 8), vB = (kr >= rsB && kr < rsB + 8);
                const LAS unsigned char* bA = (const LAS unsigned char*)btab + min(max(kr - rA + 7, 0), 14) * 128; const LAS unsigned char* bB = (const LAS unsigned char*)btab + min(max(kr - rB + 7, 0), 14) * 128;
                if (vA && vB) attn_proc32<true, true, true>(A, Bq, Kc, kst, koff, voff, cidx, bA, bB);
                else if (vA) attn_proc32<true, true, false>(A, Bq, Kc, kst, koff, voff, cidx, bA, bB);
                else if (vB) attn_proc32<true, false, true>(A, Bq, Kc, kst, koff, voff, cidx, bA, bB);
            } else {
                attn_proc32<false, true, true>(A, Bq, Kc, 0, koff, voff, cidx, (const LAS unsigned char*)btab, (const LAS unsigned char*)btab);
                attn_proc32<false, true, true>(A, Bq, Kc, 32, koff, voff, cidx, (const LAS unsigned char*)btab, (const LAS unsigned char*)btab);
            }
            asm volatile("s_waitcnt lgkmcnt(0)" ::: "memory"); __builtin_amdgcn_s_barrier(); asm volatile("" ::: "memory");
        }
#undef AT_DMA
        {
            float l = A.l; l += __shfl_xor(l, 16); l += __shfl_xor(l, 32); const float il = 1.0f / l;
#pragma unroll
            for (int dt = 0; dt < 4; ++dt) { const f32x4 o = A.o[dt] * il; u32x2 w; w.x = cvt_pk_bf16(o[0], o[1]); w.y = cvt_pk_bf16(o[2], o[3]); if (!dry) *(u32x2*)(qA + dt * 16 + fq * 4) = w; }
            l = Bq.l; l += __shfl_xor(l, 16); l += __shfl_xor(l, 32); const float il2 = 1.0f / l;
#pragma unroll
            for (int dt = 0; dt < 4; ++dt) { const f32x4 o = Bq.o[dt] * il2; u32x2 w; w.x = cvt_pk_bf16(o[0], o[1]); w.y = cvt_pk_bf16(o[2], o[3]); if (!dry) *(u32x2*)(qB + dt * 16 + fq * 4) = w; }
        }
    }
}

constexpr int N2_WRP = 0, N2_CP = 65536, N2_CV = N2_CP + 2048, N2_RS = N2_CV + 64;
__device__ __forceinline__ void phase_norm2(const Params& p, LAS unsigned char* lds) {
    const int tid = threadIdx.x, lane = tid & 63, wave = __builtin_amdgcn_readfirstlane(tid >> 6), G = gridDim.x;
    unsigned char* ws = p.ws;
    const float* MOD = (const float*)(ws + WS_MOD); unsigned char* XN2 = ws + WS_XN2; float* AFF = (float*)(ws + WS_AFF);
    const bf16_t* X1 = (const bf16_t*)(ws + WS_X1);
    LAS float* wrp = (LAS float*)(lds + N2_WRP); LAS float* cpart = (LAS float*)(lds + N2_CP); LAS float* cvec = (LAS float*)(lds + N2_CV); LAS float* rsw = (LAS float*)(lds + N2_RS) + wave * 16;
    const int r16 = lane & 15, kq = lane >> 4;
    int bcur = -1; f32x4 shv[4], scv[4];
    for (int blk = blockIdx.x; blk < MLAT / 128; blk += G) {
        const int b = blk >> 5;
        if (b != bcur) { bcur = b;
            const float* sh2 = MOD + (size_t)b * 6144 + 3072; const float* sc2 = MOD + (size_t)b * 6144 + 4096;
            __syncthreads();
            for (int e = tid; e < 16 * 1024; e += NTHREADS) wrp[e] = (1.0f + sc2[e >> 4]) * p.w_router[e];
            { const int e = tid & 15, part = tid >> 4; float a = 0.f;
              for (int i = 0; i < 32; ++i) { const int k = part + 32 * i; a += sh2[k] * p.w_router[k * 16 + e]; }
              cpart[part * 16 + e] = a; }
#pragma unroll
            for (int j = 0; j < 4; ++j) { shv[j] = *(const f32x4*)(sh2 + 4 * lane + 256 * j); scv[j] = *(const f32x4*)(sc2 + 4 * lane + 256 * j) + 1.0f; }
            __syncthreads();
            if (tid < 16) { float a = 0.f; for (int q = 0; q < 32; ++q) a += cpart[q * 16 + tid]; cvec[tid] = a; }
            __syncthreads();
        }
        const int row0 = blk * 128 + wave * 16;
        f32x4 acc = (f32x4){0.f, 0.f, 0.f, 0.f}; float ss = 0.f;
        const u32x2* xp = (const u32x2*)(X1 + (size_t)(row0 + r16) * DM + 4 * kq);
        const LAS float* wp = wrp + (4 * kq) * 16 + r16;
        u32x2 xa[8], xb[8];
#pragma unroll
        for (int u = 0; u < 8; ++u) xa[u] = xp[4 * u];
#pragma unroll 1
        for (int t0 = 0; t0 < 64; t0 += 16) {
#pragma unroll
            for (int u = 0; u < 8; ++u) xb[u] = xp[4 * (t0 + 8 + u)];
#pragma unroll
            for (int u = 0; u < 8; ++u) { const float x0 = bf2f(xa[u].x & 0xffffu), x1v = bf2f(xa[u].x >> 16), x2 = bf2f(xa[u].y & 0xffffu), x3 = bf2f(xa[u].y >> 16);
                ss += (x0 * x0 + x1v * x1v) + (x2 * x2 + x3 * x3);
                const LAS float* w = wp + (t0 + u) * 256;
                acc = __builtin_amdgcn_mfma_f32_16x16x4f32(x0, w[0], acc, 0, 0, 0); acc = __builtin_amdgcn_mfma_f32_16x16x4f32(x1v, w[16], acc, 0, 0, 0);
                acc = __builtin_amdgcn_mfma_f32_16x16x4f32(x2, w[32], acc, 0, 0, 0); acc = __builtin_amdgcn_mfma_f32_16x16x4f32(x3, w[48], acc, 0, 0, 0); }
            if (t0 + 16 < 64) {
#pragma unroll
                for (int u = 0; u < 8; ++u) xa[u] = xp[4 * (t0 + 16 + u)]; }
#pragma unroll
            for (int u = 0; u < 8; ++u) { const float x0 = bf2f(xb[u].x & 0xffffu), x1v = bf2f(xb[u].x >> 16), x2 = bf2f(xb[u].y & 0xffffu), x3 = bf2f(xb[u].y >> 16);
                ss += (x0 * x0 + x1v * x1v) + (x2 * x2 + x3 * x3);
                const LAS float* w = wp + (t0 + 8 + u) * 256;
                acc = __builtin_amdgcn_mfma_f32_16x16x4f32(x0, w[0], acc, 0, 0, 0); acc = __builtin_amdgcn_mfma_f32_16x16x4f32(x1v, w[16], acc, 0, 0, 0);
                acc = __builtin_amdgcn_mfma_f32_16x16x4f32(x2, w[32], acc, 0, 0, 0); acc = __builtin_amdgcn_mfma_f32_16x16x4f32(x3, w[48], acc, 0, 0, 0); }
        }
        ss += __shfl_xor(ss, 16); ss += __shfl_xor(ss, 32);
        const float rs = 1.0f / sqrtf(ss * (1.0f / DM) + 1e-6f);
        if (lane < 16) rsw[lane] = rs;
        LDS_WAIT(); asm volatile("" ::: "memory");
        { const float cv = cvec[r16]; float lg[4], mx[4], ex[4], sm[4];
#pragma unroll
          for (int q = 0; q < 4; ++q) { lg[q] = rsw[4 * kq + q] * acc[q] + cv; mx[q] = lg[q]; }
#pragma unroll
          for (int o = 1; o < 16; o <<= 1)
#pragma unroll
              for (int q = 0; q < 4; ++q) mx[q] = fmaxf(mx[q], __shfl_xor(mx[q], o));
#pragma unroll
          for (int q = 0; q < 4; ++q) { ex[q] = expf(lg[q] - mx[q]); sm[q] = ex[q]; }
#pragma unroll
          for (int o = 1; o < 16; o <<= 1)
#pragma unroll
              for (int q = 0; q < 4; ++q) sm[q] += __shfl_xor(sm[q], o);
#pragma unroll
          for (int q = 0; q < 4; ++q) AFF[(size_t)(row0 + 4 * kq + q) * 16 + r16] = ex[q] / sm[q]; }
        u32x2 nx[4], ny[4];
        { const u32x2* xr = (const u32x2*)(X1 + (size_t)row0 * DM) + lane;
#pragma unroll
          for (int j = 0; j < 4; ++j) { nx[j] = xr[64 * j]; ny[j] = xr[64 * j + 256]; } }
        for (int q = 0; q < 16; ++q) {
            const float rq = rsw[q];
            f32x4 v[4];
#pragma unroll
            for (int j = 0; j < 4; ++j) { v[j] = (f32x4){bf2f(nx[j].x & 0xffffu), bf2f(nx[j].x >> 16), bf2f(nx[j].y & 0xffffu), bf2f(nx[j].y >> 16)}; nx[j] = ny[j]; }
            if (q + 2 < 16) { const u32x2* xr = (const u32x2*)(X1 + (size_t)(row0 + q + 2) * DM) + lane;
#pragma unroll
                for (int j = 0; j < 4; ++j) ny[j] = xr[64 * j]; }
            unsigned* o4 = (unsigned*)(XN2 + (size_t)(row0 + q) * DM) + lane;
#pragma unroll
            for (int j = 0; j < 4; ++j) { v[j] = v[j] * rq * scv[j] + shv[j]; o4[64 * j] = pk4_fp8(v[j].x, v[j].y, v[j].z, v[j].w); }
        }
    }
}

__device__ __forceinline__ void phase_topk(const Params& p, LAS unsigned char* lds) {
    const int tid = threadIdx.x, lane = tid & 63, wave = tid >> 6, G = gridDim.x;
    unsigned char* ws = p.ws;
    const float* AFF = (const float*)(ws + WS_AFF); int* SELIDX = (int*)(ws + WS_SELIDX); float* SELG = (float*)(ws + WS_SELG); int* SLOT = (int*)(ws + WS_SLOT);
    LAS unsigned* hist = (LAS unsigned*)lds;
    LAS unsigned* ctl = hist + 256;
    LAS unsigned* wtot = hist + 264;
    for (int it = blockIdx.x; it < NB * NEXP; it += G) {
        const int b = it >> 4, e = it & 15;
        unsigned v[8];
#pragma unroll
        for (int j = 0; j < 8; ++j) v[j] = __builtin_bit_cast(unsigned, AFF[((size_t)b * SEQ + tid * 8 + j) * 16 + e]);
        unsigned prefix = 0u, mask = 0u, need = CAP;
        for (int shift = 24; shift >= 0; shift -= 8) {
            __syncthreads();
            if (tid < 256) hist[tid] = 0u;
            __syncthreads();
#pragma unroll
            for (int j = 0; j < 8; ++j) if ((v[j] & mask) == prefix) atomicAdd((unsigned*)&hist[(v[j] >> shift) & 255u], 1u);
            __syncthreads();
            if (tid < 64) {
                unsigned cb[4], tot = 0u;
#pragma unroll
                for (int k = 0; k < 4; ++k) { cb[k] = hist[255 - 4 * lane - k]; tot += cb[k]; }
                unsigned inc = tot;
#pragma unroll
                for (int o = 1; o < 64; o <<= 1) { const unsigned a = __shfl_up(inc, o); if (lane >= o) inc += a; }
                unsigned cum = inc - tot;
#pragma unroll
                for (int k = 0; k < 4; ++k) { if (cum < need && need <= cum + cb[k]) { ctl[0] = (unsigned)(255 - 4 * lane - k); ctl[1] = need - cum; } cum += cb[k]; }
            }
            __syncthreads();
            prefix |= ctl[0] << shift; mask |= 255u << shift; need = ctl[1];
        }
        unsigned ngt = 0u, neq = 0u;
#pragma unroll
        for (int j = 0; j < 8; ++j) { ngt += (v[j] > prefix) ? 1u : 0u; neq += (v[j] == prefix) ? 1u : 0u; }
        unsigned sg = ngt, se = neq;
#pragma unroll
        for (int o = 1; o < 64; o <<= 1) { const unsigned a = __shfl_up(sg, o), c2 = __shfl_up(se, o); if (lane >= o) { sg += a; se += c2; } }
        __syncthreads();
        if (lane == 63) { wtot[wave] = sg; wtot[8 + wave] = se; }
        __syncthreads();
        unsigned og = sg - ngt, oe = se - neq, totg = 0u;
        for (int w = 0; w < 8; ++w) { const unsigned a = wtot[w], c2 = wtot[8 + w]; if (w < wave) { og += a; oe += c2; } totg += a; }
#pragma unroll
        for (int j = 0; j < 8; ++j) {
            const int tkn = tid * 8 + j; int slot = -1;
            if (v[j] > prefix) slot = (int)og++;
            else if (v[j] == prefix) { if (oe < need) slot = (int)(totg + oe); ++oe; }
            const int erow = b * CAP + slot;
            SLOT[((size_t)b * SEQ + tkn) * 16 + e] = (slot >= 0) ? erow : -1;
            if (slot >= 0) { SELIDX[e * EROWS + erow] = b * SEQ + tkn; SELG[e * EROWS + erow] = __builtin_bit_cast(float, v[j]); }
        }
    }
    __syncthreads();
    {
        LAS float* scr = (LAS float*)(lds + wave * TR_SCR);
        unsigned char* WGU = ws + WS_WGU; unsigned char* WD = ws + WS_WD;
        const int gw = blockIdx.x * NWAVES + wave, NGW = G * NWAVES;
        constexpr int I_G = 16 * 32, I_D = 32 * 16, NIT = 16 * (2 * I_G + I_D);
        auto decode = [&](int it, TrItem& t) {
            const int e = it / (2 * I_G + I_D); int r = it % (2 * I_G + I_D);
            if (r < 2 * I_G) { const int up = r / I_G; r %= I_G; const int kb = r / 32, nb = r % 32;
                t.src = (up ? p.w_exp_up : p.w_exp_gate) + (size_t)e * 1024 * 2048 + (size_t)(64 * kb) * 2048 + 64 * nb; t.ldw = 2048;
                t.dst = WGU + (size_t)e * 4096 * 1024 + 64 * kb; t.ldk = 1024; t.n0 = 64 * nb; t.up = up; }
            else { r -= 2 * I_G; const int kb = r / 16, nb = r % 16;
                t.src = p.w_exp_down + (size_t)e * 2048 * 1024 + (size_t)(64 * kb) * 1024 + 64 * nb; t.ldw = 1024;
                t.dst = WD + (size_t)e * 1024 * 2048 + 64 * kb; t.ldk = 2048; t.n0 = 64 * nb; t.up = -1; }
        };
        constexpr int TR_EXTRA = 3;
        const int NT = min(G, NB * NEXP), NQ = (G - NT) * NWAVES, wq = ((int)blockIdx.x - NT) * NWAVES + wave, nx0 = NQ > 0 ? TR_EXTRA : 0;
        auto nth = [&](int n) -> int { return wq >= 0 ? (n < nx0 ? n * NQ + wq : nx0 * NQ + gw + (n - nx0) * NGW) : nx0 * NQ + gw + n * NGW; };
        TrItem ta, tb; f32x4 va[16], vb[16];
        int n = 0, it = nth(0);
        if (it < NIT) { decode(it, ta); tr_load(ta, lane, va); }
        while (it < NIT) {
            int itn = nth(n + 1);
            decode(itn < NIT ? itn : it, tb); tr_load(tb, lane, vb);
            tr_store_f8(ta, va, scr, lane);
            ++n; it = itn; if (it >= NIT) break;
            itn = nth(n + 1);
            decode(itn < NIT ? itn : it, ta); tr_load(ta, lane, va);
            tr_store_f8(tb, vb, scr, lane);
            ++n; it = itn;
        }
    }
}

__device__ __forceinline__ void phase_final(const Params& p, LAS unsigned char* lds, const bool dry) {
    const int tid = threadIdx.x, lane = tid & 63, wave = tid >> 6, G = gridDim.x;
    unsigned char* ws = p.ws;
    const float* MOD = (const float*)(ws + WS_MOD); const int* SLOT = (const int*)(ws + WS_SLOT); const unsigned char* YE = ws + WS_YE; const float* AFF = (const float*)(ws + WS_AFF);
    const bf16_t* X1 = (const bf16_t*)(ws + WS_X1);
    const int gw = blockIdx.x * NWAVES + wave, NGW = G * NWAVES;
    const int per = (MLAT + NGW - 1) / NGW, r_lo = gw * per, r_hi = min(r_lo + per, MLAT);
    if (r_lo >= r_hi) return;
    f32x4 g2v[4], fnv[4]; int bcur = -1;
#pragma unroll
    for (int j = 0; j < 4; ++j) fnv[j] = *(const f32x4*)(p.final_norm + 4 * lane + 256 * j);
    u32x2 nx[2][4]; int nslot[2]; float ngate[2];
#define FN_PREFETCH(r_) do { _Pragma("unroll") for (int t = 0; t < 2; ++t) { const int rr = min((r_) + t, r_hi - 1); \
        const u32x2* xr_ = (const u32x2*)(X1 + (size_t)rr * DM) + lane; _Pragma("unroll") for (int j = 0; j < 4; ++j) nx[t][j] = xr_[64 * j]; \
        nslot[t] = SLOT[(size_t)rr * 16 + (lane & 15)]; ngate[t] = AFF[(size_t)rr * 16 + (lane & 15)]; } } while (0)
    FN_PREFETCH(r_lo);
    for (int row = r_lo; row < r_hi; row += 2) {
        const int b = row >> 12;
        if (b != bcur) { bcur = b;
#pragma unroll
            for (int j = 0; j < 4; ++j) g2v[j] = *(const f32x4*)(MOD + (size_t)b * 6144 + 5120 + 4 * lane + 256 * j); }
        u32x2 cx[2][4]; int myslot[2]; float mygate[2]; unsigned long long live[2]; unsigned yv[2][4][4]; float gt[2][4];
#pragma unroll
        for (int t = 0; t < 2; ++t) { myslot[t] = lane < 16 ? nslot[t] : -1; mygate[t] = ngate[t]; live[t] = __ballot(myslot[t] >= 0);
#pragma unroll
            for (int j = 0; j < 4; ++j) cx[t][j] = nx[t][j]; }
#pragma unroll
        for (int t = 0; t < 2; ++t)
#pragma unroll
            for (int q = 0; q < 4; ++q) {
                const bool on = live[t] != 0ull; const int e = on ? __builtin_ctzll(live[t]) : 0; live[t] &= live[t] - 1ull;
                const int sl = __shfl(myslot[t], e); gt[t][q] = on ? __shfl(mygate[t], e) : 0.f;
                const unsigned* yp = (const unsigned*)(YE + ((size_t)e * EROWS + (on ? sl : 0)) * DM) + lane;
                if (on) {
#pragma unroll
                    for (int j = 0; j < 4; ++j) yv[t][q][j] = yp[64 * j];
                } else {
#pragma unroll
                    for (int j = 0; j < 4; ++j) yv[t][q][j] = 0u;
                }
            }
        FN_PREFETCH(row + 2);
#pragma unroll
        for (int t = 0; t < 2; ++t) {
            if (row + t >= r_hi) break;
            f32x4 v[4], mo[4];
#pragma unroll
            for (int j = 0; j < 4; ++j) { v[j] = (f32x4){bf2f(cx[t][j].x & 0xffffu), bf2f(cx[t][j].x >> 16), bf2f(cx[t][j].y & 0xffffu), bf2f(cx[t][j].y >> 16)}; mo[j] = (f32x4){0.f, 0.f, 0.f, 0.f}; }
#pragma unroll
            for (int q = 0; q < 4; ++q)
#pragma unroll
                for (int j = 0; j < 4; ++j) { const f32x2 lo = __builtin_amdgcn_cvt_pk_f32_fp8((int)yv[t][q][j], false), hi = __builtin_amdgcn_cvt_pk_f32_fp8((int)yv[t][q][j], true);
                    mo[j].x += gt[t][q] * lo.x; mo[j].y += gt[t][q] * lo.y; mo[j].z += gt[t][q] * hi.x; mo[j].w += gt[t][q] * hi.y; }
            while (live[t]) {
                const int e = __builtin_ctzll(live[t]); live[t] &= live[t] - 1ull;
                const int sl = __shfl(myslot[t], e); const float g1 = __shfl(mygate[t], e);
                const unsigned* yp = (const unsigned*)(YE + ((size_t)e * EROWS + sl) * DM) + lane;
#pragma unroll
                for (int j = 0; j < 4; ++j) { const int w = (int)yp[64 * j]; const f32x2 lo = __builtin_amdgcn_cvt_pk_f32_fp8(w, false), hi = __builtin_amdgcn_cvt_pk_f32_fp8(w, true);
                    mo[j].x += g1 * lo.x; mo[j].y += g1 * lo.y; mo[j].z += g1 * hi.x; mo[j].w += g1 * hi.y; }
            }
            float ss = 0.f;
#pragma unroll
            for (int j = 0; j < 4; ++j) { v[j] = v[j] + g2v[j] * mo[j]; ss += (v[j].x * v[j].x + v[j].y * v[j].y) + (v[j].z * v[j].z + v[j].w * v[j].w); }
            const float rs = 1.0f / sqrtf(wave_sum(ss) * (1.0f / DM) + 1e-6f);
            f32x4* xo = (f32x4*)(p.out + (size_t)(row + t) * DM) + lane;
#pragma unroll
            for (int j = 0; j < 4; ++j) { if (!dry) xo[64 * j] = v[j] * rs * fnv[j]; }
        }
    }
#undef FN_PREFETCH
}

#define XB_TMO      128
#define XB_XCNT(j)  (256  + 64 * (j))
#define XB_XSUB(j)  (1280 + 64 * (j))
#define XB_XGEN(j)  (2304 + 64 * (j))
#define XB_TOP      3328
#define XB_TOPGEN   3392
#define XCD_BAR_WORDS 3456
#define XB_SPIN_CAP (1u << 20)
__device__ __forceinline__ unsigned xb_ld(unsigned* p)              { return __hip_atomic_load(p, __ATOMIC_RELAXED, __HIP_MEMORY_SCOPE_AGENT); }
__device__ __forceinline__ unsigned xb_add(unsigned* p, unsigned v) { return __hip_atomic_fetch_add(p, v, __ATOMIC_RELAXED, __HIP_MEMORY_SCOPE_AGENT); }
__device__ __forceinline__ unsigned xb_xcc_id() { return (unsigned)__builtin_amdgcn_s_getreg((3 << 11) | 20) & 0xFu; }
#define XB_SPIN(cond, bar) do { unsigned _sp = 0; while (cond) { __builtin_amdgcn_s_sleep(1); \
    if ((++_sp & 255u) == 0u) { if (xb_ld(&(bar)[XB_TMO])) break; if (_sp > XB_SPIN_CAP) { atomicAdd(&(bar)[XB_TMO], 1u); break; } } } } while (0)
struct XcdBarrier { unsigned* bar; unsigned x; volatile LAS unsigned* st; };
__device__ __forceinline__ XcdBarrier xcd_barrier_post(unsigned* bar, volatile LAS unsigned* st) {
    XcdBarrier b; b.bar = bar; b.x = xb_xcc_id(); b.st = st;
    if (threadIdx.x == 0) (void)xb_add(&bar[XB_XCNT(b.x)], 1u);
    return b;
}
__device__ __forceinline__ void xcd_barrier_complete(unsigned* bar, unsigned x, unsigned& nloc, unsigned& nx) {
    const unsigned G = gridDim.x * gridDim.y * gridDim.z;
    unsigned sum, cnt, mine, sp = 0u;
    for (;;) {
        sum = 0u; cnt = 0u; mine = 0u;
#pragma unroll
        for (unsigned j = 0; j < 16; ++j) { const unsigned c = xb_ld(&bar[XB_XCNT(j)]); sum += c; cnt += (c > 0u) ? 1u : 0u; mine = (j == x) ? c : mine; }
        if (sum == G) break;
        __builtin_amdgcn_s_sleep(1);
        if ((++sp & 255u) == 0u) { if (xb_ld(&bar[XB_TMO])) break; if (sp > XB_SPIN_CAP) { atomicAdd(&bar[XB_TMO], 1u); break; } }
    }
    nloc = mine > 0u ? mine : 1u; nx = cnt > 0u ? cnt : 1u;
}
__device__ __forceinline__ void xcd_barrier(const XcdBarrier& b) {
    asm volatile("s_waitcnt vmcnt(0)" ::: "memory");
    __syncthreads();
    if (threadIdx.x == 0) {
        unsigned* bar = b.bar;
        __builtin_amdgcn_s_waitcnt(0);
        unsigned nloc = b.st[0], nx = b.st[1];
        if (nloc == 0u) { xcd_barrier_complete(bar, b.x, nloc, nx); b.st[0] = nloc; b.st[1] = nx; }
        const unsigned old = xb_add(&bar[XB_XSUB(b.x)], 1u);
        const unsigned gen = old / nloc;
        if (old + 1u == (gen + 1u) * nloc) {
            __builtin_amdgcn_fence(__ATOMIC_RELEASE, "agent");
            asm volatile("s_waitcnt vmcnt(0)" ::: "memory");
            const unsigned og = xb_add(&bar[XB_TOP], 1u);
            const unsigned tg = og / nx;
            if (og + 1u == (tg + 1u) * nx) xb_add(&bar[XB_TOPGEN], 1u);
            else XB_SPIN(xb_ld(&bar[XB_TOPGEN]) == tg, bar);
            __builtin_amdgcn_fence(__ATOMIC_ACQUIRE, "agent");
            xb_add(&bar[XB_XGEN(b.x)], 1u);
            asm volatile("s_waitcnt vmcnt(0)" ::: "memory");
        } else {
            XB_SPIN(xb_ld(&bar[XB_XGEN(b.x)]) == gen, bar);
            __builtin_amdgcn_fence(__ATOMIC_ACQUIRE, "agent");
            asm volatile("s_waitcnt vmcnt(0)" ::: "memory");
        }
    }
    __syncthreads();
}

constexpr int NPHASE = 12;
__global__ void __launch_bounds__(NTHREADS, 2) mk_fwd(Params p) {
    extern __shared__ __attribute__((aligned(16))) unsigned char lds_raw[];
    LAS unsigned char* lds = (LAS unsigned char*)lds_raw;
    cg::grid_group grid = cg::this_grid();
    unsigned char* ws = p.ws;
    const int G = gridDim.x, cblk = blockIdx.x;
#ifndef PH_MASK
#define PH_MASK 0xfff
#endif
#define IN(k) (((PH_MASK >> (k)) & 1) && p.ph_lo <= (k) && (k) < p.ph_hi)
    { volatile LAS unsigned* st0 = (volatile LAS unsigned*)(lds + LDS_BYTES - 256); if (threadIdx.x < 64) st0[threadIdx.x] = 0u; }
    __syncthreads();
    XcdBarrier xbar = xcd_barrier_post((unsigned*)(ws + WS_CTL) + 4096, (volatile LAS unsigned*)(lds + LDS_BYTES - 256));
    if (p.ph_lo < 0) grid.sync();
#define SEAM(k) do { if (IN(k) && IN((k) + 1)) xcd_barrier(xbar); } while (0)
    if (IN(0)) phase_prep(p, lds);
    SEAM(0);
    if (IN(1)) { phase_prep_weights(p, lds); phase_norm1(p, lds); }
    SEAM(1);
    if (IN(2)) {
        InprojSched S{(const bf16_t*)(ws + WS_XN), (const bf16_t*)(ws + WS_WINT), G, cblk, 1024, 1024, 1024};
        EpiInproj<false> E{(bf16_t*)(ws + WS_Z), (bf16_t*)(ws + WS_ZC), (const float*)(ws + WS_BINZ), (const float*)(ws + WS_ROPE)};
        if (p.probe & 4) { EpiInproj<true> E2{(bf16_t*)(ws + WS_Z), (bf16_t*)(ws + WS_ZC), (const float*)(ws + WS_BINZ), (const float*)(ws + WS_ROPE)}; pg8::gemm_phase<EpiInproj<true>, InprojSched>(lds, S, E2); xcd_barrier(xbar); }
        if (p.probe & 32768) { pg8::gemm_phase<EpiInproj<false>, InprojSched>(lds, S, E); xcd_barrier(xbar); }
        pg8::gemm_phase<EpiInproj<false>, InprojSched>(lds, S, E);
    }
    SEAM(2);
    if (IN(3)) { if (p.probe & 8) { phase_rnn(p, lds, true); __syncthreads(); } phase_rnn(p, lds, false); }
    if (IN(3) && IN(4)) __syncthreads();
    if (IN(4)) { if (p.probe & 16) { phase_attn(p, lds, true); __syncthreads(); } phase_attn(p, lds, false); }
    SEAM(4);
    if (IN(5)) {
        MixSched S{(const bf16_t*)(ws + WS_Z), (const bf16_t*)(ws + WS_WMIX), G, cblk, LDZ, 2048, 2048};
        EpiMix E{(bf16_t*)(ws + WS_Z)};
        pg8::gemm_phase<EpiMix, MixSched>(lds, S, E);
    }
    SEAM(5);
    if (IN(6)) {
        WoutSched S{(const bf16_t*)(ws + WS_Z), (const bf16_t*)(ws + WS_WOUT), G, cblk, LDZ, 1024, 1024};
        EpiWout E{p.x, (bf16_t*)(ws + WS_X1), (const float*)(ws + WS_MOD)};
        pg8::gemm_phase<EpiWout, WoutSched>(lds, S, E);
    }
    SEAM(6);
    if (IN(7)) phase_norm2(p, lds);
    SEAM(7);
    if (IN(8)) phase_topk(p, lds);
    SEAM(8);
    if (IN(9)) {
        Moe1Sched S{ws + WS_XN2, ws + WS_WGU, (const int*)(ws + WS_SELIDX), G, cblk, 1024, 1024, 1024};
        EpiMoe1 E{ws + WS_HID};
        pg8::gemm_phase<EpiMoe1, Moe1Sched, true>(lds, S, E);
    }
    SEAM(9);
    if (IN(10)) {
        Moe2Sched S{ws + WS_HID, ws + WS_WD, G, cblk, 2048, 2048, 2048};
        EpiMoe2 E{ws + WS_YE};
        pg8::gemm_phase<EpiMoe2, Moe2Sched, true>(lds, S, E);
    }
    SEAM(10);
    if (IN(11)) { if (p.probe & 2048) { phase_final(p, lds, true); __syncthreads(); } phase_final(p, lds, false); }
#undef IN
#undef SEAM
}

#ifndef MK_SINGLE
#define MK_SINGLE 1
#endif
extern "C" void kernel_launch(void* const* d_in, const int* in_sizes, int n_in, void* d_out, int out_size, void* d_ws, size_t ws_size, hipStream_t stream) {
    static int grid = 0;
    if (grid == 0) {
        int dev = 0, cus = 0, per_cu = 0;
        if (n_in != 24 || out_size != MLAT * DM || ws_size < WS_END) { fprintf(stderr, "kernel_launch: unexpected problem (n_in %d, out %d, ws %zu < %zu)\n", n_in, out_size, ws_size, (size_t)WS_END); grid = -1; return; }
        if (hipGetDevice(&dev) != hipSuccess || hipDeviceGetAttribute(&cus, hipDeviceAttributeMultiprocessorCount, dev) != hipSuccess) { grid = -1; return; }
        if (hipFuncSetAttribute((const void*)mk_fwd, hipFuncAttributeMaxDynamicSharedMemorySize, LDS_BYTES) != hipSuccess) { fprintf(stderr, "kernel_launch: hipFuncSetAttribute failed\n"); grid = -1; return; }
        if (hipOccupancyMaxActiveBlocksPerMultiprocessor(&per_cu, (const void*)mk_fwd, NTHREADS, LDS_BYTES) != hipSuccess || per_cu < 1) { fprintf(stderr, "kernel_launch: occupancy query says %d\n", per_cu); grid = -1; return; }
        grid = cus;
    }
    if (grid < 0) return;
    (void)hipMemsetAsync((char*)d_ws + WS_CTL, 0, 1 * MiB, stream);
    Params p{};
    const float** pp = (const float**)&p;
    for (int i = 0; i < 24; ++i) pp[i] = (const float*)d_in[i];
#ifndef PROBE_MASK
#define PROBE_MASK 0
#endif
    p.out = (float*)d_out; p.ws = (unsigned char*)d_ws; p.probe = PROBE_MASK;
#if MK_SINGLE
    p.ph_lo = 0; p.ph_hi = NPHASE;
    void* args[] = {&p};
    hipError_t e = hipLaunchCooperativeKernel((const void*)mk_fwd, dim3(grid), dim3(NTHREADS), args, LDS_BYTES, stream);
    if (e != hipSuccess) fprintf(stderr, "kernel_launch: cooperative launch failed: %s (grid %d)\n", hipGetErrorString(e), grid);
#else
#ifndef REP_MASK
#define REP_MASK 0
#endif
    for (int ph = 0; ph < NPHASE; ++ph) {
        p.ph_lo = ph; p.ph_hi = ph + 1;
        for (int rep = 0; rep < 1 + ((REP_MASK >> ph) & 1); ++rep) hipLaunchKernelGGL(mk_fwd, dim3(grid), dim3(NTHREADS), LDS_BYTES, stream, p);
    }
#endif
}
```

```cpp
#include <hip/hip_runtime.h>
#include <hip/hip_cooperative_groups.h>
#include <cstdio>
#include <cstdint>
namespace cg = cooperative_groups;

#define LAS __attribute__((address_space(3)))
typedef unsigned short bf16_t;
typedef short bf16x8 __attribute__((ext_vector_type(8)));
typedef float f32x4 __attribute__((ext_vector_type(4)));
typedef float f32x2 __attribute__((ext_vector_type(2)));
typedef unsigned u32x4 __attribute__((ext_vector_type(4)));
typedef unsigned u32x2 __attribute__((ext_vector_type(2)));

constexpr int NB = 8, SEQ = 4096, DM = 1024, CTX = 256;
constexpr int MLAT = NB * SEQ, MCTX = NB * CTX;
constexpr int NIN = 7168, NEXP = 16, DEXP = 2048, CAP = 512, EROWS = NB * CAP;
constexpr int LDZ = 7168, ZC_YG = 0, ZC_Q = 1024, ZC_XR = 2048, ZC_K = 3072, ZC_V = 4096, ZC_GR = 5120, ZC_GN = 6144;
constexpr int LDC = 3072, CC_XR = 0, CC_K = 1024, CC_V = 2048;
constexpr float LOG2E = 1.4426950408889634f;
constexpr float QSCALE = 0.125f * LOG2E;

constexpr size_t MiB = 1u << 20;
constexpr size_t WS_CTL = 0;
constexpr size_t WS_MOD = 1 * MiB;
constexpr size_t WS_MODP = 2 * MiB;
constexpr size_t WS_ROPE = 9 * MiB;
constexpr size_t WS_BINZ = 9 * MiB + 65536;
constexpr size_t WS_AFF = 10 * MiB;
constexpr size_t WS_SELIDX = 12 * MiB;
constexpr size_t WS_SELG = 12 * MiB + 262144;
constexpr size_t WS_SLOT = 13 * MiB;
constexpr size_t WS_WINT = 16 * MiB;
constexpr size_t WS_WMIX = 30 * MiB;
constexpr size_t WS_WOUT = 34 * MiB;
constexpr size_t WS_ZC = 36 * MiB;
constexpr size_t WS_XN = 48 * MiB;
constexpr size_t WS_Z = 116 * MiB;
constexpr size_t WS_WGU = 116 * MiB;
constexpr size_t WS_WD = 180 * MiB;
constexpr size_t WS_HID = 212 * MiB;
constexpr size_t WS_YE = 340 * MiB;
constexpr size_t WS_X1 = 48 * MiB;
constexpr size_t WS_XN2 = 468 * MiB;
constexpr size_t WS_END = 564 * MiB;

constexpr int NTHREADS = 512, NWAVES = 8;
constexpr int LDS_BYTES = 147456;

__device__ __forceinline__ unsigned f2bf(float f) { unsigned u = __builtin_bit_cast(unsigned, f); return (u + 0x7fffu + ((u >> 16) & 1u)) >> 16; }
__device__ __forceinline__ float bf2f(unsigned h) { return __builtin_bit_cast(float, h << 16); }
__device__ __forceinline__ unsigned pk2(float lo, float hi) { return f2bf(lo) | (f2bf(hi) << 16); }
__device__ __forceinline__ unsigned cvt_pk_bf16(float lo, float hi) { unsigned r; asm volatile("v_cvt_pk_bf16_f32 %0, %1, %2" : "=v"(r) : "v"(lo), "v"(hi)); return r; }
__device__ __forceinline__ float wave_sum(float v) {
#pragma unroll
    for (int o = 1; o < 64; o <<= 1) v += __shfl_xor(v, o);
    return v;
}
__device__ __forceinline__ float sigmoidf_(float x) { return __builtin_amdgcn_rcpf(1.0f + __builtin_amdgcn_exp2f(-x * LOG2E)); }
__device__ __forceinline__ float gelu_tanh(float x) { const float u = 0.7978845608028654f * (x + 0.044715f * x * x * x); return x * __builtin_amdgcn_rcpf(1.0f + __builtin_amdgcn_exp2f(-2.0f * LOG2E * u)); }
#define LDS_WAIT() asm volatile("s_waitcnt lgkmcnt(0)" ::: "memory")

namespace pg8 {
constexpr int BM = 256, BK = 64, HALF = 128, HTB = HALF * BK * 2, STAGE_BYTES = 8 * HTB, NXCD = 8, WGM = 8;
__host__ __device__ __forceinline__ int swz_f(int r) { const int u = (r >> 1) & 7; return (u & 3) | ((((u >> 1) ^ (u >> 2)) & 1) << 2); }
__host__ __device__ __forceinline__ int lds_byte(int r, int c) { return r * 128 + ((((c >> 3) ^ swz_f(r)) << 4) | ((c & 7) * 2)); }
__host__ __device__ __forceinline__ void stage_rc(int b, int& R, int& C) { R = b >> 7; C = (((b >> 4) & 7) ^ swz_f(R)) * 8; }
__host__ __device__ __forceinline__ int perm32(int rho) { const int n = rho >> 4, i = rho & 15; return 8 * (i >> 2) + 4 * n + (i & 3); }

struct Unit { int pm, pb, x0, x1; };

__device__ __forceinline__ void tile_of(int L, int nM, int nN, int& pm, int& pn) {
    const int nwg = nM * nN; int wgid = L;
    { const int q = nwg / NXCD, r = nwg % NXCD, xcd = wgid % NXCD, off = wgid / NXCD; wgid = (xcd < r ? xcd * (q + 1) : r * (q + 1) + (xcd - r) * q) + off; }
    const int nig = WGM * nN, gid = wgid / nig, fm = gid * WGM, gsz = (nM - fm) < WGM ? (nM - fm) : WGM;
    pm = fm + ((wgid % nig) % gsz); pn = (wgid % nig) / gsz;
}

typedef int i32x8 __attribute__((ext_vector_type(8)));
constexpr int F8_SCALE_W = 0x79797979, F8_SCALE_X = 0x7f7f7f7f;
template <class Epi, class Sched, bool F8 = false>
__device__ __forceinline__ void gemm_phase(LAS unsigned char* lds, const Sched& S, const Epi& E) {
    const int tid = threadIdx.x, wid = __builtin_amdgcn_readfirstlane(tid >> 6), lane = tid & 63, wr = wid >> 2, wc = wid & 3, fr = lane & 15, fq = lane >> 4;
    constexpr int ESZ = F8 ? 1 : 2;
    const int K = S.K, nt = K * ESZ / (BK * 2);
    int Rl[2], Cl[2];
    unsigned voffA[2][2], voffB[2];
#pragma unroll
    for (int i = 0; i < 2; ++i) { stage_rc(tid * 16 + i * 8192, Rl[i], Cl[i]); const int Rb = Epi::PERM ? ((Rl[i] & ~31) + perm32(Rl[i] & 31)) : Rl[i];
        voffB[i] = (unsigned)(Rb * S.ldb * ESZ + Cl[i] * 2); }
    const size_t kstep = (size_t)(BK * 2);
    const size_t hstepB = (size_t)HALF * S.ldb * ESZ, hstepA = (size_t)HALF * S.lda * ESZ;
    const unsigned ldsw = (unsigned)wid * 1024u;
    const int aof0 = F8 ? lds_byte(wr * 64 + fr, fq * 16) : lds_byte(wr * 64 + fr, fq * 8), aof1 = F8 ? lds_byte(wr * 64 + fr, fq * 16 + 8) : lds_byte(wr * 64 + fr, 32 + fq * 8);
    const int bof0 = F8 ? lds_byte(wc * 32 + fr, fq * 16) : lds_byte(wc * 32 + fr, fq * 8), bof1 = F8 ? lds_byte(wc * 32 + fr, fq * 16 + 8) : lds_byte(wc * 32 + fr, 32 + fq * 8);
#define PG8_SA(b, h) (((b) * 2 + (h)) * HTB)
#define PG8_SB(b, h) ((4 + (b) * 2 + (h)) * HTB)
#define PG8_STAGEB(bufoff, gbase) do { _Pragma("unroll") for (int _i = 0; _i < 2; ++_i) \
        __builtin_amdgcn_global_load_lds((const unsigned*)((const char*)(gbase) + voffB[_i]), (LAS unsigned*)(lds + (bufoff) + ldsw + _i * 8192), 16, 0, 0); } while (0)
#define PG8_STAGEA(bufoff, gbase, h, vo) do { _Pragma("unroll") for (int _i = 0; _i < 2; ++_i) { \
        if constexpr (Sched::GATHER) __builtin_amdgcn_global_load_lds((const unsigned*)((const char*)(gbase) + (vo)[h][_i]), (LAS unsigned*)(lds + (bufoff) + ldsw + _i * 8192), 16, 0, 0); \
        else __builtin_amdgcn_global_load_lds((const unsigned*)((const char*)(gbase) + (h) * hstepA + (vo)[0][_i]), (LAS unsigned*)(lds + (bufoff) + ldsw + _i * 8192), 16, 0, 0); } } while (0)
#define PG8_LD8(d, alo, ahi) do { const u32x4 lo_ = *(const LAS u32x4*)(alo), hi_ = *(const LAS u32x4*)(ahi); d = (i32x8){(int)lo_.x, (int)lo_.y, (int)lo_.z, (int)lo_.w, (int)hi_.x, (int)hi_.y, (int)hi_.z, (int)hi_.w}; } while (0)
#define PG8_LDA(dst, b, h) do { if constexpr (F8) { _Pragma("unroll") for (int m = 0; m < 4; ++m) PG8_LD8(dst##8[m], lds + PG8_SA(b, h) + aof0 + m * 2048, lds + PG8_SA(b, h) + aof1 + m * 2048); } \
        else { _Pragma("unroll") for (int m = 0; m < 4; ++m) _Pragma("unroll") for (int k = 0; k < 2; ++k) dst[m][k] = *(const LAS bf16x8*)(lds + PG8_SA(b, h) + (k ? aof1 : aof0) + m * 2048); } } while (0)
#define PG8_LDB(dst, b, h) do { if constexpr (F8) { _Pragma("unroll") for (int n = 0; n < 2; ++n) PG8_LD8(dst##8[n], lds + PG8_SB(b, h) + bof0 + n * 2048, lds + PG8_SB(b, h) + bof1 + n * 2048); } \
        else { _Pragma("unroll") for (int n = 0; n < 2; ++n) _Pragma("unroll") for (int k = 0; k < 2; ++k) dst[n][k] = *(const LAS bf16x8*)(lds + PG8_SB(b, h) + (k ? bof1 : bof0) + n * 2048); } } while (0)
#define PG8_MMA(ai, bj, At, Bt) do { __builtin_amdgcn_s_setprio(1); _Pragma("unroll") for (int m = 0; m < 4; ++m) _Pragma("unroll") for (int n = 0; n < 2; ++n) { \
        if constexpr (F8) acc[ai][bj][m][n] = __builtin_amdgcn_mfma_scale_f32_16x16x128_f8f6f4(Bt##8[n], At##8[m], acc[ai][bj][m][n], 0, 0, 0, F8_SCALE_W, 0, F8_SCALE_X); \
        else { _Pragma("unroll") for (int k = 0; k < 2; ++k) acc[ai][bj][m][n] = __builtin_amdgcn_mfma_f32_16x16x32_bf16(Bt[n][k], At[m][k], acc[ai][bj][m][n], 0, 0, 0); } } \
        __builtin_amdgcn_s_setprio(0); } while (0)
#define PG8_WAIT_V(n) asm volatile("s_waitcnt vmcnt(" #n ")" ::: "memory")
#define PG8_WAIT_L(n) asm volatile("s_waitcnt lgkmcnt(" #n ")" ::: "memory")
#define PG8_BAR __builtin_amdgcn_s_barrier()
#define PG8_SCHED __builtin_amdgcn_sched_barrier(0)
#define PG8_SETVO(vo, u) do { _Pragma("unroll") for (int _h = 0; _h < 2; ++_h) _Pragma("unroll") for (int _i = 0; _i < 2; ++_i) { \
        if constexpr (Sched::GATHER) (vo)[_h][_i] = (unsigned)(S.row_of(u, _h * HALF + Rl[_i]) * S.lda * ESZ + Cl[_i] * 2); \
        else (vo)[_h][_i] = (unsigned)((_h * HALF + Rl[_i]) * S.lda * ESZ + Cl[_i] * 2); } } while (0)
#define PG8_TRIP_BODY \
            const bool last = (t == nt - 2); \
            const char* a1 = cA + (size_t)(t + 1) * kstep; \
            const char* a2 = last ? nA : cA + (size_t)(t + 2) * kstep; const char* b2 = last ? nB : cB + (size_t)(t + 2) * kstep; \
            const char* a3 = a2 + kstep; const char* b3 = b2 + kstep; \
            PG8_LDB(B0, 0, 0); PG8_LDB(B1, 0, 1); PG8_SCHED; PG8_LDA(At, 0, 0); PG8_STAGEA(PG8_SA(1, 1), a1, 1, voffA); \
            if (last && has_next) { PG8_SETVO(voffA, nxt); asm volatile("" : "+v"(voffA[0][0]), "+v"(voffA[0][1]), "+v"(voffA[1][0]), "+v"(voffA[1][1])); } \
            PG8_WAIT_V(8); PG8_WAIT_L(0); PG8_BAR; PG8_MMA(0, 0, At, B0); PG8_MMA(0, 1, At, B1); PG8_BAR; PG8_SCHED; \
            PG8_LDA(At, 0, 1); PG8_STAGEB(PG8_SB(0, 0), b2); PG8_STAGEB(PG8_SB(0, 1), b2 + hstepB); PG8_STAGEA(PG8_SA(0, 0), a2, 0, voffA); \
            PG8_WAIT_V(8); PG8_WAIT_L(0); PG8_BAR; PG8_MMA(1, 0, At, B0); PG8_MMA(1, 1, At, B1); PG8_BAR; PG8_SCHED; \
            PG8_LDB(B0, 1, 0); PG8_LDB(B1, 1, 1); PG8_SCHED; PG8_LDA(At, 1, 0); PG8_STAGEA(PG8_SA(0, 1), a2, 1, voffA); \
            PG8_WAIT_V(8); PG8_WAIT_L(0); PG8_BAR; PG8_MMA(0, 0, At, B0); PG8_MMA(0, 1, At, B1); PG8_BAR; PG8_SCHED; \
            PG8_LDA(At, 1, 1); PG8_STAGEB(PG8_SB(1, 0), b3); PG8_STAGEB(PG8_SB(1, 1), b3 + hstepB); PG8_STAGEA(PG8_SA(1, 0), a3, 0, voffA); \
            PG8_WAIT_V(8); PG8_WAIT_L(0); PG8_BAR; PG8_MMA(1, 0, At, B0); PG8_MMA(1, 1, At, B1); PG8_BAR; PG8_SCHED; \

    Unit cur, nxt; int ui = 0;
    if (!S.next(0, cur)) return;
    f32x4 acc[2][2][4][2];
#pragma unroll
    for (int a = 0; a < 2; ++a)
#pragma unroll
        for (int b = 0; b < 2; ++b)
#pragma unroll
            for (int m = 0; m < 4; ++m)
#pragma unroll
                for (int n = 0; n < 2; ++n) acc[a][b][m][n] = (f32x4){0.f, 0.f, 0.f, 0.f};
    bf16x8 At[4][2], B0[2][2], B1[2][2];
    i32x8 At8[4], B08[2], B18[2];
    const char* cA = S.a_ptr(cur); const char* cB = S.b_ptr(cur);
    PG8_SETVO(voffA, cur);
    PG8_STAGEB(PG8_SB(0, 0), cB); PG8_STAGEB(PG8_SB(0, 1), cB + hstepB); PG8_STAGEA(PG8_SA(0, 0), cA, 0, voffA); PG8_STAGEA(PG8_SA(0, 1), cA, 1, voffA);
    if (wr == 1) PG8_BAR;
    PG8_WAIT_V(2); PG8_BAR;
    PG8_STAGEB(PG8_SB(1, 0), cB + kstep); PG8_STAGEA(PG8_SA(1, 0), cA + kstep, 0, voffA); PG8_STAGEB(PG8_SB(1, 1), cB + hstepB + kstep);
    PG8_WAIT_V(6); PG8_BAR;
    for (;;) {
        const bool has_next = S.next(ui + 1, nxt);
        const char* nA = has_next ? S.a_ptr(nxt) : cA; const char* nB = has_next ? S.b_ptr(nxt) : cB;
        if constexpr (Epi::MID) {
#pragma unroll 1
            for (int t = 0; t < (nt >> 1); t += 2) { PG8_TRIP_BODY }
            PG8_SCHED; E.mid(acc, cur, wr, wc, fr, fq); PG8_SCHED;
#pragma unroll 1
            for (int t = (nt >> 1); t < nt; t += 2) { PG8_TRIP_BODY }
        } else {
#pragma unroll 1
            for (int t = 0; t < nt; t += 2) { PG8_TRIP_BODY }
        }
        if (wr == 0) PG8_BAR;
        E(acc, cur, wr, wc, fr, fq);
        if (!has_next) break;
#pragma unroll
        for (int a = 0; a < 2; ++a)
#pragma unroll
            for (int b = 0; b < 2; ++b)
#pragma unroll
                for (int m = 0; m < 4; ++m)
#pragma unroll
                    for (int n = 0; n < 2; ++n) acc[a][b][m][n] = (f32x4){0.f, 0.f, 0.f, 0.f};
        cur = nxt; cA = nA; cB = nB; ++ui;
        if (wr == 1) PG8_BAR;
    }
    PG8_WAIT_V(0);
    PG8_BAR;
#undef PG8_SA
#undef PG8_SB
#undef PG8_STAGEA
#undef PG8_STAGEB
#undef PG8_LDA
#undef PG8_LDB
#undef PG8_MMA
#undef PG8_LD8
#undef PG8_WAIT_V
#undef PG8_WAIT_L
#undef PG8_BAR
#undef PG8_SCHED
#undef PG8_SETVO
#undef PG8_TRIP_BODY
}
}

struct InprojSched {
    static constexpr bool GATHER = false;
    const bf16_t* XN; const bf16_t* W; int G, c; int lda, ldb, K;
    __device__ __forceinline__ bool next(int i, pg8::Unit& u) const {
        const int L = i * G + c;
        if (L < 128 * 28) { int pm, pn; pg8::tile_of(L, 128, 28, pm, pn); u.pm = pm; u.pb = pn; u.x0 = 0; u.x1 = 0; return true; }
        const int idx = L - 128 * 28; if (idx >= 96) return false;
        u.pm = 128 + (idx & 7); u.pb = 8 + (idx >> 3); u.x0 = 1; u.x1 = 0; return true;
    }
    __device__ __forceinline__ const char* a_ptr(const pg8::Unit& u) const { return (const char*)XN + (size_t)u.pm * 256 * 1024 * 2; }
    __device__ __forceinline__ const char* b_ptr(const pg8::Unit& u) const { return (const char*)W + (size_t)u.pb * 256 * 1024 * 2; }
    __device__ __forceinline__ int row_of(const pg8::Unit&, int r) const { return r; }
};
struct MixSched {
    static constexpr bool GATHER = false;
    const bf16_t* Z; const bf16_t* W; int G, c; int lda, ldb, K;
    __device__ __forceinline__ bool next(int i, pg8::Unit& u) const {
        const int L = i * G + c; if (L >= 128 * 4) return false;
        int pm, pn; pg8::tile_of(L, 128, 4, pm, pn); u.pm = pm; u.pb = pn; u.x0 = pn; u.x1 = 0; return true;
    }
    __device__ __forceinline__ const char* a_ptr(const pg8::Unit& u) const { return (const char*)Z + (size_t)u.pm * 256 * LDZ * 2; }
    __device__ __forceinline__ const char* b_ptr(const pg8::Unit& u) const { return (const char*)W + (size_t)u.pb * 256 * 2048 * 2; }
    __device__ __forceinline__ int row_of(const pg8::Unit&, int r) const { return r; }
};
struct WoutSched {
    static constexpr bool GATHER = false;
    const bf16_t* Z; const bf16_t* W; int G, c; int lda, ldb, K;
    __device__ __forceinline__ bool next(int i, pg8::Unit& u) const {
        const int L = i * G + c; if (L >= 128 * 4) return false;
        int pm, pn; pg8::tile_of(L, 128, 4, pm, pn); u.pm = pm; u.pb = pn; u.x0 = pn; u.x1 = 0; return true;
    }
    __device__ __forceinline__ const char* a_ptr(const pg8::Unit& u) const { return (const char*)Z + ((size_t)u.pm * 256 * LDZ + ZC_XR) * 2; }
    __device__ __forceinline__ const char* b_ptr(const pg8::Unit& u) const { return (const char*)W + (size_t)u.pb * 256 * 1024 * 2; }
    __device__ __forceinline__ int row_of(const pg8::Unit&, int r) const { return r; }
};
struct Moe1Sched {
    static constexpr bool GATHER = true;
    const unsigned char* XN2; const unsigned char* W; const int* selidx; int G, c; int lda, ldb, K;
    __device__ __forceinline__ bool next(int i, pg8::Unit& u) const {
        const int L = i * G + c; if (L >= 16 * 256) return false;
        const int e = L >> 8, w = L & 255, x = w & 7, j = w >> 3;
        const int mt = (x & 3) * 4 + (j & 3), nt = (x >> 2) * 8 + (j >> 2);
        u.pm = e * 16 + mt; u.pb = e * 16 + nt; u.x0 = nt; u.x1 = e; return true;
    }
    __device__ __forceinline__ const char* a_ptr(const pg8::Unit&) const { return (const char*)XN2; }
    __device__ __forceinline__ const char* b_ptr(const pg8::Unit& u) const { return (const char*)W + (size_t)u.pb * 256 * 1024; }
    __device__ __forceinline__ int row_of(const pg8::Unit& u, int r) const { return selidx[u.pm * 256 + r]; }
};
struct Moe2Sched {
    static constexpr bool GATHER = true;
    const unsigned char* HID; const unsigned char* W; int G, c; int lda, ldb, K;
    __device__ __forceinline__ bool next(int i, pg8::Unit& u) const {
        const int L = i * G + c; if (L >= 16 * 64) return false;
        const int x = L & 7, j = (L >> 3) & 31, e = ((L >> 8) << 2) + (j >> 3), r = j & 7, mt = 2 * x + (r >> 2), pn = r & 3;
        u.pm = e * 16 + mt; u.pb = e * 4 + pn; u.x0 = pn; u.x1 = e; return true;
    }
    __device__ __forceinline__ const char* a_ptr(const pg8::Unit& u) const { return (const char*)HID + (size_t)u.pm * 256 * 2048; }
    __device__ __forceinline__ const char* b_ptr(const pg8::Unit& u) const { return (const char*)W + (size_t)u.pb * 256 * 2048; }
    __device__ __forceinline__ int row_of(const pg8::Unit&, int r) const { return r; }
};

typedef const f32x4 (&AccRef)[2][2][4][2];
template <bool PLAIN = false> struct EpiInproj {
    static constexpr bool PERM = true, MID = false;
    bf16_t* Z; bf16_t* ZC; const float* binz; const float* rope;
    __device__ __forceinline__ void operator()(AccRef acc, const pg8::Unit& u, int wr, int wc, int fr, int fq) const {
        const bool isctx = u.x0 != 0;
        const int seg = PLAIN ? 2 : (u.pb >> 2), colt = u.pb * 256, cl = wc * 32 + 8 * fq;
        f32x4 bv[2][2];
#pragma unroll
        for (int bj = 0; bj < 2; ++bj)
#pragma unroll
            for (int n = 0; n < 2; ++n) bv[bj][n] = *(const f32x4*)(binz + colt + bj * 128 + cl + 4 * n);
        bf16_t* base; int ld, row0;
        if (!isctx) { base = Z + colt; ld = LDZ; row0 = u.pm * 256; } else { base = ZC + (colt - 2048); ld = LDC; row0 = (u.pm - 128) * 256; }
        const bool dorope = (seg == 1) || (seg == 3 && !isctx);
        const float qs = (seg == 1) ? QSCALE : 1.0f;
        if (dorope) {
            f32x4 ca[2][2], cb[2][2];
#define IP_LOAD(buf, g) do { _Pragma("unroll") for (int mm = 0; mm < 2; ++mm) { const int t = (row0 + ((g) >> 1) * 128 + wr * 64 + (2 * ((g) & 1) + mm) * 16 + fr) & 4095; const int pos = (wc & 1) ? (t & 63) : (t >> 6); \
            const float* cp = rope + (pos * 16 + 4 * fq) * 2; buf[mm][0] = *(const f32x4*)cp; buf[mm][1] = *(const f32x4*)(cp + 4); } } while (0)
#define IP_PROC(buf, g) do { _Pragma("unroll") for (int mm = 0; mm < 2; ++mm) { const int ai = (g) >> 1, m = 2 * ((g) & 1) + mm; \
            bf16_t* rowp = base + (size_t)(row0 + ai * 128 + wr * 64 + m * 16 + fr) * ld + cl; \
            const float c[4] = {buf[mm][0][0], buf[mm][0][2], buf[mm][1][0], buf[mm][1][2]}, sn[4] = {buf[mm][0][1], buf[mm][0][3], buf[mm][1][1], buf[mm][1][3]}; \
            _Pragma("unroll") for (int bj = 0; bj < 2; ++bj) { \
                f32x4 v0 = acc[ai][bj][m][0] + bv[bj][0], v1 = acc[ai][bj][m][1] + bv[bj][1]; \
                _Pragma("unroll") for (int j = 0; j < 4; ++j) { const float x1 = v0[j], x2 = v1[j]; v0[j] = (x1 * c[j] - x2 * sn[j]) * qs; v1[j] = (x1 * sn[j] + x2 * c[j]) * qs; } \
                u32x4 w; w.x = cvt_pk_bf16(v0[0], v0[1]); w.y = cvt_pk_bf16(v0[2], v0[3]); w.z = cvt_pk_bf16(v1[0], v1[1]); w.w = cvt_pk_bf16(v1[2], v1[3]); \
                *(u32x4*)(rowp + bj * 128) = w; } } } while (0)
            IP_LOAD(ca, 0); IP_LOAD(cb, 1);
            __builtin_amdgcn_sched_barrier(0);
            IP_PROC(ca, 0); __builtin_amdgcn_sched_barrier(0); IP_LOAD(ca, 2); __builtin_amdgcn_sched_barrier(0);
            IP_PROC(cb, 1); __builtin_amdgcn_sched_barrier(0); IP_LOAD(cb, 3); __builtin_amdgcn_sched_barrier(0);
            IP_PROC(ca, 2); __builtin_amdgcn_sched_barrier(0);
            IP_PROC(cb, 3);
#undef IP_LOAD
#undef IP_PROC
            return;
        }
#pragma unroll
        for (int ai = 0; ai < 2; ++ai)
#pragma unroll
            for (int m = 0; m < 4; ++m) {
                const int r = row0 + ai * 128 + wr * 64 + m * 16 + fr;
                bf16_t* rowp = base + (size_t)r * ld + cl;
#pragma unroll
                for (int bj = 0; bj < 2; ++bj) {
                    f32x4 v0 = acc[ai][bj][m][0] + bv[bj][0], v1 = acc[ai][bj][m][1] + bv[bj][1];
                    if (seg == 0) {
#pragma unroll
                        for (int j = 0; j < 4; ++j) { v0[j] = gelu_tanh(v0[j]); v1[j] = gelu_tanh(v1[j]); }
                    } else if (seg >= 5) {
                        unsigned q[8];
#pragma unroll
                        for (int j = 0; j < 4; ++j) { q[j] = (unsigned)__builtin_rintf(255.0f * sigmoidf_(v0[j])); q[4 + j] = (unsigned)__builtin_rintf(255.0f * sigmoidf_(v1[j])); }
                        u32x2 w8; w8.x = q[0] | (q[1] << 8) | (q[2] << 16) | (q[3] << 24); w8.y = q[4] | (q[5] << 8) | (q[6] << 16) | (q[7] << 24);
                        *(u32x2*)((unsigned char*)(Z + (size_t)r * LDZ) + 2 * ZC_GR + 1024 * (seg - 5) + ((u.pb & 3) * 256 + cl + bj * 128)) = w8;
                        continue;
                    }
                    u32x4 w; w.x = cvt_pk_bf16(v0[0], v0[1]); w.y = cvt_pk_bf16(v0[2], v0[3]); w.z = cvt_pk_bf16(v1[0], v1[1]); w.w = cvt_pk_bf16(v1[2], v1[3]);
                    *(u32x4*)(rowp + bj * 128) = w;
                }
            }
    }
};
__device__ __forceinline__ void unpack_u8x8(u32x2 g, f32x4& lo, f32x4& hi) {
    const float k = 1.0f / 255.0f;
    lo = (f32x4){(float)(g.x & 0xffu), (float)((g.x >> 8) & 0xffu), (float)((g.x >> 16) & 0xffu), (float)(g.x >> 24)} * k;
    hi = (f32x4){(float)(g.y & 0xffu), (float)((g.y >> 8) & 0xffu), (float)((g.y >> 16) & 0xffu), (float)(g.y >> 24)} * k;
}
struct EpiMix {
    static constexpr bool PERM = true, MID = true;
    bf16_t* Z;
    __device__ __forceinline__ void mid(f32x4 (&acc)[2][2][4][2], const pg8::Unit& u, int wr, int wc, int fr, int fq) const {
        const int colt = u.x0 * 256, cl = wc * 32 + 8 * fq;
        int r0 = u.pm * 256 + wr * 64 + fr; asm volatile("" : "+v"(r0));
        u32x2 gr[2][4][2], gn[2][4][2];
#pragma unroll
        for (int ai = 0; ai < 2; ++ai)
#pragma unroll
            for (int m = 0; m < 4; ++m) {
                const unsigned char* rowg = (const unsigned char*)(Z + (size_t)(r0 + ai * 128 + m * 16) * LDZ) + 2 * ZC_GR + colt + cl;
#pragma unroll
                for (int bj = 0; bj < 2; ++bj) { gr[ai][m][bj] = *(const u32x2*)(rowg + bj * 128); gn[ai][m][bj] = *(const u32x2*)(rowg + 1024 + bj * 128); }
            }
        __builtin_amdgcn_sched_barrier(0);
#pragma unroll
        for (int ai = 0; ai < 2; ++ai)
#pragma unroll
            for (int m = 0; m < 4; ++m)
#pragma unroll
                for (int bj = 0; bj < 2; ++bj) {
                    f32x4 r0v, r1v, n0v, n1v; unpack_u8x8(gr[ai][m][bj], r0v, r1v); unpack_u8x8(gn[ai][m][bj], n0v, n1v);
#pragma unroll
                    for (int j = 0; j < 4; ++j) { acc[ai][bj][m][0][j] *= r0v[j] * __builtin_amdgcn_rcpf(fmaxf(n0v[j], 1.0f / 255.0f)); acc[ai][bj][m][1][j] *= r1v[j] * __builtin_amdgcn_rcpf(fmaxf(n1v[j], 1.0f / 255.0f)); }
                }
    }
    __device__ __forceinline__ void operator()(AccRef acc, const pg8::Unit& u, int wr, int wc, int fr, int fq) const {
        const int colt = u.x0 * 256, cl = wc * 32 + 8 * fq;
        int r0 = u.pm * 256 + wr * 64 + fr; asm volatile("" : "+v"(r0));
        u32x2 gn[2][4][2];
#pragma unroll
        for (int ai = 0; ai < 2; ++ai)
#pragma unroll
            for (int m = 0; m < 4; ++m) {
                const unsigned char* rowg = (const unsigned char*)(Z + (size_t)(r0 + ai * 128 + m * 16) * LDZ) + 2 * ZC_GR + 1024 + colt + cl;
#pragma unroll
                for (int bj = 0; bj < 2; ++bj) gn[ai][m][bj] = *(const u32x2*)(rowg + bj * 128);
            }
        __builtin_amdgcn_sched_barrier(0);
#pragma unroll
        for (int ai = 0; ai < 2; ++ai)
#pragma unroll
            for (int m = 0; m < 4; ++m) {
                bf16_t* rowz = Z + (size_t)(r0 + ai * 128 + m * 16) * LDZ + colt + cl;
#pragma unroll
                for (int bj = 0; bj < 2; ++bj) {
                    f32x4 n0v, n1v; unpack_u8x8(gn[ai][m][bj], n0v, n1v);
                    n0v = __builtin_elementwise_max(n0v, (f32x4){1.0f / 255.0f, 1.0f / 255.0f, 1.0f / 255.0f, 1.0f / 255.0f}); n1v = __builtin_elementwise_max(n1v, (f32x4){1.0f / 255.0f, 1.0f / 255.0f, 1.0f / 255.0f, 1.0f / 255.0f});
                    const f32x4 v0 = acc[ai][bj][m][0] * n0v, v1 = acc[ai][bj][m][1] * n1v;
                    u32x4 w; w.x = cvt_pk_bf16(v0[0], v0[1]); w.y = cvt_pk_bf16(v0[2], v0[3]); w.z = cvt_pk_bf16(v1[0], v1[1]); w.w = cvt_pk_bf16(v1[2], v1[3]);
                    *(u32x4*)(rowz + ZC_XR + bj * 128) = w;
                }
            }
    }
};
struct EpiWout {
    static constexpr bool PERM = true, MID = false;
    const float* x; bf16_t* x1; const float* mod;
    __device__ __forceinline__ void operator()(AccRef acc, const pg8::Unit& u, int wr, int wc, int fr, int fq) const {
        const int col0 = u.x0 * 256 + wc * 32 + 8 * fq;
        const float* g1p = mod + (size_t)(u.pm >> 4) * 6144 + 2048 + col0;
        f32x4 gv[2][2];
#pragma unroll
        for (int bj = 0; bj < 2; ++bj)
#pragma unroll
            for (int n = 0; n < 2; ++n) gv[bj][n] = *(const f32x4*)(g1p + bj * 128 + n * 4);
        const size_t off0 = (size_t)(u.pm * 256 + wr * 64 + fr) * DM + col0;
        f32x4 xa[2][2][2], xb[2][2][2];
#define WO_LOAD(buf, g) do { _Pragma("unroll") for (int mm = 0; mm < 2; ++mm) _Pragma("unroll") for (int bj = 0; bj < 2; ++bj) { \
            const size_t off = off0 + (size_t)(((g) >> 1) * 128 + (2 * ((g) & 1) + mm) * 16) * DM + bj * 128; buf[mm][bj][0] = *(const f32x4*)(x + off); buf[mm][bj][1] = *(const f32x4*)(x + off + 4); } } while (0)
#define WO_PROC(buf, g) do { _Pragma("unroll") for (int mm = 0; mm < 2; ++mm) _Pragma("unroll") for (int bj = 0; bj < 2; ++bj) { \
            const int ai = (g) >> 1, m = 2 * ((g) & 1) + mm; const size_t off = off0 + (size_t)(ai * 128 + m * 16) * DM + bj * 128; \
            const f32x4 v0 = buf[mm][bj][0] + gv[bj][0] * acc[ai][bj][m][0], v1 = buf[mm][bj][1] + gv[bj][1] * acc[ai][bj][m][1]; \
            u32x4 w; w.x = cvt_pk_bf16(v0[0], v0[1]); w.y = cvt_pk_bf16(v0[2], v0[3]); w.z = cvt_pk_bf16(v1[0], v1[1]); w.w = cvt_pk_bf16(v1[2], v1[3]); \
            *(u32x4*)(x1 + off) = w; } } while (0)
        WO_LOAD(xa, 0); WO_LOAD(xb, 1);
        __builtin_amdgcn_sched_barrier(0);
        WO_PROC(xa, 0); __builtin_amdgcn_sched_barrier(0); WO_LOAD(xa, 2); __builtin_amdgcn_sched_barrier(0);
        WO_PROC(xb, 1); __builtin_amdgcn_sched_barrier(0); WO_LOAD(xb, 3); __builtin_amdgcn_sched_barrier(0);
        WO_PROC(xa, 2); __builtin_amdgcn_sched_barrier(0);
        WO_PROC(xb, 3);
#undef WO_LOAD
#undef WO_PROC
    }
};
__device__ __forceinline__ unsigned pk4_fp8(float a, float b, float c, float d) { int w = 0; w = __builtin_amdgcn_cvt_pk_fp8_f32(a, b, w, false); w = __builtin_amdgcn_cvt_pk_fp8_f32(c, d, w, true); return (unsigned)w; }
struct EpiMoe1 {
    static constexpr bool PERM = true, MID = false;
    unsigned char* HID;
    __device__ __forceinline__ void operator()(AccRef acc, const pg8::Unit& u, int wr, int wc, int fr, int fq) const {
        const int col0 = u.x0 * 128 + wc * 32 + 8 * fq;
#pragma unroll
        for (int ai = 0; ai < 2; ++ai)
#pragma unroll
            for (int m = 0; m < 4; ++m) {
                const size_t r = (size_t)u.pm * 256 + ai * 128 + wr * 64 + m * 16 + fr;
                f32x4 h0, h1;
#pragma unroll
                for (int j = 0; j < 4; ++j) { const float g0 = acc[ai][0][m][0][j], g1 = acc[ai][0][m][1][j];
                    h0[j] = g0 * sigmoidf_(g0) * acc[ai][1][m][0][j]; h1[j] = g1 * sigmoidf_(g1) * acc[ai][1][m][1][j]; }
                u32x2 w; w.x = pk4_fp8(h0[0], h0[1], h0[2], h0[3]); w.y = pk4_fp8(h1[0], h1[1], h1[2], h1[3]);
                *(u32x2*)(HID + r * DEXP + col0) = w;
            }
    }
};
struct EpiMoe2 {
    static constexpr bool PERM = true, MID = false;
    unsigned char* YE;
    __device__ __forceinline__ void operator()(AccRef acc, const pg8::Unit& u, int wr, int wc, int fr, int fq) const {
        const int col0 = u.x0 * 256 + wc * 32 + 8 * fq;
        const size_t r0 = (size_t)u.pm * 256 + wr * 64 + fr;
        unsigned char* base = YE + r0 * DM + col0;
#pragma unroll
        for (int ai = 0; ai < 2; ++ai)
#pragma unroll
            for (int m = 0; m < 4; ++m) {
                unsigned char* rowp = base + (size_t)(ai * 128 + m * 16) * DM;
#pragma unroll
                for (int bj = 0; bj < 2; ++bj) {
                    const f32x4 v0 = acc[ai][bj][m][0], v1 = acc[ai][bj][m][1];
                    u32x2 w; w.x = pk4_fp8(v0[0], v0[1], v0[2], v0[3]); w.y = pk4_fp8(v1[0], v1[1], v1[2], v1[3]);
                    *(u32x2*)(rowp + bj * 128) = w;
                }
            }
    }
};

struct Params {
    const float *x, *c, *ctx, *c_ctx, *w_mod, *b_mod, *w_in, *b_in, *conv_w, *conv_b, *lru_wa, *lru_ba, *lru_wi, *lru_bi, *lru_lambda, *na_rpb,
                *w_proj_rnn, *w_proj_na, *w_out, *w_router, *w_exp_gate, *w_exp_up, *w_exp_down, *final_norm;
    float* out; unsigned char* ws;
    int ph_lo, ph_hi, probe, pad;
};

__device__ __forceinline__ int zcol_of(int n) {
    const int seg = n >> 10, o = n & 1023;
    if (seg == 0) return ZC_YG + o;
    if (seg == 1) return ZC_XR + o;
    if (seg == 4) return ZC_V + o;
    if (seg == 5) return ZC_GR + o;
    if (seg == 6) return ZC_GN + o;
    const int hh = o >> 6, d = o & 63, g2 = d >> 5, dd = d & 31, nn = dd >> 4, j = dd & 15, a = j >> 2, jj = j & 3;
    return (seg == 2 ? ZC_Q : ZC_K) + hh * 64 + g2 * 32 + 8 * a + 4 * nn + jj;
}
constexpr int TR_SCR = 64 * 65 * 4;
template <class RowMap>
__device__ __forceinline__ void transpose_item(const float* W, int ldw, int k0, int n0, bf16_t* WT, int ldk, RowMap rowmap, LAS float* scr, int lane) {
    const int ln = lane & 15, lk = lane >> 4;
    f32x4 v[16];
#pragma unroll
    for (int i = 0; i < 16; ++i) v[i] = *(const f32x4*)(W + (size_t)(k0 + 4 * i + lk) * ldw + n0 + 4 * ln);
#pragma unroll
    for (int i = 0; i < 16; ++i) { LAS float* d = scr + (4 * i + lk) * 65 + 4 * ln; d[0] = v[i].x; d[1] = v[i].y; d[2] = v[i].z; d[3] = v[i].w; }
    LDS_WAIT(); asm volatile("" ::: "memory");
    const int kg = lane & 7;
#pragma unroll
    for (int j = 0; j < 8; ++j) { const int n = (lane >> 3) + 8 * j; const LAS float* sp = scr + (8 * kg) * 65 + n;
        u32x4 o; o.x = cvt_pk_bf16(sp[0 * 65], sp[1 * 65]); o.y = cvt_pk_bf16(sp[2 * 65], sp[3 * 65]); o.z = cvt_pk_bf16(sp[4 * 65], sp[5 * 65]); o.w = cvt_pk_bf16(sp[6 * 65], sp[7 * 65]);
        *(u32x4*)(WT + (size_t)rowmap(n0 + n) * ldk + k0 + 8 * kg) = o; }
    LDS_WAIT(); asm volatile("" ::: "memory");
}
template <class RowMap>
__device__ __forceinline__ void transpose_item_f8(const float* W, int ldw, int k0, int n0, unsigned char* WT, int ldk, RowMap rowmap, LAS float* scr, int lane) {
    const int ln = lane & 15, lk = lane >> 4;
    f32x4 v[16];
#pragma unroll
    for (int i = 0; i < 16; ++i) v[i] = *(const f32x4*)(W + (size_t)(k0 + 4 * i + lk) * ldw + n0 + 4 * ln);
#pragma unroll
    for (int i = 0; i < 16; ++i) { LAS float* d = scr + (4 * i + lk) * 65 + 4 * ln; d[0] = v[i].x * 64.f; d[1] = v[i].y * 64.f; d[2] = v[i].z * 64.f; d[3] = v[i].w * 64.f; }
    LDS_WAIT(); asm volatile("" ::: "memory");
    const int kq = lane & 3;
#pragma unroll
    for (int j = 0; j < 4; ++j) { const int n = (lane >> 2) + 16 * j; const LAS float* sp = scr + (16 * kq) * 65 + n;
        u32x4 o; o.x = pk4_fp8(sp[0 * 65], sp[1 * 65], sp[2 * 65], sp[3 * 65]); o.y = pk4_fp8(sp[4 * 65], sp[5 * 65], sp[6 * 65], sp[7 * 65]);
        o.z = pk4_fp8(sp[8 * 65], sp[9 * 65], sp[10 * 65], sp[11 * 65]); o.w = pk4_fp8(sp[12 * 65], sp[13 * 65], sp[14 * 65], sp[15 * 65]);
        *(u32x4*)(WT + (size_t)rowmap(n0 + n) * ldk + k0 + 16 * kq) = o; }
    LDS_WAIT(); asm volatile("" ::: "memory");
}
struct TrItem { const float* src; unsigned char* dst; int ldw, ldk, n0, up; };
__device__ __forceinline__ void tr_load(const TrItem& t, int lane, f32x4 (&v)[16]) {
    const int ln = lane & 15, lk = lane >> 4;
#pragma unroll
    for (int i = 0; i < 16; ++i) v[i] = *(const f32x4*)(t.src + (size_t)(4 * i + lk) * t.ldw + 4 * ln);
}
__device__ __forceinline__ void tr_store_f8(const TrItem& t, const f32x4 (&v)[16], LAS float* scr, int lane) {
    const int ln = lane & 15, lk = lane >> 4;
#pragma unroll
    for (int i = 0; i < 16; ++i) { LAS float* d = scr + (4 * i + lk) * 65 + 4 * ln; d[0] = v[i].x * 64.f; d[1] = v[i].y * 64.f; d[2] = v[i].z * 64.f; d[3] = v[i].w * 64.f; }
    LDS_WAIT(); asm volatile("" ::: "memory");
    const int kq = lane & 3;
#pragma unroll
    for (int j = 0; j < 4; ++j) { const int n = (lane >> 2) + 16 * j, na = t.n0 + n; const LAS float* sp = scr + (16 * kq) * 65 + n;
        const int row = t.up < 0 ? na : 256 * (na >> 7) + 128 * t.up + (na & 127);
        u32x4 o; o.x = pk4_fp8(sp[0 * 65], sp[1 * 65], sp[2 * 65], sp[3 * 65]); o.y = pk4_fp8(sp[4 * 65], sp[5 * 65], sp[6 * 65], sp[7 * 65]);
        o.z = pk4_fp8(sp[8 * 65], sp[9 * 65], sp[10 * 65], sp[11 * 65]); o.w = pk4_fp8(sp[12 * 65], sp[13 * 65], sp[14 * 65], sp[15 * 65]);
        *(u32x4*)(t.dst + (size_t)row * t.ldk + 16 * kq) = o; }
    LDS_WAIT(); asm volatile("" ::: "memory");
}
__device__ __forceinline__ void phase_prep(const Params& p, LAS unsigned char* lds) {
    const int tid = threadIdx.x, lane = tid & 63, wave = tid >> 6, G = gridDim.x;
    unsigned char* ws = p.ws;
    {
        LAS float* sS = (LAS float*)lds;
        LAS float* red = sS + 9 * 1024;
        float* MOD = (float*)(ws + WS_MOD);
        if (blockIdx.x < 192) {
            for (int e = tid; e < 9 * 1024; e += NTHREADS) { const int r = e >> 10, k = e & 1023; const float v = (r < 8) ? p.c[r * 1024 + k] : p.c_ctx[k]; sS[e] = v * sigmoidf_(v); }
            __syncthreads();
        }
        for (int it = blockIdx.x; it < 192; it += G) {
            const int n0 = it * 32, kk = tid >> 3, c4 = tid & 7;
            f32x4 a[9];
#pragma unroll
            for (int r = 0; r < 9; ++r) a[r] = (f32x4){0.f, 0.f, 0.f, 0.f};
#pragma unroll 4
            for (int i = 0; i < 16; ++i) { const int k = kk + 64 * i; const f32x4 w = *(const f32x4*)(p.w_mod + (size_t)k * 6144 + n0 + 4 * c4);
#pragma unroll
                for (int r = 0; r < 9; ++r) a[r] += w * sS[r * 1024 + k]; }
#pragma unroll
            for (int r = 0; r < 9; ++r) *(LAS f32x4*)(red + (kk * 9 + r) * 32 + 4 * c4) = a[r];
            __syncthreads();
            if (tid < 288) { const int r = tid >> 5, col = tid & 31; float sum = p.b_mod[n0 + col];
                for (int q = 0; q < 64; ++q) sum += red[(q * 9 + r) * 32 + col];
                MOD[r * 6144 + n0 + col] = sum; }
            __syncthreads();
        }
    }
    {
        float* ROPE = (float*)(ws + WS_ROPE); float* BINZ = (float*)(ws + WS_BINZ);
        const int gt = blockIdx.x * NTHREADS + tid, NGT = G * NTHREADS;
        for (int e = gt; e < 64 * 16; e += NGT) { const int pos = e >> 4, j = e & 15; const float inv = powf(10000.0f, -(float)j / 16.0f); const float ang = (float)pos * inv; ROPE[2 * e] = cosf(ang); ROPE[2 * e + 1] = sinf(ang); }
        for (int n = gt; n < NIN; n += NGT) BINZ[zcol_of(n)] = p.b_in[n];
    }
}
__device__ __forceinline__ void phase_prep_weights(const Params& p, LAS unsigned char* lds) {
    const int tid = threadIdx.x, lane = tid & 63, wave = tid >> 6, G = gridDim.x;
    unsigned char* ws = p.ws;
    {
        LAS float* scr = (LAS float*)(lds + wave * TR_SCR);
        bf16_t* WINT = (bf16_t*)(ws + WS_WINT); bf16_t* WMIX = (bf16_t*)(ws + WS_WMIX); bf16_t* WOUT = (bf16_t*)(ws + WS_WOUT);
        const int gw = blockIdx.x * NWAVES + wave, NGW = G * NWAVES;
        constexpr int I_IN = 16 * (NIN / 64), I_P = 16 * 16;
        for (int it = gw; it < I_IN + 3 * I_P; it += NGW) {
            int r = it;
            if (r < I_IN) { const int nblk = NIN / 64, kb = r / nblk, nb = r % nblk; transpose_item(p.w_in, NIN, 64 * kb, 64 * nb, WINT, 1024, [](int n) { return zcol_of(n); }, scr, lane); continue; } r -= I_IN;
            const int kb = (r % I_P) / 16, nb = (r % I_P) % 16, which = r / I_P;
            if (which == 0) transpose_item(p.w_proj_rnn, 1024, 64 * kb, 64 * nb, WMIX, 2048, [](int n) { return n; }, scr, lane);
            else if (which == 1) transpose_item(p.w_proj_na, 1024, 64 * kb, 64 * nb, WMIX + 1024, 2048, [](int n) { return n; }, scr, lane);
            else transpose_item(p.w_out, 1024, 64 * kb, 64 * nb, WOUT, 1024, [](int n) { return n; }, scr, lane);
        }
    }
}

__device__ __forceinline__ const float* norm1_row(const Params& p, int row) { return row >= MLAT ? p.ctx + (size_t)(row - MLAT) * DM : p.x + (size_t)row * DM; }
__device__ __forceinline__ void phase_norm1(const Params& p, LAS unsigned char* lds) {
    const int tid = threadIdx.x, lane = tid & 63, wave = tid >> 6, G = gridDim.x;
    unsigned char* ws = p.ws;
    const float* MOD = (const float*)(ws + WS_MOD);
    bf16_t* XN = (bf16_t*)(ws + WS_XN);
    const int gw = blockIdx.x * NWAVES + wave, NGW = G * NWAVES;
    constexpr int NROW = MLAT + MCTX;
    const int per = (NROW + NGW - 1) / NGW, r_lo = gw * per, r_hi = min(r_lo + per, NROW);
    if (r_lo >= r_hi) return;
    f32x4 nx[4], ny[4], shv[4], scv[4]; int mcur = -1;
    { const f32x4* xr = (const f32x4*)norm1_row(p, r_lo) + lane;
#pragma unroll
      for (int j = 0; j < 4; ++j) nx[j] = xr[64 * j];
      if (r_lo + 1 < r_hi) { const f32x4* xs = (const f32x4*)norm1_row(p, r_lo + 1) + lane;
#pragma unroll
          for (int j = 0; j < 4; ++j) ny[j] = xs[64 * j]; } }
    for (int row = r_lo; row < r_hi; ++row) {
        const int mr = (row >= MLAT) ? 8 : (row >> 12);
        if (mr != mcur) { mcur = mr; const float* sh = MOD + (size_t)mr * 6144;
#pragma unroll
            for (int j = 0; j < 4; ++j) { shv[j] = *(const f32x4*)(sh + 4 * lane + 256 * j); scv[j] = *(const f32x4*)(sh + 1024 + 4 * lane + 256 * j) + 1.0f; } }
        f32x4 v[4]; float s = 0.f;
#pragma unroll
        for (int j = 0; j < 4; ++j) { v[j] = nx[j]; nx[j] = ny[j]; s += (v[j].x * v[j].x + v[j].y * v[j].y) + (v[j].z * v[j].z + v[j].w * v[j].w); }
        if (row + 2 < r_hi) { const f32x4* xr = (const f32x4*)norm1_row(p, row + 2) + lane;
#pragma unroll
            for (int j = 0; j < 4; ++j) ny[j] = xr[64 * j]; }
        const float rs = 1.0f / sqrtf(wave_sum(s) * (1.0f / DM) + 1e-6f);
        unsigned long long* o8 = (unsigned long long*)(XN + (size_t)row * DM) + lane;
#pragma unroll
        for (int j = 0; j < 4; ++j) { const f32x4 y = v[j] * rs * scv[j] + shv[j];
            o8[64 * j] = (unsigned long long)pk2(y.x, y.y) | ((unsigned long long)pk2(y.z, y.w) << 32); }
    }
}

typedef float f32x16 __attribute__((ext_vector_type(16)));
constexpr int RN_XS = 144;
constexpr int RN_XC = 0, RN_WT = 256 * RN_XS, RN_SEG = RN_WT + 64 * RN_XS, RN_ST = RN_SEG + 10240;
__device__ __forceinline__ void phase_rnn(const Params& p, LAS unsigned char* lds, const bool dry) {
    const int tid = threadIdx.x, lane = tid & 63, wave = __builtin_amdgcn_readfirstlane(tid >> 6), G = gridDim.x;
    unsigned char* ws = p.ws;
    bf16_t* Z = (bf16_t*)(ws + WS_Z); const bf16_t* ZCb = (const bf16_t*)(ws + WS_ZC); bf16_t* HF = (bf16_t*)(ws + WS_XN);
    LAS unsigned char* xcb = lds + RN_XC;
    LAS unsigned char* wtb = lds + RN_WT;
    LAS float* seg0 = (LAS float*)(lds + RN_SEG);
    LAS unsigned char* stg = lds + RN_ST;
    const int c = lane & 31, hh = lane >> 5;
    const int taur = 16 * ((c >> 2) & 1) + 4 * (c >> 3) + (c & 3);
    const int cg8 = tid & 7, run = tid >> 3;
    for (int it = blockIdx.x; it < 256; it += G) {
        const int b = it >> 5, g = (it >> 1) & 15, half = it & 1;
        const int ch = 64 * g + 32 * half + c;
        const int ch0 = 64 * g + 32 * half;
        f32x2 cw2[4][4], cb2[4];
#pragma unroll
        for (int j = 0; j < 4; ++j) { cb2[j] = *(const f32x2*)(p.conv_b + 64 * g + 8 * cg8 + 2 * j);
#pragma unroll
            for (int k = 0; k < 4; ++k) cw2[k][j] = *(const f32x2*)(p.conv_w + k * 1024 + 64 * g + 8 * cg8 + 2 * j); }
        const bf16_t* srcL = Z + (size_t)b * SEQ * LDZ + ZC_XR + 64 * g + 8 * cg8;
        const bf16_t* srcC = ZCb + (size_t)b * CTX * LDC + CC_XR + 64 * g + 8 * cg8;
        for (int dir = 0; dir < 2; ++dir) {
            u32x4 xr[7];
#pragma unroll
            for (int q = 0; q < 7; ++q) { const int ts = 4 * run - 2 + q; xr[q] = (ts >= 0 && ts < CTX) ? *(const u32x4*)(srcC + (size_t)ts * LDC) : (u32x4){0u, 0u, 0u, 0u}; }
            __syncthreads();
            for (int e = tid; e < 2 * 64 * 32; e += NTHREADS) { const int mat = e >> 11, i = (e >> 5) & 63, cc = e & 31;
                const float* src = mat ? p.lru_wi : p.lru_wa;
                *(LAS bf16_t*)(wtb + (mat * 32 + cc) * RN_XS + i * 2) = (bf16_t)f2bf(src[(((size_t)dir * 16 + g) * 64 + i) * 64 + 32 * half + cc]); }
            __syncthreads();
            const float nbaL = -LOG2E * p.lru_ba[dir * 1024 + ch], nbiL = -LOG2E * p.lru_bi[dir * 1024 + ch];
            const float lam = p.lru_lambda[dir * 1024 + ch];
            const float sp = (lam > 15.f) ? expf(-lam) : log1pf(expf(-lam));
            const float clam = -8.0f * sp * LOG2E;
            float hc = 0.f;
            for (int step = 0; step < 17; ++step) {
                const bool isctx = (step == 0);
                const int t0 = isctx ? 0 : 256 * (dir == 0 ? step - 1 : 16 - step);
                {
                    f32x2 ac[4][4];
#pragma unroll
                    for (int i = 0; i < 4; ++i)
#pragma unroll
                        for (int j = 0; j < 4; ++j) ac[i][j] = cb2[j];
#pragma unroll
                    for (int q = 0; q < 7; ++q) {
                        f32x2 x2[4];
                        x2[0] = (f32x2){bf2f(xr[q].x & 0xffffu), bf2f(xr[q].x >> 16)}; x2[1] = (f32x2){bf2f(xr[q].y & 0xffffu), bf2f(xr[q].y >> 16)};
                        x2[2] = (f32x2){bf2f(xr[q].z & 0xffffu), bf2f(xr[q].z >> 16)}; x2[3] = (f32x2){bf2f(xr[q].w & 0xffffu), bf2f(xr[q].w >> 16)};
#pragma unroll
                        for (int i = 0; i < 4; ++i) { const int k = q - i; if (k >= 0 && k < 4) {
#pragma unroll
                            for (int j = 0; j < 4; ++j) ac[i][j] = __builtin_elementwise_fma(cw2[k][j], x2[j], ac[i][j]); } }
                    }
#pragma unroll
                    for (int i = 0; i < 4; ++i) { u32x4 w; w.x = cvt_pk_bf16(ac[i][0].x, ac[i][0].y); w.y = cvt_pk_bf16(ac[i][1].x, ac[i][1].y); w.z = cvt_pk_bf16(ac[i][2].x, ac[i][2].y); w.w = cvt_pk_bf16(ac[i][3].x, ac[i][3].y);
                        *(LAS u32x4*)(xcb + (4 * run + i) * RN_XS + cg8 * 16) = w; }
                }
                if (step < 16) { const int tn = 256 * (dir == 0 ? step : 15 - step);
                    if (tn >= 2 && tn + 258 <= SEQ) {
                        const bf16_t* rp = srcL + (size_t)(tn + 4 * run - 2) * LDZ;
#pragma unroll
                        for (int q = 0; q < 7; ++q) xr[q] = *(const u32x4*)(rp + (size_t)q * LDZ);
                    } else {
#pragma unroll
                        for (int q = 0; q < 7; ++q) { const int ts = tn + 4 * run - 2 + q; xr[q] = (ts >= 0 && ts < SEQ) ? *(const u32x4*)(srcL + (size_t)ts * LDZ) : (u32x4){0u, 0u, 0u, 0u}; } } }
                u32x4 hfr[2], ygr[2];
                const size_t tb = (size_t)b * SEQ + t0;
                if (!isctx && dir == 1) {
#pragma unroll
                    for (int i = 0; i < 2; ++i) { const int pl = lane + 64 * i, tk = 32 * wave + (pl >> 2), part = pl & 3;
                        hfr[i] = *(const u32x4*)(HF + (tb + tk) * DM + ch0 + 8 * part); ygr[i] = *(const u32x4*)(Z + (tb + tk) * LDZ + ZC_YG + ch0 + 8 * part); } }
                f32x16 ar, ai;
#pragma unroll
                for (int j = 0; j < 16; ++j) { ar[j] = 0.f; ai[j] = 0.f; }
                const LAS unsigned char* arow = xcb + (32 * wave + taur) * RN_XS + 16 * hh;
#pragma unroll
                for (int s4 = 0; s4 < 4; ++s4) { const bf16x8 af = *(const LAS bf16x8*)(arow + 32 * s4);
                    const bf16x8 bw0 = *(const LAS bf16x8*)(wtb + c * RN_XS + (16 * s4 + 8 * hh) * 2), bw1 = *(const LAS bf16x8*)(wtb + (32 + c) * RN_XS + (16 * s4 + 8 * hh) * 2);
                    ar = __builtin_amdgcn_mfma_f32_32x32x16_bf16(af, bw0, ar, 0, 0, 0);
                    ai = __builtin_amdgcn_mfma_f32_32x32x16_bf16(af, bw1, ai, 0, 0, 0); }
                const LAS unsigned char* xcol = xcb + (32 * wave + 16 * hh) * RN_XS + (32 * half + c) * 2;
#pragma unroll
                for (int j = 0; j < 16; ++j) {
                    const float r = __builtin_amdgcn_rcpf(1.0f + __builtin_amdgcn_exp2f(__builtin_fmaf(ar[j], -LOG2E, nbaL))), ig = __builtin_amdgcn_rcpf(1.0f + __builtin_amdgcn_exp2f(__builtin_fmaf(ai[j], -LOG2E, nbiL)));
                    const float a = __builtin_amdgcn_exp2f(r * clam);
                    const float om = __builtin_fmaf(-a, a, 1.0f);
                    const float xv = bf2f(*(const LAS bf16_t*)(xcol + j * RN_XS));
                    ar[j] = a; ai[j] = __builtin_amdgcn_sqrtf(om) * ig * xv;
                }
                float P = 1.f, H = 0.f;
                if (dir == 0) {
#pragma unroll
                    for (int j = 0; j < 16; ++j) { H = ar[j] * H + ai[j]; P *= ar[j]; }
                } else {
#pragma unroll
                    for (int j = 15; j >= 0; --j) { H = ar[j] * H + ai[j]; P *= ar[j]; }
                }
                const int s = 2 * wave + hh;
                LAS float* segA = seg0 + (step & 1) * 1280; LAS float* segB = segA + 640;
                segA[c * 20 + s] = P; segB[c * 20 + s] = H;
                __syncthreads();
                float h = hc, hin;
                {   f32x4 sa[4], sb[4];
#pragma unroll
                    for (int q4 = 0; q4 < 4; ++q4) { sa[q4] = *(const LAS f32x4*)(segA + c * 20 + 4 * q4); sb[q4] = *(const LAS f32x4*)(segB + c * 20 + 4 * q4); }
                    float h0v = 0.f, h1v = 0.f;
                    if (dir == 0) {
#pragma unroll
                        for (int q = 0; q < 16; ++q) { if (q == 2 * wave) h0v = h; if (q == 2 * wave + 1) h1v = h; h = sa[q >> 2][q & 3] * h + sb[q >> 2][q & 3]; } }
                    else {
#pragma unroll
                        for (int q = 15; q >= 0; --q) { if (q == 2 * wave) h0v = h; if (q == 2 * wave + 1) h1v = h; h = sa[q >> 2][q & 3] * h + sb[q >> 2][q & 3]; } }
                    hin = hh ? h1v : h0v;
                }
                hc = h;
                if (!isctx) {
                    LAS float* sp0 = (LAS float*)(stg + (32 * wave + 16 * hh) * RN_XS) + c;
                    h = hin;
                    if (dir == 0) {
#pragma unroll
                        for (int j = 0; j < 16; ++j) { h = ar[j] * h + ai[j]; sp0[j * (RN_XS / 4)] = h; }
                    } else {
#pragma unroll
                        for (int j = 15; j >= 0; --j) { h = ar[j] * h + ai[j]; sp0[j * (RN_XS / 4)] = h; }
                    }
#pragma unroll
                    for (int i = 0; i < 2; ++i) { const int pl = lane + 64 * i, tk = 32 * wave + (pl >> 2), part = pl & 3;
                        const LAS f32x4* sr = (const LAS f32x4*)(stg + tk * RN_XS + part * 32);
                        f32x4 h0 = sr[0], h1 = sr[1];
                        if (dir == 1) {
                            const u32x4 f = hfr[i], y = ygr[i];
                            h0 = (h0 + (f32x4){bf2f(f.x & 0xffffu), bf2f(f.x >> 16), bf2f(f.y & 0xffffu), bf2f(f.y >> 16)}) * (f32x4){bf2f(y.x & 0xffffu), bf2f(y.x >> 16), bf2f(y.y & 0xffffu), bf2f(y.y >> 16)};
                            h1 = (h1 + (f32x4){bf2f(f.z & 0xffffu), bf2f(f.z >> 16), bf2f(f.w & 0xffffu), bf2f(f.w >> 16)}) * (f32x4){bf2f(y.z & 0xffffu), bf2f(y.z >> 16), bf2f(y.w & 0xffffu), bf2f(y.w >> 16)};
                        }
                        u32x4 w; w.x = cvt_pk_bf16(h0[0], h0[1]); w.y = cvt_pk_bf16(h0[2], h0[3]); w.z = cvt_pk_bf16(h1[0], h1[1]); w.w = cvt_pk_bf16(h1[2], h1[3]);
                        if (!dry) { if (dir == 0) *(u32x4*)(HF + (tb + tk) * DM + ch0 + 8 * part) = w; else *(u32x4*)(Z + (tb + tk) * LDZ + ZC_YG + ch0 + 8 * part) = w; }
                    }
                }
            }
        }
    }
}

constexpr int AT_SLOT = 16384, AT_NS = 4, AT_BIAS = AT_NS * AT_SLOT;
__device__ __forceinline__ void glds16(const void* gsrc, unsigned lds_dst) { unsigned keep;
    asm volatile("s_mov_b32 %0, m0\n\ts_mov_b32 m0, %2\n\ts_nop 0\n\tglobal_load_lds_dwordx4 %1, off\n\ts_mov_b32 m0, %0" : "=&s"(keep) : "v"(gsrc), "s"(lds_dst) : "memory"); }
typedef short s16x4 __attribute__((ext_vector_type(4)));
struct QBlk { bf16x8 q[2]; f32x4 o[4]; float l; };
template <bool LOCAL, bool DOA, bool DOB>
__device__ __forceinline__ void attn_proc32(QBlk& A, QBlk& B, const LAS unsigned char* Kc, int kc0, const int (&koff)[2][2], const int (&voff)[4][2], const int (&cidx)[8], const LAS unsigned char* browA, const LAS unsigned char* browB) {
    const LAS unsigned char* Kb = Kc + kc0 * 128; const LAS unsigned char* Vb = Kc + 8192 + kc0 * 128;
    f32x4 a0 = (f32x4){0.f, 0.f, 0.f, 0.f}, a1 = a0, b0 = a0, b1 = a0;
#pragma unroll
    for (int ks = 0; ks < 2; ++ks) {
        const bf16x8 k0 = *(const LAS bf16x8*)(Kb + koff[0][ks]);
        const bf16x8 k1 = *(const LAS bf16x8*)(Kb + koff[1][ks]);
        if (DOA) { a0 = __builtin_amdgcn_mfma_f32_16x16x32_bf16(k0, A.q[ks], a0, 0, 0, 0); a1 = __builtin_amdgcn_mfma_f32_16x16x32_bf16(k1, A.q[ks], a1, 0, 0, 0); }
        if (DOB) { b0 = __builtin_amdgcn_mfma_f32_16x16x32_bf16(k0, B.q[ks], b0, 0, 0, 0); b1 = __builtin_amdgcn_mfma_f32_16x16x32_bf16(k1, B.q[ks], b1, 0, 0, 0); }
    }
    if (LOCAL) {
#pragma unroll
        for (int r = 0; r < 4; ++r) {
            if (DOA) { a0[r] += *(const LAS float*)(browA + cidx[r]); a1[r] += *(const LAS float*)(browA + cidx[4 + r]); }
            if (DOB) { b0[r] += *(const LAS float*)(browB + cidx[r]); b1[r] += *(const LAS float*)(browB + cidx[4 + r]); }
        }
    }
    float psA = 0.f, psB = 0.f;
#pragma unroll
    for (int r = 0; r < 4; ++r) {
        if (DOA) { a0[r] = __builtin_amdgcn_exp2f(a0[r]); a1[r] = __builtin_amdgcn_exp2f(a1[r]); psA += a0[r] + a1[r]; }
        if (DOB) { b0[r] = __builtin_amdgcn_exp2f(b0[r]); b1[r] = __builtin_amdgcn_exp2f(b1[r]); psB += b0[r] + b1[r]; }
    }
    bf16x8 pA, pB;
    if (DOA) { A.l += psA; const u32x4 w = (u32x4){cvt_pk_bf16(a0[0], a0[1]), cvt_pk_bf16(a0[2], a0[3]), cvt_pk_bf16(a1[0], a1[1]), cvt_pk_bf16(a1[2], a1[3])}; pA = __builtin_bit_cast(bf16x8, w); }
    if (DOB) { B.l += psB; const u32x4 w = (u32x4){cvt_pk_bf16(b0[0], b0[1]), cvt_pk_bf16(b0[2], b0[3]), cvt_pk_bf16(b1[0], b1[1]), cvt_pk_bf16(b1[2], b1[3])}; pB = __builtin_bit_cast(bf16x8, w); }
#pragma unroll
    for (int dt = 0; dt < 4; ++dt) {
        const s16x4 lo4 = __builtin_bit_cast(s16x4, __builtin_amdgcn_ds_read_tr16_b64_v4i16((LAS s16x4*)(Vb + voff[dt][0])));
        const s16x4 hi4 = __builtin_bit_cast(s16x4, __builtin_amdgcn_ds_read_tr16_b64_v4i16((LAS s16x4*)(Vb + voff[dt][1])));
        const bf16x8 av = (bf16x8){lo4[0], lo4[1], lo4[2], lo4[3], hi4[0], hi4[1], hi4[2], hi4[3]};
        if (DOA) A.o[dt] = __builtin_amdgcn_mfma_f32_16x16x32_bf16(av, pA, A.o[dt], 0, 0, 0);
        if (DOB) B.o[dt] = __builtin_amdgcn_mfma_f32_16x16x32_bf16(av, pB, B.o[dt], 0, 0, 0);
    }
}
__device__ __forceinline__ void phase_attn(const Params& p, LAS unsigned char* lds, const bool dry) {
    const int tid = threadIdx.x, lane = tid & 63, wave = __builtin_amdgcn_readfirstlane(tid >> 6), G = gridDim.x;
    unsigned char* ws = p.ws;
    bf16_t* Z = (bf16_t*)(ws + WS_Z); const bf16_t* ZCb = (const bf16_t*)(ws + WS_ZC);
    LAS float* btab = (LAS float*)(lds + AT_BIAS);
    const int j = wave & 3, c16 = lane & 15, fq = lane >> 4;
    const int cq = 16 * j + c16, cst = min(max(cq - 8, 0), 48), kst = min(max(16 * j - 8, 0), 32);
    const int lo = cst - kst - 4 * fq;
    const int dc0 = kst + 4 * fq - cq + 15;
    int cidx[8];
#pragma unroll
    for (int q = 0; q < 8; ++q) { const int li = 16 * (q >> 2) + (q & 3); cidx[q] = 4 * ((li >= lo && li < lo + 16) ? min(max(dc0 + li, 0), 30) : 31); }
    int koff[2][2], voff[4][2];
    { const int i = lane & 15, kq = lane >> 4, jj = (lane & 15) >> 2, q = lane & 3, vr = 4 * kq + jj;
#pragma unroll
      for (int t = 0; t < 2; ++t)
#pragma unroll
          for (int ks = 0; ks < 2; ++ks) koff[t][ks] = (16 * t + i) * 128 + (((4 * ks + kq) ^ (i & 7)) << 4);
#pragma unroll
      for (int dt = 0; dt < 4; ++dt)
#pragma unroll
          for (int t = 0; t < 2; ++t) voff[dt][t] = (16 * t + vr) * 128 + (((2 * dt + (q >> 1)) ^ (vr & 7)) << 4) + 8 * (q & 1); }
    const int drow = 8 * wave + (lane >> 3), dpc = (lane & 7) ^ (lane >> 3);
    const unsigned lds0 = (unsigned)(uintptr_t)lds;
    for (int u = blockIdx.x; u < NB * 16 * 16; u += G) {
        const int b = u >> 8, h = (u >> 4) & 15, r0 = 4 * (u & 15);
        const int kr_lo = min(max(r0 - 4, 0), 56), kr_hi = min(max(r0 - 1, 0), 56) + 7, nloc = kr_hi - kr_lo + 1, nch = nloc + 4;
        const int rA = r0 + (wave >> 2), rB = rA + 2, rsA = min(max(rA - 4, 0), 56), rsB = min(max(rB - 4, 0), 56);
        bf16_t* qA = Z + ((size_t)b * SEQ + rA * 64 + cq) * LDZ + ZC_Q + h * 64;
        bf16_t* qB = Z + ((size_t)b * SEQ + rB * 64 + cq) * LDZ + ZC_Q + h * 64;
        QBlk A, Bq;
#pragma unroll
        for (int ks = 0; ks < 2; ++ks) { A.q[ks] = *(const bf16x8*)(qA + ks * 32 + fq * 8); Bq.q[ks] = *(const bf16x8*)(qB + ks * 32 + fq * 8); }
#pragma unroll
        for (int dt = 0; dt < 4; ++dt) { A.o[dt] = (f32x4){0.f, 0.f, 0.f, 0.f}; Bq.o[dt] = (f32x4){0.f, 0.f, 0.f, 0.f}; }
        A.l = 0.f; Bq.l = 0.f;
        if (u == (int)blockIdx.x) { for (int e = tid; e < 15 * 32; e += NTHREADS) btab[e] = ((e & 31) < 31) ? p.na_rpb[(size_t)h * 465 + (e >> 5) * 31 + (e & 31)] * LOG2E : -1e30f; }
        asm volatile("" :: "v"(A.q[0]), "v"(A.q[1]), "v"(Bq.q[0]), "v"(Bq.q[1]));
        const bf16_t* kbase = Z + ((size_t)b * SEQ + drow) * LDZ + ZC_K + h * 64 + dpc * 8;
        const bf16_t* cbase = ZCb + ((size_t)b * CTX + drow) * LDC + CC_K + h * 64 + dpc * 8;
#define AT_DMA(c_) do { const int c__ = (c_); const unsigned d_ = (unsigned)__builtin_amdgcn_readfirstlane((int)(lds0 + (unsigned)((c__ & (AT_NS - 1)) * AT_SLOT + wave * 1024))); \
            if (c__ < nloc) { const bf16_t* s_ = kbase + (size_t)(kr_lo + c__) * 64 * LDZ; glds16(s_, d_); glds16(s_ + (ZC_V - ZC_K), d_ + 8192u); } \
            else { const bf16_t* s_ = cbase + (size_t)(c__ - nloc) * 64 * LDC; glds16(s_, d_); glds16(s_ + (CC_V - CC_K), d_ + 8192u); } } while (0)
        AT_DMA(0); AT_DMA(1); AT_DMA(2);
        asm volatile("s_waitcnt vmcnt(4) lgkmcnt(0)" ::: "memory"); __builtin_amdgcn_s_barrier(); asm volatile("" ::: "memory");
        for (int c = 0; c < nch; ++c) {
            if (c + 3 < nch) AT_DMA(c + 3);
            { const int nrem = min(nch - 1, c + 3) - (c + 1);
              if (nrem >= 2) asm volatile("s_waitcnt vmcnt(4)" ::: "memory"); else if (nrem == 1) asm volatile("s_waitcnt vmcnt(2)" ::: "memory"); else asm volatile("s_waitcnt vmcnt(0)" ::: "memory"); }
            const LAS unsigned char* Kc = lds + (c & (AT_NS - 1)) * AT_SLOT;
            if (c < nloc) {
                const int kr = kr_lo + c;
                const bool vA = (kr >= rsA && kr < rsA + 8), vB = (kr >= rsB && kr < rsB + 8);
                const LAS unsigned char* bA = (const LAS unsigned char*)btab + min(max(kr - rA + 7, 0), 14) * 128; const LAS unsigned char* bB = (const LAS unsigned char*)btab + min(max(kr - rB + 7, 0), 14) * 128;
                if (vA && vB) attn_proc32<true, true, true>(A, Bq, Kc, kst, koff, voff, cidx, bA, bB);
                else if (vA) attn_proc32<true, true, false>(A, Bq, Kc, kst, koff, voff, cidx, bA, bB);
                else if (vB) attn_proc32<true, false, true>(A, Bq, Kc, kst, koff, voff, cidx, bA, bB);
            } else {
                attn_proc32<false, true, true>(A, Bq, Kc, 0, koff, voff, cidx, (const LAS unsigned char*)btab, (const LAS unsigned char*)btab);
                attn_proc32<false, true, true>(A, Bq, Kc, 32, koff, voff, cidx, (const LAS unsigned char*)btab, (const LAS unsigned char*)btab);
            }
            asm volatile("s_waitcnt lgkmcnt(0)" ::: "memory"); __builtin_amdgcn_s_barrier(); asm volatile("" ::: "memory");
        }
#undef AT_DMA
        {
            float l = A.l; l += __shfl_xor(l, 16); l += __shfl_xor(l, 32); const float il = 1.0f / l;
#pragma unroll
            for (int dt = 0; dt < 4; ++dt) { const f32x4 o = A.o[dt] * il; u32x2 w; w.x = cvt_pk_bf16(o[0], o[1]); w.y = cvt_pk_bf16(o[2], o[3]); if (!dry) *(u32x2*)(qA + dt * 16 + fq * 4) = w; }
            l = Bq.l; l += __shfl_xor(l, 16); l += __shfl_xor(l, 32); const float il2 = 1.0f / l;
#pragma unroll
            for (int dt = 0; dt < 4; ++dt) { const f32x4 o = Bq.o[dt] * il2; u32x2 w; w.x = cvt_pk_bf16(o[0], o[1]); w.y = cvt_pk_bf16(o[2], o[3]); if (!dry) *(u32x2*)(qB + dt * 16 + fq * 4) = w; }
        }
    }
}

constexpr int N2_WRP = 0, N2_CP = 65536, N2_CV = N2_CP + 2048, N2_RS = N2_CV + 64;
__device__ __forceinline__ void phase_norm2(const Params& p, LAS unsigned char* lds) {
    const int tid = threadIdx.x, lane = tid & 63, wave = __builtin_amdgcn_readfirstlane(tid >> 6), G = gridDim.x;
    unsigned char* ws = p.ws;
    const float* MOD = (const float*)(ws + WS_MOD); unsigned char* XN2 = ws + WS_XN2; float* AFF = (float*)(ws + WS_AFF);
    const bf16_t* X1 = (const bf16_t*)(ws + WS_X1);
    LAS float* wrp = (LAS float*)(lds + N2_WRP); LAS float* cpart = (LAS float*)(lds + N2_CP); LAS float* cvec = (LAS float*)(lds + N2_CV); LAS float* rsw = (LAS float*)(lds + N2_RS) + wave * 16;
    const int r16 = lane & 15, kq = lane >> 4;
    int bcur = -1; f32x4 shv[4], scv[4];
    for (int blk = blockIdx.x; blk < MLAT / 128; blk += G) {
        const int b = blk >> 5;
        if (b != bcur) { bcur = b;
            const float* sh2 = MOD + (size_t)b * 6144 + 3072; const float* sc2 = MOD + (size_t)b * 6144 + 4096;
            __syncthreads();
            for (int e = tid; e < 16 * 1024; e += NTHREADS) wrp[e] = (1.0f + sc2[e >> 4]) * p.w_router[e];
            { const int e = tid & 15, part = tid >> 4; float a = 0.f;
              for (int i = 0; i < 32; ++i) { const int k = part + 32 * i; a += sh2[k] * p.w_router[k * 16 + e]; }
              cpart[part * 16 + e] = a; }
#pragma unroll
            for (int j = 0; j < 4; ++j) { shv[j] = *(const f32x4*)(sh2 + 4 * lane + 256 * j); scv[j] = *(const f32x4*)(sc2 + 4 * lane + 256 * j) + 1.0f; }
            __syncthreads();
            if (tid < 16) { float a = 0.f; for (int q = 0; q < 32; ++q) a += cpart[q * 16 + tid]; cvec[tid] = a; }
            __syncthreads();
        }
        const int row0 = blk * 128 + wave * 16;
        f32x4 acc = (f32x4){0.f, 0.f, 0.f, 0.f}; float ss = 0.f;
        const u32x2* xp = (const u32x2*)(X1 + (size_t)(row0 + r16) * DM + 4 * kq);
        const LAS float* wp = wrp + (4 * kq) * 16 + r16;
        u32x2 xa[8], xb[8];
#pragma unroll
        for (int u = 0; u < 8; ++u) xa[u] = xp[4 * u];
#pragma unroll 1
        for (int t0 = 0; t0 < 64; t0 += 16) {
#pragma unroll
            for (int u = 0; u < 8; ++u) xb[u] = xp[4 * (t0 + 8 + u)];
#pragma unroll
            for (int u = 0; u < 8; ++u) { const float x0 = bf2f(xa[u].x & 0xffffu), x1v = bf2f(xa[u].x >> 16), x2 = bf2f(xa[u].y & 0xffffu), x3 = bf2f(xa[u].y >> 16);
                ss += (x0 * x0 + x1v * x1v) + (x2 * x2 + x3 * x3);
                const LAS float* w = wp + (t0 + u) * 256;
                acc = __builtin_amdgcn_mfma_f32_16x16x4f32(x0, w[0], acc, 0, 0, 0); acc = __builtin_amdgcn_mfma_f32_16x16x4f32(x1v, w[16], acc, 0, 0, 0);
                acc = __builtin_amdgcn_mfma_f32_16x16x4f32(x2, w[32], acc, 0, 0, 0); acc = __builtin_amdgcn_mfma_f32_16x16x4f32(x3, w[48], acc, 0, 0, 0); }
            if (t0 + 16 < 64) {
#pragma unroll
                for (int u = 0; u < 8; ++u) xa[u] = xp[4 * (t0 + 16 + u)]; }
#pragma unroll
            for (int u = 0; u < 8; ++u) { const float x0 = bf2f(xb[u].x & 0xffffu), x1v = bf2f(xb[u].x >> 16), x2 = bf2f(xb[u].y & 0xffffu), x3 = bf2f(xb[u].y >> 16);
                ss += (x0 * x0 + x1v * x1v) + (x2 * x2 + x3 * x3);
                const LAS float* w = wp + (t0 + 8 + u) * 256;
                acc = __builtin_amdgcn_mfma_f32_16x16x4f32(x0, w[0], acc, 0, 0, 0); acc = __builtin_amdgcn_mfma_f32_16x16x4f32(x1v, w[16], acc, 0, 0, 0);
                acc = __builtin_amdgcn_mfma_f32_16x16x4f32(x2, w[32], acc, 0, 0, 0); acc = __builtin_amdgcn_mfma_f32_16x16x4f32(x3, w[48], acc, 0, 0, 0); }
        }
        ss += __shfl_xor(ss, 16); ss += __shfl_xor(ss, 32);
        const float rs = 1.0f / sqrtf(ss * (1.0f / DM) + 1e-6f);
        if (lane < 16) rsw[lane] = rs;
        LDS_WAIT(); asm volatile("" ::: "memory");
        { const float cv = cvec[r16]; float lg[4], mx[4], ex[4], sm[4];
#pragma unroll
          for (int q = 0; q < 4; ++q) { lg[q] = rsw[4 * kq + q] * acc[q] + cv; mx[q] = lg[q]; }
#pragma unroll
          for (int o = 1; o < 16; o <<= 1)
#pragma unroll
              for (int q = 0; q < 4; ++q) mx[q] = fmaxf(mx[q], __shfl_xor(mx[q], o));
#pragma unroll
          for (int q = 0; q < 4; ++q) { ex[q] = expf(lg[q] - mx[q]); sm[q] = ex[q]; }
#pragma unroll
          for (int o = 1; o < 16; o <<= 1)
#pragma unroll
              for (int q = 0; q < 4; ++q) sm[q] += __shfl_xor(sm[q], o);
#pragma unroll
          for (int q = 0; q < 4; ++q) AFF[(size_t)(row0 + 4 * kq + q) * 16 + r16] = ex[q] / sm[q]; }
        u32x2 nx[4], ny[4];
        { const u32x2* xr = (const u32x2*)(X1 + (size_t)row0 * DM) + lane;
#pragma unroll
          for (int j = 0; j < 4; ++j) { nx[j] = xr[64 * j]; ny[j] = xr[64 * j + 256]; } }
        for (int q = 0; q < 16; ++q) {
            const float rq = rsw[q];
            f32x4 v[4];
#pragma unroll
            for (int j = 0; j < 4; ++j) { v[j] = (f32x4){bf2f(nx[j].x & 0xffffu), bf2f(nx[j].x >> 16), bf2f(nx[j].y & 0xffffu), bf2f(nx[j].y >> 16)}; nx[j] = ny[j]; }
            if (q + 2 < 16) { const u32x2* xr = (const u32x2*)(X1 + (size_t)(row0 + q + 2) * DM) + lane;
#pragma unroll
                for (int j = 0; j < 4; ++j) ny[j] = xr[64 * j]; }
            unsigned* o4 = (unsigned*)(XN2 + (size_t)(row0 + q) * DM) + lane;
#pragma unroll
            for (int j = 0; j < 4; ++j) { v[j] = v[j] * rq * scv[j] + shv[j]; o4[64 * j] = pk4_fp8(v[j].x, v[j].y, v[j].z, v[j].w); }
        }
    }
}

__device__ __forceinline__ void phase_topk(const Params& p, LAS unsigned char* lds) {
    const int tid = threadIdx.x, lane = tid & 63, wave = tid >> 6, G = gridDim.x;
    unsigned char* ws = p.ws;
    const float* AFF = (const float*)(ws + WS_AFF); int* SELIDX = (int*)(ws + WS_SELIDX); float* SELG = (float*)(ws + WS_SELG); int* SLOT = (int*)(ws + WS_SLOT);
    LAS unsigned* hist = (LAS unsigned*)lds;
    LAS unsigned* ctl = hist + 256;
    LAS unsigned* wtot = hist + 264;
    for (int it = blockIdx.x; it < NB * NEXP; it += G) {
        const int b = it >> 4, e = it & 15;
        unsigned v[8];
#pragma unroll
        for (int j = 0; j < 8; ++j) v[j] = __builtin_bit_cast(unsigned, AFF[((size_t)b * SEQ + tid * 8 + j) * 16 + e]);
        unsigned prefix = 0u, mask = 0u, need = CAP;
        for (int shift = 24; shift >= 0; shift -= 8) {
            __syncthreads();
            if (tid < 256) hist[tid] = 0u;
            __syncthreads();
#pragma unroll
            for (int j = 0; j < 8; ++j) if ((v[j] & mask) == prefix) atomicAdd((unsigned*)&hist[(v[j] >> shift) & 255u], 1u);
            __syncthreads();
            if (tid < 64) {
                unsigned cb[4], tot = 0u;
#pragma unroll
                for (int k = 0; k < 4; ++k) { cb[k] = hist[255 - 4 * lane - k]; tot += cb[k]; }
                unsigned inc = tot;
#pragma unroll
                for (int o = 1; o < 64; o <<= 1) { const unsigned a = __shfl_up(inc, o); if (lane >= o) inc += a; }
                unsigned cum = inc - tot;
#pragma unroll
                for (int k = 0; k < 4; ++k) { if (cum < need && need <= cum + cb[k]) { ctl[0] = (unsigned)(255 - 4 * lane - k); ctl[1] = need - cum; } cum += cb[k]; }
            }
            __syncthreads();
            prefix |= ctl[0] << shift; mask |= 255u << shift; need = ctl[1];
        }
        unsigned ngt = 0u, neq = 0u;
#pragma unroll
        for (int j = 0; j < 8; ++j) { ngt += (v[j] > prefix) ? 1u : 0u; neq += (v[j] == prefix) ? 1u : 0u; }
        unsigned sg = ngt, se = neq;
#pragma unroll
        for (int o = 1; o < 64; o <<= 1) { const unsigned a = __shfl_up(sg, o), c2 = __shfl_up(se, o); if (lane >= o) { sg += a; se += c2; } }
        __syncthreads();
        if (lane == 63) { wtot[wave] = sg; wtot[8 + wave] = se; }
        __syncthreads();
        unsigned og = sg - ngt, oe = se - neq, totg = 0u;
        for (int w = 0; w < 8; ++w) { const unsigned a = wtot[w], c2 = wtot[8 + w]; if (w < wave) { og += a; oe += c2; } totg += a; }
#pragma unroll
        for (int j = 0; j < 8; ++j) {
            const int tkn = tid * 8 + j; int slot = -1;
            if (v[j] > prefix) slot = (int)og++;
            else if (v[j] == prefix) { if (oe < need) slot = (int)(totg + oe); ++oe; }
            const int erow = b * CAP + slot;
            SLOT[((size_t)b * SEQ + tkn) * 16 + e] = (slot >= 0) ? erow : -1;
            if (slot >= 0) { SELIDX[e * EROWS + erow] = b * SEQ + tkn; SELG[e * EROWS + erow] = __builtin_bit_cast(float, v[j]); }
        }
    }
    __syncthreads();
    {
        LAS float* scr = (LAS float*)(lds + wave * TR_SCR);
        unsigned char* WGU = ws + WS_WGU; unsigned char* WD = ws + WS_WD;
        const int gw = blockIdx.x * NWAVES + wave, NGW = G * NWAVES;
        constexpr int I_G = 16 * 32, I_D = 32 * 16, NIT = 16 * (2 * I_G + I_D);
        auto decode = [&](int it, TrItem& t) {
            const int e = it / (2 * I_G + I_D); int r = it % (2 * I_G + I_D);
            if (r < 2 * I_G) { const int up = r / I_G; r %= I_G; const int kb = r / 32, nb = r % 32;
                t.src = (up ? p.w_exp_up : p.w_exp_gate) + (size_t)e * 1024 * 2048 + (size_t)(64 * kb) * 2048 + 64 * nb; t.ldw = 2048;
                t.dst = WGU + (size_t)e * 4096 * 1024 + 64 * kb; t.ldk = 1024; t.n0 = 64 * nb; t.up = up; }
            else { r -= 2 * I_G; const int kb = r / 16, nb = r % 16;
                t.src = p.w_exp_down + (size_t)e * 2048 * 1024 + (size_t)(64 * kb) * 1024 + 64 * nb; t.ldw = 1024;
                t.dst = WD + (size_t)e * 1024 * 2048 + 64 * kb; t.ldk = 2048; t.n0 = 64 * nb; t.up = -1; }
        };
        constexpr int TR_EXTRA = 3;
        const int NT = min(G, NB * NEXP), NQ = (G - NT) * NWAVES, wq = ((int)blockIdx.x - NT) * NWAVES + wave, nx0 = NQ > 0 ? TR_EXTRA : 0;
        auto nth = [&](int n) -> int { return wq >= 0 ? (n < nx0 ? n * NQ + wq : nx0 * NQ + gw + (n - nx0) * NGW) : nx0 * NQ + gw + n * NGW; };
        TrItem ta, tb; f32x4 va[16], vb[16];
        int n = 0, it = nth(0);
        if (it < NIT) { decode(it, ta); tr_load(ta, lane, va); }
        while (it < NIT) {
            int itn = nth(n + 1);
            decode(itn < NIT ? itn : it, tb); tr_load(tb, lane, vb);
            tr_store_f8(ta, va, scr, lane);
            ++n; it = itn; if (it >= NIT) break;
            itn = nth(n + 1);
            decode(itn < NIT ? itn : it, ta); tr_load(ta, lane, va);
            tr_store_f8(tb, vb, scr, lane);
            ++n; it = itn;
        }
    }
}

__device__ __forceinline__ void phase_final(const Params& p, LAS unsigned char* lds, const bool dry) {
    const int tid = threadIdx.x, lane = tid & 63, wave = tid >> 6, G = gridDim.x;
    unsigned char* ws = p.ws;
    const float* MOD = (const float*)(ws + WS_MOD); const int* SLOT = (const int*)(ws + WS_SLOT); const unsigned char* YE = ws + WS_YE; const float* AFF = (const float*)(ws + WS_AFF);
    const bf16_t* X1 = (const bf16_t*)(ws + WS_X1);
    const int gw = blockIdx.x * NWAVES + wave, NGW = G * NWAVES;
    const int per = (MLAT + NGW - 1) / NGW, r_lo = gw * per, r_hi = min(r_lo + per, MLAT);
    if (r_lo >= r_hi) return;
    f32x4 g2v[4], fnv[4]; int bcur = -1;
#pragma unroll
    for (int j = 0; j < 4; ++j) fnv[j] = *(const f32x4*)(p.final_norm + 4 * lane + 256 * j);
    u32x2 nx[2][4]; int nslot[2]; float ngate[2];
#define FN_PREFETCH(r_) do { _Pragma("unroll") for (int t = 0; t < 2; ++t) { const int rr = min((r_) + t, r_hi - 1); \
        const u32x2* xr_ = (const u32x2*)(X1 + (size_t)rr * DM) + lane; _Pragma("unroll") for (int j = 0; j < 4; ++j) nx[t][j] = xr_[64 * j]; \
        nslot[t] = SLOT[(size_t)rr * 16 + (lane & 15)]; ngate[t] = AFF[(size_t)rr * 16 + (lane & 15)]; } } while (0)
    FN_PREFETCH(r_lo);
    for (int row = r_lo; row < r_hi; row += 2) {
        const int b = row >> 12;
        if (b != bcur) { bcur = b;
#pragma unroll
            for (int j = 0; j < 4; ++j) g2v[j] = *(const f32x4*)(MOD + (size_t)b * 6144 + 5120 + 4 * lane + 256 * j); }
        u32x2 cx[2][4]; int myslot[2]; float mygate[2]; unsigned long long live[2]; unsigned yv[2][4][4]; float gt[2][4];
#pragma unroll
        for (int t = 0; t < 2; ++t) { myslot[t] = lane < 16 ? nslot[t] : -1; mygate[t] = ngate[t]; live[t] = __ballot(myslot[t] >= 0);
#pragma unroll
            for (int j = 0; j < 4; ++j) cx[t][j] = nx[t][j]; }
#pragma unroll
        for (int t = 0; t < 2; ++t)
#pragma unroll
            for (int q = 0; q < 4; ++q) {
                const bool on = live[t] != 0ull; const int e = on ? __builtin_ctzll(live[t]) : 0; live[t] &= live[t] - 1ull;
                const int sl = __shfl(myslot[t], e); gt[t][q] = on ? __shfl(mygate[t], e) : 0.f;
                const unsigned* yp = (const unsigned*)(YE + ((size_t)e * EROWS + (on ? sl : 0)) * DM) + lane;
                if (on) {
#pragma unroll
                    for (int j = 0; j < 4; ++j) yv[t][q][j] = yp[64 * j];
                } else {
#pragma unroll
                    for (int j = 0; j < 4; ++j) yv[t][q][j] = 0u;
                }
            }
        FN_PREFETCH(row + 2);
#pragma unroll
        for (int t = 0; t < 2; ++t) {
            if (row + t >= r_hi) break;
            f32x4 v[4], mo[4];
#pragma unroll
            for (int j = 0; j < 4; ++j) { v[j] = (f32x4){bf2f(cx[t][j].x & 0xffffu), bf2f(cx[t][j].x >> 16), bf2f(cx[t][j].y & 0xffffu), bf2f(cx[t][j].y >> 16)}; mo[j] = (f32x4){0.f, 0.f, 0.f, 0.f}; }
#pragma unroll
            for (int q = 0; q < 4; ++q)
#pragma unroll
                for (int j = 0; j < 4; ++j) { const f32x2 lo = __builtin_amdgcn_cvt_pk_f32_fp8((int)yv[t][q][j], false), hi = __builtin_amdgcn_cvt_pk_f32_fp8((int)yv[t][q][j], true);
                    mo[j].x += gt[t][q] * lo.x; mo[j].y += gt[t][q] * lo.y; mo[j].z += gt[t][q] * hi.x; mo[j].w += gt[t][q] * hi.y; }
            while (live[t]) {
                const int e = __builtin_ctzll(live[t]); live[t] &= live[t] - 1ull;
                const int sl = __shfl(myslot[t], e); const float g1 = __shfl(mygate[t], e);
                const unsigned* yp = (const unsigned*)(YE + ((size_t)e * EROWS + sl) * DM) + lane;
#pragma unroll
                for (int j = 0; j < 4; ++j) { const int w = (int)yp[64 * j]; const f32x2 lo = __builtin_amdgcn_cvt_pk_f32_fp8(w, false), hi = __builtin_amdgcn_cvt_pk_f32_fp8(w, true);
                    mo[j].x += g1 * lo.x; mo[j].y += g1 * lo.y; mo[j].z += g1 * hi.x; mo[j].w += g1 * hi.y; }
            }
            float ss = 0.f;
#pragma unroll
            for (int j = 0; j < 4; ++j) { v[j] = v[j] + g2v[j] * mo[j]; ss += (v[j].x * v[j].x + v[j].y * v[j].y) + (v[j].z * v[j].z + v[j].w * v[j].w); }
            const float rs = 1.0f / sqrtf(wave_sum(ss) * (1.0f / DM) + 1e-6f);
            f32x4* xo = (f32x4*)(p.out + (size_t)(row + t) * DM) + lane;
#pragma unroll
            for (int j = 0; j < 4; ++j) { if (!dry) xo[64 * j] = v[j] * rs * fnv[j]; }
        }
    }
#undef FN_PREFETCH
}

#define XB_TMO      128
#define XB_XCNT(j)  (256  + 64 * (j))
#define XB_XSUB(j)  (1280 + 64 * (j))
#define XB_XGEN(j)  (2304 + 64 * (j))
#define XB_TOP      3328
#define XB_TOPGEN   3392
#define XCD_BAR_WORDS 3456
#define XB_SPIN_CAP (1u << 20)
__device__ __forceinline__ unsigned xb_ld(unsigned* p)              { return __hip_atomic_load(p, __ATOMIC_RELAXED, __HIP_MEMORY_SCOPE_AGENT); }
__device__ __forceinline__ unsigned xb_add(unsigned* p, unsigned v) { return __hip_atomic_fetch_add(p, v, __ATOMIC_RELAXED, __HIP_MEMORY_SCOPE_AGENT); }
__device__ __forceinline__ unsigned xb_xcc_id() { return (unsigned)__builtin_amdgcn_s_getreg((3 << 11) | 20) & 0xFu; }
#define XB_SPIN(cond, bar) do { unsigned _sp = 0; while (cond) { __builtin_amdgcn_s_sleep(1); \
    if ((++_sp & 255u) == 0u) { if (xb_ld(&(bar)[XB_TMO])) break; if (_sp > XB_SPIN_CAP) { atomicAdd(&(bar)[XB_TMO], 1u); break; } } } } while (0)
struct XcdBarrier { unsigned* bar; unsigned x; volatile LAS unsigned* st; };
__device__ __forceinline__ XcdBarrier xcd_barrier_post(unsigned* bar, volatile LAS unsigned* st) {
    XcdBarrier b; b.bar = bar; b.x = xb_xcc_id(); b.st = st;
    if (threadIdx.x == 0) (void)xb_add(&bar[XB_XCNT(b.x)], 1u);
    return b;
}
__device__ __forceinline__ void xcd_barrier_complete(unsigned* bar, unsigned x, unsigned& nloc, unsigned& nx) {
    const unsigned G = gridDim.x * gridDim.y * gridDim.z;
    unsigned sum, cnt, mine, sp = 0u;
    for (;;) {
        sum = 0u; cnt = 0u; mine = 0u;
#pragma unroll
        for (unsigned j = 0; j < 16; ++j) { const unsigned c = xb_ld(&bar[XB_XCNT(j)]); sum += c; cnt += (c > 0u) ? 1u : 0u; mine = (j == x) ? c : mine; }
        if (sum == G) break;
        __builtin_amdgcn_s_sleep(1);
        if ((++sp & 255u) == 0u) { if (xb_ld(&bar[XB_TMO])) break; if (sp > XB_SPIN_CAP) { atomicAdd(&bar[XB_TMO], 1u); break; } }
    }
    nloc = mine > 0u ? mine : 1u; nx = cnt > 0u ? cnt : 1u;
}
__device__ __forceinline__ void xcd_barrier(const XcdBarrier& b) {
    asm volatile("s_waitcnt vmcnt(0)" ::: "memory");
    __syncthreads();
    if (threadIdx.x == 0) {
        unsigned* bar = b.bar;
        __builtin_amdgcn_s_waitcnt(0);
        unsigned nloc = b.st[0], nx = b.st[1];
        if (nloc == 0u) { xcd_barrier_complete(bar, b.x, nloc, nx); b.st[0] = nloc; b.st[1] = nx; }
        const unsigned old = xb_add(&bar[XB_XSUB(b.x)], 1u);
        const unsigned gen = old / nloc;
        if (old + 1u == (gen + 1u) * nloc) {
            __builtin_amdgcn_fence(__ATOMIC_RELEASE, "agent");
            asm volatile("s_waitcnt vmcnt(0)" ::: "memory");
            const unsigned og = xb_add(&bar[XB_TOP], 1u);
            const unsigned tg = og / nx;
            if (og + 1u == (tg + 1u) * nx) xb_add(&bar[XB_TOPGEN], 1u);
            else XB_SPIN(xb_ld(&bar[XB_TOPGEN]) == tg, bar);
            __builtin_amdgcn_fence(__ATOMIC_ACQUIRE, "agent");
            xb_add(&bar[XB_XGEN(b.x)], 1u);
            asm volatile("s_waitcnt vmcnt(0)" ::: "memory");
        } else {
            XB_SPIN(xb_ld(&bar[XB_XGEN(b.x)]) == gen, bar);
            __builtin_amdgcn_fence(__ATOMIC_ACQUIRE, "agent");
            asm volatile("s_waitcnt vmcnt(0)" ::: "memory");
        }
    }
    __syncthreads();
}

constexpr int NPHASE = 12;
__global__ void __launch_bounds__(NTHREADS, 2) mk_fwd(Params p) {
    extern __shared__ __attribute__((aligned(16))) unsigned char lds_raw[];
    LAS unsigned char* lds = (LAS unsigned char*)lds_raw;
    cg::grid_group grid = cg::this_grid();
    unsigned char* ws = p.ws;
    const int G = gridDim.x, cblk = blockIdx.x;
#ifndef PH_MASK
#define PH_MASK 0xfff
#endif
#define IN(k) (((PH_MASK >> (k)) & 1) && p.ph_lo <= (k) && (k) < p.ph_hi)
    { volatile LAS unsigned* st0 = (volatile LAS unsigned*)(lds + LDS_BYTES - 256); if (threadIdx.x < 64) st0[threadIdx.x] = 0u; }
    __syncthreads();
    XcdBarrier xbar = xcd_barrier_post((unsigned*)(ws + WS_CTL) + 4096, (volatile LAS unsigned*)(lds + LDS_BYTES - 256));
    if (p.ph_lo < 0) grid.sync();
#define SEAM(k) do { if (IN(k) && IN((k) + 1)) xcd_barrier(xbar); } while (0)
    if (IN(0)) phase_prep(p, lds);
    SEAM(0);
    if (IN(1)) { phase_prep_weights(p, lds); phase_norm1(p, lds); }
    SEAM(1);
    if (IN(2)) {
        InprojSched S{(const bf16_t*)(ws + WS_XN), (const bf16_t*)(ws + WS_WINT), G, cblk, 1024, 1024, 1024};
        EpiInproj<false> E{(bf16_t*)(ws + WS_Z), (bf16_t*)(ws + WS_ZC), (const float*)(ws + WS_BINZ), (const float*)(ws + WS_ROPE)};
        if (p.probe & 4) { EpiInproj<true> E2{(bf16_t*)(ws + WS_Z), (bf16_t*)(ws + WS_ZC), (const float*)(ws + WS_BINZ), (const float*)(ws + WS_ROPE)}; pg8::gemm_phase<EpiInproj<true>, InprojSched>(lds, S, E2); xcd_barrier(xbar); }
        if (p.probe & 32768) { pg8::gemm_phase<EpiInproj<false>, InprojSched>(lds, S, E); xcd_barrier(xbar); }
        pg8::gemm_phase<EpiInproj<false>, InprojSched>(lds, S, E);
    }
    SEAM(2);
    if (IN(3)) { if (p.probe & 8) { phase_rnn(p, lds, true); __syncthreads(); } phase_rnn(p, lds, false); }
    if (IN(3) && IN(4)) __syncthreads();
    if (IN(4)) { if (p.probe & 16) { phase_attn(p, lds, true); __syncthreads(); } phase_attn(p, lds, false); }
    SEAM(4);
    if (IN(5)) {
        MixSched S{(const bf16_t*)(ws + WS_Z), (const bf16_t*)(ws + WS_WMIX), G, cblk, LDZ, 2048, 2048};
        EpiMix E{(bf16_t*)(ws + WS_Z)};
        pg8::gemm_phase<EpiMix, MixSched>(lds, S, E);
    }
    SEAM(5);
    if (IN(6)) {
        WoutSched S{(const bf16_t*)(ws + WS_Z), (const bf16_t*)(ws + WS_WOUT), G, cblk, LDZ, 1024, 1024};
        EpiWout E{p.x, (bf16_t*)(ws + WS_X1), (const float*)(ws + WS_MOD)};
        pg8::gemm_phase<EpiWout, WoutSched>(lds, S, E);
    }
    SEAM(6);
    if (IN(7)) phase_norm2(p, lds);
    SEAM(7);
    if (IN(8)) phase_topk(p, lds);
    SEAM(8);
    if (IN(9)) {
        Moe1Sched S{ws + WS_XN2, ws + WS_WGU, (const int*)(ws + WS_SELIDX), G, cblk, 1024, 1024, 1024};
        EpiMoe1 E{ws + WS_HID};
        pg8::gemm_phase<EpiMoe1, Moe1Sched, true>(lds, S, E);
    }
    SEAM(9);
    if (IN(10)) {
        Moe2Sched S{ws + WS_HID, ws + WS_WD, G, cblk, 2048, 2048, 2048};
        EpiMoe2 E{ws + WS_YE};
        pg8::gemm_phase<EpiMoe2, Moe2Sched, true>(lds, S, E);
    }
    SEAM(10);
    if (IN(11)) { if (p.probe & 2048) { phase_final(p, lds, true); __syncthreads(); } phase_final(p, lds, false); }
#undef IN
#undef SEAM
}

#ifndef MK_SINGLE
#define MK_SINGLE 1
#endif
extern "C" void kernel_launch(void* const* d_in, const int* in_sizes, int n_in, void* d_out, int out_size, void* d_ws, size_t ws_size, hipStream_t stream) {
    static int grid = 0;
    if (grid == 0) {
        int dev = 0, cus = 0, per_cu = 0;
        if (n_in != 24 || out_size != MLAT * DM || ws_size < WS_END) { fprintf(stderr, "kernel_launch: unexpected problem (n_in %d, out %d, ws %zu < %zu)\n", n_in, out_size, ws_size, (size_t)WS_END); grid = -1; return; }
        if (hipGetDevice(&dev) != hipSuccess || hipDeviceGetAttribute(&cus, hipDeviceAttributeMultiprocessorCount, dev) != hipSuccess) { grid = -1; return; }
        if (hipFuncSetAttribute((const void*)mk_fwd, hipFuncAttributeMaxDynamicSharedMemorySize, LDS_BYTES) != hipSuccess) { fprintf(stderr, "kernel_launch: hipFuncSetAttribute failed\n"); grid = -1; return; }
        if (hipOccupancyMaxActiveBlocksPerMultiprocessor(&per_cu, (const void*)mk_fwd, NTHREADS, LDS_BYTES) != hipSuccess || per_cu < 1) { fprintf(stderr, "kernel_launch: occupancy query says %d\n", per_cu); grid = -1; return; }
        grid = cus;
    }
    if (grid < 0) return;
    (void)hipMemsetAsync((char*)d_ws + WS_CTL, 0, 1 * MiB, stream);
    Params p{};
    const float** pp = (const float**)&p;
    for (int i = 0; i < 24; ++i) pp[i] = (const float*)d_in[i];
#ifndef PROBE_MASK
#define PROBE_MASK 0
#endif
    p.out = (float*)d_out; p.ws = (unsigned char*)d_ws; p.probe = PROBE_MASK;
#if MK_SINGLE
    p.ph_lo = 0; p.ph_hi = NPHASE;
    void* args[] = {&p};
    hipError_t e = hipLaunchCooperativeKernel((const void*)mk_fwd, dim3(grid), dim3(NTHREADS), args, LDS_BYTES, stream);
    if (e != hipSuccess) fprintf(stderr, "kernel_launch: cooperative launch failed: %s (grid %d)\n", hipGetErrorString(e), grid);
#else
#ifndef REP_MASK
#define REP_MASK 0
#endif
    for (int ph = 0; ph < NPHASE; ++ph) {
        p.ph_lo = ph; p.ph_hi = ph + 1;
        for (int rep = 0; rep < 1 + ((REP_MASK >> ph) & 1); ++rep) hipLaunchKernelGGL(mk_fwd, dim3(grid), dim3(NTHREADS), LDS_BYTES, stream, p);
    }
#endif
}
```
